# Optimizing an MI355X kernel written in HIP

```python
import math
import jax, jax.numpy as jnp
from jax import lax
import numpy as np

D_MODEL = 1024
BATCH = 16
SEQ = 2048
DEPTH = 2

CTX_LEN = 256
GRID_W = 64
EPS = 1e-6
ROPE_BASE = 10000.0
Q_BLOCK = 128

MLA_HEADS = 4
MLA_Q_RANK = 256
MLA_KV_RANK = 128
MLA_NOPE_DIM = 128
MLA_ROPE_DIM = 64
MLA_V_DIM = 128

GLA_HEADS = 4
GLA_DK = 64
GLA_DV = 128
GLA_GATE_RANK = 16
GLA_TAU = 16.0
GLA_CHUNK = 64

DIFF_HEADS = 8
DIFF_DIM = 64

FFN_DIM = 2816
N_EXPERTS = 8
TOP_K = 2
EXPERT_DIM = 3584
MOE_BLOCK = 128

N_EVEN = (DEPTH + 1) // 2
N_ODD = DEPTH // 2

IN_A_SIZES = (MLA_Q_RANK, MLA_KV_RANK, MLA_ROPE_DIM,
              GLA_HEADS * GLA_DK, GLA_HEADS * GLA_DK, GLA_HEADS * GLA_DV, GLA_HEADS * GLA_DV,
              GLA_GATE_RANK, GLA_GATE_RANK)
IN_A_DIM = sum(IN_A_SIZES)
MIX_A_DIM = MLA_HEADS * MLA_V_DIM + GLA_HEADS * GLA_DV
MIX_C_DIM = DIFF_HEADS * 2 * DIFF_DIM

kernel_name = 'hybrid_mla_gla_diffattn_moe_dit'


def _rmsnorm(x, g):
    xf = x.astype(jnp.float32)
    y = xf * lax.rsqrt(jnp.mean(xf * xf, axis=-1, keepdims=True) + EPS)
    return (y * g.astype(jnp.float32)).astype(x.dtype)


def _axial_rope(n_tokens, rot_dim):
    rows = n_tokens // GRID_W
    row = jnp.repeat(jnp.arange(rows, dtype=jnp.float32), GRID_W)
    col = jnp.tile(jnp.arange(GRID_W, dtype=jnp.float32), rows)
    n_freq = rot_dim // 4
    freq = ROPE_BASE ** (-jnp.arange(n_freq, dtype=jnp.float32) / n_freq)
    ang = jnp.concatenate([row[:, None] * freq, col[:, None] * freq], axis=-1)
    return jnp.cos(ang), jnp.sin(ang)


def _apply_rope(x, cos, sin):
    half = x.shape[-1] // 2
    x1 = x[..., :half].astype(jnp.float32)
    x2 = x[..., half:].astype(jnp.float32)
    cs, sn = cos[None, :, None, :], sin[None, :, None, :]
    return jnp.concatenate([x1 * cs - x2 * sn, x2 * cs + x1 * sn], axis=-1).astype(x.dtype)


def _split_cols(p, sizes):
    return jnp.split(p, [int(o) for o in np.cumsum(sizes)[:-1]], axis=-1)


def _query_blocks(a):
    b, t = a.shape[:2]
    nb = t // Q_BLOCK
    return a.reshape((b, nb, Q_BLOCK) + a.shape[2:]).swapaxes(0, 1)


def _unblock(o):
    nb, b, qb = o.shape[:3]
    return o.swapaxes(0, 1).reshape((b, nb * qb) + o.shape[3:])


def _attend(q, k, v):
    scale = q.shape[-1] ** -0.5

    def one(qb):
        s = jnp.einsum('bqhd,bkhd->bhqk', qb, k, preferred_element_type=jnp.float32) * scale
        p = jax.nn.softmax(s, axis=-1)
        return jnp.einsum('bhqk,bkhd->bqhd', p.astype(v.dtype), v)

    return _unblock(lax.map(one, _query_blocks(q)))


def _diff_attend(q1, q2, k1, k2, v, lam):
    scale = q1.shape[-1] ** -0.5

    def one(args):
        a1, a2 = args
        s1 = jnp.einsum('bqhd,bkhd->bhqk', a1, k1, preferred_element_type=jnp.float32) * scale
        s2 = jnp.einsum('bqhd,bkhd->bhqk', a2, k2, preferred_element_type=jnp.float32) * scale
        p = jax.nn.softmax(s1, axis=-1) - lam * jax.nn.softmax(s2, axis=-1)
        return jnp.einsum('bhqk,bkhd->bqhd', p.astype(v.dtype), v)

    return _unblock(lax.map(one, (_query_blocks(q1), _query_blocks(q2))))


def _mla_qkv(c_q, c_kv, k_r, g_q, w_uq, g_kv, w_ukv, cos, sin):
    b, t, _ = c_q.shape
    q = (_rmsnorm(c_q, g_q) @ w_uq).reshape(b, t, MLA_HEADS, MLA_NOPE_DIM + MLA_ROPE_DIM)
    kv = (_rmsnorm(c_kv, g_kv) @ w_ukv).reshape(b, t, MLA_HEADS, MLA_NOPE_DIM + MLA_V_DIM)
    q_nope, q_rope = q[..., :MLA_NOPE_DIM], q[..., MLA_NOPE_DIM:]
    k_nope, v = kv[..., :MLA_NOPE_DIM], kv[..., MLA_NOPE_DIM:]
    k_rope = k_r[:, :, None, :]
    if cos is not None:
        q_rope = _apply_rope(q_rope, cos, sin)
        k_rope = _apply_rope(k_rope, cos, sin)
    q = jnp.concatenate([q_nope, q_rope], axis=-1)
    k = jnp.concatenate([k_nope, jnp.broadcast_to(k_rope, (b, t, MLA_HEADS, MLA_ROPE_DIM))], axis=-1)
    return q, k, v


def _gla_scan(q, k, v, log_a, s0):
    b, t, h, dk = q.shape
    dv = v.shape[-1]
    n = t // GLA_CHUNK

    def chunks(a):
        return a.astype(jnp.float32).reshape(b, n, GLA_CHUNK, h, a.shape[-1]).swapaxes(0, 1)

    mask = jnp.tril(jnp.ones((GLA_CHUNK, GLA_CHUNK), dtype=bool))[None, :, :, None, None]

    def step(state, inp):
        qc, kc, vc, lac = inp
        cum = jnp.cumsum(lac, axis=1)
        o_inter = jnp.einsum('bchk,bhkv->bchv', qc * jnp.exp(cum), state)
        rel = cum[:, :, None] - cum[:, None, :]
        decay = jnp.exp(jnp.where(mask, rel, -jnp.inf))
        att = jnp.einsum('bthk,btshk,bshk->bths', qc, decay, kc)
        o_intra = jnp.einsum('bths,bshv->bthv', att, vc)
        last = cum[:, -1]
        new_state = jnp.exp(last)[..., None] * state + jnp.einsum(
            'bshk,bshv->bhkv', kc * jnp.exp(last[:, None] - cum), vc)
        return new_state, o_inter + o_intra

    s_fin, o = lax.scan(step, s0.astype(jnp.float32), (chunks(q), chunks(k), chunks(v), chunks(log_a)))
    return o.swapaxes(0, 1).reshape(b, t, h, dv).astype(v.dtype), s_fin


def _gla_bidir(parts_l, parts_x, w_gf, b_gf, w_gb, b_gb, g_o, need_ctx):
    def prep(parts):
        q, k, v, r, af, ab = parts
        b, t, _ = q.shape
        q = q.reshape(b, t, GLA_HEADS, GLA_DK) * (GLA_DK ** -0.5)
        k = k.reshape(b, t, GLA_HEADS, GLA_DK)
        v = v.reshape(b, t, GLA_HEADS, GLA_DV)
        la_f = (jax.nn.log_sigmoid((af @ w_gf + b_gf).astype(jnp.float32)) / GLA_TAU).reshape(b, t, GLA_HEADS, GLA_DK)
        la_b = (jax.nn.log_sigmoid((ab @ w_gb + b_gb).astype(jnp.float32)) / GLA_TAU).reshape(b, t, GLA_HEADS, GLA_DK)
        return q, k, v, r, la_f, la_b

    ql, kl, vl, rl, lfl, lbl = prep(parts_l)
    qx, kx, vx, rx, lfx, lbx = prep(parts_x)
    flip = lambda a: jnp.flip(a, axis=1)
    s0 = jnp.zeros((ql.shape[0], GLA_HEADS, GLA_DK, GLA_DV), jnp.float32)
    ox_f, sx_f = _gla_scan(qx, kx, vx, lfx, s0)
    ox_b, sx_b = _gla_scan(flip(qx), flip(kx), flip(vx), flip(lbx), s0)
    ol_f, _ = _gla_scan(ql, kl, vl, lfl, sx_f)
    ol_b, _ = _gla_scan(flip(ql), flip(kl), flip(vl), flip(lbl), sx_b)

    def finish(o, r):
        b, t = o.shape[:2]
        gate = jax.nn.silu(r.reshape(b, t, GLA_HEADS, GLA_DV))
        return (_rmsnorm(o, g_o) * gate).reshape(b, t, GLA_HEADS * GLA_DV)

    out_l = finish(ol_f + flip(ol_b), rl)
    out_x = finish(ox_f + flip(ox_b), rx) if need_ctx else None
    return out_l, out_x


def _mixer_mla_gla(h, hx, w_in, g_q, w_uq, g_kv, w_ukv, w_gf, b_gf, w_gb, b_gb, g_o, w_out,
                   cos, sin, need_ctx):
    b, t, _ = h.shape
    parts = _split_cols(h @ w_in, IN_A_SIZES)
    parts_x = _split_cols(hx @ w_in, IN_A_SIZES)
    q_l, k_l, v_l = _mla_qkv(parts[0], parts[1], parts[2], g_q, w_uq, g_kv, w_ukv, cos, sin)
    q_x, k_x, v_x = _mla_qkv(parts_x[0], parts_x[1], parts_x[2], g_q, w_uq, g_kv, w_ukv, None, None)
    a_l = _attend(q_l, jnp.concatenate([k_x, k_l], axis=1), jnp.concatenate([v_x, v_l], axis=1))
    g_l, g_x = _gla_bidir(parts[3:], parts_x[3:], w_gf, b_gf, w_gb, b_gb, g_o, need_ctx)
    y = jnp.concatenate([a_l.reshape(b, t, MLA_HEADS * MLA_V_DIM), g_l], axis=-1) @ w_out
    yx = None
    if need_ctx:
        a_x = _attend(q_x, k_x, v_x)
        bx, tx = hx.shape[:2]
        yx = jnp.concatenate([a_x.reshape(bx, tx, MLA_HEADS * MLA_V_DIM), g_x], axis=-1) @ w_out
    return y, yx


def _diff_qkv(h, w_qkv, cos, sin):
    b, t, _ = h.shape
    q, k, v = jnp.split(h @ w_qkv, 3, axis=-1)
    q = q.reshape(b, t, 2 * DIFF_HEADS, DIFF_DIM)
    k = k.reshape(b, t, 2 * DIFF_HEADS, DIFF_DIM)
    if cos is not None:
        q = _apply_rope(q, cos, sin)
        k = _apply_rope(k, cos, sin)
    q = q.reshape(b, t, DIFF_HEADS, 2, DIFF_DIM)
    k = k.reshape(b, t, DIFF_HEADS, 2, DIFF_DIM)
    v = v.reshape(b, t, DIFF_HEADS, 2 * DIFF_DIM)
    return q[..., 0, :], q[..., 1, :], k[..., 0, :], k[..., 1, :], v


def _mixer_diff(h, hx, w_qkv, lq1, lk1, lq2, lk2, g_o, w_out, lam_init, cos, sin, need_ctx):
    f32 = jnp.float32
    lam = (jnp.exp(jnp.sum(lq1.astype(f32) * lk1.astype(f32)))
           - jnp.exp(jnp.sum(lq2.astype(f32) * lk2.astype(f32))) + lam_init)
    q1, q2, k1, k2, v = _diff_qkv(h, w_qkv, cos, sin)
    q1x, q2x, k1x, k2x, vx = _diff_qkv(hx, w_qkv, None, None)
    cat = lambda a, b_: jnp.concatenate([a, b_], axis=1)

    def finish(o):
        b, t = o.shape[:2]
        return (_rmsnorm(o, g_o) * (1.0 - lam_init)).reshape(b, t, MIX_C_DIM) @ w_out

    y = finish(_diff_attend(q1, q2, cat(k1x, k1), cat(k2x, k2), cat(vx, v), lam))
    yx = finish(_diff_attend(q1x, q2x, k1x, k2x, vx, lam)) if need_ctx else None
    return y, yx


def _swiglu(h, w_gate, w_up, w_down):
    return (jax.nn.silu(h @ w_gate) * (h @ w_up)) @ w_down


def _moe_swiglu(h, w_router, w_gate, w_up, w_down):
    n, d = h.shape
    logits = jnp.dot(h, w_router, preferred_element_type=jnp.float32)
    top_val, top_idx = lax.top_k(logits, TOP_K)
    gates = jax.nn.softmax(top_val, axis=-1)
    flat_e = top_idx.reshape(-1)
    flat_t = jnp.repeat(jnp.arange(n, dtype=jnp.int32), TOP_K)
    flat_g = gates.reshape(-1)
    order = jnp.argsort(flat_e, stable=True)
    e_s, t_s, g_s = flat_e[order], flat_t[order], flat_g[order]
    sizes = jnp.bincount(flat_e, length=N_EXPERTS)
    padded = (sizes + MOE_BLOCK - 1) // MOE_BLOCK * MOE_BLOCK
    start = jnp.cumsum(sizes) - sizes
    pend = jnp.cumsum(padded)
    pstart = pend - padded
    dest = pstart[e_s] + (jnp.arange(n * TOP_K) - start[e_s])
    cap = -(-(n * TOP_K) // MOE_BLOCK) * MOE_BLOCK + N_EXPERTS * MOE_BLOCK
    nb = cap // MOE_BLOCK
    buf_t = jnp.zeros((cap,), jnp.int32).at[dest].set(t_s)
    buf_g = jnp.zeros((cap,), jnp.float32).at[dest].set(g_s)
    blk_e = jnp.minimum(jnp.searchsorted(pend, jnp.arange(nb) * MOE_BLOCK, side='right'), N_EXPERTS - 1)
    xs = h[buf_t].reshape(nb, MOE_BLOCK, d)

    def expert_block(args):
        xb, e = args
        return (jax.nn.silu(xb @ w_gate[e]) * (xb @ w_up[e])) @ w_down[e]

    ys = lax.map(expert_block, (xs, blk_e)).reshape(cap, d)
    return jnp.zeros_like(h).at[buf_t].add(ys * buf_g[:, None].astype(h.dtype))


def setup_inputs(seed: int = 0) -> dict:
    key = jax.random.key(seed)
    ks = iter(jax.random.split(key, 48))
    D = D_MODEL

    def nrm(shape, scale):
        return scale * jax.random.normal(next(ks), shape, jnp.float32)

    def gain(shape):
        return 1.0 + nrm(shape, 0.05)

    return {
        'x': nrm((BATCH, SEQ, D), 1.0),
        'c': nrm((BATCH, D), 1.0),
        'ctx': nrm((BATCH, CTX_LEN, D), 1.0),
        'c_ctx': nrm((D,), 1.0),
        'w_mod': nrm((DEPTH, D, 6 * D), D ** -0.5),
        'b_mod': nrm((DEPTH, 6 * D), 0.02),
        'g_pre_mix': gain((DEPTH, D)),
        'g_post_mix': gain((DEPTH, D)),
        'g_pre_ffn': gain((DEPTH, D)),
        'g_post_ffn': gain((DEPTH, D)),
        'w_in_a': nrm((N_EVEN, D, IN_A_DIM), D ** -0.5),
        'mla_g_q': gain((N_EVEN, MLA_Q_RANK)),
        'mla_w_uq': nrm((N_EVEN, MLA_Q_RANK, MLA_HEADS * (MLA_NOPE_DIM + MLA_ROPE_DIM)), MLA_Q_RANK ** -0.5),
        'mla_g_kv': gain((N_EVEN, MLA_KV_RANK)),
        'mla_w_ukv': nrm((N_EVEN, MLA_KV_RANK, MLA_HEADS * (MLA_NOPE_DIM + MLA_V_DIM)), MLA_KV_RANK ** -0.5),
        'gla_w_gate_f': nrm((N_EVEN, GLA_GATE_RANK, GLA_HEADS * GLA_DK), GLA_GATE_RANK ** -0.5),
        'gla_b_gate_f': nrm((N_EVEN, GLA_HEADS * GLA_DK), 0.1),
        'gla_w_gate_b': nrm((N_EVEN, GLA_GATE_RANK, GLA_HEADS * GLA_DK), GLA_GATE_RANK ** -0.5),
        'gla_b_gate_b': nrm((N_EVEN, GLA_HEADS * GLA_DK), 0.1),
        'gla_g_out': gain((N_EVEN, GLA_DV)),
        'w_out_a': nrm((N_EVEN, MIX_A_DIM, D), MIX_A_DIM ** -0.5),
        'w_qkv_c': nrm((N_ODD, D, 3 * MIX_C_DIM), D ** -0.5),
        'diff_lq1': nrm((N_ODD, DIFF_DIM), 0.1),
        'diff_lk1': nrm((N_ODD, DIFF_DIM), 0.1),
        'diff_lq2': nrm((N_ODD, DIFF_DIM), 0.1),
        'diff_lk2': nrm((N_ODD, DIFF_DIM), 0.1),
        'diff_g_out': gain((N_ODD, 2 * DIFF_DIM)),
        'w_out_c': nrm((N_ODD, MIX_C_DIM, D), MIX_C_DIM ** -0.5),
        'ffn_w_gate': nrm((N_EVEN, D, FFN_DIM), D ** -0.5),
        'ffn_w_up': nrm((N_EVEN, D, FFN_DIM), D ** -0.5),
        'ffn_w_down': nrm((N_EVEN, FFN_DIM, D), FFN_DIM ** -0.5),
        'moe_w_router': nrm((N_ODD, D, N_EXPERTS), D ** -0.5),
        'moe_w_gate': nrm((N_ODD, N_EXPERTS, D, EXPERT_DIM), D ** -0.5),
        'moe_w_up': nrm((N_ODD, N_EXPERTS, D, EXPERT_DIM), D ** -0.5),
        'moe_w_down': nrm((N_ODD, N_EXPERTS, EXPERT_DIM, D), EXPERT_DIM ** -0.5),
    }


def reference(x, c, ctx, c_ctx, w_mod, b_mod, g_pre_mix, g_post_mix, g_pre_ffn, g_post_ffn,
              w_in_a, mla_g_q, mla_w_uq, mla_g_kv, mla_w_ukv,
              gla_w_gate_f, gla_b_gate_f, gla_w_gate_b, gla_b_gate_b, gla_g_out, w_out_a,
              w_qkv_c, diff_lq1, diff_lk1, diff_lq2, diff_lk2, diff_g_out, w_out_c,
              ffn_w_gate, ffn_w_up, ffn_w_down,
              moe_w_router, moe_w_gate, moe_w_up, moe_w_down):
    b, t, d = x.shape
    cos_a, sin_a = _axial_rope(t, MLA_ROPE_DIM)
    cos_c, sin_c = _axial_rope(t, DIFF_DIM)
    silu_c = jax.nn.silu(c)[:, None, :]
    silu_cx = jax.nn.silu(c_ctx)

    for i in range(DEPTH):
        last = i == DEPTH - 1
        j = i // 2
        mod = jnp.split(silu_c @ w_mod[i] + b_mod[i], 6, axis=-1)
        modx = jnp.split(silu_cx @ w_mod[i] + b_mod[i], 6, axis=-1)

        h = _rmsnorm(x, g_pre_mix[i]) * (1.0 + mod[1]) + mod[0]
        hx = _rmsnorm(ctx, g_pre_mix[i]) * (1.0 + modx[1]) + modx[0]
        if i % 2 == 0:
            y, yx = _mixer_mla_gla(h, hx, w_in_a[j], mla_g_q[j], mla_w_uq[j], mla_g_kv[j], mla_w_ukv[j],
                                   gla_w_gate_f[j], gla_b_gate_f[j], gla_w_gate_b[j], gla_b_gate_b[j],
                                   gla_g_out[j], w_out_a[j], cos_a, sin_a, not last)
        else:
            lam_init = 0.8 - 0.6 * math.exp(-0.3 * i)
            y, yx = _mixer_diff(h, hx, w_qkv_c[j], diff_lq1[j], diff_lk1[j], diff_lq2[j], diff_lk2[j],
                                diff_g_out[j], w_out_c[j], lam_init, cos_c, sin_c, not last)
        x = x + mod[2] * _rmsnorm(y, g_post_mix[i])
        if not last:
            ctx = ctx + modx[2] * _rmsnorm(yx, g_post_mix[i])

        h = _rmsnorm(x, g_pre_ffn[i]) * (1.0 + mod[4]) + mod[3]
        if i % 2 == 0:
            f = _swiglu(h, ffn_w_gate[j], ffn_w_up[j], ffn_w_down[j])
        else:
            f = _moe_swiglu(h.reshape(-1, d), moe_w_router[j], moe_w_gate[j], moe_w_up[j],
                            moe_w_down[j]).reshape(b, t, d)
        x = x + mod[5] * _rmsnorm(f, g_post_ffn[i])
        if not last:
            hx = _rmsnorm(ctx, g_pre_ffn[i]) * (1.0 + modx[4]) + modx[3]
            if i % 2 == 0:
                fx = _swiglu(hx, ffn_w_gate[j], ffn_w_up[j], ffn_w_down[j])
            else:
                fx = _moe_swiglu(hx.reshape(-1, d), moe_w_router[j], moe_w_gate[j], moe_w_up[j],
                                 moe_w_down[j]).reshape(ctx.shape)
            ctx = ctx + modx[5] * _rmsnorm(fx, g_post_ffn[i])
    return x
```

```cpp
#include <hip/hip_runtime.h>
#include <cstdio>
#include <cstdint>

constexpr int D = 1024, NB = 16, SEQ = 2048, CTXL = 256;
constexpr int ML = NB * SEQ, MX = NB * CTXL, M = ML + MX;
constexpr int IN_A = 2016, IN_AP = 2048;
constexpr int C_CQ = 0, C_CKV = 256, C_KR = 384, C_GQ = 448, C_GK = 704, C_GV = 960, C_GR = 1472, C_AF = 1984, C_AB = 2000;
constexpr int UPN = 1792;
constexpr int FFN = 2816, NE = 8, ED = 3584;
constexpr int CAP = 2 * ML + NE * 256, MAXT = CAP / 256;
constexpr int CHUNK_T = 64;
constexpr float EPS = 1e-6f;
constexpr float LAM_INIT = 0.35550906759f;

constexpr size_t MiB = 1u << 20;
constexpr size_t WS_CTL = 0, CTL_ZERO_BYTES = 1 * MiB;
constexpr size_t WS_MOD = 1 * MiB;
constexpr size_t WS_ROPE = 2 * MiB;
constexpr size_t WS_TOKE = 2 * MiB + 512 * 1024;
constexpr size_t WS_TOKG = WS_TOKE + 256 * 1024;
constexpr size_t WS_TOKP = WS_TOKG + 256 * 1024;
constexpr size_t WS_CTXS = 4 * MiB;
constexpr size_t WS_W = 20 * MiB;
constexpr size_t WS_R0 = 52 * MiB;
constexpr size_t WS_PARTS = 124 * MiB;
constexpr size_t WS_Y = 124 * MiB;
constexpr size_t WS_H1 = 196 * MiB;
constexpr size_t WS_HC = 116 * MiB;
constexpr size_t WS_XS = 180 * MiB;
constexpr size_t WS_A2 = 268 * MiB;
constexpr size_t WS_KROPE = 295 * MiB;
constexpr size_t WS_R3 = 300 * MiB;
constexpr size_t WS_MOEW = 332 * MiB;
constexpr size_t WS_END = 516 * MiB;
constexpr int CW_BAR = 4096;
constexpr int CW_ECNT = 8192;
constexpr int CW_MOET = 9000;
constexpr int CW_TILEE = 9216;

typedef unsigned short u16;
typedef float f32x4 __attribute__((ext_vector_type(4)));
#define LAS __attribute__((address_space(3)))
constexpr int LDS_BYTES = 147456;
constexpr int MISC_OFF = 131072 + 320;

#define XB_TMO      128
#define XB_XCNT(j)  (256  + 64 * (j))
#define XB_XSUB(j)  (1280 + 64 * (j))
#define XB_XGEN(j)  (2304 + 64 * (j))
#define XB_TOP      3328
#define XB_TOPGEN   3392
#define XCD_BAR_WORDS 3456
#define XB_SPIN_CAP (1u << 23)
__device__ __forceinline__ unsigned xb_ld(unsigned* p)              { return __hip_atomic_load(p, __ATOMIC_RELAXED, __HIP_MEMORY_SCOPE_AGENT); }
__device__ __forceinline__ unsigned xb_add(unsigned* p, unsigned v) { return __hip_atomic_fetch_add(p, v, __ATOMIC_RELAXED, __HIP_MEMORY_SCOPE_AGENT); }
__device__ __forceinline__ unsigned xb_xcc_id() { return (unsigned)__builtin_amdgcn_s_getreg((3 << 11) | 20) & 0xFu; }
#define XB_SPIN(cond, bar) do { unsigned _sp = 0; while (cond) { __builtin_amdgcn_s_sleep(1); \
    if ((++_sp & 255u) == 0u) { if (xb_ld(&(bar)[XB_TMO])) break; if (_sp > XB_SPIN_CAP) { atomicAdd(&(bar)[XB_TMO], 1u); break; } } } } while (0)
struct XcdBarrier { unsigned* bar; unsigned x; volatile LAS unsigned* st; };
__device__ __forceinline__ XcdBarrier xcd_barrier_post(unsigned* bar, volatile LAS unsigned* st) {
    XcdBarrier b; b.bar = bar; b.x = xb_xcc_id(); b.st = st;
    if (threadIdx.x == 0) (void)xb_add(&bar[XB_XCNT(b.x)], 1u);
    return b;
}
__device__ __forceinline__ void xcd_barrier_complete(unsigned* bar, unsigned x, unsigned& nloc, unsigned& nx) {
    const unsigned G = gridDim.x * gridDim.y * gridDim.z;
    unsigned sum, cnt, mine, sp = 0u;
    for (;;) {
        sum = 0u; cnt = 0u; mine = 0u;
#pragma unroll
        for (unsigned j = 0; j < 16; ++j) { const unsigned c = xb_ld(&bar[XB_XCNT(j)]); sum += c; cnt += (c > 0u) ? 1u : 0u; mine = (j == x) ? c : mine; }
        if (sum == G) break;
        __builtin_amdgcn_s_sleep(1);
        if ((++sp & 255u) == 0u) { if (xb_ld(&bar[XB_TMO])) break; if (sp > XB_SPIN_CAP) { atomicAdd(&bar[XB_TMO], 1u); break; } }
    }
    nloc = mine > 0u ? mine : 1u; nx = cnt > 0u ? cnt : 1u;
}
__device__ __forceinline__ void xcd_barrier(const XcdBarrier& b) {
    asm volatile("s_waitcnt vmcnt(0)" ::: "memory");
    __syncthreads();
    if (threadIdx.x == 0) {
        unsigned* bar = b.bar;
        __builtin_amdgcn_s_waitcnt(0);
        unsigned nloc = b.st[0], nx = b.st[1];
        if (nloc == 0u) { xcd_barrier_complete(bar, b.x, nloc, nx); b.st[0] = nloc; b.st[1] = nx; }
        const unsigned old = xb_add(&bar[XB_XSUB(b.x)], 1u);
        const unsigned gen = old / nloc;
        if (old + 1u == (gen + 1u) * nloc) {
            __builtin_amdgcn_fence(__ATOMIC_RELEASE, "agent");
            asm volatile("s_waitcnt vmcnt(0)" ::: "memory");
            const unsigned og = xb_add(&bar[XB_TOP], 1u);
            const unsigned tg = og / nx;
            if (og + 1u == (tg + 1u) * nx) xb_add(&bar[XB_TOPGEN], 1u);
            else XB_SPIN(xb_ld(&bar[XB_TOPGEN]) == tg, bar);
            __builtin_amdgcn_fence(__ATOMIC_ACQUIRE, "agent");
            xb_add(&bar[XB_XGEN(b.x)], 1u);
            asm volatile("s_waitcnt vmcnt(0)" ::: "memory");
        } else {
            XB_SPIN(xb_ld(&bar[XB_XGEN(b.x)]) == gen, bar);
            __builtin_amdgcn_fence(__ATOMIC_ACQUIRE, "agent");
            asm volatile("s_waitcnt vmcnt(0)" ::: "memory");
        }
    }
    __syncthreads();
}

__device__ __forceinline__ float bf2f(unsigned h) { return __uint_as_float(h << 16); }
__device__ __forceinline__ unsigned f2bf(float f) { unsigned u = __float_as_uint(f); return (u + 0x7fffu + ((u >> 16) & 1u)) >> 16; }
__device__ __forceinline__ float wave_sum(float v) {
#pragma unroll
    for (int o = 1; o < 64; o <<= 1) v += __shfl_xor(v, o);
    return v;
}
__device__ __forceinline__ float silu_f(float x) { return x / (1.0f + __expf(-x)); }
__device__ __forceinline__ void ld_row_f32(const float* p, int lane, f32x4 (&v)[4]) {
#pragma unroll
    for (int j = 0; j < 4; ++j) v[j] = *(const f32x4*)(p + 4 * lane + 256 * j);
}
__device__ __forceinline__ void ld_row_bf16(const u16* p, int lane, f32x4 (&v)[4]) {
#pragma unroll
    for (int j = 0; j < 4; ++j) { const uint2 w = *(const uint2*)(p + 4 * lane + 256 * j);
        v[j] = (f32x4){bf2f(w.x & 0xffffu), bf2f(w.x >> 16), bf2f(w.y & 0xffffu), bf2f(w.y >> 16)}; }
}
__device__ __forceinline__ void st_row_f32(float* p, int lane, const f32x4 (&v)[4]) {
#pragma unroll
    for (int j = 0; j < 4; ++j) *(f32x4*)(p + 4 * lane + 256 * j) = v[j];
}
__device__ __forceinline__ void st_row_bf16(u16* p, int lane, const f32x4 (&v)[4]) {
#pragma unroll
    for (int j = 0; j < 4; ++j) { uint2 w; w.x = f2bf(v[j].x) | (f2bf(v[j].y) << 16); w.y = f2bf(v[j].z) | (f2bf(v[j].w) << 16);
        *(uint2*)(p + 4 * lane + 256 * j) = w; }
}
__device__ __forceinline__ float row_rstd(const f32x4 (&v)[4]) {
    float s = 0.f;
#pragma unroll
    for (int j = 0; j < 4; ++j) s += (v[j].x * v[j].x + v[j].y * v[j].y) + (v[j].z * v[j].z + v[j].w * v[j].w);
    s = wave_sum(s);
    return 1.0f / sqrtf(s * (1.0f / 1024.0f) + EPS);
}
__device__ __forceinline__ void rms_apply(f32x4 (&v)[4], const float* g, int lane) {
    const float r = row_rstd(v);
#pragma unroll
    for (int j = 0; j < 4; ++j) { const f32x4 gg = *(const f32x4*)(g + 4 * lane + 256 * j); v[j] = v[j] * r * gg; }
}
__device__ __forceinline__ void premod(const f32x4 (&x)[4], f32x4 (&h)[4], const float* g, const float* shift, const float* scale, int lane) {
    const float r = row_rstd(x);
#pragma unroll
    for (int j = 0; j < 4; ++j) { const int c = 4 * lane + 256 * j; const f32x4 gg = *(const f32x4*)(g + c), sh = *(const f32x4*)(shift + c), sc = *(const f32x4*)(scale + c);
        h[j] = x[j] * r * gg * (1.0f + sc) + sh; }
}

struct Args { const float* in[35]; float* out; unsigned char* ws; int ph_lo, ph_hi; };

__device__ __forceinline__ const float* modp(const unsigned char* ws, int l, int r, int which) { return (const float*)(ws + WS_MOD) + ((size_t)(l * 17 + r) * 6 + which) * 1024; }

template <bool DUAL, class Epi>
__device__ __forceinline__ void naive_gemm(LAS unsigned char* lds, const u16* A, int lda, int ntiles_m, const float* W0, const float* W1, int K, int N, int ldw,
                                           const unsigned* tile_e, size_t estride, const Epi& epi) {
    LAS float* As = (LAS float*)lds;
    LAS float* Ws0 = As + 16 * 132;
    LAS float* Ws1 = Ws0 + 16 * 64;
    const int tid = threadIdx.x, ty = tid >> 4, tx = tid & 15;
    const int ntn = (N + 63) / 64;
    const int total = ntiles_m * ntn;
    for (int u = blockIdx.x; u < total; u += gridDim.x) {
        const int tm = u / ntn, tn = u % ntn;
        const int row0 = tm * 128, col0 = tn * 64;
        const float* w0 = W0; const float* w1 = W1;
        if (tile_e) { const unsigned e = tile_e[tm >> 1]; w0 += (size_t)e * estride; if (DUAL) w1 += (size_t)e * estride; }
        float acc0[4][4], acc1[4][4];
#pragma unroll
        for (int i = 0; i < 4; ++i)
#pragma unroll
            for (int j = 0; j < 4; ++j) { acc0[i][j] = 0.f; acc1[i][j] = 0.f; }
        for (int k0 = 0; k0 < K; k0 += 16) {
            { const int r = tid >> 2, kq = (tid & 3) * 4; const uint2 w = *(const uint2*)(A + (size_t)(row0 + r) * lda + k0 + kq);
              As[(kq + 0) * 132 + r] = bf2f(w.x & 0xffffu); As[(kq + 1) * 132 + r] = bf2f(w.x >> 16);
              As[(kq + 2) * 132 + r] = bf2f(w.y & 0xffffu); As[(kq + 3) * 132 + r] = bf2f(w.y >> 16); }
            { const int kk = tid >> 5, n = (tid & 31) * 2, c = col0 + n;
              float a = 0.f, b = 0.f;
              if (c < N) { const float2 t = *(const float2*)(w0 + (size_t)(k0 + kk) * ldw + c); a = t.x; b = t.y; }
              Ws0[kk * 64 + n] = a; Ws0[kk * 64 + n + 1] = b;
              if (DUAL) { float a1 = 0.f, b1 = 0.f;
                  if (c < N) { const float2 t = *(const float2*)(w1 + (size_t)(k0 + kk) * ldw + c); a1 = t.x; b1 = t.y; }
                  Ws1[kk * 64 + n] = a1; Ws1[kk * 64 + n + 1] = b1; } }
            __syncthreads();
#pragma unroll
            for (int kk = 0; kk < 16; ++kk) {
                const f32x4 a = *(const LAS f32x4*)(As + kk * 132 + ty * 4);
                const f32x4 b = *(const LAS f32x4*)(Ws0 + kk * 64 + tx * 4);
#pragma unroll
                for (int i = 0; i < 4; ++i)
#pragma unroll
                    for (int j = 0; j < 4; ++j) acc0[i][j] += a[i] * b[j];
                if (DUAL) { const f32x4 b1 = *(const LAS f32x4*)(Ws1 + kk * 64 + tx * 4);
#pragma unroll
                    for (int i = 0; i < 4; ++i)
#pragma unroll
                        for (int j = 0; j < 4; ++j) acc1[i][j] += a[i] * b1[j]; }
            }
            __syncthreads();
        }
#pragma unroll
        for (int i = 0; i < 4; ++i)
#pragma unroll
            for (int j = 0; j < 4; ++j) { const int r = row0 + ty * 4 + i, c = col0 + tx * 4 + j; if (c < N) epi(r, c, acc0[i][j], acc1[i][j]); }
    }
}

template <int DQ, class QL, class KL, class VL, class OS>
__device__ __forceinline__ void naive_attn_unit(LAS unsigned char* lds, int nkeys, float scale, const QL& ql, const KL& kl, const VL& vl, const OS& os) {
    LAS float* Qs = (LAS float*)lds;
    LAS float* Ks = Qs + 32 * (DQ + 1);
    LAS float* Vs = Ks + 64 * (DQ + 1);
    LAS float* Ps = Vs + 64 * 128;
    const int tid = threadIdx.x, r = tid >> 4, j = tid & 15;
    __syncthreads();
    for (int e = tid; e < 32 * DQ; e += 512) { const int rr = e / DQ, d = e % DQ; Qs[rr * (DQ + 1) + d] = ql(rr, d); }
    float m = -1e30f, l = 0.f, o[8];
#pragma unroll
    for (int dd = 0; dd < 8; ++dd) o[dd] = 0.f;
    for (int k0 = 0; k0 < nkeys; k0 += 64) {
        __syncthreads();
        for (int e = tid; e < 64 * DQ; e += 512) { const int key = e / DQ, d = e % DQ; Ks[key * (DQ + 1) + d] = kl(k0 + key, d); }
        for (int e = tid; e < 64 * 128; e += 512) { const int key = e >> 7, d = e & 127; Vs[key * 128 + d] = vl(k0 + key, d); }
        __syncthreads();
        float s[4];
#pragma unroll
        for (int c = 0; c < 4; ++c) { const LAS float* kp = Ks + (j + 16 * c) * (DQ + 1); const LAS float* qp = Qs + r * (DQ + 1); float a = 0.f;
            for (int d = 0; d < DQ; ++d) a += qp[d] * kp[d];
            s[c] = a * scale; }
        float tmax = fmaxf(fmaxf(s[0], s[1]), fmaxf(s[2], s[3]));
#pragma unroll
        for (int off = 1; off < 16; off <<= 1) tmax = fmaxf(tmax, __shfl_xor(tmax, off));
        const float mn = fmaxf(m, tmax), alpha = __expf(m - mn);
        float ps = 0.f;
#pragma unroll
        for (int c = 0; c < 4; ++c) { const float p = __expf(s[c] - mn); Ps[r * 64 + j + 16 * c] = p; ps += p; }
#pragma unroll
        for (int off = 1; off < 16; off <<= 1) ps += __shfl_xor(ps, off);
        l = l * alpha + ps; m = mn;
#pragma unroll
        for (int dd = 0; dd < 8; ++dd) o[dd] *= alpha;
        __syncthreads();
        for (int key = 0; key < 64; ++key) { const float p = Ps[r * 64 + key]; const LAS float* vp = Vs + key * 128 + j * 8;
#pragma unroll
            for (int dd = 0; dd < 8; ++dd) o[dd] += p * vp[dd]; }
    }
    const float il = 1.0f / l;
#pragma unroll
    for (int dd = 0; dd < 8; ++dd) os(r, j * 8 + dd, o[dd] * il);
}

__global__ void __launch_bounds__(512, 2) fwd_kernel(Args args) {
    extern __shared__ __attribute__((aligned(16))) unsigned char lds_raw[];
    LAS unsigned char* lds = (LAS unsigned char*)lds_raw;
    const int tid = threadIdx.x, lane = tid & 63, wave = __builtin_amdgcn_readfirstlane(tid >> 6);
    const int G = gridDim.x, gw = blockIdx.x * 8 + wave, NGW = G * 8;
    unsigned char* ws = args.ws;
    unsigned* ctl = (unsigned*)(ws + WS_CTL);
    volatile LAS unsigned* MISC = (volatile LAS unsigned*)(lds + MISC_OFF);
    for (int u = tid; u < (LDS_BYTES - 131072) / 4; u += 512) ((LAS unsigned*)(lds + 131072))[u] = 0u;
    __syncthreads();
    XcdBarrier bar = xcd_barrier_post(ctl + CW_BAR, MISC + 8);
    const int lo = args.ph_lo, hi = args.ph_hi;
#define IN(k) (lo <= (k) && (k) < hi)
#define GRID_BAR() xcd_barrier(bar)

    const float* x_in = args.in[0]; const float* c_in = args.in[1]; const float* ctx_in = args.in[2]; const float* cctx_in = args.in[3];
    const float* w_mod = args.in[4]; const float* b_mod = args.in[5];
    const float* g_pre_mix = args.in[6]; const float* g_post_mix = args.in[7]; const float* g_pre_ffn = args.in[8]; const float* g_post_ffn = args.in[9];
    const float* w_in_a = args.in[10]; const float* mla_g_q = args.in[11]; const float* mla_w_uq = args.in[12]; const float* mla_g_kv = args.in[13]; const float* mla_w_ukv = args.in[14];
    const float* gla_w_gf = args.in[15]; const float* gla_b_gf = args.in[16]; const float* gla_w_gb = args.in[17]; const float* gla_b_gb = args.in[18]; const float* gla_g_out = args.in[19];
    const float* w_out_a = args.in[20]; const float* w_qkv_c = args.in[21];
    const float* diff_lq1 = args.in[22]; const float* diff_lk1 = args.in[23]; const float* diff_lq2 = args.in[24]; const float* diff_lk2 = args.in[25]; const float* diff_g_out = args.in[26];
    const float* w_out_c = args.in[27]; const float* ffn_w_gate = args.in[28]; const float* ffn_w_up = args.in[29]; const float* ffn_w_down = args.in[30];
    const float* moe_w_router = args.in[31]; const float* moe_w_gate = args.in[32]; const float* moe_w_up = args.in[33]; const float* moe_w_down = args.in[34];
    float* out = args.out;
    float* MODB = (float*)(ws + WS_MOD);
    float* ROPEC = (float*)(ws + WS_ROPE); float* ROPES = ROPEC + 2048 * 32;
    int* TOKE = (int*)(ws + WS_TOKE); float* TOKG = (float*)(ws + WS_TOKG); int* TOKP = (int*)(ws + WS_TOKP);
    float* CTXS = (float*)(ws + WS_CTXS);
    u16* H0 = (u16*)(ws + WS_R0); u16* CAT = (u16*)(ws + WS_R0); u16* FB = (u16*)(ws + WS_R0); u16* O16 = (u16*)(ws + WS_R0); u16* Y2 = (u16*)(ws + WS_R0); u16* HIDC = (u16*)(ws + WS_R0);
    u16* PARTS = (u16*)(ws + WS_PARTS); u16* YB = (u16*)(ws + WS_Y); u16* HB = (u16*)(ws + WS_Y);
    u16* H1 = (u16*)(ws + WS_H1); u16* CAT2 = (u16*)(ws + WS_H1);
    u16* HC = (u16*)(ws + WS_HC); u16* XS = (u16*)(ws + WS_XS);
    u16* A2 = (u16*)(ws + WS_A2); u16* KROPE = (u16*)(ws + WS_KROPE);
    float* OF = (float*)(ws + WS_R3); float* OB = OF + (size_t)M * 512;
    u16* QKVUP = (u16*)(ws + WS_R3); u16* HID = (u16*)(ws + WS_R3); u16* QKVC = (u16*)(ws + WS_R3);

    if (IN(0)) {
        LAS float* sT = (LAS float*)lds;
        LAS float* red = sT + 1024 * 20;
        for (int e = tid; e < 17 * 1024; e += 512) { const int r = e >> 10, k = e & 1023; const float v = r < 16 ? c_in[r * 1024 + k] : cctx_in[k]; sT[k * 20 + r] = silu_f(v); }
        __syncthreads();
        for (int g = blockIdx.x; g < 192; g += G) {
            const int l = g / 96, n = (g % 96) * 64 + lane;
            const float* wp = w_mod + (size_t)l * 1024 * 6144 + n;
            float acc[17];
#pragma unroll
            for (int r = 0; r < 17; ++r) acc[r] = 0.f;
            const int kb = wave * 128;
#pragma unroll 4
            for (int kk = 0; kk < 128; ++kk) { const int k = kb + kk; const float w = wp[(size_t)k * 6144];
                const LAS float* sp = sT + k * 20;
#pragma unroll
                for (int r = 0; r < 17; ++r) acc[r] += sp[r] * w; }
#pragma unroll
            for (int r = 0; r < 17; ++r) red[(wave * 17 + r) * 64 + lane] = acc[r];
            __syncthreads();
            for (int e = tid; e < 17 * 64; e += 512) { const int r = e >> 6, ln = e & 63; float s = 0.f;
#pragma unroll
                for (int w8 = 0; w8 < 8; ++w8) s += red[(w8 * 17 + r) * 64 + ln];
                const int nn = (g % 96) * 64 + ln;
                MODB[(size_t)(l * 17 + r) * 6144 + nn] = s + b_mod[l * 6144 + nn]; }
            __syncthreads();
        }
        for (int e = blockIdx.x * 512 + tid; e < 2048 * 32; e += G * 512) { const int t = e >> 5, i = e & 31; const int pos = i < 16 ? (t >> 6) : (t & 63);
            const float freq = powf(10000.0f, -(float)(i & 15) / 16.0f); const float ang = (float)pos * freq;
            ROPEC[e] = cosf(ang); ROPES[e] = sinf(ang); }
        GRID_BAR();
    }
    if (IN(1)) {
        for (int row = gw; row < M; row += NGW) {
            const float* src = row < ML ? x_in + (size_t)row * 1024 : ctx_in + (size_t)(row - ML) * 1024;
            const int mr = row < ML ? (row >> 11) : 16;
            f32x4 xv[4], hv[4]; ld_row_f32(src, lane, xv);
            premod(xv, hv, g_pre_mix, modp(ws, 0, mr, 0), modp(ws, 0, mr, 1), lane);
            st_row_bf16(H0 + (size_t)row * 1024, lane, hv);
        }
        GRID_BAR();
    }
    if (IN(2)) {
        auto epi = [&](int r, int c, float a, float) { PARTS[(size_t)r * IN_AP + c] = (u16)f2bf(a); };
        naive_gemm<false>(lds, H0, 1024, M / 128, w_in_a, nullptr, 1024, IN_A, IN_A, nullptr, 0, epi);
        GRID_BAR();
    }
    if (IN(3)) {
        for (int row = gw; row < M; row += NGW) {
            const u16* pr = PARTS + (size_t)row * IN_AP;
            { const uint2 w = *(const uint2*)(pr + C_CQ + 4 * lane); float v[4] = {bf2f(w.x & 0xffffu), bf2f(w.x >> 16), bf2f(w.y & 0xffffu), bf2f(w.y >> 16)};
              float s = wave_sum(v[0] * v[0] + v[1] * v[1] + v[2] * v[2] + v[3] * v[3]); const float r = 1.0f / sqrtf(s * (1.0f / 256.0f) + EPS);
              const f32x4 g = *(const f32x4*)(mla_g_q + 4 * lane);
              uint2 o; o.x = f2bf(v[0] * r * g.x) | (f2bf(v[1] * r * g.y) << 16); o.y = f2bf(v[2] * r * g.z) | (f2bf(v[3] * r * g.w) << 16);
              *(uint2*)(A2 + (size_t)row * 384 + 4 * lane) = o; }
            { const unsigned w = *(const unsigned*)(pr + C_CKV + 2 * lane); float v0 = bf2f(w & 0xffffu), v1 = bf2f(w >> 16);
              float s = wave_sum(v0 * v0 + v1 * v1); const float r = 1.0f / sqrtf(s * (1.0f / 128.0f) + EPS);
              const float2 g = *(const float2*)(mla_g_kv + 2 * lane);
              *(unsigned*)(A2 + (size_t)row * 384 + 256 + 2 * lane) = f2bf(v0 * r * g.x) | (f2bf(v1 * r * g.y) << 16); }
            if (lane < 32) { float x1 = bf2f(pr[C_KR + lane]), x2 = bf2f(pr[C_KR + 32 + lane]);
              if (row < ML) { const int t = row & 2047; const float cs = ROPEC[t * 32 + lane], sn = ROPES[t * 32 + lane]; const float n1 = x1 * cs - x2 * sn, n2 = x2 * cs + x1 * sn; x1 = n1; x2 = n2; }
              KROPE[(size_t)row * 64 + lane] = (u16)f2bf(x1); KROPE[(size_t)row * 64 + 32 + lane] = (u16)f2bf(x2); }
        }
        GRID_BAR();
    }
    if (IN(4)) {
        LAS float* qs = (LAS float*)lds;
        LAS float* ks = qs + 16 * 64;
        LAS float* as = ks + 16 * 64;
        LAS float* vs = as + 16 * 64;
        LAS float* opart = vs + 16 * 128;
        for (int u = blockIdx.x; u < 128; u += G) {
            const int dir = u & 1, h = (u >> 1) & 3, b = u >> 3;
            const float* wg = dir ? gla_w_gb : gla_w_gf; const float* bg = dir ? gla_b_gb : gla_b_gf; const int caf = dir ? C_AB : C_AF;
            float* Od = dir ? OB : OF;
            const int kg = tid >> 7, v = tid & 127;
            float S[16];
#pragma unroll
            for (int i = 0; i < 16; ++i) S[i] = 0.f;
            for (int sb = 0; sb < (CTXL + SEQ) / 16; ++sb) {
                __syncthreads();
                for (int e = tid; e < 16 * 64; e += 512) { const int tok = e >> 6, k = e & 63; const int n = sb * 16 + tok;
                    const int row = n < CTXL ? (ML + b * CTXL + (dir ? CTXL - 1 - n : n)) : (b * SEQ + (dir ? SEQ - 1 - (n - CTXL) : (n - CTXL)));
                    const u16* pr = PARTS + (size_t)row * IN_AP;
                    float pre = bg[h * 64 + k];
#pragma unroll
                    for (int jj = 0; jj < 16; ++jj) pre += bf2f(pr[caf + jj]) * wg[jj * 256 + h * 64 + k];
                    const float ls = fminf(pre, 0.f) - log1pf(__expf(-fabsf(pre)));
                    qs[e] = bf2f(pr[C_GQ + h * 64 + k]) * 0.125f; ks[e] = bf2f(pr[C_GK + h * 64 + k]); as[e] = __expf(ls * (1.0f / 16.0f)); }
                for (int e = tid; e < 16 * 128; e += 512) { const int tok = e >> 7, vv = e & 127; const int n = sb * 16 + tok;
                    const int row = n < CTXL ? (ML + b * CTXL + (dir ? CTXL - 1 - n : n)) : (b * SEQ + (dir ? SEQ - 1 - (n - CTXL) : (n - CTXL)));
                    vs[e] = bf2f(PARTS[(size_t)row * IN_AP + C_GV + h * 128 + vv]); }
                __syncthreads();
                for (int tok = 0; tok < 16; ++tok) { const float vv = vs[tok * 128 + v]; float po = 0.f;
#pragma unroll
                    for (int i = 0; i < 16; ++i) { const int k = kg * 16 + i; S[i] = as[tok * 64 + k] * S[i] + ks[tok * 64 + k] * vv; po += qs[tok * 64 + k] * S[i]; }
                    opart[(tok * 4 + kg) * 128 + v] = po; }
                __syncthreads();
                for (int e = tid; e < 16 * 128; e += 512) { const int tok = e >> 7, vv = e & 127; const int n = sb * 16 + tok;
                    const int row = n < CTXL ? (ML + b * CTXL + (dir ? CTXL - 1 - n : n)) : (b * SEQ + (dir ? SEQ - 1 - (n - CTXL) : (n - CTXL)));
                    Od[(size_t)row * 512 + h * 128 + vv] = (opart[(tok * 4 + 0) * 128 + vv] + opart[(tok * 4 + 1) * 128 + vv]) + (opart[(tok * 4 + 2) * 128 + vv] + opart[(tok * 4 + 3) * 128 + vv]); }
            }
        }
        GRID_BAR();
    }
    if (IN(5)) {
        for (int row = gw; row < M; row += NGW) {
            const int h = lane >> 4, v0 = (lane & 15) * 8;
            const float* pf = OF + (size_t)row * 512 + h * 128 + v0; const float* pb = OB + (size_t)row * 512 + h * 128 + v0;
            float o[8]; float s = 0.f;
#pragma unroll
            for (int i = 0; i < 8; ++i) { o[i] = pf[i] + pb[i]; s += o[i] * o[i]; }
#pragma unroll
            for (int off = 1; off < 16; off <<= 1) s += __shfl_xor(s, off);
            const float r = 1.0f / sqrtf(s * (1.0f / 128.0f) + EPS);
            const u16* pr = PARTS + (size_t)row * IN_AP + C_GR + h * 128 + v0;
            u16* po = CAT + (size_t)row * 1024 + 512 + h * 128 + v0;
#pragma unroll
            for (int i = 0; i < 8; ++i) po[i] = (u16)f2bf(o[i] * r * gla_g_out[v0 + i] * silu_f(bf2f(pr[i])));
        }
        GRID_BAR();
    }
    if (IN(6)) {
        auto epiq = [&](int r, int c, float a, float) { QKVUP[(size_t)r * UPN + c] = (u16)f2bf(a); };
        naive_gemm<false>(lds, A2, 384, M / 128, mla_w_uq, nullptr, 256, 768, 768, nullptr, 0, epiq);
        auto epik = [&](int r, int c, float a, float) { QKVUP[(size_t)r * UPN + 768 + c] = (u16)f2bf(a); };
        naive_gemm<false>(lds, A2 + 256, 384, M / 128, mla_w_ukv, nullptr, 128, 1024, 1024, nullptr, 0, epik);
        GRID_BAR();
    }
    if (IN(7)) {
        for (int row = gw; row < ML; row += NGW) {
            const int t = row & 2047;
#pragma unroll
            for (int jj = 0; jj < 2; ++jj) { const int p = lane + 64 * jj, h = p >> 5, i = p & 31;
                u16* q = QKVUP + (size_t)row * UPN + h * 192 + 128;
                const float x1 = bf2f(q[i]), x2 = bf2f(q[32 + i]), cs = ROPEC[t * 32 + i], sn = ROPES[t * 32 + i];
                q[i] = (u16)f2bf(x1 * cs - x2 * sn); q[32 + i] = (u16)f2bf(x2 * cs + x1 * sn); }
        }
        GRID_BAR();
    }
    if (IN(8)) {
        const float scale = 0.07216878364870322f;
        const int NU_L = NB * 4 * 64, NU_X = NB * 4 * 8;
        for (int u = blockIdx.x; u < NU_L + NU_X; u += G) {
            const bool isx = u >= NU_L; const int uu = isx ? u - NU_L : u;
            const int nqb = isx ? 8 : 64;
            const int qb = uu % nqb, h = (uu / nqb) & 3, b = uu / (nqb * 4);
            const int r0 = isx ? (ML + b * CTXL + qb * 32) : (b * SEQ + qb * 32);
            const int nkeys = isx ? CTXL : (CTXL + SEQ);
            auto krow = [&](int key) { return key < CTXL ? (ML + b * CTXL + key) : (b * SEQ + key - CTXL); };
            auto ql = [&](int r, int d) { return bf2f(QKVUP[(size_t)(r0 + r) * UPN + h * 192 + d]); };
            auto kl = [&](int key, int d) { const int row = krow(key); return d < 128 ? bf2f(QKVUP[(size_t)row * UPN + 768 + h * 256 + d]) : bf2f(KROPE[(size_t)row * 64 + d - 128]); };
            auto vl = [&](int key, int d) { const int row = krow(key); return bf2f(QKVUP[(size_t)row * UPN + 768 + h * 256 + 128 + d]); };
            auto os = [&](int r, int d, float val) { CAT[(size_t)(r0 + r) * 1024 + h * 128 + d] = (u16)f2bf(val); };
            naive_attn_unit<192>(lds, nkeys, scale, ql, kl, vl, os);
        }
        GRID_BAR();
    }
    if (IN(9)) {
        auto epi = [&](int r, int c, float a, float) { YB[(size_t)r * 1024 + c] = (u16)f2bf(a); };
        naive_gemm<false>(lds, CAT, 1024, M / 128, w_out_a, nullptr, 1024, 1024, 1024, nullptr, 0, epi);
        GRID_BAR();
    }
    if (IN(10)) {
        for (int row = gw; row < M; row += NGW) {
            const float* src = row < ML ? x_in + (size_t)row * 1024 : ctx_in + (size_t)(row - ML) * 1024;
            float* dst = row < ML ? out + (size_t)row * 1024 : CTXS + (size_t)(row - ML) * 1024;
            const int mr = row < ML ? (row >> 11) : 16;
            f32x4 xv[4], tv[4], hv[4]; ld_row_f32(src, lane, xv); ld_row_bf16(YB + (size_t)row * 1024, lane, tv);
            rms_apply(tv, g_post_mix, lane);
            const float* gate = modp(ws, 0, mr, 2);
#pragma unroll
            for (int j = 0; j < 4; ++j) xv[j] = xv[j] + *(const f32x4*)(gate + 4 * lane + 256 * j) * tv[j];
            st_row_f32(dst, lane, xv);
            premod(xv, hv, g_pre_ffn, modp(ws, 0, mr, 3), modp(ws, 0, mr, 4), lane);
            st_row_bf16(H1 + (size_t)row * 1024, lane, hv);
        }
        GRID_BAR();
    }
    if (IN(11)) {
        auto epi = [&](int r, int c, float a, float b2) { HID[(size_t)r * FFN + c] = (u16)f2bf(silu_f(a) * b2); };
        naive_gemm<true>(lds, H1, 1024, M / 128, ffn_w_gate, ffn_w_up, 1024, FFN, FFN, nullptr, 0, epi);
        GRID_BAR();
    }
    if (IN(12)) {
        auto epi = [&](int r, int c, float a, float) { FB[(size_t)r * 1024 + c] = (u16)f2bf(a); };
        naive_gemm<false>(lds, HID, FFN, M / 128, ffn_w_down, nullptr, FFN, 1024, 1024, nullptr, 0, epi);
        GRID_BAR();
    }
    if (IN(13)) {
        for (int row = gw; row < M; row += NGW) {
            float* dst = row < ML ? out + (size_t)row * 1024 : CTXS + (size_t)(row - ML) * 1024;
            const int mr = row < ML ? (row >> 11) : 16;
            f32x4 xv[4], tv[4], hv[4]; ld_row_f32(dst, lane, xv); ld_row_bf16(FB + (size_t)row * 1024, lane, tv);
            rms_apply(tv, g_post_ffn, lane);
            const float* gate = modp(ws, 0, mr, 5);
#pragma unroll
            for (int j = 0; j < 4; ++j) xv[j] = xv[j] + *(const f32x4*)(gate + 4 * lane + 256 * j) * tv[j];
            st_row_f32(dst, lane, xv);
            premod(xv, hv, g_pre_mix + 1024, modp(ws, 1, mr, 0), modp(ws, 1, mr, 1), lane);
            st_row_bf16(HB + (size_t)row * 1024, lane, hv);
        }
        GRID_BAR();
    }
    if (IN(14)) {
        auto epi = [&](int r, int c, float a, float) { QKVC[(size_t)r * 3072 + c] = (u16)f2bf(a); };
        naive_gemm<false>(lds, HB, 1024, M / 128, w_qkv_c, nullptr, 1024, 3072, 3072, nullptr, 0, epi);
        GRID_BAR();
    }
    if (IN(15)) {
        for (int row = gw; row < ML; row += NGW) {
            const int t = row & 2047;
#pragma unroll 4
            for (int jj = 0; jj < 16; ++jj) { const int p = lane + 64 * jj, which = p >> 9, hh = (p & 511) >> 5, i = p & 31;
                u16* q = QKVC + (size_t)row * 3072 + which * 1024 + hh * 64;
                const float x1 = bf2f(q[i]), x2 = bf2f(q[32 + i]), cs = ROPEC[t * 32 + i], sn = ROPES[t * 32 + i];
                q[i] = (u16)f2bf(x1 * cs - x2 * sn); q[32 + i] = (u16)f2bf(x2 * cs + x1 * sn); }
        }
        GRID_BAR();
    }
    if (IN(16)) {
        const int NU = NB * 16 * 64;
        for (int u = blockIdx.x; u < NU; u += G) {
            const int qb = u & 63, j = (u >> 6) & 15, b = u >> 10;
            const int r0 = b * SEQ + qb * 32;
            auto krow = [&](int key) { return key < CTXL ? (ML + b * CTXL + key) : (b * SEQ + key - CTXL); };
            auto ql = [&](int r, int d) { return bf2f(QKVC[(size_t)(r0 + r) * 3072 + j * 64 + d]); };
            auto kl = [&](int key, int d) { return bf2f(QKVC[(size_t)krow(key) * 3072 + 1024 + j * 64 + d]); };
            auto vl = [&](int key, int d) { return bf2f(QKVC[(size_t)krow(key) * 3072 + 2048 + (j >> 1) * 128 + d]); };
            auto os = [&](int r, int d, float val) { O16[(size_t)(r0 + r) * 2048 + j * 128 + d] = (u16)f2bf(val); };
            naive_attn_unit<64>(lds, CTXL + SEQ, 0.125f, ql, kl, vl, os);
        }
        GRID_BAR();
    }
    if (IN(17)) {
        const float s1 = wave_sum(diff_lq1[lane] * diff_lk1[lane]), s2 = wave_sum(diff_lq2[lane] * diff_lk2[lane]);
        const float lam = expf(s1) - expf(s2) + LAM_INIT;
        for (int row = gw; row < ML; row += NGW) {
            const int h = lane >> 3, v0 = (lane & 7) * 16;
            const u16* p1 = O16 + (size_t)row * 2048 + (2 * h) * 128 + v0; const u16* p2 = p1 + 128;
            float o[16]; float s = 0.f;
#pragma unroll
            for (int i = 0; i < 16; ++i) { o[i] = bf2f(p1[i]) - lam * bf2f(p2[i]); s += o[i] * o[i]; }
#pragma unroll
            for (int off = 1; off < 8; off <<= 1) s += __shfl_xor(s, off);
            const float r = 1.0f / sqrtf(s * (1.0f / 128.0f) + EPS);
            u16* po = CAT2 + (size_t)row * 1024 + h * 128 + v0;
#pragma unroll
            for (int i = 0; i < 16; ++i) po[i] = (u16)f2bf(o[i] * r * diff_g_out[v0 + i] * (1.0f - LAM_INIT));
        }
        GRID_BAR();
    }
    if (IN(18)) {
        auto epi = [&](int r, int c, float a, float) { Y2[(size_t)r * 1024 + c] = (u16)f2bf(a); };
        naive_gemm<false>(lds, CAT2, 1024, ML / 128, w_out_c, nullptr, 1024, 1024, 1024, nullptr, 0, epi);
        GRID_BAR();
    }
    if (IN(19)) {
        LAS int* lcnt = (LAS int*)lds;
        LAS int* gbase = lcnt + 8;
        LAS int* le = gbase + 8;
        LAS int* lr = le + 256;
        LAS float* lg = (LAS float*)(lr + 256);
        for (int base = blockIdx.x * 128; base < ML; base += G * 128) {
            __syncthreads();
            if (tid < 8) lcnt[tid] = 0;
            __syncthreads();
            for (int i = 0; i < 16; ++i) {
                const int lrow = wave * 16 + i, row = base + lrow;
                float* dst = out + (size_t)row * 1024;
                const int mr = row >> 11;
                f32x4 xv[4], tv[4], hv[4]; ld_row_f32(dst, lane, xv); ld_row_bf16(Y2 + (size_t)row * 1024, lane, tv);
                rms_apply(tv, g_post_mix + 1024, lane);
                const float* gate = modp(ws, 1, mr, 2);
#pragma unroll
                for (int j = 0; j < 4; ++j) xv[j] = xv[j] + *(const f32x4*)(gate + 4 * lane + 256 * j) * tv[j];
                st_row_f32(dst, lane, xv);
                premod(xv, hv, g_pre_ffn + 1024, modp(ws, 1, mr, 3), modp(ws, 1, mr, 4), lane);
                st_row_bf16(HC + (size_t)row * 1024, lane, hv);
                float lg8[8];
#pragma unroll
                for (int e = 0; e < 8; ++e) lg8[e] = 0.f;
#pragma unroll
                for (int j = 0; j < 4; ++j)
#pragma unroll
                    for (int q = 0; q < 4; ++q) { const int k = 4 * lane + 256 * j + q; const float hvv = hv[j][q];
                        const f32x4 wa = *(const f32x4*)(moe_w_router + (size_t)k * 8), wb = *(const f32x4*)(moe_w_router + (size_t)k * 8 + 4);
                        lg8[0] += hvv * wa.x; lg8[1] += hvv * wa.y; lg8[2] += hvv * wa.z; lg8[3] += hvv * wa.w;
                        lg8[4] += hvv * wb.x; lg8[5] += hvv * wb.y; lg8[6] += hvv * wb.z; lg8[7] += hvv * wb.w; }
#pragma unroll
                for (int e = 0; e < 8; ++e) lg8[e] = wave_sum(lg8[e]);
                if (lane == 0) {
                    int e0 = 0; float v0 = lg8[0];
#pragma unroll
                    for (int e = 1; e < 8; ++e) if (lg8[e] > v0) { v0 = lg8[e]; e0 = e; }
                    int e1 = -1; float v1 = -3.0e38f;
#pragma unroll
                    for (int e = 0; e < 8; ++e) if (e != e0 && lg8[e] > v1) { v1 = lg8[e]; e1 = e; }
                    const float g0 = 1.0f / (1.0f + expf(v1 - v0));
                    le[lrow * 2] = e0; le[lrow * 2 + 1] = e1; lg[lrow * 2] = g0; lg[lrow * 2 + 1] = 1.0f - g0;
                    lr[lrow * 2] = __hip_atomic_fetch_add(&lcnt[e0], 1, __ATOMIC_RELAXED, __HIP_MEMORY_SCOPE_WORKGROUP); lr[lrow * 2 + 1] = __hip_atomic_fetch_add(&lcnt[e1], 1, __ATOMIC_RELAXED, __HIP_MEMORY_SCOPE_WORKGROUP);
                }
            }
            __syncthreads();
            if (tid < 8) gbase[tid] = (int)atomicAdd(ctl + CW_ECNT + 64 * tid, (unsigned)lcnt[tid]);
            __syncthreads();
            if (tid < 256) { const int e = le[tid]; TOKE[(size_t)base * 2 + tid] = e; TOKG[(size_t)base * 2 + tid] = lg[tid]; TOKP[(size_t)base * 2 + tid] = gbase[e] + lr[tid]; }
        }
        GRID_BAR();
    }
    if (IN(20)) {
        LAS int* pst = (LAS int*)lds;
        if (tid == 0) { int acc = 0; for (int e = 0; e < 8; ++e) { pst[e] = acc; const int c = (int)ctl[CW_ECNT + 64 * e]; acc += (c + 255) / 256 * 256; } pst[8] = acc; }
        __syncthreads();
        if (blockIdx.x == 0) {
            if (tid == 0) ctl[CW_MOET] = (unsigned)(pst[8] / 256);
            for (int t = tid; t < pst[8] / 256; t += 512) { int e = 0; for (int q = 1; q < 8; ++q) if (t * 256 >= pst[q]) e = q; ctl[CW_TILEE + t] = (unsigned)e; }
        }
        for (int s = gw; s < 2 * ML; s += NGW) {
            const int e = TOKE[s], pos = pst[e] + TOKP[s];
            const uint4* src = (const uint4*)(HC + (size_t)(s >> 1) * 1024); uint4* dstp = (uint4*)(XS + (size_t)pos * 1024);
            const uint4 a = src[lane], b2 = src[lane + 64];
            dstp[lane] = a; dstp[lane + 64] = b2;
            if (lane == 0) TOKP[s] = pos;
        }
        GRID_BAR();
    }
    if (IN(21)) {
        const int T = (int)ctl[CW_MOET];
        for (int c0 = 0; c0 < T; c0 += CHUNK_T) {
            const int nt = (T - c0) < CHUNK_T ? (T - c0) : CHUNK_T;
            { auto epi = [&](int r, int c, float a, float b2) { HIDC[(size_t)r * ED + c] = (u16)f2bf(silu_f(a) * b2); };
              naive_gemm<true>(lds, XS + (size_t)c0 * 256 * 1024, 1024, nt * 2, moe_w_gate, moe_w_up, 1024, ED, ED, ctl + CW_TILEE + c0, (size_t)1024 * ED, epi); }
            GRID_BAR();
            { u16* ys = XS + (size_t)c0 * 256 * 1024;
              auto epi = [&](int r, int c, float a, float) { ys[(size_t)r * 1024 + c] = (u16)f2bf(a); };
              naive_gemm<false>(lds, HIDC, ED, nt * 2, moe_w_down, nullptr, ED, 1024, 1024, ctl + CW_TILEE + c0, (size_t)ED * 1024, epi); }
            GRID_BAR();
        }
    }
    if (IN(22)) {
        for (int row = gw; row < ML; row += NGW) {
            float* dst = out + (size_t)row * 1024;
            const int mr = row >> 11;
            const int p0 = TOKP[row * 2], p1 = TOKP[row * 2 + 1]; const float g0 = TOKG[row * 2], g1 = TOKG[row * 2 + 1];
            f32x4 xv[4], a[4], b2[4]; ld_row_f32(dst, lane, xv); ld_row_bf16(XS + (size_t)p0 * 1024, lane, a); ld_row_bf16(XS + (size_t)p1 * 1024, lane, b2);
#pragma unroll
            for (int j = 0; j < 4; ++j) a[j] = a[j] * g0 + b2[j] * g1;
            rms_apply(a, g_post_ffn + 1024, lane);
            const float* gate = modp(ws, 1, mr, 5);
#pragma unroll
            for (int j = 0; j < 4; ++j) xv[j] = xv[j] + *(const f32x4*)(gate + 4 * lane + 256 * j) * a[j];
            st_row_f32(dst, lane, xv);
        }
    }
#undef IN
#undef GRID_BAR
}

extern "C" void kernel_launch(void* const* d_in, const int* in_sizes, int n_in, void* d_out, int out_size, void* d_ws, size_t ws_size, hipStream_t stream) {
    static int grid = 0;
    if (grid == 0) {
        if (n_in != 35 || in_sizes[0] != ML * D || out_size != ML * D || ws_size < WS_END) {
            fprintf(stderr, "kernel_launch: shape mismatch n_in %d in0 %d out %d ws %zu (need %zu)\n", n_in, n_in > 0 ? in_sizes[0] : -1, out_size, ws_size, (size_t)WS_END); grid = -1; return; }
        int dev = 0, cus = 0, per_cu = 0;
        if (hipGetDevice(&dev) != hipSuccess || hipDeviceGetAttribute(&cus, hipDeviceAttributeMultiprocessorCount, dev) != hipSuccess) { grid = -1; return; }
        if (hipFuncSetAttribute((const void*)fwd_kernel, hipFuncAttributeMaxDynamicSharedMemorySize, LDS_BYTES) != hipSuccess) { fprintf(stderr, "kernel_launch: hipFuncSetAttribute failed\n"); grid = -1; return; }
        if (hipOccupancyMaxActiveBlocksPerMultiprocessor(&per_cu, (const void*)fwd_kernel, 512, LDS_BYTES) != hipSuccess || per_cu < 1)
            fprintf(stderr, "kernel_launch: occupancy query reports %d\n", per_cu);
        (void)hipGetLastError();
        grid = cus;
    }
    if (grid < 0) return;
    if (hipMemsetAsync((char*)d_ws + WS_CTL, 0, CTL_ZERO_BYTES, stream) != hipSuccess) return;
    Args a{};
    for (int i = 0; i < 35; ++i) a.in[i] = (const float*)d_in[i];
    a.out = (float*)d_out; a.ws = (unsigned char*)d_ws; a.ph_lo = 0; a.ph_hi = 100;
    hipLaunchKernelGGL(fwd_kernel, dim3(grid), dim3(512), LDS_BYTES, stream, a);
}
```

```cpp
#include <hip/hip_runtime.h>
#include <cstdio>
#include <cstdint>

constexpr int D = 1024, NB = 16, SEQ = 2048, CTXL = 256;
constexpr int ML = NB * SEQ, MX = NB * CTXL, M = ML + MX;
constexpr int IN_A = 2016, IN_AP = 2048;
constexpr int C_CQ = 0, C_CKV = 256, C_KR = 384, C_GQ = 448, C_GK = 704, C_GV = 960, C_GR = 1472, C_AF = 1984, C_AB = 2000;
constexpr int UPN = 1792;
constexpr int FFN = 2816, NE = 8, ED = 3584;
constexpr int CAP = 2 * ML + NE * 256, MAXT = CAP / 256;
constexpr int CHUNK_T = 64;
constexpr float EPS = 1e-6f;
constexpr float LAM_INIT = 0.35550906759f;

constexpr size_t MiB = 1u << 20;
constexpr size_t WS_CTL = 0, CTL_ZERO_BYTES = 1 * MiB;
constexpr size_t WS_MOD = 1 * MiB;
constexpr size_t WS_ROPE = 2 * MiB;
constexpr size_t WS_TOKE = 2 * MiB + 512 * 1024;
constexpr size_t WS_TOKG = WS_TOKE + 256 * 1024;
constexpr size_t WS_TOKP = WS_TOKG + 256 * 1024;
constexpr size_t WS_CTXS = 4 * MiB;
constexpr size_t WS_W = 20 * MiB;
constexpr size_t WS_R0 = 52 * MiB;
constexpr size_t WS_PARTS = 124 * MiB;
constexpr size_t WS_Y = 124 * MiB;
constexpr size_t WS_H1 = 196 * MiB;
constexpr size_t WS_HC = 116 * MiB;
constexpr size_t WS_XS = 180 * MiB;
constexpr size_t WS_A2 = 268 * MiB;
constexpr size_t WS_KROPE = 295 * MiB;
constexpr size_t WS_R3 = 300 * MiB;
constexpr size_t WS_MOEW = 332 * MiB;
constexpr size_t WS_END = 516 * MiB;
constexpr int CW_BAR = 4096;
constexpr int CW_ECNT = 8192;
constexpr int CW_MOET = 9000;
constexpr int CW_TILEE = 9216;

typedef unsigned short u16;
typedef float f32x4 __attribute__((ext_vector_type(4)));
#define LAS __attribute__((address_space(3)))
constexpr int LDS_BYTES = 147456;
constexpr int MISC_OFF = 131072 + 320;

#define XB_TMO      128
#define XB_XCNT(j)  (256  + 64 * (j))
#define XB_XSUB(j)  (1280 + 64 * (j))
#define XB_XGEN(j)  (2304 + 64 * (j))
#define XB_TOP      3328
#define XB_TOPGEN   3392
#define XCD_BAR_WORDS 3456
#define XB_SPIN_CAP (1u << 23)
__device__ __forceinline__ unsigned xb_ld(unsigned* p)              { return __hip_atomic_load(p, __ATOMIC_RELAXED, __HIP_MEMORY_SCOPE_AGENT); }
__device__ __forceinline__ unsigned xb_add(unsigned* p, unsigned v) { return __hip_atomic_fetch_add(p, v, __ATOMIC_RELAXED, __HIP_MEMORY_SCOPE_AGENT); }
__device__ __forceinline__ unsigned xb_xcc_id() { return (unsigned)__builtin_amdgcn_s_getreg((3 << 11) | 20) & 0xFu; }
#define XB_SPIN(cond, bar) do { unsigned _sp = 0; while (cond) { __builtin_amdgcn_s_sleep(1); \
    if ((++_sp & 255u) == 0u) { if (xb_ld(&(bar)[XB_TMO])) break; if (_sp > XB_SPIN_CAP) { atomicAdd(&(bar)[XB_TMO], 1u); break; } } } } while (0)
struct XcdBarrier { unsigned* bar; unsigned x; volatile LAS unsigned* st; };
__device__ __forceinline__ XcdBarrier xcd_barrier_post(unsigned* bar, volatile LAS unsigned* st) {
    XcdBarrier b; b.bar = bar; b.x = xb_xcc_id(); b.st = st;
    if (threadIdx.x == 0) (void)xb_add(&bar[XB_XCNT(b.x)], 1u);
    return b;
}
__device__ __forceinline__ void xcd_barrier_complete(unsigned* bar, unsigned x, unsigned& nloc, unsigned& nx) {
    const unsigned G = gridDim.x * gridDim.y * gridDim.z;
    unsigned sum, cnt, mine, sp = 0u;
    for (;;) {
        sum = 0u; cnt = 0u; mine = 0u;
#pragma unroll
        for (unsigned j = 0; j < 16; ++j) { const unsigned c = xb_ld(&bar[XB_XCNT(j)]); sum += c; cnt += (c > 0u) ? 1u : 0u; mine = (j == x) ? c : mine; }
        if (sum == G) break;
        __builtin_amdgcn_s_sleep(1);
        if ((++sp & 255u) == 0u) { if (xb_ld(&bar[XB_TMO])) break; if (sp > XB_SPIN_CAP) { atomicAdd(&bar[XB_TMO], 1u); break; } }
    }
    nloc = mine > 0u ? mine : 1u; nx = cnt > 0u ? cnt : 1u;
}
__device__ __forceinline__ void xcd_barrier(const XcdBarrier& b) {
    asm volatile("s_waitcnt vmcnt(0)" ::: "memory");
    __syncthreads();
    if (threadIdx.x == 0) {
        unsigned* bar = b.bar;
        __builtin_amdgcn_s_waitcnt(0);
        unsigned nloc = b.st[0], nx = b.st[1];
        if (nloc == 0u) { xcd_barrier_complete(bar, b.x, nloc, nx); b.st[0] = nloc; b.st[1] = nx; }
        const unsigned old = xb_add(&bar[XB_XSUB(b.x)], 1u);
        const unsigned gen = old / nloc;
        if (old + 1u == (gen + 1u) * nloc) {
            __builtin_amdgcn_fence(__ATOMIC_RELEASE, "agent");
            asm volatile("s_waitcnt vmcnt(0)" ::: "memory");
            const unsigned og = xb_add(&bar[XB_TOP], 1u);
            const unsigned tg = og / nx;
            if (og + 1u == (tg + 1u) * nx) xb_add(&bar[XB_TOPGEN], 1u);
            else XB_SPIN(xb_ld(&bar[XB_TOPGEN]) == tg, bar);
            __builtin_amdgcn_fence(__ATOMIC_ACQUIRE, "agent");
            xb_add(&bar[XB_XGEN(b.x)], 1u);
            asm volatile("s_waitcnt vmcnt(0)" ::: "memory");
        } else {
            XB_SPIN(xb_ld(&bar[XB_XGEN(b.x)]) == gen, bar);
            __builtin_amdgcn_fence(__ATOMIC_ACQUIRE, "agent");
            asm volatile("s_waitcnt vmcnt(0)" ::: "memory");
        }
    }
    __syncthreads();
}

__device__ __forceinline__ float bf2f(unsigned h) { return __uint_as_float(h << 16); }
__device__ __forceinline__ unsigned f2bf(float f) { unsigned u = __float_as_uint(f); return (u + 0x7fffu + ((u >> 16) & 1u)) >> 16; }
__device__ __forceinline__ float wave_sum(float v) {
#pragma unroll
    for (int o = 1; o < 64; o <<= 1) v += __shfl_xor(v, o);
    return v;
}
__device__ __forceinline__ float silu_f(float x) { return x / (1.0f + __expf(-x)); }
__device__ __forceinline__ void ld_row_f32(const float* p, int lane, f32x4 (&v)[4]) {
#pragma unroll
    for (int j = 0; j < 4; ++j) v[j] = *(const f32x4*)(p + 4 * lane + 256 * j);
}
__device__ __forceinline__ void ld_row_bf16(const u16* p, int lane, f32x4 (&v)[4]) {
#pragma unroll
    for (int j = 0; j < 4; ++j) { const uint2 w = *(const uint2*)(p + 4 * lane + 256 * j);
        v[j] = (f32x4){bf2f(w.x & 0xffffu), bf2f(w.x >> 16), bf2f(w.y & 0xffffu), bf2f(w.y >> 16)}; }
}
__device__ __forceinline__ void st_row_f32(float* p, int lane, const f32x4 (&v)[4]) {
#pragma unroll
    for (int j = 0; j < 4; ++j) *(f32x4*)(p + 4 * lane + 256 * j) = v[j];
}
__device__ __forceinline__ void st_row_bf16(u16* p, int lane, const f32x4 (&v)[4]) {
#pragma unroll
    for (int j = 0; j < 4; ++j) { uint2 w; w.x = f2bf(v[j].x) | (f2bf(v[j].y) << 16); w.y = f2bf(v[j].z) | (f2bf(v[j].w) << 16);
        *(uint2*)(p + 4 * lane + 256 * j) = w; }
}
__device__ __forceinline__ float row_rstd(const f32x4 (&v)[4]) {
    float s = 0.f;
#pragma unroll
    for (int j = 0; j < 4; ++j) s += (v[j].x * v[j].x + v[j].y * v[j].y) + (v[j].z * v[j].z + v[j].w * v[j].w);
    s = wave_sum(s);
    return 1.0f / sqrtf(s * (1.0f / 1024.0f) + EPS);
}
__device__ __forceinline__ void rms_apply(f32x4 (&v)[4], const float* g, int lane) {
    const float r = row_rstd(v);
#pragma unroll
    for (int j = 0; j < 4; ++j) { const f32x4 gg = *(const f32x4*)(g + 4 * lane + 256 * j); v[j] = v[j] * r * gg; }
}
__device__ __forceinline__ void premod(const f32x4 (&x)[4], f32x4 (&h)[4], const float* g, const float* shift, const float* scale, int lane) {
    const float r = row_rstd(x);
#pragma unroll
    for (int j = 0; j < 4; ++j) { const int c = 4 * lane + 256 * j; const f32x4 gg = *(const f32x4*)(g + c), sh = *(const f32x4*)(shift + c), sc = *(const f32x4*)(scale + c);
        h[j] = x[j] * r * gg * (1.0f + sc) + sh; }
}

struct Args { const float* in[35]; float* out; unsigned char* ws; int ph_lo, ph_hi; };

__device__ __forceinline__ const float* modp(const unsigned char* ws, int l, int r, int which) { return (const float*)(ws + WS_MOD) + ((size_t)(l * 17 + r) * 6 + which) * 1024; }

template <bool DUAL, class Epi>
__device__ __forceinline__ void naive_gemm(LAS unsigned char* lds, const u16* A, int lda, int ntiles_m, const float* W0, const float* W1, int K, int N, int ldw,
                                           const unsigned* tile_e, size_t estride, const Epi& epi) {
    LAS float* As = (LAS float*)lds;
    LAS float* Ws0 = As + 16 * 132;
    LAS float* Ws1 = Ws0 + 16 * 64;
    const int tid = threadIdx.x, ty = tid >> 4, tx = tid & 15;
    const int ntn = (N + 63) / 64;
    const int total = ntiles_m * ntn;
    for (int u = blockIdx.x; u < total; u += gridDim.x) {
        const int tm = u / ntn, tn = u % ntn;
        const int row0 = tm * 128, col0 = tn * 64;
        const float* w0 = W0; const float* w1 = W1;
        if (tile_e) { const unsigned e = tile_e[tm >> 1]; w0 += (size_t)e * estride; if (DUAL) w1 += (size_t)e * estride; }
        float acc0[4][4], acc1[4][4];
#pragma unroll
        for (int i = 0; i < 4; ++i)
#pragma unroll
            for (int j = 0; j < 4; ++j) { acc0[i][j] = 0.f; acc1[i][j] = 0.f; }
        for (int k0 = 0; k0 < K; k0 += 16) {
            { const int r = tid >> 2, kq = (tid & 3) * 4; const uint2 w = *(const uint2*)(A + (size_t)(row0 + r) * lda + k0 + kq);
              As[(kq + 0) * 132 + r] = bf2f(w.x & 0xffffu); As[(kq + 1) * 132 + r] = bf2f(w.x >> 16);
              As[(kq + 2) * 132 + r] = bf2f(w.y & 0xffffu); As[(kq + 3) * 132 + r] = bf2f(w.y >> 16); }
            { const int kk = tid >> 5, n = (tid & 31) * 2, c = col0 + n;
              float a = 0.f, b = 0.f;
              if (c < N) { const float2 t = *(const float2*)(w0 + (size_t)(k0 + kk) * ldw + c); a = t.x; b = t.y; }
              Ws0[kk * 64 + n] = a; Ws0[kk * 64 + n + 1] = b;
              if (DUAL) { float a1 = 0.f, b1 = 0.f;
                  if (c < N) { const float2 t = *(const float2*)(w1 + (size_t)(k0 + kk) * ldw + c); a1 = t.x; b1 = t.y; }
                  Ws1[kk * 64 + n] = a1; Ws1[kk * 64 + n + 1] = b1; } }
            __syncthreads();
#pragma unroll
            for (int kk = 0; kk < 16; ++kk) {
                const f32x4 a = *(const LAS f32x4*)(As + kk * 132 + ty * 4);
                const f32x4 b = *(const LAS f32x4*)(Ws0 + kk * 64 + tx * 4);
#pragma unroll
                for (int i = 0; i < 4; ++i)
#pragma unroll
                    for (int j = 0; j < 4; ++j) acc0[i][j] += a[i] * b[j];
                if (DUAL) { const f32x4 b1 = *(const LAS f32x4*)(Ws1 + kk * 64 + tx * 4);
#pragma unroll
                    for (int i = 0; i < 4; ++i)
#pragma unroll
                        for (int j = 0; j < 4; ++j) acc1[i][j] += a[i] * b1[j]; }
            }
            __syncthreads();
        }
#pragma unroll
        for (int i = 0; i < 4; ++i)
#pragma unroll
            for (int j = 0; j < 4; ++j) { const int r = row0 + ty * 4 + i, c = col0 + tx * 4 + j; if (c < N) epi(r, c, acc0[i][j], acc1[i][j]); }
    }
}

template <int DQ, class QL, class KL, class VL, class OS>
__device__ __forceinline__ void naive_attn_unit(LAS unsigned char* lds, int nkeys, float scale, const QL& ql, const KL& kl, const VL& vl, const OS& os) {
    LAS float* Qs = (LAS float*)lds;
    LAS float* Ks = Qs + 32 * (DQ + 1);
    LAS float* Vs = Ks + 64 * (DQ + 1);
    LAS float* Ps = Vs + 64 * 128;
    const int tid = threadIdx.x, r = tid >> 4, j = tid & 15;
    __syncthreads();
    for (int e = tid; e < 32 * DQ; e += 512) { const int rr = e / DQ, d = e % DQ; Qs[rr * (DQ + 1) + d] = ql(rr, d); }
    float m = -1e30f, l = 0.f, o[8];
#pragma unroll
    for (int dd = 0; dd < 8; ++dd) o[dd] = 0.f;
    for (int k0 = 0; k0 < nkeys; k0 += 64) {
        __syncthreads();
        for (int e = tid; e < 64 * DQ; e += 512) { const int key = e / DQ, d = e % DQ; Ks[key * (DQ + 1) + d] = kl(k0 + key, d); }
        for (int e = tid; e < 64 * 128; e += 512) { const int key = e >> 7, d = e & 127; Vs[key * 128 + d] = vl(k0 + key, d); }
        __syncthreads();
        float s[4];
#pragma unroll
        for (int c = 0; c < 4; ++c) { const LAS float* kp = Ks + (j + 16 * c) * (DQ + 1); const LAS float* qp = Qs + r * (DQ + 1); float a = 0.f;
            for (int d = 0; d < DQ; ++d) a += qp[d] * kp[d];
            s[c] = a * scale; }
        float tmax = fmaxf(fmaxf(s[0], s[1]), fmaxf(s[2], s[3]));
#pragma unroll
        for (int off = 1; off < 16; off <<= 1) tmax = fmaxf(tmax, __shfl_xor(tmax, off));
        const float mn = fmaxf(m, tmax), alpha = __expf(m - mn);
        float ps = 0.f;
#pragma unroll
        for (int c = 0; c < 4; ++c) { const float p = __expf(s[c] - mn); Ps[r * 64 + j + 16 * c] = p; ps += p; }
#pragma unroll
        for (int off = 1; off < 16; off <<= 1) ps += __shfl_xor(ps, off);
        l = l * alpha + ps; m = mn;
#pragma unroll
        for (int dd = 0; dd < 8; ++dd) o[dd] *= alpha;
        __syncthreads();
        for (int key = 0; key < 64; ++key) { const float p = Ps[r * 64 + key]; const LAS float* vp = Vs + key * 128 + j * 8;
#pragma unroll
            for (int dd = 0; dd < 8; ++dd) o[dd] += p * vp[dd]; }
    }
    const float il = 1.0f / l;
#pragma unroll
    for (int dd = 0; dd < 8; ++dd) os(r, j * 8 + dd, o[dd] * il);
}


#ifndef FAST_GEMM
#define FAST_GEMM 1
#endif
#ifndef PG8_SP2
#define PG8_SP2 true
#endif
#ifndef PG8_ALIGN
#define PG8_ALIGN true
#endif
namespace pg8 {
typedef short bf16x8 __attribute__((ext_vector_type(8)));
typedef unsigned u32x4 __attribute__((ext_vector_type(4)));
constexpr int BM = 256, BK = 64, HALF = 128, HTB = HALF * BK * 2, STAGE_BYTES = 8 * HTB, NXCD = 8, WGM = 8;
__host__ __device__ __forceinline__ int lds_byte(int r, int c) { const int st = (r >> 4) * 2 + (c >> 5), rr = r & 15, cc = c & 31, ob = rr * 64 + cc * 2; return st * 1024 + (ob ^ (((ob >> 9) & 1) << 5)); }
__host__ __device__ __forceinline__ void stage_rc(int b, int& R, int& C) { const int st = b / 1024, sb = b % 1024, swz = sb ^ (((sb >> 9) & 1) << 5); R = (st >> 1) * 16 + swz / 64; C = (st & 1) * 32 + (swz % 64) / 2; }
__host__ __device__ __forceinline__ int perm32(int rho) { const int n = rho >> 4, i = rho & 15; return 8 * (i >> 2) + 4 * n + (i & 3); }

struct Unit { int pm, pn, po, pc; };
struct Gemm { const u16* A; const u16* Bt; int lda; int K; };

struct DenseOrder {
    int nM, nN, nwg, G, c;
    __device__ __forceinline__ void init(int nM_, int nN_, int G_, int c_) { nM = nM_; nN = nN_; nwg = nM * nN; G = G_; c = c_; }
    __device__ __forceinline__ bool next2(int i, int& pm, int& pn) const {
        const long L = (long)i * G + c; if (L >= nwg) return false;
        int wgid = (int)L; { const int q = nwg / NXCD, r = nwg % NXCD, xcd = wgid % NXCD, off = wgid / NXCD; wgid = (xcd < r ? xcd * (q + 1) : r * (q + 1) + (xcd - r) * q) + off; }
        const int nig = WGM * nN, gid = wgid / nig, fm = gid * WGM, gsz = (nM - fm) < WGM ? (nM - fm) : WGM;
        pm = fm + ((wgid % nig) % gsz); pn = (wgid % nig) / gsz; return true;
    }
    __device__ __forceinline__ bool next(int i, Unit& u) const { int pm, pn; if (!next2(i, pm, pn)) return false; u.pm = pm; u.pn = pn; u.po = pm; u.pc = pn; return true; }
    __device__ __forceinline__ void a_ready(const Unit&) const {}
    __device__ __forceinline__ void done(const Unit&) const {}
};
struct MoeOrder : DenseOrder {
    const unsigned* tile_e; int nper, a_off, o_off;
    __device__ __forceinline__ bool next(int i, Unit& u) const { int pm, pn; if (!next2(i, pm, pn)) return false;
        const int e = (int)tile_e[pm]; u.pm = a_off + pm; u.pn = e * nper + pn; u.po = o_off + pm; u.pc = pn; return true; }
};

__device__ __forceinline__ unsigned cvt_pk_bf16(float lo, float hi) { unsigned r; asm volatile("v_cvt_pk_bf16_f32 %0, %1, %2" : "=v"(r) : "v"(lo), "v"(hi)); return r; }

struct EpiStore {
    static constexpr bool PERM = true, AFTER_DRAIN = false;
    u16* O; int ldc;
    __device__ __forceinline__ void operator()(const f32x4 (&acc)[2][2][4][2], const Unit& u, int wr, int wc, int fr, int fq) const {
        const int row0 = u.po * BM + wr * 64 + fr, col0 = u.pc * BM + wc * 32 + 8 * fq;
#pragma unroll
        for (int ai = 0; ai < 2; ++ai)
#pragma unroll
            for (int m = 0; m < 4; ++m) { u16* rowp = O + (size_t)(row0 + ai * HALF + m * 16) * ldc + col0;
#pragma unroll
                for (int bj = 0; bj < 2; ++bj) { const f32x4 v0 = acc[ai][bj][m][0], v1 = acc[ai][bj][m][1];
                    u32x4 w; w.x = cvt_pk_bf16(v0[0], v0[1]); w.y = cvt_pk_bf16(v0[2], v0[3]); w.z = cvt_pk_bf16(v1[0], v1[1]); w.w = cvt_pk_bf16(v1[2], v1[3]);
                    *(u32x4*)(rowp + bj * HALF) = w; } }
    }
};
struct EpiSwiglu {
    static constexpr bool PERM = true, AFTER_DRAIN = false;
    u16* O; int ldc;
    __device__ __forceinline__ void operator()(const f32x4 (&acc)[2][2][4][2], const Unit& u, int wr, int wc, int fr, int fq) const {
        const int row0 = u.po * BM + wr * 64 + fr, col0 = u.pc * HALF + wc * 32 + 8 * fq;
#pragma unroll
        for (int ai = 0; ai < 2; ++ai)
#pragma unroll
            for (int m = 0; m < 4; ++m) { u16* rowp = O + (size_t)(row0 + ai * HALF + m * 16) * ldc + col0;
                float hv[8];
#pragma unroll
                for (int n = 0; n < 2; ++n)
#pragma unroll
                    for (int q = 0; q < 4; ++q) { const float g = acc[ai][0][m][n][q], up = acc[ai][1][m][n][q]; hv[n * 4 + q] = g * __builtin_amdgcn_rcpf(1.0f + __expf(-g)) * up; }
                u32x4 w; w.x = cvt_pk_bf16(hv[0], hv[1]); w.y = cvt_pk_bf16(hv[2], hv[3]); w.z = cvt_pk_bf16(hv[4], hv[5]); w.w = cvt_pk_bf16(hv[6], hv[7]);
                *(u32x4*)rowp = w; }
    }
};

template <class Epi, class Sched, bool ALIGN_EPI = false, bool SP2 = false>
__device__ __forceinline__ void gemm_phase(LAS unsigned char* lds, const Gemm g, const Sched& S, const Epi& E) {
    const int tid = threadIdx.x, wid = __builtin_amdgcn_readfirstlane(tid >> 6), lane = tid & 63, wr = wid >> 2, wc = wid & 3, fr = lane & 15, fq = lane >> 4;
    const int K = g.K, nt = K / BK, lda = g.lda;
    unsigned voffA[2], voffB[2];
#pragma unroll
    for (int i = 0; i < 2; ++i) { int R, C; stage_rc(tid * 16 + i * 8192, R, C); const int Rb = Epi::PERM ? ((R & ~31) + perm32(R & 31)) : R;
        voffA[i] = (unsigned)(R * lda + C) * 2u; voffB[i] = (unsigned)(Rb * K + C) * 2u; }
    const size_t kstep = (size_t)(BK * 2);
    const size_t hA = (size_t)HALF * lda * 2, hB = (size_t)HALF * K * 2;
    const size_t tA = 2 * hA, tB = 2 * hB;
    const unsigned ldsw = (unsigned)wid * 1024u;
    const int aoff = lds_byte(wr * 64 + fr, fq * 8), boff = lds_byte(wc * 32 + fr, fq * 8);
#define PG8_SA(b, h) (((b) * 2 + (h)) * HTB)
#define PG8_SB(b, h) ((4 + (b) * 2 + (h)) * HTB)
#define PG8_STAGE(bufoff, gbase, voff) do { _Pragma("unroll") for (int _i = 0; _i < 2; ++_i) \
        __builtin_amdgcn_global_load_lds((const unsigned*)((const char*)(gbase) + (voff)[_i]), (LAS unsigned*)(lds + (bufoff) + ldsw + _i * 8192), 16, 0, 0); } while (0)
#define PG8_LDA(dst, b, h) do { _Pragma("unroll") for (int m = 0; m < 4; ++m) _Pragma("unroll") for (int k = 0; k < 2; ++k) dst[m][k] = *(const LAS bf16x8*)(lds + PG8_SA(b, h) + aoff + m * 2048 + k * 1024); } while (0)
#define PG8_LDB(dst, b, h) do { _Pragma("unroll") for (int n = 0; n < 2; ++n) _Pragma("unroll") for (int k = 0; k < 2; ++k) dst[n][k] = *(const LAS bf16x8*)(lds + PG8_SB(b, h) + boff + n * 2048 + k * 1024); } while (0)
#define PG8_MMA(ai, bj, At, Bt) do { __builtin_amdgcn_s_setprio(1); _Pragma("unroll") for (int m = 0; m < 4; ++m) _Pragma("unroll") for (int n = 0; n < 2; ++n) _Pragma("unroll") for (int k = 0; k < 2; ++k) \
        acc[ai][bj][m][n] = __builtin_amdgcn_mfma_f32_16x16x32_bf16(Bt[n][k], At[m][k], acc[ai][bj][m][n], 0, 0, 0); __builtin_amdgcn_s_setprio(0); } while (0)
#define PG8_WAIT_V(n) asm volatile("s_waitcnt vmcnt(" #n ")" ::: "memory")
#define PG8_WAIT_L(n) asm volatile("s_waitcnt lgkmcnt(" #n ")" ::: "memory")
#define PG8_BAR __builtin_amdgcn_s_barrier()
#define PG8_SCHED __builtin_amdgcn_sched_barrier(0)
    Unit cur, nxt; int ui = 0;
    if (!S.next(0, cur)) return;
    f32x4 acc[2][2][4][2];
#pragma unroll
    for (int a = 0; a < 2; ++a)
#pragma unroll
        for (int b = 0; b < 2; ++b)
#pragma unroll
            for (int m = 0; m < 4; ++m)
#pragma unroll
                for (int n = 0; n < 2; ++n) acc[a][b][m][n] = (f32x4){0.f, 0.f, 0.f, 0.f};
    bf16x8 At[4][2], B0[2][2], B1[2][2];
    const char* cA = (const char*)g.A + (size_t)cur.pm * tA; const char* cB = (const char*)g.Bt + (size_t)cur.pn * tB;
    S.a_ready(cur);
    if constexpr (SP2) {
        PG8_STAGE(PG8_SB(0, 0), cB, voffB); PG8_STAGE(PG8_SB(0, 1), cB + hB, voffB); PG8_STAGE(PG8_SA(0, 0), cA, voffA); PG8_STAGE(PG8_SA(0, 1), cA + hA, voffA);
        if (wr == 1) PG8_BAR;
        PG8_WAIT_V(2); PG8_BAR;
        PG8_STAGE(PG8_SB(1, 0), cB + kstep, voffB); PG8_STAGE(PG8_SA(1, 0), cA + kstep, voffA); PG8_STAGE(PG8_SB(1, 1), cB + hB + kstep, voffB);
        PG8_WAIT_V(6); PG8_BAR;
    } else {
        PG8_STAGE(PG8_SB(0, 0), cB, voffB); PG8_STAGE(PG8_SA(0, 0), cA, voffA); PG8_STAGE(PG8_SB(0, 1), cB + hB, voffB); PG8_STAGE(PG8_SA(0, 1), cA + hA, voffA);
        if (wr == 1) PG8_BAR;
        PG8_WAIT_V(4); PG8_BAR;
        PG8_STAGE(PG8_SB(1, 0), cB + kstep, voffB); PG8_STAGE(PG8_SA(1, 0), cA + kstep, voffA); PG8_STAGE(PG8_SB(1, 1), cB + hB + kstep, voffB);
        PG8_WAIT_V(6); PG8_BAR;
    }
    for (;;) {
        const bool has_next = S.next(ui + 1, nxt);
        const char* nA = has_next ? (const char*)g.A + (size_t)nxt.pm * tA : cA; const char* nB = has_next ? (const char*)g.Bt + (size_t)nxt.pn * tB : cB;
        for (int t = 0; t < nt; t += 2) {
            const bool last = (t == nt - 2);
            const char* a1 = cA + (size_t)(t + 1) * kstep;
            const char* a2 = last ? nA : cA + (size_t)(t + 2) * kstep; const char* b2 = last ? nB : cB + (size_t)(t + 2) * kstep;
            const char* a3 = a2 + kstep; const char* b3 = b2 + kstep;
            if (last && has_next) S.a_ready(nxt);
            if constexpr (SP2) {
            PG8_LDB(B0, 0, 0); PG8_LDB(B1, 0, 1); PG8_SCHED; PG8_LDA(At, 0, 0); PG8_STAGE(PG8_SA(1, 1), a1 + hA, voffA);
            PG8_WAIT_V(8); PG8_WAIT_L(0); PG8_BAR; PG8_MMA(0, 0, At, B0); PG8_MMA(0, 1, At, B1); PG8_BAR; PG8_SCHED;
            PG8_LDA(At, 0, 1); PG8_STAGE(PG8_SB(0, 0), b2, voffB); PG8_STAGE(PG8_SB(0, 1), b2 + hB, voffB); PG8_STAGE(PG8_SA(0, 0), a2, voffA);
            PG8_WAIT_V(8); PG8_WAIT_L(0); PG8_BAR; PG8_MMA(1, 0, At, B0); PG8_MMA(1, 1, At, B1); PG8_BAR; PG8_SCHED;
            PG8_LDB(B0, 1, 0); PG8_LDB(B1, 1, 1); PG8_SCHED; PG8_LDA(At, 1, 0); PG8_STAGE(PG8_SA(0, 1), a2 + hA, voffA);
            PG8_WAIT_V(8); PG8_WAIT_L(0); PG8_BAR; PG8_MMA(0, 0, At, B0); PG8_MMA(0, 1, At, B1); PG8_BAR; PG8_SCHED;
            PG8_LDA(At, 1, 1); PG8_STAGE(PG8_SB(1, 0), b3, voffB); PG8_STAGE(PG8_SB(1, 1), b3 + hB, voffB); PG8_STAGE(PG8_SA(1, 0), a3, voffA);
            PG8_WAIT_V(8); PG8_WAIT_L(0); PG8_BAR; PG8_MMA(1, 0, At, B0); PG8_MMA(1, 1, At, B1); PG8_BAR; PG8_SCHED;
            } else {
            PG8_LDB(B0, 0, 0); PG8_SCHED; PG8_LDA(At, 0, 0); PG8_STAGE(PG8_SA(1, 1), a1 + hA, voffA);
            PG8_WAIT_L(8); PG8_BAR; PG8_WAIT_L(0); PG8_MMA(0, 0, At, B0); PG8_BAR; PG8_SCHED;
            PG8_LDB(B1, 0, 1); PG8_STAGE(PG8_SB(0, 0), b2, voffB);
            PG8_BAR; PG8_WAIT_L(0); PG8_MMA(0, 1, At, B1); PG8_BAR;
            PG8_LDA(At, 0, 1); PG8_STAGE(PG8_SA(0, 0), a2, voffA);
            PG8_BAR; PG8_WAIT_L(0); PG8_MMA(1, 0, At, B0); PG8_BAR; PG8_SCHED;
            PG8_STAGE(PG8_SB(0, 1), b2 + hB, voffB);
            PG8_WAIT_V(6); PG8_BAR; PG8_MMA(1, 1, At, B1); PG8_BAR;
            PG8_LDB(B0, 1, 0); PG8_SCHED; PG8_LDA(At, 1, 0); PG8_STAGE(PG8_SA(0, 1), a2 + hA, voffA);
            PG8_WAIT_L(8); PG8_BAR; PG8_WAIT_L(0); PG8_MMA(0, 0, At, B0); PG8_BAR; PG8_SCHED;
            PG8_LDB(B1, 1, 1); PG8_STAGE(PG8_SB(1, 0), b3, voffB);
            PG8_BAR; PG8_WAIT_L(0); PG8_MMA(0, 1, At, B1); PG8_BAR;
            PG8_LDA(At, 1, 1); PG8_STAGE(PG8_SA(1, 0), a3, voffA);
            PG8_BAR; PG8_WAIT_L(0); PG8_MMA(1, 0, At, B0); PG8_BAR; PG8_SCHED;
            PG8_STAGE(PG8_SB(1, 1), b3 + hB, voffB);
            PG8_WAIT_V(6); PG8_BAR; PG8_MMA(1, 1, At, B1); PG8_BAR;
            }
        }
        if constexpr (ALIGN_EPI) { if (wr == 0) PG8_BAR; }
        E(acc, cur, wr, wc, fr, fq); S.done(cur);
        if (!has_next) break;
#pragma unroll
        for (int a = 0; a < 2; ++a)
#pragma unroll
            for (int b = 0; b < 2; ++b)
#pragma unroll
                for (int m = 0; m < 4; ++m)
#pragma unroll
                    for (int n = 0; n < 2; ++n) acc[a][b][m][n] = (f32x4){0.f, 0.f, 0.f, 0.f};
        cur = nxt; cA = nA; cB = nB; ++ui;
        if constexpr (ALIGN_EPI) { if (wr == 1) PG8_BAR; }
    }
    PG8_WAIT_V(0);
    if constexpr (!ALIGN_EPI) { if (wr == 0) PG8_BAR; }
    PG8_BAR;
#undef PG8_SA
#undef PG8_SB
#undef PG8_STAGE
#undef PG8_LDA
#undef PG8_LDB
#undef PG8_MMA
#undef PG8_WAIT_V
#undef PG8_WAIT_L
#undef PG8_BAR
#undef PG8_SCHED
}
}

__device__ __forceinline__ void cvt_item(const float* W, int ldw, u16* WT, int ldt, int k0, int n0, int drow0, int dcol0, LAS float* scr, int lane) {
#pragma unroll 8
    for (int i = 0; i < 32; ++i) { const int kk = 2 * i + (lane >> 5); scr[kk * 33 + (lane & 31)] = W[(size_t)(k0 + kk) * ldw + n0 + (lane & 31)]; }
    asm volatile("s_waitcnt lgkmcnt(0)" ::: "memory");
    const int c = lane & 7;
#pragma unroll
    for (int j = 0; j < 4; ++j) { const int n = (lane >> 3) + 8 * j; const LAS float* s = scr + (8 * c) * 33 + n;
        uint4 o; o.x = f2bf(s[0 * 33]) | (f2bf(s[1 * 33]) << 16); o.y = f2bf(s[2 * 33]) | (f2bf(s[3 * 33]) << 16); o.z = f2bf(s[4 * 33]) | (f2bf(s[5 * 33]) << 16); o.w = f2bf(s[6 * 33]) | (f2bf(s[7 * 33]) << 16);
        *(uint4*)(WT + (size_t)(drow0 + n) * ldt + dcol0 + k0 + 8 * c) = o; }
    asm volatile("s_waitcnt lgkmcnt(0)" ::: "memory");
}
template <class RowMap>
__device__ __forceinline__ void cvt_matrix(const float* W, int K, int N, u16* WT, int ldt, int dcol0, const RowMap& rowmap, LAS float* scr, int lane, int gw, int NGW, int& off) {
    const int nblk = N / 32, nitems = (K / 64) * nblk;
    int it = (gw - off) % NGW; if (it < 0) it += NGW;
    for (; it < nitems; it += NGW) { const int kb = it / nblk, nb = it % nblk; cvt_item(W, N, WT, ldt, kb * 64, nb * 32, rowmap(nb * 32), dcol0, scr, lane); }
    off = (off + nitems) % NGW;
}

__global__ void __launch_bounds__(512, 2) fwd_kernel(Args args) {
    extern __shared__ __attribute__((aligned(16))) unsigned char lds_raw[];
    LAS unsigned char* lds = (LAS unsigned char*)lds_raw;
    const int tid = threadIdx.x, lane = tid & 63, wave = __builtin_amdgcn_readfirstlane(tid >> 6);
    const int G = gridDim.x, gw = blockIdx.x * 8 + wave, NGW = G * 8;
    unsigned char* ws = args.ws;
    unsigned* ctl = (unsigned*)(ws + WS_CTL);
    volatile LAS unsigned* MISC = (volatile LAS unsigned*)(lds + MISC_OFF);
    for (int u = tid; u < (LDS_BYTES - 131072) / 4; u += 512) ((LAS unsigned*)(lds + 131072))[u] = 0u;
    __syncthreads();
    XcdBarrier bar = xcd_barrier_post(ctl + CW_BAR, MISC + 8);
    const int lo = args.ph_lo, hi = args.ph_hi;
#define IN(k) (lo <= (k) && (k) < hi)
#define GRID_BAR() xcd_barrier(bar)

    const float* x_in = args.in[0]; const float* c_in = args.in[1]; const float* ctx_in = args.in[2]; const float* cctx_in = args.in[3];
    const float* w_mod = args.in[4]; const float* b_mod = args.in[5];
    const float* g_pre_mix = args.in[6]; const float* g_post_mix = args.in[7]; const float* g_pre_ffn = args.in[8]; const float* g_post_ffn = args.in[9];
    const float* w_in_a = args.in[10]; const float* mla_g_q = args.in[11]; const float* mla_w_uq = args.in[12]; const float* mla_g_kv = args.in[13]; const float* mla_w_ukv = args.in[14];
    const float* gla_w_gf = args.in[15]; const float* gla_b_gf = args.in[16]; const float* gla_w_gb = args.in[17]; const float* gla_b_gb = args.in[18]; const float* gla_g_out = args.in[19];
    const float* w_out_a = args.in[20]; const float* w_qkv_c = args.in[21];
    const float* diff_lq1 = args.in[22]; const float* diff_lk1 = args.in[23]; const float* diff_lq2 = args.in[24]; const float* diff_lk2 = args.in[25]; const float* diff_g_out = args.in[26];
    const float* w_out_c = args.in[27]; const float* ffn_w_gate = args.in[28]; const float* ffn_w_up = args.in[29]; const float* ffn_w_down = args.in[30];
    const float* moe_w_router = args.in[31]; const float* moe_w_gate = args.in[32]; const float* moe_w_up = args.in[33]; const float* moe_w_down = args.in[34];
    float* out = args.out;
    float* MODB = (float*)(ws + WS_MOD);
    float* ROPEC = (float*)(ws + WS_ROPE); float* ROPES = ROPEC + 2048 * 32;
    int* TOKE = (int*)(ws + WS_TOKE); float* TOKG = (float*)(ws + WS_TOKG); int* TOKP = (int*)(ws + WS_TOKP);
    float* CTXS = (float*)(ws + WS_CTXS);
    u16* H0 = (u16*)(ws + WS_R0); u16* CAT = (u16*)(ws + WS_R0); u16* FB = (u16*)(ws + WS_R0); u16* O16 = (u16*)(ws + WS_R0); u16* Y2 = (u16*)(ws + WS_R0); u16* HIDC = (u16*)(ws + WS_R0);
    u16* PARTS = (u16*)(ws + WS_PARTS); u16* YB = (u16*)(ws + WS_Y); u16* HB = (u16*)(ws + WS_Y);
    u16* H1 = (u16*)(ws + WS_H1); u16* CAT2 = (u16*)(ws + WS_H1);
    u16* HC = (u16*)(ws + WS_HC); u16* XS = (u16*)(ws + WS_XS);
    u16* A2 = (u16*)(ws + WS_A2); u16* KROPE = (u16*)(ws + WS_KROPE);
    float* OF = (float*)(ws + WS_R3); float* OB = OF + (size_t)M * 512;
    u16* QKVUP = (u16*)(ws + WS_R3); u16* HID = (u16*)(ws + WS_R3); u16* QKVC = (u16*)(ws + WS_R3);
    u16* W_IN = (u16*)(ws + WS_W);
    u16* W_UP = (u16*)(ws + WS_W + 4 * MiB);
    u16* W_OA = (u16*)(ws + WS_W + 4 * MiB + 1536 * 1024);
    u16* W_FGU = (u16*)(ws + WS_W + 7 * MiB + 512 * 1024);
    u16* W_FD = (u16*)(ws + WS_W + 18 * MiB + 512 * 1024);
    u16* W_QKV = (u16*)(ws + WS_W + 24 * MiB);
    u16* W_OC = (u16*)(ws + WS_W + 30 * MiB);
    u16* W_MGU = (u16*)(ws + WS_MOEW);
    u16* W_MD = (u16*)(ws + WS_MOEW + 112 * MiB);
    auto map_id = [](int n0) { return n0; };
    auto map_gate = [](int n0) { return (n0 >> 7) * 256 + (n0 & 127); };
    auto map_up = [](int n0) { return (n0 >> 7) * 256 + 128 + (n0 & 127); };

    if (IN(0)) {
        LAS float* sT = (LAS float*)lds;
        LAS float* red = sT + 1024 * 20;
        for (int e = tid; e < 17 * 1024; e += 512) { const int r = e >> 10, k = e & 1023; const float v = r < 16 ? c_in[r * 1024 + k] : cctx_in[k]; sT[k * 20 + r] = silu_f(v); }
        __syncthreads();
        for (int g = blockIdx.x; g < 192; g += G) {
            const int l = g / 96, n = (g % 96) * 64 + lane;
            const float* wp = w_mod + (size_t)l * 1024 * 6144 + n;
            float acc[17];
#pragma unroll
            for (int r = 0; r < 17; ++r) acc[r] = 0.f;
            const int kb = wave * 128;
#pragma unroll 4
            for (int kk = 0; kk < 128; ++kk) { const int k = kb + kk; const float w = wp[(size_t)k * 6144];
                const LAS float* sp = sT + k * 20;
#pragma unroll
                for (int r = 0; r < 17; ++r) acc[r] += sp[r] * w; }
#pragma unroll
            for (int r = 0; r < 17; ++r) red[(wave * 17 + r) * 64 + lane] = acc[r];
            __syncthreads();
            for (int e = tid; e < 17 * 64; e += 512) { const int r = e >> 6, ln = e & 63; float s = 0.f;
#pragma unroll
                for (int w8 = 0; w8 < 8; ++w8) s += red[(w8 * 17 + r) * 64 + ln];
                const int nn = (g % 96) * 64 + ln;
                MODB[(size_t)(l * 17 + r) * 6144 + nn] = s + b_mod[l * 6144 + nn]; }
            __syncthreads();
        }
        for (int e = blockIdx.x * 512 + tid; e < 2048 * 32; e += G * 512) { const int t = e >> 5, i = e & 31; const int pos = i < 16 ? (t >> 6) : (t & 63);
            const float freq = powf(10000.0f, -(float)(i & 15) / 16.0f); const float ang = (float)pos * freq;
            ROPEC[e] = cosf(ang); ROPES[e] = sinf(ang); }
#if FAST_GEMM
        __syncthreads();
        { LAS float* scr = (LAS float*)(lds + wave * 8448); int off = 0;
          cvt_matrix(w_in_a, 1024, IN_A, W_IN, 1024, 0, map_id, scr, lane, gw, NGW, off);
          cvt_matrix(mla_w_uq, 256, 768, W_UP, 384, 0, map_id, scr, lane, gw, NGW, off);
          cvt_matrix(mla_w_ukv, 128, 1024, W_UP, 384, 256, [](int n0) { return 768 + n0; }, scr, lane, gw, NGW, off);
          cvt_matrix(w_out_a, 1024, 1024, W_OA, 1024, 0, map_id, scr, lane, gw, NGW, off);
          cvt_matrix(ffn_w_gate, 1024, FFN, W_FGU, 1024, 0, map_gate, scr, lane, gw, NGW, off);
          cvt_matrix(ffn_w_up, 1024, FFN, W_FGU, 1024, 0, map_up, scr, lane, gw, NGW, off);
          cvt_matrix(ffn_w_down, FFN, 1024, W_FD, FFN, 0, map_id, scr, lane, gw, NGW, off);
          cvt_matrix(w_qkv_c, 1024, 3072, W_QKV, 1024, 0, map_id, scr, lane, gw, NGW, off);
          cvt_matrix(w_out_c, 1024, 1024, W_OC, 1024, 0, map_id, scr, lane, gw, NGW, off);
          const uint4 z = make_uint4(0u, 0u, 0u, 0u);
          for (int e = blockIdx.x * 512 + tid; e < 32 * 128; e += G * 512) *(uint4*)(W_IN + (size_t)IN_A * 1024 + (size_t)e * 8) = z;
          for (int e = blockIdx.x * 512 + tid; e < 768 * 16; e += G * 512) { const int r = e >> 4, c8 = e & 15; *(uint4*)(W_UP + (size_t)r * 384 + 256 + c8 * 8) = z; }
          for (int e = blockIdx.x * 512 + tid; e < 1024 * 32; e += G * 512) { const int r = 768 + (e >> 5), c8 = e & 31; *(uint4*)(W_UP + (size_t)r * 384 + c8 * 8) = z; } }
#endif
        GRID_BAR();
    }
    if (IN(1)) {
        for (int row = gw; row < M; row += NGW) {
            const float* src = row < ML ? x_in + (size_t)row * 1024 : ctx_in + (size_t)(row - ML) * 1024;
            const int mr = row < ML ? (row >> 11) : 16;
            f32x4 xv[4], hv[4]; ld_row_f32(src, lane, xv);
            premod(xv, hv, g_pre_mix, modp(ws, 0, mr, 0), modp(ws, 0, mr, 1), lane);
            st_row_bf16(H0 + (size_t)row * 1024, lane, hv);
        }
        GRID_BAR();
    }
    if (IN(2)) {
#if FAST_GEMM
        { pg8::Gemm g{H0, W_IN, 1024, 1024}; pg8::DenseOrder S; S.init(M / 256, IN_AP / 256, G, (int)blockIdx.x); pg8::EpiStore E{PARTS, IN_AP};
          pg8::gemm_phase<pg8::EpiStore, pg8::DenseOrder, PG8_ALIGN, PG8_SP2>(lds, g, S, E); }
#else
        auto epi = [&](int r, int c, float a, float) { PARTS[(size_t)r * IN_AP + c] = (u16)f2bf(a); };
        naive_gemm<false>(lds, H0, 1024, M / 128, w_in_a, nullptr, 1024, IN_A, IN_A, nullptr, 0, epi);
#endif
        GRID_BAR();
    }
    if (IN(3)) {
        for (int row = gw; row < M; row += NGW) {
            const u16* pr = PARTS + (size_t)row * IN_AP;
            { const uint2 w = *(const uint2*)(pr + C_CQ + 4 * lane); float v[4] = {bf2f(w.x & 0xffffu), bf2f(w.x >> 16), bf2f(w.y & 0xffffu), bf2f(w.y >> 16)};
              float s = wave_sum(v[0] * v[0] + v[1] * v[1] + v[2] * v[2] + v[3] * v[3]); const float r = 1.0f / sqrtf(s * (1.0f / 256.0f) + EPS);
              const f32x4 g = *(const f32x4*)(mla_g_q + 4 * lane);
              uint2 o; o.x = f2bf(v[0] * r * g.x) | (f2bf(v[1] * r * g.y) << 16); o.y = f2bf(v[2] * r * g.z) | (f2bf(v[3] * r * g.w) << 16);
              *(uint2*)(A2 + (size_t)row * 384 + 4 * lane) = o; }
            { const unsigned w = *(const unsigned*)(pr + C_CKV + 2 * lane); float v0 = bf2f(w & 0xffffu), v1 = bf2f(w >> 16);
              float s = wave_sum(v0 * v0 + v1 * v1); const float r = 1.0f / sqrtf(s * (1.0f / 128.0f) + EPS);
              const float2 g = *(const float2*)(mla_g_kv + 2 * lane);
              *(unsigned*)(A2 + (size_t)row * 384 + 256 + 2 * lane) = f2bf(v0 * r * g.x) | (f2bf(v1 * r * g.y) << 16); }
            if (lane < 32) { float x1 = bf2f(pr[C_KR + lane]), x2 = bf2f(pr[C_KR + 32 + lane]);
              if (row < ML) { const int t = row & 2047; const float cs = ROPEC[t * 32 + lane], sn = ROPES[t * 32 + lane]; const float n1 = x1 * cs - x2 * sn, n2 = x2 * cs + x1 * sn; x1 = n1; x2 = n2; }
              KROPE[(size_t)row * 64 + lane] = (u16)f2bf(x1); KROPE[(size_t)row * 64 + 32 + lane] = (u16)f2bf(x2); }
        }
        GRID_BAR();
    }
    if (IN(4)) {
        LAS float* qs = (LAS float*)lds;
        LAS float* ks = qs + 16 * 64;
        LAS float* as = ks + 16 * 64;
        LAS float* vs = as + 16 * 64;
        LAS float* opart = vs + 16 * 128;
        for (int u = blockIdx.x; u < 128; u += G) {
            const int dir = u & 1, h = (u >> 1) & 3, b = u >> 3;
            const float* wg = dir ? gla_w_gb : gla_w_gf; const float* bg = dir ? gla_b_gb : gla_b_gf; const int caf = dir ? C_AB : C_AF;
            float* Od = dir ? OB : OF;
            const int kg = tid >> 7, v = tid & 127;
            float S[16];
#pragma unroll
            for (int i = 0; i < 16; ++i) S[i] = 0.f;
            for (int sb = 0; sb < (CTXL + SEQ) / 16; ++sb) {
                __syncthreads();
                for (int e = tid; e < 16 * 64; e += 512) { const int tok = e >> 6, k = e & 63; const int n = sb * 16 + tok;
                    const int row = n < CTXL ? (ML + b * CTXL + (dir ? CTXL - 1 - n : n)) : (b * SEQ + (dir ? SEQ - 1 - (n - CTXL) : (n - CTXL)));
                    const u16* pr = PARTS + (size_t)row * IN_AP;
                    float pre = bg[h * 64 + k];
#pragma unroll
                    for (int jj = 0; jj < 16; ++jj) pre += bf2f(pr[caf + jj]) * wg[jj * 256 + h * 64 + k];
                    const float ls = fminf(pre, 0.f) - log1pf(__expf(-fabsf(pre)));
                    qs[e] = bf2f(pr[C_GQ + h * 64 + k]) * 0.125f; ks[e] = bf2f(pr[C_GK + h * 64 + k]); as[e] = __expf(ls * (1.0f / 16.0f)); }
                for (int e = tid; e < 16 * 128; e += 512) { const int tok = e >> 7, vv = e & 127; const int n = sb * 16 + tok;
                    const int row = n < CTXL ? (ML + b * CTXL + (dir ? CTXL - 1 - n : n)) : (b * SEQ + (dir ? SEQ - 1 - (n - CTXL) : (n - CTXL)));
                    vs[e] = bf2f(PARTS[(size_t)row * IN_AP + C_GV + h * 128 + vv]); }
                __syncthreads();
                for (int tok = 0; tok < 16; ++tok) { const float vv = vs[tok * 128 + v]; float po = 0.f;
#pragma unroll
                    for (int i = 0; i < 16; ++i) { const int k = kg * 16 + i; S[i] = as[tok * 64 + k] * S[i] + ks[tok * 64 + k] * vv; po += qs[tok * 64 + k] * S[i]; }
                    opart[(tok * 4 + kg) * 128 + v] = po; }
                __syncthreads();
                for (int e = tid; e < 16 * 128; e += 512) { const int tok = e >> 7, vv = e & 127; const int n = sb * 16 + tok;
                    const int row = n < CTXL ? (ML + b * CTXL + (dir ? CTXL - 1 - n : n)) : (b * SEQ + (dir ? SEQ - 1 - (n - CTXL) : (n - CTXL)));
                    Od[(size_t)row * 512 + h * 128 + vv] = (opart[(tok * 4 + 0) * 128 + vv] + opart[(tok * 4 + 1) * 128 + vv]) + (opart[(tok * 4 + 2) * 128 + vv] + opart[(tok * 4 + 3) * 128 + vv]); }
            }
        }
        GRID_BAR();
    }
    if (IN(5)) {
        for (int row = gw; row < M; row += NGW) {
            const int h = lane >> 4, v0 = (lane & 15) * 8;
            const float* pf = OF + (size_t)row * 512 + h * 128 + v0; const float* pb = OB + (size_t)row * 512 + h * 128 + v0;
            float o[8]; float s = 0.f;
#pragma unroll
            for (int i = 0; i < 8; ++i) { o[i] = pf[i] + pb[i]; s += o[i] * o[i]; }
#pragma unroll
            for (int off = 1; off < 16; off <<= 1) s += __shfl_xor(s, off);
            const float r = 1.0f / sqrtf(s * (1.0f / 128.0f) + EPS);
            const u16* pr = PARTS + (size_t)row * IN_AP + C_GR + h * 128 + v0;
            u16* po = CAT + (size_t)row * 1024 + 512 + h * 128 + v0;
#pragma unroll
            for (int i = 0; i < 8; ++i) po[i] = (u16)f2bf(o[i] * r * gla_g_out[v0 + i] * silu_f(bf2f(pr[i])));
        }
        GRID_BAR();
    }
    if (IN(6)) {
#if FAST_GEMM
        { pg8::Gemm g{A2, W_UP, 384, 384}; pg8::DenseOrder S; S.init(M / 256, UPN / 256, G, (int)blockIdx.x); pg8::EpiStore E{QKVUP, UPN};
          pg8::gemm_phase<pg8::EpiStore, pg8::DenseOrder, PG8_ALIGN, PG8_SP2>(lds, g, S, E); }
#else
        auto epiq = [&](int r, int c, float a, float) { QKVUP[(size_t)r * UPN + c] = (u16)f2bf(a); };
        naive_gemm<false>(lds, A2, 384, M / 128, mla_w_uq, nullptr, 256, 768, 768, nullptr, 0, epiq);
        auto epik = [&](int r, int c, float a, float) { QKVUP[(size_t)r * UPN + 768 + c] = (u16)f2bf(a); };
        naive_gemm<false>(lds, A2 + 256, 384, M / 128, mla_w_ukv, nullptr, 128, 1024, 1024, nullptr, 0, epik);
#endif
        GRID_BAR();
    }
    if (IN(7)) {
        for (int row = gw; row < ML; row += NGW) {
            const int t = row & 2047;
#pragma unroll
            for (int jj = 0; jj < 2; ++jj) { const int p = lane + 64 * jj, h = p >> 5, i = p & 31;
                u16* q = QKVUP + (size_t)row * UPN + h * 192 + 128;
                const float x1 = bf2f(q[i]), x2 = bf2f(q[32 + i]), cs = ROPEC[t * 32 + i], sn = ROPES[t * 32 + i];
                q[i] = (u16)f2bf(x1 * cs - x2 * sn); q[32 + i] = (u16)f2bf(x2 * cs + x1 * sn); }
        }
        GRID_BAR();
    }
    if (IN(8)) {
        const float scale = 0.07216878364870322f;
        const int NU_L = NB * 4 * 64, NU_X = NB * 4 * 8;
        for (int u = blockIdx.x; u < NU_L + NU_X; u += G) {
            const bool isx = u >= NU_L; const int uu = isx ? u - NU_L : u;
            const int nqb = isx ? 8 : 64;
            const int qb = uu % nqb, h = (uu / nqb) & 3, b = uu / (nqb * 4);
            const int r0 = isx ? (ML + b * CTXL + qb * 32) : (b * SEQ + qb * 32);
            const int nkeys = isx ? CTXL : (CTXL + SEQ);
            auto krow = [&](int key) { return key < CTXL ? (ML + b * CTXL + key) : (b * SEQ + key - CTXL); };
            auto ql = [&](int r, int d) { return bf2f(QKVUP[(size_t)(r0 + r) * UPN + h * 192 + d]); };
            auto kl = [&](int key, int d) { const int row = krow(key); return d < 128 ? bf2f(QKVUP[(size_t)row * UPN + 768 + h * 256 + d]) : bf2f(KROPE[(size_t)row * 64 + d - 128]); };
            auto vl = [&](int key, int d) { const int row = krow(key); return bf2f(QKVUP[(size_t)row * UPN + 768 + h * 256 + 128 + d]); };
            auto os = [&](int r, int d, float val) { CAT[(size_t)(r0 + r) * 1024 + h * 128 + d] = (u16)f2bf(val); };
            naive_attn_unit<192>(lds, nkeys, scale, ql, kl, vl, os);
        }
        GRID_BAR();
    }
    if (IN(9)) {
#if FAST_GEMM
        { pg8::Gemm g{CAT, W_OA, 1024, 1024}; pg8::DenseOrder S; S.init(M / 256, 4, G, (int)blockIdx.x); pg8::EpiStore E{YB, 1024};
          pg8::gemm_phase<pg8::EpiStore, pg8::DenseOrder, PG8_ALIGN, PG8_SP2>(lds, g, S, E); }
#else
        auto epi = [&](int r, int c, float a, float) { YB[(size_t)r * 1024 + c] = (u16)f2bf(a); };
        naive_gemm<false>(lds, CAT, 1024, M / 128, w_out_a, nullptr, 1024, 1024, 1024, nullptr, 0, epi);
#endif
        GRID_BAR();
    }
    if (IN(10)) {
        for (int row = gw; row < M; row += NGW) {
            const float* src = row < ML ? x_in + (size_t)row * 1024 : ctx_in + (size_t)(row - ML) * 1024;
            float* dst = row < ML ? out + (size_t)row * 1024 : CTXS + (size_t)(row - ML) * 1024;
            const int mr = row < ML ? (row >> 11) : 16;
            f32x4 xv[4], tv[4], hv[4]; ld_row_f32(src, lane, xv); ld_row_bf16(YB + (size_t)row * 1024, lane, tv);
            rms_apply(tv, g_post_mix, lane);
            const float* gate = modp(ws, 0, mr, 2);
#pragma unroll
            for (int j = 0; j < 4; ++j) xv[j] = xv[j] + *(const f32x4*)(gate + 4 * lane + 256 * j) * tv[j];
            st_row_f32(dst, lane, xv);
            premod(xv, hv, g_pre_ffn, modp(ws, 0, mr, 3), modp(ws, 0, mr, 4), lane);
            st_row_bf16(H1 + (size_t)row * 1024, lane, hv);
        }
        GRID_BAR();
    }
    if (IN(11)) {
#if FAST_GEMM
        { pg8::Gemm g{H1, W_FGU, 1024, 1024}; pg8::DenseOrder S; S.init(M / 256, 2 * FFN / 256, G, (int)blockIdx.x); pg8::EpiSwiglu E{HID, FFN};
          pg8::gemm_phase<pg8::EpiSwiglu, pg8::DenseOrder, PG8_ALIGN, PG8_SP2>(lds, g, S, E); }
#else
        auto epi = [&](int r, int c, float a, float b2) { HID[(size_t)r * FFN + c] = (u16)f2bf(silu_f(a) * b2); };
        naive_gemm<true>(lds, H1, 1024, M / 128, ffn_w_gate, ffn_w_up, 1024, FFN, FFN, nullptr, 0, epi);
#endif
        GRID_BAR();
    }
    if (IN(12)) {
#if FAST_GEMM
        { pg8::Gemm g{HID, W_FD, FFN, FFN}; pg8::DenseOrder S; S.init(M / 256, 4, G, (int)blockIdx.x); pg8::EpiStore E{FB, 1024};
          pg8::gemm_phase<pg8::EpiStore, pg8::DenseOrder, PG8_ALIGN, PG8_SP2>(lds, g, S, E); }
#else
        auto epi = [&](int r, int c, float a, float) { FB[(size_t)r * 1024 + c] = (u16)f2bf(a); };
        naive_gemm<false>(lds, HID, FFN, M / 128, ffn_w_down, nullptr, FFN, 1024, 1024, nullptr, 0, epi);
#endif
        GRID_BAR();
    }
    if (IN(13)) {
        for (int row = gw; row < M; row += NGW) {
            float* dst = row < ML ? out + (size_t)row * 1024 : CTXS + (size_t)(row - ML) * 1024;
            const int mr = row < ML ? (row >> 11) : 16;
            f32x4 xv[4], tv[4], hv[4]; ld_row_f32(dst, lane, xv); ld_row_bf16(FB + (size_t)row * 1024, lane, tv);
            rms_apply(tv, g_post_ffn, lane);
            const float* gate = modp(ws, 0, mr, 5);
#pragma unroll
            for (int j = 0; j < 4; ++j) xv[j] = xv[j] + *(const f32x4*)(gate + 4 * lane + 256 * j) * tv[j];
            st_row_f32(dst, lane, xv);
            premod(xv, hv, g_pre_mix + 1024, modp(ws, 1, mr, 0), modp(ws, 1, mr, 1), lane);
            st_row_bf16(HB + (size_t)row * 1024, lane, hv);
        }
        GRID_BAR();
    }
    if (IN(14)) {
#if FAST_GEMM
        { pg8::Gemm g{HB, W_QKV, 1024, 1024}; pg8::DenseOrder S; S.init(M / 256, 12, G, (int)blockIdx.x); pg8::EpiStore E{QKVC, 3072};
          pg8::gemm_phase<pg8::EpiStore, pg8::DenseOrder, PG8_ALIGN, PG8_SP2>(lds, g, S, E); }
#else
        auto epi = [&](int r, int c, float a, float) { QKVC[(size_t)r * 3072 + c] = (u16)f2bf(a); };
        naive_gemm<false>(lds, HB, 1024, M / 128, w_qkv_c, nullptr, 1024, 3072, 3072, nullptr, 0, epi);
#endif
        GRID_BAR();
    }
    if (IN(15)) {
        for (int row = gw; row < ML; row += NGW) {
            const int t = row & 2047;
#pragma unroll 4
            for (int jj = 0; jj < 16; ++jj) { const int p = lane + 64 * jj, which = p >> 9, hh = (p & 511) >> 5, i = p & 31;
                u16* q = QKVC + (size_t)row * 3072 + which * 1024 + hh * 64;
                const float x1 = bf2f(q[i]), x2 = bf2f(q[32 + i]), cs = ROPEC[t * 32 + i], sn = ROPES[t * 32 + i];
                q[i] = (u16)f2bf(x1 * cs - x2 * sn); q[32 + i] = (u16)f2bf(x2 * cs + x1 * sn); }
        }
        GRID_BAR();
    }
    if (IN(16)) {
        const int NU = NB * 16 * 64;
        for (int u = blockIdx.x; u < NU; u += G) {
            const int qb = u & 63, j = (u >> 6) & 15, b = u >> 10;
            const int r0 = b * SEQ + qb * 32;
            auto krow = [&](int key) { return key < CTXL ? (ML + b * CTXL + key) : (b * SEQ + key - CTXL); };
            auto ql = [&](int r, int d) { return bf2f(QKVC[(size_t)(r0 + r) * 3072 + j * 64 + d]); };
            auto kl = [&](int key, int d) { return bf2f(QKVC[(size_t)krow(key) * 3072 + 1024 + j * 64 + d]); };
            auto vl = [&](int key, int d) { return bf2f(QKVC[(size_t)krow(key) * 3072 + 2048 + (j >> 1) * 128 + d]); };
            auto os = [&](int r, int d, float val) { O16[(size_t)(r0 + r) * 2048 + j * 128 + d] = (u16)f2bf(val); };
            naive_attn_unit<64>(lds, CTXL + SEQ, 0.125f, ql, kl, vl, os);
        }
        GRID_BAR();
    }
    if (IN(17)) {
#if FAST_GEMM
        { LAS float* scr = (LAS float*)(lds + wave * 8448); int off = 0;
#pragma unroll 1
          for (int e = 0; e < NE; ++e) {
              cvt_matrix(moe_w_gate + (size_t)e * 1024 * ED, 1024, ED, W_MGU + (size_t)e * 2 * ED * 1024, 1024, 0, map_gate, scr, lane, gw, NGW, off);
              cvt_matrix(moe_w_up + (size_t)e * 1024 * ED, 1024, ED, W_MGU + (size_t)e * 2 * ED * 1024, 1024, 0, map_up, scr, lane, gw, NGW, off);
              cvt_matrix(moe_w_down + (size_t)e * ED * 1024, ED, 1024, W_MD + (size_t)e * 1024 * ED, ED, 0, map_id, scr, lane, gw, NGW, off); } }
#endif
        const float s1 = wave_sum(diff_lq1[lane] * diff_lk1[lane]), s2 = wave_sum(diff_lq2[lane] * diff_lk2[lane]);
        const float lam = expf(s1) - expf(s2) + LAM_INIT;
        for (int row = gw; row < ML; row += NGW) {
            const int h = lane >> 3, v0 = (lane & 7) * 16;
            const u16* p1 = O16 + (size_t)row * 2048 + (2 * h) * 128 + v0; const u16* p2 = p1 + 128;
            float o[16]; float s = 0.f;
#pragma unroll
            for (int i = 0; i < 16; ++i) { o[i] = bf2f(p1[i]) - lam * bf2f(p2[i]); s += o[i] * o[i]; }
#pragma unroll
            for (int off = 1; off < 8; off <<= 1) s += __shfl_xor(s, off);
            const float r = 1.0f / sqrtf(s * (1.0f / 128.0f) + EPS);
            u16* po = CAT2 + (size_t)row * 1024 + h * 128 + v0;
#pragma unroll
            for (int i = 0; i < 16; ++i) po[i] = (u16)f2bf(o[i] * r * diff_g_out[v0 + i] * (1.0f - LAM_INIT));
        }
        GRID_BAR();
    }
    if (IN(18)) {
#if FAST_GEMM
        { pg8::Gemm g{CAT2, W_OC, 1024, 1024}; pg8::DenseOrder S; S.init(ML / 256, 4, G, (int)blockIdx.x); pg8::EpiStore E{Y2, 1024};
          pg8::gemm_phase<pg8::EpiStore, pg8::DenseOrder, PG8_ALIGN, PG8_SP2>(lds, g, S, E); }
#else
        auto epi = [&](int r, int c, float a, float) { Y2[(size_t)r * 1024 + c] = (u16)f2bf(a); };
        naive_gemm<false>(lds, CAT2, 1024, ML / 128, w_out_c, nullptr, 1024, 1024, 1024, nullptr, 0, epi);
#endif
        GRID_BAR();
    }
    if (IN(19)) {
        LAS int* lcnt = (LAS int*)lds;
        LAS int* gbase = lcnt + 8;
        LAS int* le = gbase + 8;
        LAS int* lr = le + 256;
        LAS float* lg = (LAS float*)(lr + 256);
        for (int base = blockIdx.x * 128; base < ML; base += G * 128) {
            __syncthreads();
            if (tid < 8) lcnt[tid] = 0;
            __syncthreads();
            for (int i = 0; i < 16; ++i) {
                const int lrow = wave * 16 + i, row = base + lrow;
                float* dst = out + (size_t)row * 1024;
                const int mr = row >> 11;
                f32x4 xv[4], tv[4], hv[4]; ld_row_f32(dst, lane, xv); ld_row_bf16(Y2 + (size_t)row * 1024, lane, tv);
                rms_apply(tv, g_post_mix + 1024, lane);
                const float* gate = modp(ws, 1, mr, 2);
#pragma unroll
                for (int j = 0; j < 4; ++j) xv[j] = xv[j] + *(const f32x4*)(gate + 4 * lane + 256 * j) * tv[j];
                st_row_f32(dst, lane, xv);
                premod(xv, hv, g_pre_ffn + 1024, modp(ws, 1, mr, 3), modp(ws, 1, mr, 4), lane);
                st_row_bf16(HC + (size_t)row * 1024, lane, hv);
                float lg8[8];
#pragma unroll
                for (int e = 0; e < 8; ++e) lg8[e] = 0.f;
#pragma unroll
                for (int j = 0; j < 4; ++j)
#pragma unroll
                    for (int q = 0; q < 4; ++q) { const int k = 4 * lane + 256 * j + q; const float hvv = hv[j][q];
                        const f32x4 wa = *(const f32x4*)(moe_w_router + (size_t)k * 8), wb = *(const f32x4*)(moe_w_router + (size_t)k * 8 + 4);
                        lg8[0] += hvv * wa.x; lg8[1] += hvv * wa.y; lg8[2] += hvv * wa.z; lg8[3] += hvv * wa.w;
                        lg8[4] += hvv * wb.x; lg8[5] += hvv * wb.y; lg8[6] += hvv * wb.z; lg8[7] += hvv * wb.w; }
#pragma unroll
                for (int e = 0; e < 8; ++e) lg8[e] = wave_sum(lg8[e]);
                if (lane == 0) {
                    int e0 = 0; float v0 = lg8[0];
#pragma unroll
                    for (int e = 1; e < 8; ++e) if (lg8[e] > v0) { v0 = lg8[e]; e0 = e; }
                    int e1 = -1; float v1 = -3.0e38f;
#pragma unroll
                    for (int e = 0; e < 8; ++e) if (e != e0 && lg8[e] > v1) { v1 = lg8[e]; e1 = e; }
                    const float g0 = 1.0f / (1.0f + expf(v1 - v0));
                    le[lrow * 2] = e0; le[lrow * 2 + 1] = e1; lg[lrow * 2] = g0; lg[lrow * 2 + 1] = 1.0f - g0;
                    lr[lrow * 2] = __hip_atomic_fetch_add(&lcnt[e0], 1, __ATOMIC_RELAXED, __HIP_MEMORY_SCOPE_WORKGROUP); lr[lrow * 2 + 1] = __hip_atomic_fetch_add(&lcnt[e1], 1, __ATOMIC_RELAXED, __HIP_MEMORY_SCOPE_WORKGROUP);
                }
            }
            __syncthreads();
            if (tid < 8) gbase[tid] = (int)atomicAdd(ctl + CW_ECNT + 64 * tid, (unsigned)lcnt[tid]);
            __syncthreads();
            if (tid < 256) { const int e = le[tid]; TOKE[(size_t)base * 2 + tid] = e; TOKG[(size_t)base * 2 + tid] = lg[tid]; TOKP[(size_t)base * 2 + tid] = gbase[e] + lr[tid]; }
        }
        GRID_BAR();
    }
    if (IN(20)) {
        LAS int* pst = (LAS int*)lds;
        if (tid == 0) { int acc = 0; for (int e = 0; e < 8; ++e) { pst[e] = acc; const int c = (int)ctl[CW_ECNT + 64 * e]; acc += (c + 255) / 256 * 256; } pst[8] = acc; }
        __syncthreads();
        if (blockIdx.x == 0) {
            if (tid == 0) ctl[CW_MOET] = (unsigned)(pst[8] / 256);
            for (int t = tid; t < pst[8] / 256; t += 512) { int e = 0; for (int q = 1; q < 8; ++q) if (t * 256 >= pst[q]) e = q; ctl[CW_TILEE + t] = (unsigned)e; }
        }
        for (int s = gw; s < 2 * ML; s += NGW) {
            const int e = TOKE[s], pos = pst[e] + TOKP[s];
            const uint4* src = (const uint4*)(HC + (size_t)(s >> 1) * 1024); uint4* dstp = (uint4*)(XS + (size_t)pos * 1024);
            const uint4 a = src[lane], b2 = src[lane + 64];
            dstp[lane] = a; dstp[lane + 64] = b2;
            if (lane == 0) TOKP[s] = pos;
        }
        GRID_BAR();
    }
    if (IN(21)) {
        const int T = (int)ctl[CW_MOET];
        for (int c0 = 0; c0 < T; c0 += CHUNK_T) {
            const int nt = (T - c0) < CHUNK_T ? (T - c0) : CHUNK_T;
#if FAST_GEMM
            { pg8::Gemm g{XS, W_MGU, 1024, 1024}; pg8::MoeOrder S; S.init(nt, 2 * ED / 256, G, (int)blockIdx.x); S.tile_e = ctl + CW_TILEE + c0; S.nper = 2 * ED / 256; S.a_off = c0; S.o_off = 0;
              pg8::EpiSwiglu E{HIDC, ED};
              pg8::gemm_phase<pg8::EpiSwiglu, pg8::MoeOrder, PG8_ALIGN, PG8_SP2>(lds, g, S, E); }
#else
            { auto epi = [&](int r, int c, float a, float b2) { HIDC[(size_t)r * ED + c] = (u16)f2bf(silu_f(a) * b2); };
              naive_gemm<true>(lds, XS + (size_t)c0 * 256 * 1024, 1024, nt * 2, moe_w_gate, moe_w_up, 1024, ED, ED, ctl + CW_TILEE + c0, (size_t)1024 * ED, epi); }
#endif
            GRID_BAR();
#if FAST_GEMM
            { pg8::Gemm g{HIDC, W_MD, ED, ED}; pg8::MoeOrder S; S.init(nt, 4, G, (int)blockIdx.x); S.tile_e = ctl + CW_TILEE + c0; S.nper = 4; S.a_off = 0; S.o_off = c0;
              pg8::EpiStore E{XS, 1024};
              pg8::gemm_phase<pg8::EpiStore, pg8::MoeOrder, PG8_ALIGN, PG8_SP2>(lds, g, S, E); }
#else
            { u16* ys = XS + (size_t)c0 * 256 * 1024;
              auto epi = [&](int r, int c, float a, float) { ys[(size_t)r * 1024 + c] = (u16)f2bf(a); };
              naive_gemm<false>(lds, HIDC, ED, nt * 2, moe_w_down, nullptr, ED, 1024, 1024, ctl + CW_TILEE + c0, (size_t)ED * 1024, epi); }
#endif
            GRID_BAR();
        }
    }
    if (IN(22)) {
        for (int row = gw; row < ML; row += NGW) {
            float* dst = out + (size_t)row * 1024;
            const int mr = row >> 11;
            const int p0 = TOKP[row * 2], p1 = TOKP[row * 2 + 1]; const float g0 = TOKG[row * 2], g1 = TOKG[row * 2 + 1];
            f32x4 xv[4], a[4], b2[4]; ld_row_f32(dst, lane, xv); ld_row_bf16(XS + (size_t)p0 * 1024, lane, a); ld_row_bf16(XS + (size_t)p1 * 1024, lane, b2);
#pragma unroll
            for (int j = 0; j < 4; ++j) a[j] = a[j] * g0 + b2[j] * g1;
            rms_apply(a, g_post_ffn + 1024, lane);
            const float* gate = modp(ws, 1, mr, 5);
#pragma unroll
            for (int j = 0; j < 4; ++j) xv[j] = xv[j] + *(const f32x4*)(gate + 4 * lane + 256 * j) * a[j];
            st_row_f32(dst, lane, xv);
        }
    }
#undef IN
#undef GRID_BAR
}

extern "C" void kernel_launch(void* const* d_in, const int* in_sizes, int n_in, void* d_out, int out_size, void* d_ws, size_t ws_size, hipStream_t stream) {
    static int grid = 0;
    if (grid == 0) {
        if (n_in != 35 || in_sizes[0] != ML * D || out_size != ML * D || ws_size < WS_END) {
            fprintf(stderr, "kernel_launch: shape mismatch n_in %d in0 %d out %d ws %zu (need %zu)\n", n_in, n_in > 0 ? in_sizes[0] : -1, out_size, ws_size, (size_t)WS_END); grid = -1; return; }
        int dev = 0, cus = 0, per_cu = 0;
        if (hipGetDevice(&dev) != hipSuccess || hipDeviceGetAttribute(&cus, hipDeviceAttributeMultiprocessorCount, dev) != hipSuccess) { grid = -1; return; }
        if (hipFuncSetAttribute((const void*)fwd_kernel, hipFuncAttributeMaxDynamicSharedMemorySize, LDS_BYTES) != hipSuccess) { fprintf(stderr, "kernel_launch: hipFuncSetAttribute failed\n"); grid = -1; return; }
        if (hipOccupancyMaxActiveBlocksPerMultiprocessor(&per_cu, (const void*)fwd_kernel, 512, LDS_BYTES) != hipSuccess || per_cu < 1)
            fprintf(stderr, "kernel_launch: occupancy query reports %d\n", per_cu);
        (void)hipGetLastError();
        grid = cus;
    }
    if (grid < 0) return;
    if (hipMemsetAsync((char*)d_ws + WS_CTL, 0, CTL_ZERO_BYTES, stream) != hipSuccess) return;
    Args a{};
    for (int i = 0; i < 35; ++i) a.in[i] = (const float*)d_in[i];
    a.out = (float*)d_out; a.ws = (unsigned char*)d_ws; a.ph_lo = 0; a.ph_hi = 100;
    hipLaunchKernelGGL(fwd_kernel, dim3(grid), dim3(512), LDS_BYTES, stream, a);
}
```

```cpp
#include <hip/hip_runtime.h>
#include <cstdio>
#include <cstdint>

constexpr int D = 1024, NB = 16, SEQ = 2048, CTXL = 256;
constexpr int ML = NB * SEQ, MX = NB * CTXL, M = ML + MX;
constexpr int IN_A = 2016, IN_AP = 2048;
constexpr int C_CQ = 0, C_CKV = 256, C_KR = 384, C_GQ = 448, C_GK = 704, C_GV = 960, C_GR = 1472, C_AF = 1984, C_AB = 2000;
constexpr int UPN = 1792;
constexpr int FFN = 2816, NE = 8, ED = 3584;
constexpr int CAP = 2 * ML + NE * 256, MAXT = CAP / 256;
constexpr int CHUNK_T = 64;
constexpr float EPS = 1e-6f;
constexpr float LAM_INIT = 0.35550906759f;

constexpr size_t MiB = 1u << 20;
constexpr size_t WS_CTL = 0, CTL_ZERO_BYTES = 1 * MiB;
constexpr size_t WS_MOD = 1 * MiB;
constexpr size_t WS_ROPE = 2 * MiB;
constexpr size_t WS_TOKE = 2 * MiB + 512 * 1024;
constexpr size_t WS_TOKG = WS_TOKE + 256 * 1024;
constexpr size_t WS_TOKP = WS_TOKG + 256 * 1024;
constexpr size_t WS_CTXS = 4 * MiB;
constexpr size_t WS_W = 20 * MiB;
constexpr size_t WS_R0 = 52 * MiB;
constexpr size_t WS_PARTS = 124 * MiB;
constexpr size_t WS_Y = 124 * MiB;
constexpr size_t WS_H1 = 196 * MiB;
constexpr size_t WS_HC = 116 * MiB;
constexpr size_t WS_XS = 180 * MiB;
constexpr size_t WS_A2 = 268 * MiB;
constexpr size_t WS_KROPE = 295 * MiB;
constexpr size_t WS_R3 = 300 * MiB;
constexpr size_t WS_MOEW = 332 * MiB;
constexpr size_t WS_END = 516 * MiB;
constexpr int CW_BAR = 4096;
constexpr int CW_ECNT = 8192;
constexpr int CW_MOET = 9000;
constexpr int CW_TILEE = 9216;

typedef unsigned short u16;
typedef float f32x4 __attribute__((ext_vector_type(4)));
#define LAS __attribute__((address_space(3)))
constexpr int LDS_BYTES = 147456;
constexpr int MISC_OFF = 131072 + 320;

#define XB_TMO      128
#define XB_XCNT(j)  (256  + 64 * (j))
#define XB_XSUB(j)  (1280 + 64 * (j))
#define XB_XGEN(j)  (2304 + 64 * (j))
#define XB_TOP      3328
#define XB_TOPGEN   3392
#define XCD_BAR_WORDS 3456
#define XB_SPIN_CAP (1u << 23)
__device__ __forceinline__ unsigned xb_ld(unsigned* p)              { return __hip_atomic_load(p, __ATOMIC_RELAXED, __HIP_MEMORY_SCOPE_AGENT); }
__device__ __forceinline__ unsigned xb_add(unsigned* p, unsigned v) { return __hip_atomic_fetch_add(p, v, __ATOMIC_RELAXED, __HIP_MEMORY_SCOPE_AGENT); }
__device__ __forceinline__ unsigned xb_xcc_id() { return (unsigned)__builtin_amdgcn_s_getreg((3 << 11) | 20) & 0xFu; }
#define XB_SPIN(cond, bar) do { unsigned _sp = 0; while (cond) { __builtin_amdgcn_s_sleep(1); \
    if ((++_sp & 255u) == 0u) { if (xb_ld(&(bar)[XB_TMO])) break; if (_sp > XB_SPIN_CAP) { atomicAdd(&(bar)[XB_TMO], 1u); break; } } } } while (0)
struct XcdBarrier { unsigned* bar; unsigned x; volatile LAS unsigned* st; };
__device__ __forceinline__ XcdBarrier xcd_barrier_post(unsigned* bar, volatile LAS unsigned* st) {
    XcdBarrier b; b.bar = bar; b.x = xb_xcc_id(); b.st = st;
    if (threadIdx.x == 0) (void)xb_add(&bar[XB_XCNT(b.x)], 1u);
    return b;
}
__device__ __forceinline__ void xcd_barrier_complete(unsigned* bar, unsigned x, unsigned& nloc, unsigned& nx) {
    const unsigned G = gridDim.x * gridDim.y * gridDim.z;
    unsigned sum, cnt, mine, sp = 0u;
    for (;;) {
        sum = 0u; cnt = 0u; mine = 0u;
#pragma unroll
        for (unsigned j = 0; j < 16; ++j) { const unsigned c = xb_ld(&bar[XB_XCNT(j)]); sum += c; cnt += (c > 0u) ? 1u : 0u; mine = (j == x) ? c : mine; }
        if (sum == G) break;
        __builtin_amdgcn_s_sleep(1);
        if ((++sp & 255u) == 0u) { if (xb_ld(&bar[XB_TMO])) break; if (sp > XB_SPIN_CAP) { atomicAdd(&bar[XB_TMO], 1u); break; } }
    }
    nloc = mine > 0u ? mine : 1u; nx = cnt > 0u ? cnt : 1u;
}
__device__ __forceinline__ void xcd_barrier(const XcdBarrier& b) {
    asm volatile("s_waitcnt vmcnt(0)" ::: "memory");
    __syncthreads();
    if (threadIdx.x == 0) {
        unsigned* bar = b.bar;
        __builtin_amdgcn_s_waitcnt(0);
        unsigned nloc = b.st[0], nx = b.st[1];
        if (nloc == 0u) { xcd_barrier_complete(bar, b.x, nloc, nx); b.st[0] = nloc; b.st[1] = nx; }
        const unsigned old = xb_add(&bar[XB_XSUB(b.x)], 1u);
        const unsigned gen = old / nloc;
        if (old + 1u == (gen + 1u) * nloc) {
            __builtin_amdgcn_fence(__ATOMIC_RELEASE, "agent");
            asm volatile("s_waitcnt vmcnt(0)" ::: "memory");
            const unsigned og = xb_add(&bar[XB_TOP], 1u);
            const unsigned tg = og / nx;
            if (og + 1u == (tg + 1u) * nx) xb_add(&bar[XB_TOPGEN], 1u);
            else XB_SPIN(xb_ld(&bar[XB_TOPGEN]) == tg, bar);
            __builtin_amdgcn_fence(__ATOMIC_ACQUIRE, "agent");
            xb_add(&bar[XB_XGEN(b.x)], 1u);
            asm volatile("s_waitcnt vmcnt(0)" ::: "memory");
        } else {
            XB_SPIN(xb_ld(&bar[XB_XGEN(b.x)]) == gen, bar);
            __builtin_amdgcn_fence(__ATOMIC_ACQUIRE, "agent");
            asm volatile("s_waitcnt vmcnt(0)" ::: "memory");
        }
    }
    __syncthreads();
}

__device__ __forceinline__ float bf2f(unsigned h) { return __uint_as_float(h << 16); }
__device__ __forceinline__ unsigned f2bf(float f) { unsigned u = __float_as_uint(f); return (u + 0x7fffu + ((u >> 16) & 1u)) >> 16; }
__device__ __forceinline__ float wave_sum(float v) {
#pragma unroll
    for (int o = 1; o < 64; o <<= 1) v += __shfl_xor(v, o);
    return v;
}
__device__ __forceinline__ float silu_f(float x) { return x / (1.0f + __expf(-x)); }
__device__ __forceinline__ void ld_row_f32(const float* p, int lane, f32x4 (&v)[4]) {
#pragma unroll
    for (int j = 0; j < 4; ++j) v[j] = *(const f32x4*)(p + 4 * lane + 256 * j);
}
__device__ __forceinline__ void ld_row_bf16(const u16* p, int lane, f32x4 (&v)[4]) {
#pragma unroll
    for (int j = 0; j < 4; ++j) { const uint2 w = *(const uint2*)(p + 4 * lane + 256 * j);
        v[j] = (f32x4){bf2f(w.x & 0xffffu), bf2f(w.x >> 16), bf2f(w.y & 0xffffu), bf2f(w.y >> 16)}; }
}
__device__ __forceinline__ void st_row_f32(float* p, int lane, const f32x4 (&v)[4]) {
#pragma unroll
    for (int j = 0; j < 4; ++j) *(f32x4*)(p + 4 * lane + 256 * j) = v[j];
}
__device__ __forceinline__ void st_row_bf16(u16* p, int lane, const f32x4 (&v)[4]) {
#pragma unroll
    for (int j = 0; j < 4; ++j) { uint2 w; w.x = f2bf(v[j].x) | (f2bf(v[j].y) << 16); w.y = f2bf(v[j].z) | (f2bf(v[j].w) << 16);
        *(uint2*)(p + 4 * lane + 256 * j) = w; }
}
__device__ __forceinline__ float row_rstd(const f32x4 (&v)[4]) {
    float s = 0.f;
#pragma unroll
    for (int j = 0; j < 4; ++j) s += (v[j].x * v[j].x + v[j].y * v[j].y) + (v[j].z * v[j].z + v[j].w * v[j].w);
    s = wave_sum(s);
    return 1.0f / sqrtf(s * (1.0f / 1024.0f) + EPS);
}
__device__ __forceinline__ void rms_apply(f32x4 (&v)[4], const float* g, int lane) {
    const float r = row_rstd(v);
#pragma unroll
    for (int j = 0; j < 4; ++j) { const f32x4 gg = *(const f32x4*)(g + 4 * lane + 256 * j); v[j] = v[j] * r * gg; }
}
__device__ __forceinline__ void premod(const f32x4 (&x)[4], f32x4 (&h)[4], const float* g, const float* shift, const float* scale, int lane) {
    const float r = row_rstd(x);
#pragma unroll
    for (int j = 0; j < 4; ++j) { const int c = 4 * lane + 256 * j; const f32x4 gg = *(const f32x4*)(g + c), sh = *(const f32x4*)(shift + c), sc = *(const f32x4*)(scale + c);
        h[j] = x[j] * r * gg * (1.0f + sc) + sh; }
}

struct Args { const float* in[35]; float* out; unsigned char* ws; int ph_lo, ph_hi; };

__device__ __forceinline__ const float* modp(const unsigned char* ws, int l, int r, int which) { return (const float*)(ws + WS_MOD) + ((size_t)(l * 17 + r) * 6 + which) * 1024; }

template <bool DUAL, class Epi>
__device__ __forceinline__ void naive_gemm(LAS unsigned char* lds, const u16* A, int lda, int ntiles_m, const float* W0, const float* W1, int K, int N, int ldw,
                                           const unsigned* tile_e, size_t estride, const Epi& epi) {
    LAS float* As = (LAS float*)lds;
    LAS float* Ws0 = As + 16 * 132;
    LAS float* Ws1 = Ws0 + 16 * 64;
    const int tid = threadIdx.x, ty = tid >> 4, tx = tid & 15;
    const int ntn = (N + 63) / 64;
    const int total = ntiles_m * ntn;
    for (int u = blockIdx.x; u < total; u += gridDim.x) {
        const int tm = u / ntn, tn = u % ntn;
        const int row0 = tm * 128, col0 = tn * 64;
        const float* w0 = W0; const float* w1 = W1;
        if (tile_e) { const unsigned e = tile_e[tm >> 1]; w0 += (size_t)e * estride; if (DUAL) w1 += (size_t)e * estride; }
        float acc0[4][4], acc1[4][4];
#pragma unroll
        for (int i = 0; i < 4; ++i)
#pragma unroll
            for (int j = 0; j < 4; ++j) { acc0[i][j] = 0.f; acc1[i][j] = 0.f; }
        for (int k0 = 0; k0 < K; k0 += 16) {
            { const int r = tid >> 2, kq = (tid & 3) * 4; const uint2 w = *(const uint2*)(A + (size_t)(row0 + r) * lda + k0 + kq);
              As[(kq + 0) * 132 + r] = bf2f(w.x & 0xffffu); As[(kq + 1) * 132 + r] = bf2f(w.x >> 16);
              As[(kq + 2) * 132 + r] = bf2f(w.y & 0xffffu); As[(kq + 3) * 132 + r] = bf2f(w.y >> 16); }
            { const int kk = tid >> 5, n = (tid & 31) * 2, c = col0 + n;
              float a = 0.f, b = 0.f;
              if (c < N) { const float2 t = *(const float2*)(w0 + (size_t)(k0 + kk) * ldw + c); a = t.x; b = t.y; }
              Ws0[kk * 64 + n] = a; Ws0[kk * 64 + n + 1] = b;
              if (DUAL) { float a1 = 0.f, b1 = 0.f;
                  if (c < N) { const float2 t = *(const float2*)(w1 + (size_t)(k0 + kk) * ldw + c); a1 = t.x; b1 = t.y; }
                  Ws1[kk * 64 + n] = a1; Ws1[kk * 64 + n + 1] = b1; } }
            __syncthreads();
#pragma unroll
            for (int kk = 0; kk < 16; ++kk) {
                const f32x4 a = *(const LAS f32x4*)(As + kk * 132 + ty * 4);
                const f32x4 b = *(const LAS f32x4*)(Ws0 + kk * 64 + tx * 4);
#pragma unroll
                for (int i = 0; i < 4; ++i)
#pragma unroll
                    for (int j = 0; j < 4; ++j) acc0[i][j] += a[i] * b[j];
                if (DUAL) { const f32x4 b1 = *(const LAS f32x4*)(Ws1 + kk * 64 + tx * 4);
#pragma unroll
                    for (int i = 0; i < 4; ++i)
#pragma unroll
                        for (int j = 0; j < 4; ++j) acc1[i][j] += a[i] * b1[j]; }
            }
            __syncthreads();
        }
#pragma unroll
        for (int i = 0; i < 4; ++i)
#pragma unroll
            for (int j = 0; j < 4; ++j) { const int r = row0 + ty * 4 + i, c = col0 + tx * 4 + j; if (c < N) epi(r, c, acc0[i][j], acc1[i][j]); }
    }
}

template <int DQ, class QL, class KL, class VL, class OS>
__device__ __forceinline__ void naive_attn_unit(LAS unsigned char* lds, int nkeys, float scale, const QL& ql, const KL& kl, const VL& vl, const OS& os) {
    LAS float* Qs = (LAS float*)lds;
    LAS float* Ks = Qs + 32 * (DQ + 1);
    LAS float* Vs = Ks + 64 * (DQ + 1);
    LAS float* Ps = Vs + 64 * 128;
    const int tid = threadIdx.x, r = tid >> 4, j = tid & 15;
    __syncthreads();
    for (int e = tid; e < 32 * DQ; e += 512) { const int rr = e / DQ, d = e % DQ; Qs[rr * (DQ + 1) + d] = ql(rr, d); }
    float m = -1e30f, l = 0.f, o[8];
#pragma unroll
    for (int dd = 0; dd < 8; ++dd) o[dd] = 0.f;
    for (int k0 = 0; k0 < nkeys; k0 += 64) {
        __syncthreads();
        for (int e = tid; e < 64 * DQ; e += 512) { const int key = e / DQ, d = e % DQ; Ks[key * (DQ + 1) + d] = kl(k0 + key, d); }
        for (int e = tid; e < 64 * 128; e += 512) { const int key = e >> 7, d = e & 127; Vs[key * 128 + d] = vl(k0 + key, d); }
        __syncthreads();
        float s[4];
#pragma unroll
        for (int c = 0; c < 4; ++c) { const LAS float* kp = Ks + (j + 16 * c) * (DQ + 1); const LAS float* qp = Qs + r * (DQ + 1); float a = 0.f;
            for (int d = 0; d < DQ; ++d) a += qp[d] * kp[d];
            s[c] = a * scale; }
        float tmax = fmaxf(fmaxf(s[0], s[1]), fmaxf(s[2], s[3]));
#pragma unroll
        for (int off = 1; off < 16; off <<= 1) tmax = fmaxf(tmax, __shfl_xor(tmax, off));
        const float mn = fmaxf(m, tmax), alpha = __expf(m - mn);
        float ps = 0.f;
#pragma unroll
        for (int c = 0; c < 4; ++c) { const float p = __expf(s[c] - mn); Ps[r * 64 + j + 16 * c] = p; ps += p; }
#pragma unroll
        for (int off = 1; off < 16; off <<= 1) ps += __shfl_xor(ps, off);
        l = l * alpha + ps; m = mn;
#pragma unroll
        for (int dd = 0; dd < 8; ++dd) o[dd] *= alpha;
        __syncthreads();
        for (int key = 0; key < 64; ++key) { const float p = Ps[r * 64 + key]; const LAS float* vp = Vs + key * 128 + j * 8;
#pragma unroll
            for (int dd = 0; dd < 8; ++dd) o[dd] += p * vp[dd]; }
    }
    const float il = 1.0f / l;
#pragma unroll
    for (int dd = 0; dd < 8; ++dd) os(r, j * 8 + dd, o[dd] * il);
}


#ifndef FAST_GEMM
#define FAST_GEMM 1
#endif
#ifndef PG8_SP2
#define PG8_SP2 true
#endif
#ifndef PG8_ALIGN
#define PG8_ALIGN true
#endif
namespace pg8 {
typedef short bf16x8 __attribute__((ext_vector_type(8)));
typedef unsigned u32x4 __attribute__((ext_vector_type(4)));
constexpr int BM = 256, BK = 64, HALF = 128, HTB = HALF * BK * 2, STAGE_BYTES = 8 * HTB, NXCD = 8, WGM = 8;
__host__ __device__ __forceinline__ int lds_byte(int r, int c) { const int st = (r >> 4) * 2 + (c >> 5), rr = r & 15, cc = c & 31, ob = rr * 64 + cc * 2; return st * 1024 + (ob ^ (((ob >> 9) & 1) << 5)); }
__host__ __device__ __forceinline__ void stage_rc(int b, int& R, int& C) { const int st = b / 1024, sb = b % 1024, swz = sb ^ (((sb >> 9) & 1) << 5); R = (st >> 1) * 16 + swz / 64; C = (st & 1) * 32 + (swz % 64) / 2; }
__host__ __device__ __forceinline__ int perm32(int rho) { const int n = rho >> 4, i = rho & 15; return 8 * (i >> 2) + 4 * n + (i & 3); }

struct Unit { int pm, pn, po, pc; };
struct Gemm { const u16* A; const u16* Bt; int lda; int K; };

struct DenseOrder {
    int nM, nN, nwg, G, c;
    __device__ __forceinline__ void init(int nM_, int nN_, int G_, int c_) { nM = nM_; nN = nN_; nwg = nM * nN; G = G_; c = c_; }
    __device__ __forceinline__ bool next2(int i, int& pm, int& pn) const {
        const long L = (long)i * G + c; if (L >= nwg) return false;
        int wgid = (int)L; { const int q = nwg / NXCD, r = nwg % NXCD, xcd = wgid % NXCD, off = wgid / NXCD; wgid = (xcd < r ? xcd * (q + 1) : r * (q + 1) + (xcd - r) * q) + off; }
        const int nig = WGM * nN, gid = wgid / nig, fm = gid * WGM, gsz = (nM - fm) < WGM ? (nM - fm) : WGM;
        pm = fm + ((wgid % nig) % gsz); pn = (wgid % nig) / gsz; return true;
    }
    __device__ __forceinline__ bool next(int i, Unit& u) const { int pm, pn; if (!next2(i, pm, pn)) return false; u.pm = pm; u.pn = pn; u.po = pm; u.pc = pn; return true; }
    __device__ __forceinline__ void a_ready(const Unit&) const {}
    __device__ __forceinline__ void done(const Unit&) const {}
};
struct MoeOrder : DenseOrder {
    const unsigned* tile_e; int nper, a_off, o_off;
    __device__ __forceinline__ bool next(int i, Unit& u) const { int pm, pn; if (!next2(i, pm, pn)) return false;
        const int e = (int)tile_e[pm]; u.pm = a_off + pm; u.pn = e * nper + pn; u.po = o_off + pm; u.pc = pn; return true; }
};

__device__ __forceinline__ unsigned cvt_pk_bf16(float lo, float hi) { unsigned r; asm volatile("v_cvt_pk_bf16_f32 %0, %1, %2" : "=v"(r) : "v"(lo), "v"(hi)); return r; }

struct EpiStore {
    static constexpr bool PERM = true, AFTER_DRAIN = false;
    u16* O; int ldc;
    __device__ __forceinline__ void operator()(const f32x4 (&acc)[2][2][4][2], const Unit& u, int wr, int wc, int fr, int fq) const {
        const int row0 = u.po * BM + wr * 64 + fr, col0 = u.pc * BM + wc * 32 + 8 * fq;
#pragma unroll
        for (int ai = 0; ai < 2; ++ai)
#pragma unroll
            for (int m = 0; m < 4; ++m) { u16* rowp = O + (size_t)(row0 + ai * HALF + m * 16) * ldc + col0;
#pragma unroll
                for (int bj = 0; bj < 2; ++bj) { const f32x4 v0 = acc[ai][bj][m][0], v1 = acc[ai][bj][m][1];
                    u32x4 w; w.x = cvt_pk_bf16(v0[0], v0[1]); w.y = cvt_pk_bf16(v0[2], v0[3]); w.z = cvt_pk_bf16(v1[0], v1[1]); w.w = cvt_pk_bf16(v1[2], v1[3]);
                    *(u32x4*)(rowp + bj * HALF) = w; } }
    }
};
struct EpiSwiglu {
    static constexpr bool PERM = true, AFTER_DRAIN = false;
    u16* O; int ldc;
    __device__ __forceinline__ void operator()(const f32x4 (&acc)[2][2][4][2], const Unit& u, int wr, int wc, int fr, int fq) const {
        const int row0 = u.po * BM + wr * 64 + fr, col0 = u.pc * HALF + wc * 32 + 8 * fq;
#pragma unroll
        for (int ai = 0; ai < 2; ++ai)
#pragma unroll
            for (int m = 0; m < 4; ++m) { u16* rowp = O + (size_t)(row0 + ai * HALF + m * 16) * ldc + col0;
                float hv[8];
#pragma unroll
                for (int n = 0; n < 2; ++n)
#pragma unroll
                    for (int q = 0; q < 4; ++q) { const float g = acc[ai][0][m][n][q], up = acc[ai][1][m][n][q]; hv[n * 4 + q] = g * __builtin_amdgcn_rcpf(1.0f + __expf(-g)) * up; }
                u32x4 w; w.x = cvt_pk_bf16(hv[0], hv[1]); w.y = cvt_pk_bf16(hv[2], hv[3]); w.z = cvt_pk_bf16(hv[4], hv[5]); w.w = cvt_pk_bf16(hv[6], hv[7]);
                *(u32x4*)rowp = w; }
    }
};

template <class Epi, class Sched, bool ALIGN_EPI = false, bool SP2 = false>
__device__ __forceinline__ void gemm_phase(LAS unsigned char* lds, const Gemm g, const Sched& S, const Epi& E) {
    const int tid = threadIdx.x, wid = __builtin_amdgcn_readfirstlane(tid >> 6), lane = tid & 63, wr = wid >> 2, wc = wid & 3, fr = lane & 15, fq = lane >> 4;
    const int K = g.K, nt = K / BK, lda = g.lda;
    unsigned voffA[2], voffB[2];
#pragma unroll
    for (int i = 0; i < 2; ++i) { int R, C; stage_rc(tid * 16 + i * 8192, R, C); const int Rb = Epi::PERM ? ((R & ~31) + perm32(R & 31)) : R;
        voffA[i] = (unsigned)(R * lda + C) * 2u; voffB[i] = (unsigned)(Rb * K + C) * 2u; }
    const size_t kstep = (size_t)(BK * 2);
    const size_t hA = (size_t)HALF * lda * 2, hB = (size_t)HALF * K * 2;
    const size_t tA = 2 * hA, tB = 2 * hB;
    const unsigned ldsw = (unsigned)wid * 1024u;
    const int aoff = lds_byte(wr * 64 + fr, fq * 8), boff = lds_byte(wc * 32 + fr, fq * 8);
#define PG8_SA(b, h) (((b) * 2 + (h)) * HTB)
#define PG8_SB(b, h) ((4 + (b) * 2 + (h)) * HTB)
#define PG8_STAGE(bufoff, gbase, voff) do { _Pragma("unroll") for (int _i = 0; _i < 2; ++_i) \
        __builtin_amdgcn_global_load_lds((const unsigned*)((const char*)(gbase) + (voff)[_i]), (LAS unsigned*)(lds + (bufoff) + ldsw + _i * 8192), 16, 0, 0); } while (0)
#define PG8_LDA(dst, b, h) do { _Pragma("unroll") for (int m = 0; m < 4; ++m) _Pragma("unroll") for (int k = 0; k < 2; ++k) dst[m][k] = *(const LAS bf16x8*)(lds + PG8_SA(b, h) + aoff + m * 2048 + k * 1024); } while (0)
#define PG8_LDB(dst, b, h) do { _Pragma("unroll") for (int n = 0; n < 2; ++n) _Pragma("unroll") for (int k = 0; k < 2; ++k) dst[n][k] = *(const LAS bf16x8*)(lds + PG8_SB(b, h) + boff + n * 2048 + k * 1024); } while (0)
#define PG8_MMA(ai, bj, At, Bt) do { __builtin_amdgcn_s_setprio(1); _Pragma("unroll") for (int m = 0; m < 4; ++m) _Pragma("unroll") for (int n = 0; n < 2; ++n) _Pragma("unroll") for (int k = 0; k < 2; ++k) \
        acc[ai][bj][m][n] = __builtin_amdgcn_mfma_f32_16x16x32_bf16(Bt[n][k], At[m][k], acc[ai][bj][m][n], 0, 0, 0); __builtin_amdgcn_s_setprio(0); } while (0)
#define PG8_WAIT_V(n) asm volatile("s_waitcnt vmcnt(" #n ")" ::: "memory")
#define PG8_WAIT_L(n) asm volatile("s_waitcnt lgkmcnt(" #n ")" ::: "memory")
#define PG8_BAR __builtin_amdgcn_s_barrier()
#define PG8_SCHED __builtin_amdgcn_sched_barrier(0)
    Unit cur, nxt; int ui = 0;
    if (!S.next(0, cur)) return;
    f32x4 acc[2][2][4][2];
#pragma unroll
    for (int a = 0; a < 2; ++a)
#pragma unroll
        for (int b = 0; b < 2; ++b)
#pragma unroll
            for (int m = 0; m < 4; ++m)
#pragma unroll
                for (int n = 0; n < 2; ++n) acc[a][b][m][n] = (f32x4){0.f, 0.f, 0.f, 0.f};
    bf16x8 At[4][2], B0[2][2], B1[2][2];
    const char* cA = (const char*)g.A + (size_t)cur.pm * tA; const char* cB = (const char*)g.Bt + (size_t)cur.pn * tB;
    S.a_ready(cur);
    if constexpr (SP2) {
        PG8_STAGE(PG8_SB(0, 0), cB, voffB); PG8_STAGE(PG8_SB(0, 1), cB + hB, voffB); PG8_STAGE(PG8_SA(0, 0), cA, voffA); PG8_STAGE(PG8_SA(0, 1), cA + hA, voffA);
        if (wr == 1) PG8_BAR;
        PG8_WAIT_V(2); PG8_BAR;
        PG8_STAGE(PG8_SB(1, 0), cB + kstep, voffB); PG8_STAGE(PG8_SA(1, 0), cA + kstep, voffA); PG8_STAGE(PG8_SB(1, 1), cB + hB + kstep, voffB);
        PG8_WAIT_V(6); PG8_BAR;
    } else {
        PG8_STAGE(PG8_SB(0, 0), cB, voffB); PG8_STAGE(PG8_SA(0, 0), cA, voffA); PG8_STAGE(PG8_SB(0, 1), cB + hB, voffB); PG8_STAGE(PG8_SA(0, 1), cA + hA, voffA);
        if (wr == 1) PG8_BAR;
        PG8_WAIT_V(4); PG8_BAR;
        PG8_STAGE(PG8_SB(1, 0), cB + kstep, voffB); PG8_STAGE(PG8_SA(1, 0), cA + kstep, voffA); PG8_STAGE(PG8_SB(1, 1), cB + hB + kstep, voffB);
        PG8_WAIT_V(6); PG8_BAR;
    }
    for (;;) {
        const bool has_next = S.next(ui + 1, nxt);
        const char* nA = has_next ? (const char*)g.A + (size_t)nxt.pm * tA : cA; const char* nB = has_next ? (const char*)g.Bt + (size_t)nxt.pn * tB : cB;
        for (int t = 0; t < nt; t += 2) {
            const bool last = (t == nt - 2);
            const char* a1 = cA + (size_t)(t + 1) * kstep;
            const char* a2 = last ? nA : cA + (size_t)(t + 2) * kstep; const char* b2 = last ? nB : cB + (size_t)(t + 2) * kstep;
            const char* a3 = a2 + kstep; const char* b3 = b2 + kstep;
            if (last && has_next) S.a_ready(nxt);
            if constexpr (SP2) {
            PG8_LDB(B0, 0, 0); PG8_LDB(B1, 0, 1); PG8_SCHED; PG8_LDA(At, 0, 0); PG8_STAGE(PG8_SA(1, 1), a1 + hA, voffA);
            PG8_WAIT_V(8); PG8_WAIT_L(0); PG8_BAR; PG8_MMA(0, 0, At, B0); PG8_MMA(0, 1, At, B1); PG8_BAR; PG8_SCHED;
            PG8_LDA(At, 0, 1); PG8_STAGE(PG8_SB(0, 0), b2, voffB); PG8_STAGE(PG8_SB(0, 1), b2 + hB, voffB); PG8_STAGE(PG8_SA(0, 0), a2, voffA);
            PG8_WAIT_V(8); PG8_WAIT_L(0); PG8_BAR; PG8_MMA(1, 0, At, B0); PG8_MMA(1, 1, At, B1); PG8_BAR; PG8_SCHED;
            PG8_LDB(B0, 1, 0); PG8_LDB(B1, 1, 1); PG8_SCHED; PG8_LDA(At, 1, 0); PG8_STAGE(PG8_SA(0, 1), a2 + hA, voffA);
            PG8_WAIT_V(8); PG8_WAIT_L(0); PG8_BAR; PG8_MMA(0, 0, At, B0); PG8_MMA(0, 1, At, B1); PG8_BAR; PG8_SCHED;
            PG8_LDA(At, 1, 1); PG8_STAGE(PG8_SB(1, 0), b3, voffB); PG8_STAGE(PG8_SB(1, 1), b3 + hB, voffB); PG8_STAGE(PG8_SA(1, 0), a3, voffA);
            PG8_WAIT_V(8); PG8_WAIT_L(0); PG8_BAR; PG8_MMA(1, 0, At, B0); PG8_MMA(1, 1, At, B1); PG8_BAR; PG8_SCHED;
            } else {
            PG8_LDB(B0, 0, 0); PG8_SCHED; PG8_LDA(At, 0, 0); PG8_STAGE(PG8_SA(1, 1), a1 + hA, voffA);
            PG8_WAIT_L(8); PG8_BAR; PG8_WAIT_L(0); PG8_MMA(0, 0, At, B0); PG8_BAR; PG8_SCHED;
            PG8_LDB(B1, 0, 1); PG8_STAGE(PG8_SB(0, 0), b2, voffB);
            PG8_BAR; PG8_WAIT_L(0); PG8_MMA(0, 1, At, B1); PG8_BAR;
            PG8_LDA(At, 0, 1); PG8_STAGE(PG8_SA(0, 0), a2, voffA);
            PG8_BAR; PG8_WAIT_L(0); PG8_MMA(1, 0, At, B0); PG8_BAR; PG8_SCHED;
            PG8_STAGE(PG8_SB(0, 1), b2 + hB, voffB);
            PG8_WAIT_V(6); PG8_BAR; PG8_MMA(1, 1, At, B1); PG8_BAR;
            PG8_LDB(B0, 1, 0); PG8_SCHED; PG8_LDA(At, 1, 0); PG8_STAGE(PG8_SA(0, 1), a2 + hA, voffA);
            PG8_WAIT_L(8); PG8_BAR; PG8_WAIT_L(0); PG8_MMA(0, 0, At, B0); PG8_BAR; PG8_SCHED;
            PG8_LDB(B1, 1, 1); PG8_STAGE(PG8_SB(1, 0), b3, voffB);
            PG8_BAR; PG8_WAIT_L(0); PG8_MMA(0, 1, At, B1); PG8_BAR;
            PG8_LDA(At, 1, 1); PG8_STAGE(PG8_SA(1, 0), a3, voffA);
            PG8_BAR; PG8_WAIT_L(0); PG8_MMA(1, 0, At, B0); PG8_BAR; PG8_SCHED;
            PG8_STAGE(PG8_SB(1, 1), b3 + hB, voffB);
            PG8_WAIT_V(6); PG8_BAR; PG8_MMA(1, 1, At, B1); PG8_BAR;
            }
        }
        if constexpr (ALIGN_EPI) { if (wr == 0) PG8_BAR; }
        E(acc, cur, wr, wc, fr, fq); S.done(cur);
        if (!has_next) break;
#pragma unroll
        for (int a = 0; a < 2; ++a)
#pragma unroll
            for (int b = 0; b < 2; ++b)
#pragma unroll
                for (int m = 0; m < 4; ++m)
#pragma unroll
                    for (int n = 0; n < 2; ++n) acc[a][b][m][n] = (f32x4){0.f, 0.f, 0.f, 0.f};
        cur = nxt; cA = nA; cB = nB; ++ui;
        if constexpr (ALIGN_EPI) { if (wr == 1) PG8_BAR; }
    }
    PG8_WAIT_V(0);
    if constexpr (!ALIGN_EPI) { if (wr == 0) PG8_BAR; }
    PG8_BAR;
#undef PG8_SA
#undef PG8_SB
#undef PG8_STAGE
#undef PG8_LDA
#undef PG8_LDB
#undef PG8_MMA
#undef PG8_WAIT_V
#undef PG8_WAIT_L
#undef PG8_BAR
#undef PG8_SCHED
}
}

__device__ __forceinline__ void cvt_item(const float* W, int ldw, u16* WT, int ldt, int k0, int n0, int drow0, int dcol0, LAS float* scr, int lane) {
#pragma unroll 8
    for (int i = 0; i < 32; ++i) { const int kk = 2 * i + (lane >> 5); scr[kk * 33 + (lane & 31)] = W[(size_t)(k0 + kk) * ldw + n0 + (lane & 31)]; }
    asm volatile("s_waitcnt lgkmcnt(0)" ::: "memory");
    const int c = lane & 7;
#pragma unroll
    for (int j = 0; j < 4; ++j) { const int n = (lane >> 3) + 8 * j; const LAS float* s = scr + (8 * c) * 33 + n;
        uint4 o; o.x = f2bf(s[0 * 33]) | (f2bf(s[1 * 33]) << 16); o.y = f2bf(s[2 * 33]) | (f2bf(s[3 * 33]) << 16); o.z = f2bf(s[4 * 33]) | (f2bf(s[5 * 33]) << 16); o.w = f2bf(s[6 * 33]) | (f2bf(s[7 * 33]) << 16);
        *(uint4*)(WT + (size_t)(drow0 + n) * ldt + dcol0 + k0 + 8 * c) = o; }
    asm volatile("s_waitcnt lgkmcnt(0)" ::: "memory");
}
template <class RowMap>
__device__ __forceinline__ void cvt_matrix(const float* W, int K, int N, u16* WT, int ldt, int dcol0, const RowMap& rowmap, LAS float* scr, int lane, int gw, int NGW, int& off) {
    const int nblk = N / 32, nitems = (K / 64) * nblk;
    int it = (gw - off) % NGW; if (it < 0) it += NGW;
    for (; it < nitems; it += NGW) { const int kb = it / nblk, nb = it % nblk; cvt_item(W, N, WT, ldt, kb * 64, nb * 32, rowmap(nb * 32), dcol0, scr, lane); }
    off = (off + nitems) % NGW;
}


#ifndef FAST_ATTN
#define FAST_ATTN 1
#endif
namespace fa {
using bf16x8 = __attribute__((ext_vector_type(8))) short;
using s16x4  = __attribute__((ext_vector_type(4))) short;
using f32x16 = __attribute__((ext_vector_type(16))) float;
using u32x4  = __attribute__((ext_vector_type(4))) unsigned;
constexpr int NW = 8, QBLK = 32, KVBLK = 64, DV = 128;
constexpr float THR = 8.f;
constexpr size_t SHM_V = KVBLK * DV * 2;
#define FA_SBAR() __builtin_amdgcn_sched_barrier(0)
__device__ __forceinline__ int crow(int r, int hi) { return (r & 3) + 8 * (r >> 2) + 4 * hi; }
__device__ __forceinline__ unsigned cvtpk(float lo, float hi) { unsigned r; asm volatile("v_cvt_pk_bf16_f32 %0, %1, %2" : "=v"(r) : "v"(lo), "v"(hi)); return r; }
template <int DQ> struct Cfg {
    static constexpr int NK = DQ / 16, NCH = DQ / 8, KPT = NCH / 8;
    static constexpr size_t SHM_K = (size_t)KVBLK * DQ * 2;
    static constexpr float SCALE = DQ == 192 ? 0.07216878364870322f : (DQ == 64 ? 0.125f : 0.08838834764831845f);
    __device__ static __forceinline__ int kswz(int row, int colB) { return row * (DQ * 2) + (colB ^ ((row & 7) << 4)); }
};
template <int DQ> __device__ __forceinline__ void partialSM(f32x16& p0, f32x16& p1, float& m_reg, float& mn, float& alpha) {
    constexpr float SCALE = Cfg<DQ>::SCALE, C = SCALE * 1.4426950408889634f;
    float pmax = p0[0];
#pragma unroll
    for (int r = 1; r < 16; ++r) pmax = fmaxf(pmax, p0[r]);
#pragma unroll
    for (int r = 0; r < 16; ++r) pmax = fmaxf(pmax, p1[r]);
    { auto rr = __builtin_amdgcn_permlane32_swap(__float_as_uint(pmax), __float_as_uint(pmax), false, false);
      pmax = fmaxf(__uint_as_float(rr[0]), __uint_as_float(rr[1])); }
    if (__builtin_expect(__all(pmax - m_reg <= THR / SCALE), 1)) { mn = m_reg; alpha = 1.f; }
    else { mn = fmaxf(m_reg, pmax); alpha = __builtin_amdgcn_exp2f((m_reg - mn) * C); m_reg = mn; }
    const float mnC = -mn * C;
#pragma unroll
    for (int r = 0; r < 16; ++r) p0[r] = fmaf(p0[r], C, mnC);
#pragma unroll
    for (int r = 0; r < 16; ++r) p1[r] = fmaf(p1[r], C, mnC);
#pragma unroll
    for (int r = 0; r < 16; ++r) p0[r] = __builtin_amdgcn_exp2f(p0[r]);
}
__device__ __forceinline__ void finishSM(f32x16& p0, f32x16& p1, float alpha, float& l_reg, bf16x8& pa0, bf16x8& pa1, bf16x8& pa2, bf16x8& pa3) {
#pragma unroll
    for (int r = 0; r < 16; ++r) p1[r] = __builtin_amdgcn_exp2f(p1[r]);
    float ps = 0;
#pragma unroll
    for (int r = 0; r < 16; ++r) ps += p0[r];
#pragma unroll
    for (int r = 0; r < 16; ++r) ps += p1[r];
    { auto rr = __builtin_amdgcn_permlane32_swap(__float_as_uint(ps), __float_as_uint(ps), false, false);
      ps = __uint_as_float(rr[0]) + __uint_as_float(rr[1]); }
    l_reg = l_reg * alpha + ps;
#define FA_PK4(P, BASE, OUT) do { unsigned a0 = cvtpk(P[BASE + 0], P[BASE + 1]), a1 = cvtpk(P[BASE + 2], P[BASE + 3]);   \
    unsigned b0 = cvtpk(P[BASE + 4], P[BASE + 5]), b1 = cvtpk(P[BASE + 6], P[BASE + 7]);                              \
    auto r0 = __builtin_amdgcn_permlane32_swap(a0, b0, false, false); auto r1 = __builtin_amdgcn_permlane32_swap(a1, b1, false, false); \
    u32x4 w = {r0[0], r1[0], r0[1], r1[1]}; OUT = *reinterpret_cast<bf16x8*>(&w); } while (0)
    FA_PK4(p0, 0, pa0); FA_PK4(p0, 8, pa1); FA_PK4(p1, 0, pa2); FA_PK4(p1, 8, pa3);
#undef FA_PK4
}
template <int DQ> __device__ __forceinline__ void qkt(f32x16& p0, f32x16& p1, const char* Ks, const bf16x8* qr, int r32, int hi) {
    p0 = f32x16{}; p1 = f32x16{};
#pragma unroll
    for (int d0 = 0; d0 < Cfg<DQ>::NK; ++d0) { const int cb = (d0 * 16 + hi * 8) * 2;
        const bf16x8 b0 = *reinterpret_cast<const bf16x8*>(Ks + Cfg<DQ>::kswz(r32, cb));
        const bf16x8 b1 = *reinterpret_cast<const bf16x8*>(Ks + Cfg<DQ>::kswz(32 + r32, cb));
        p0 = __builtin_amdgcn_mfma_f32_32x32x16_bf16(b0, qr[d0], p0, 0, 0, 0);
        p1 = __builtin_amdgcn_mfma_f32_32x32x16_bf16(b1, qr[d0], p1, 0, 0, 0); }
}
__device__ __forceinline__ int v_st(int k, int c) { const int kk = (k & ~0xC) | ((k & 4) << 1) | ((k & 8) >> 1); return ((kk >> 3) * 4 + (c >> 5)) * 512 + ((kk & 7) * 32 + (c & 31)) * 2; }
__device__ __forceinline__ int v_rd_base(int lane) { return ((lane & 3) << 3) | (((lane >> 2) & 3) << 6) | (((lane >> 4) & 1) << 5) | (((lane >> 5) & 1) << 8); }
constexpr int v_rd_off(int d0, int ks, int half) { return d0 * 512 + ks * 4096 + half * 2048; }
template <int OFF> __device__ __forceinline__ s16x4 tr_read(int vb) {
    s16x4 r; asm volatile("ds_read_b64_tr_b16 %0, %1 offset:%2" : "=&v"(r) : "v"(vb), "i"(OFF) : "memory"); return r;
}
template <int D0> __device__ __forceinline__ void pv_one(f32x16& od, int vb, bf16x8 pa0, bf16x8 pa1, bf16x8 pa2, bf16x8 pa3) {
    const s16x4 l0 = tr_read<v_rd_off(D0, 0, 0)>(vb), h0 = tr_read<v_rd_off(D0, 0, 1)>(vb), l1 = tr_read<v_rd_off(D0, 1, 0)>(vb), h1 = tr_read<v_rd_off(D0, 1, 1)>(vb);
    const s16x4 l2 = tr_read<v_rd_off(D0, 2, 0)>(vb), h2 = tr_read<v_rd_off(D0, 2, 1)>(vb), l3 = tr_read<v_rd_off(D0, 3, 0)>(vb), h3 = tr_read<v_rd_off(D0, 3, 1)>(vb);
    asm volatile("s_waitcnt lgkmcnt(0)" ::: "memory"); FA_SBAR();
#define FA_PK(L, H) (bf16x8){L[0], L[1], L[2], L[3], H[0], H[1], H[2], H[3]}
    od = __builtin_amdgcn_mfma_f32_32x32x16_bf16(pa0, FA_PK(l0, h0), od, 0, 0, 0);
    od = __builtin_amdgcn_mfma_f32_32x32x16_bf16(pa1, FA_PK(l1, h1), od, 0, 0, 0);
    od = __builtin_amdgcn_mfma_f32_32x32x16_bf16(pa2, FA_PK(l2, h2), od, 0, 0, 0);
    od = __builtin_amdgcn_mfma_f32_32x32x16_bf16(pa3, FA_PK(l3, h3), od, 0, 0, 0);
#undef FA_PK
}
__device__ __forceinline__ void pv_d0(f32x16* o, int vb, bf16x8 pa0, bf16x8 pa1, bf16x8 pa2, bf16x8 pa3) {
    pv_one<0>(o[0], vb, pa0, pa1, pa2, pa3); pv_one<1>(o[1], vb, pa0, pa1, pa2, pa3); pv_one<2>(o[2], vb, pa0, pa1, pa2, pa3); pv_one<3>(o[3], vb, pa0, pa1, pa2, pa3);
}
struct KVSrc { const u16* k0; int kst0; const u16* k1; int kst1; int split8; const u16* v; int vst; int xrow0, lrow0; };
constexpr size_t shm_bytes(int DQ) { return 2 * SHM_V + 2 * (size_t)KVBLK * DQ * 2 + NW * 64 * 4; }

template <int DQ>
__device__ __forceinline__ void attn_unit(const u16* __restrict__ Qb, int LDQ, const KVSrc S, u16* __restrict__ Ob, int LDO, int NT, char* lds) {
    using C = Cfg<DQ>;
    constexpr int NK = C::NK, NCH = C::NCH, KPT = C::KPT;
    constexpr size_t SHM_K = C::SHM_K;
    const int tid = threadIdx.x, wid = tid >> 6, lane = tid & 63, r32 = lane & 31, hi = lane >> 5;
    char* V_lds = lds; char* K_lds = lds + 2 * SHM_V;
    float* wsf = (float*)(lds + 2 * SHM_V + 2 * SHM_K) + wid * 64; float* li_l = wsf; float* al_l = wsf + 32;
    float m_reg = -1e30f, l_reg = 0; f32x16 o[4] = {}; bf16x8 qr[NK];
    const u16* Qw = Qb + (long)(wid * QBLK + r32) * LDQ + hi * 8;
#pragma unroll
    for (int d0 = 0; d0 < NK; ++d0) qr[d0] = *reinterpret_cast<const bf16x8*>(Qw + d0 * 16);
    const int sr = tid >> 4, sc = (tid & 15) * 8, vst0 = v_st(sr, sc), vst1 = v_st(32 + sr, sc);
    const int vb0 = (int)(uintptr_t)V_lds + v_rd_base(lane);
    const u16* kp[KPT]; int kst[KPT]; int kw[KPT];
#pragma unroll
    for (int i = 0; i < KPT; ++i) { const int c = tid + 512 * i, row = c / NCH, c8 = c % NCH;
        if (c8 < S.split8) { kp[i] = S.k0 + (long)row * S.kst0 + c8 * 8; kst[i] = S.kst0; } else { kp[i] = S.k1 + (long)row * S.kst1 + (c8 - S.split8) * 8; kst[i] = S.kst1; }
        kw[i] = C::kswz(row, c8 * 16); }
    const u16* vp0 = S.v + (long)sr * S.vst + sc; const u16* vp1 = S.v + (long)(32 + sr) * S.vst + sc;
    struct { bf16x8 vs0, vs1, ks[KPT]; } sr_[2];
#define FA_ROW0(kt) ((kt) < 4 ? S.xrow0 + 64 * (kt) : S.lrow0 + 64 * ((kt) - 4))
#define FA_SLOAD(i, kt) do { const long _r = FA_ROW0(kt); sr_[i].vs0 = *reinterpret_cast<const bf16x8*>(vp0 + _r * S.vst); sr_[i].vs1 = *reinterpret_cast<const bf16x8*>(vp1 + _r * S.vst); \
    _Pragma("unroll") for (int _q = 0; _q < KPT; ++_q) sr_[i].ks[_q] = *reinterpret_cast<const bf16x8*>(kp[_q] + _r * kst[_q]); } while (0)
#define FA_SWRITE(b, i) do { *(bf16x8*)(V_lds + (b) * SHM_V + vst0) = sr_[i].vs0; *(bf16x8*)(V_lds + (b) * SHM_V + vst1) = sr_[i].vs1; \
    _Pragma("unroll") for (int _q = 0; _q < KPT; ++_q) *(bf16x8*)(K_lds + (b) * SHM_K + kw[_q]) = sr_[i].ks[_q]; } while (0)
#define FA_SWAIT() asm volatile("s_waitcnt vmcnt(%0)" :: "n"(2 + KPT) : "memory")
#define FA_RESC(a) do { if (__any((a) < 1.f)) { if (hi == 0) al_l[r32] = (a); asm volatile("s_waitcnt lgkmcnt(0)" ::: "memory"); \
    _Pragma("unroll") for (int d = 0; d < 4; ++d) _Pragma("unroll") for (int r = 0; r < 16; ++r) o[d][r] *= al_l[crow(r, hi)]; } } while (0)
    f32x16 pA0, pA1, pB0, pB1; float mnA, mnB, alA, alB; bf16x8 pa0, pa1, pa2, pa3;
    constexpr int SE = 0, SO = 1;
    FA_SLOAD(SE, 0); asm volatile("s_waitcnt vmcnt(0)" ::: "memory"); FA_SWRITE(0, SE); __syncthreads();
    qkt<DQ>(pA0, pA1, K_lds, qr, r32, hi); partialSM<DQ>(pA0, pA1, m_reg, mnA, alA);
    FA_SLOAD(SO, 1); if (2 < NT) FA_SLOAD(SE, 2);
    FA_SWAIT(); FA_SWRITE(1, SO); __syncthreads();
    for (int j = 1; j + 1 < NT; j += 2) {
        FA_SBAR(); qkt<DQ>(pB0, pB1, K_lds + SHM_K, qr, r32, hi);
        finishSM(pA0, pA1, alA, l_reg, pa0, pa1, pa2, pa3); FA_SBAR();
        FA_SLOAD(SO, j + 2); FA_SBAR();
        pv_d0(o, vb0, pa0, pa1, pa2, pa3); partialSM<DQ>(pB0, pB1, m_reg, mnB, alB);
        __syncthreads(); FA_SWAIT(); FA_SWRITE(0, SE);
        FA_RESC(alB); __syncthreads();
        FA_SBAR(); qkt<DQ>(pA0, pA1, K_lds, qr, r32, hi);
        finishSM(pB0, pB1, alB, l_reg, pa0, pa1, pa2, pa3); FA_SBAR();
        if (j + 3 < NT) FA_SLOAD(SE, j + 3); FA_SBAR();
        pv_d0(o, vb0 + (int)SHM_V, pa0, pa1, pa2, pa3); partialSM<DQ>(pA0, pA1, m_reg, mnA, alA);
        __syncthreads(); FA_SWAIT(); FA_SWRITE(1, SO);
        FA_RESC(alA); __syncthreads();
    }
    FA_SBAR(); qkt<DQ>(pB0, pB1, K_lds + SHM_K, qr, r32, hi);
    finishSM(pA0, pA1, alA, l_reg, pa0, pa1, pa2, pa3); FA_SBAR();
    pv_d0(o, vb0, pa0, pa1, pa2, pa3); partialSM<DQ>(pB0, pB1, m_reg, mnB, alB);
    __syncthreads(); FA_RESC(alB);
    finishSM(pB0, pB1, alB, l_reg, pa0, pa1, pa2, pa3); FA_SBAR();
    pv_d0(o, vb0 + (int)SHM_V, pa0, pa1, pa2, pa3);
    if (hi == 0) li_l[r32] = l_reg; asm volatile("s_waitcnt lgkmcnt(0)" ::: "memory");
    float rli[16];
#pragma unroll
    for (int r = 0; r < 16; ++r) rli[r] = __builtin_amdgcn_rcpf(li_l[crow(r, hi)]);
    u16* Ow = Ob + (long)(wid * QBLK) * LDO;
#pragma unroll
    for (int r = 0; r < 16; ++r) { const int orow = crow(r, hi);
#pragma unroll
        for (int d0 = 0; d0 < 4; ++d0) Ow[(long)orow * LDO + d0 * 32 + r32] = (u16)f2bf(o[d0][r] * rli[r]); }
#undef FA_ROW0
#undef FA_SLOAD
#undef FA_SWRITE
#undef FA_SWAIT
#undef FA_RESC
}

template <int DQ, int SPLIT8>
__device__ __forceinline__ void attn_unit_sp(const u16* __restrict__ Qb, int LDQ, const KVSrc S, u16* __restrict__ Ob, int LDO, int NT, char* lds) {
    using C = Cfg<DQ>;
    constexpr int NK = C::NK, NCH = C::NCH, KPT = C::KPT, KPT0 = SPLIT8 / 8, NCH1 = NCH - SPLIT8;
    constexpr size_t SHM_K = C::SHM_K;
    const int tid = threadIdx.x, wid = tid >> 6, lane = tid & 63, r32 = lane & 31, hi = lane >> 5;
    char* V_lds = lds; char* K_lds = lds + 2 * SHM_V;
    float* wsf = (float*)(lds + 2 * SHM_V + 2 * SHM_K) + wid * 64; float* li_l = wsf; float* al_l = wsf + 32;
    float m_reg = -1e30f, l_reg = 0; f32x16 o[4] = {}; bf16x8 qr[NK];
    { const u16* Qw = Qb + (long)(wid * QBLK + r32) * LDQ + hi * 8;
#pragma unroll
      for (int d0 = 0; d0 < NK; ++d0) qr[d0] = *reinterpret_cast<const bf16x8*>(Qw + d0 * 16); }
    const int sr = tid >> 4, sc = (tid & 15) * 8, vst0 = v_st(sr, sc), vst1 = v_st(32 + sr, sc);
    const int vb0 = (int)(uintptr_t)V_lds + v_rd_base(lane);
    int koff[KPT], kw[KPT];
#pragma unroll
    for (int i = 0; i < KPT; ++i) {
        if (i < KPT0) { const int c = tid + 512 * i, row = c / SPLIT8, c8 = c % SPLIT8; koff[i] = row * S.kst0 + c8 * 8; kw[i] = C::kswz(row, c8 * 16); }
        else { const int c = tid + 512 * (i - KPT0), row = c / (NCH1 > 0 ? NCH1 : 1), c8 = c % (NCH1 > 0 ? NCH1 : 1); koff[i] = row * S.kst1 + c8 * 8; kw[i] = C::kswz(row, (SPLIT8 + c8) * 16); } }
    const int voff0 = sr * S.vst + sc, voff1 = (32 + sr) * S.vst + sc;
    bf16x8 vs0, vs1, ks[KPT];
#define FA_ROW0(kt) ((kt) < 4 ? S.xrow0 + 64 * (kt) : S.lrow0 + 64 * ((kt) - 4))
#define FA_SLOAD(kt) do { const long _r = FA_ROW0(kt); const u16* _v = S.v + _r * S.vst; const u16* _k0 = S.k0 + _r * S.kst0; const u16* _k1 = S.k1 + _r * S.kst1; \
    vs0 = *reinterpret_cast<const bf16x8*>(_v + voff0); vs1 = *reinterpret_cast<const bf16x8*>(_v + voff1); \
    _Pragma("unroll") for (int _q = 0; _q < KPT; ++_q) ks[_q] = *reinterpret_cast<const bf16x8*>((_q < KPT0 ? _k0 : _k1) + koff[_q]); } while (0)
#define FA_SWRITE(b) do { *(bf16x8*)(V_lds + (b) * SHM_V + vst0) = vs0; *(bf16x8*)(V_lds + (b) * SHM_V + vst1) = vs1; \
    _Pragma("unroll") for (int _q = 0; _q < KPT; ++_q) *(bf16x8*)(K_lds + (b) * SHM_K + kw[_q]) = ks[_q]; } while (0)
    f32x16 p0, p1; float mn, al; bf16x8 pa0, pa1, pa2, pa3;
    FA_SLOAD(0); asm volatile("s_waitcnt vmcnt(0)" ::: "memory"); FA_SWRITE(0); __syncthreads();
    for (int j = 0; j < NT; ++j) {
        const int b = j & 1;
        FA_SBAR(); qkt<DQ>(p0, p1, K_lds + b * SHM_K, qr, r32, hi);
        partialSM<DQ>(p0, p1, m_reg, mn, al);
        if (__any(al < 1.f)) { if (hi == 0) al_l[r32] = al; asm volatile("s_waitcnt lgkmcnt(0)" ::: "memory");
#pragma unroll
            for (int d = 0; d < 4; ++d)
#pragma unroll
                for (int r = 0; r < 16; ++r) o[d][r] *= al_l[crow(r, hi)]; }
        finishSM(p0, p1, al, l_reg, pa0, pa1, pa2, pa3); FA_SBAR();
        if (j + 1 < NT) FA_SLOAD(j + 1);
        FA_SBAR();
        pv_d0(o, vb0 + b * (int)SHM_V, pa0, pa1, pa2, pa3);
        if (j + 1 < NT) { asm volatile("s_waitcnt vmcnt(0)" ::: "memory"); FA_SWRITE(b ^ 1); }
        __syncthreads();
    }
    if (hi == 0) li_l[r32] = l_reg; asm volatile("s_waitcnt lgkmcnt(0)" ::: "memory");
    float rli[16];
#pragma unroll
    for (int r = 0; r < 16; ++r) rli[r] = __builtin_amdgcn_rcpf(li_l[crow(r, hi)]);
    u16* Ow = Ob + (long)(wid * QBLK) * LDO;
#pragma unroll
    for (int r = 0; r < 16; ++r) { const int orow = crow(r, hi);
#pragma unroll
        for (int d0 = 0; d0 < 4; ++d0) Ow[(long)orow * LDO + d0 * 32 + r32] = (u16)f2bf(o[d0][r] * rli[r]); }
#undef FA_ROW0
#undef FA_SLOAD
#undef FA_SWRITE
}
}

__global__ void __launch_bounds__(512, 2) fwd_kernel(Args args) {
    extern __shared__ __attribute__((aligned(16))) unsigned char lds_raw[];
    LAS unsigned char* lds = (LAS unsigned char*)lds_raw;
    const int tid = threadIdx.x, lane = tid & 63, wave = __builtin_amdgcn_readfirstlane(tid >> 6);
    const int G = gridDim.x, gw = blockIdx.x * 8 + wave, NGW = G * 8;
    unsigned char* ws = args.ws;
    unsigned* ctl = (unsigned*)(ws + WS_CTL);
    volatile LAS unsigned* MISC = (volatile LAS unsigned*)(lds + MISC_OFF);
    for (int u = tid; u < (LDS_BYTES - 131072) / 4; u += 512) ((LAS unsigned*)(lds + 131072))[u] = 0u;
    __syncthreads();
    XcdBarrier bar = xcd_barrier_post(ctl + CW_BAR, MISC + 8);
    const int lo = args.ph_lo, hi = args.ph_hi;
#define IN(k) (lo <= (k) && (k) < hi)
#define GRID_BAR() xcd_barrier(bar)

    const float* x_in = args.in[0]; const float* c_in = args.in[1]; const float* ctx_in = args.in[2]; const float* cctx_in = args.in[3];
    const float* w_mod = args.in[4]; const float* b_mod = args.in[5];
    const float* g_pre_mix = args.in[6]; const float* g_post_mix = args.in[7]; const float* g_pre_ffn = args.in[8]; const float* g_post_ffn = args.in[9];
    const float* w_in_a = args.in[10]; const float* mla_g_q = args.in[11]; const float* mla_w_uq = args.in[12]; const float* mla_g_kv = args.in[13]; const float* mla_w_ukv = args.in[14];
    const float* gla_w_gf = args.in[15]; const float* gla_b_gf = args.in[16]; const float* gla_w_gb = args.in[17]; const float* gla_b_gb = args.in[18]; const float* gla_g_out = args.in[19];
    const float* w_out_a = args.in[20]; const float* w_qkv_c = args.in[21];
    const float* diff_lq1 = args.in[22]; const float* diff_lk1 = args.in[23]; const float* diff_lq2 = args.in[24]; const float* diff_lk2 = args.in[25]; const float* diff_g_out = args.in[26];
    const float* w_out_c = args.in[27]; const float* ffn_w_gate = args.in[28]; const float* ffn_w_up = args.in[29]; const float* ffn_w_down = args.in[30];
    const float* moe_w_router = args.in[31]; const float* moe_w_gate = args.in[32]; const float* moe_w_up = args.in[33]; const float* moe_w_down = args.in[34];
    float* out = args.out;
    float* MODB = (float*)(ws + WS_MOD);
    float* ROPEC = (float*)(ws + WS_ROPE); float* ROPES = ROPEC + 2048 * 32;
    int* TOKE = (int*)(ws + WS_TOKE); float* TOKG = (float*)(ws + WS_TOKG); int* TOKP = (int*)(ws + WS_TOKP);
    float* CTXS = (float*)(ws + WS_CTXS);
    u16* H0 = (u16*)(ws + WS_R0); u16* CAT = (u16*)(ws + WS_R0); u16* FB = (u16*)(ws + WS_R0); u16* O16 = (u16*)(ws + WS_R0); u16* Y2 = (u16*)(ws + WS_R0); u16* HIDC = (u16*)(ws + WS_R0);
    u16* PARTS = (u16*)(ws + WS_PARTS); u16* YB = (u16*)(ws + WS_Y); u16* HB = (u16*)(ws + WS_Y);
    u16* H1 = (u16*)(ws + WS_H1); u16* CAT2 = (u16*)(ws + WS_H1);
    u16* HC = (u16*)(ws + WS_HC); u16* XS = (u16*)(ws + WS_XS);
    u16* A2 = (u16*)(ws + WS_A2); u16* KROPE = (u16*)(ws + WS_KROPE);
    float* OF = (float*)(ws + WS_R3); float* OB = OF + (size_t)M * 512;
    u16* QKVUP = (u16*)(ws + WS_R3); u16* HID = (u16*)(ws + WS_R3); u16* QKVC = (u16*)(ws + WS_R3);
    u16* W_IN = (u16*)(ws + WS_W);
    u16* W_UP = (u16*)(ws + WS_W + 4 * MiB);
    u16* W_OA = (u16*)(ws + WS_W + 4 * MiB + 1536 * 1024);
    u16* W_FGU = (u16*)(ws + WS_W + 7 * MiB + 512 * 1024);
    u16* W_FD = (u16*)(ws + WS_W + 18 * MiB + 512 * 1024);
    u16* W_QKV = (u16*)(ws + WS_W + 24 * MiB);
    u16* W_OC = (u16*)(ws + WS_W + 30 * MiB);
    u16* W_MGU = (u16*)(ws + WS_MOEW);
    u16* W_MD = (u16*)(ws + WS_MOEW + 112 * MiB);
    auto map_id = [](int n0) { return n0; };
    auto map_gate = [](int n0) { return (n0 >> 7) * 256 + (n0 & 127); };
    auto map_up = [](int n0) { return (n0 >> 7) * 256 + 128 + (n0 & 127); };

    if (IN(0)) {
        LAS float* sT = (LAS float*)lds;
        LAS float* red = sT + 1024 * 20;
        for (int e = tid; e < 17 * 1024; e += 512) { const int r = e >> 10, k = e & 1023; const float v = r < 16 ? c_in[r * 1024 + k] : cctx_in[k]; sT[k * 20 + r] = silu_f(v); }
        __syncthreads();
        for (int g = blockIdx.x; g < 192; g += G) {
            const int l = g / 96, n = (g % 96) * 64 + lane;
            const float* wp = w_mod + (size_t)l * 1024 * 6144 + n;
            float acc[17];
#pragma unroll
            for (int r = 0; r < 17; ++r) acc[r] = 0.f;
            const int kb = wave * 128;
#pragma unroll 4
            for (int kk = 0; kk < 128; ++kk) { const int k = kb + kk; const float w = wp[(size_t)k * 6144];
                const LAS float* sp = sT + k * 20;
#pragma unroll
                for (int r = 0; r < 17; ++r) acc[r] += sp[r] * w; }
#pragma unroll
            for (int r = 0; r < 17; ++r) red[(wave * 17 + r) * 64 + lane] = acc[r];
            __syncthreads();
            for (int e = tid; e < 17 * 64; e += 512) { const int r = e >> 6, ln = e & 63; float s = 0.f;
#pragma unroll
                for (int w8 = 0; w8 < 8; ++w8) s += red[(w8 * 17 + r) * 64 + ln];
                const int nn = (g % 96) * 64 + ln;
                MODB[(size_t)(l * 17 + r) * 6144 + nn] = s + b_mod[l * 6144 + nn]; }
            __syncthreads();
        }
        for (int e = blockIdx.x * 512 + tid; e < 2048 * 32; e += G * 512) { const int t = e >> 5, i = e & 31; const int pos = i < 16 ? (t >> 6) : (t & 63);
            const float freq = powf(10000.0f, -(float)(i & 15) / 16.0f); const float ang = (float)pos * freq;
            ROPEC[e] = cosf(ang); ROPES[e] = sinf(ang); }
#if FAST_GEMM
        __syncthreads();
        { LAS float* scr = (LAS float*)(lds + wave * 8448); int off = 0;
          cvt_matrix(w_in_a, 1024, IN_A, W_IN, 1024, 0, map_id, scr, lane, gw, NGW, off);
          cvt_matrix(mla_w_uq, 256, 768, W_UP, 384, 0, map_id, scr, lane, gw, NGW, off);
          cvt_matrix(mla_w_ukv, 128, 1024, W_UP, 384, 256, [](int n0) { return 768 + n0; }, scr, lane, gw, NGW, off);
          cvt_matrix(w_out_a, 1024, 1024, W_OA, 1024, 0, map_id, scr, lane, gw, NGW, off);
          cvt_matrix(ffn_w_gate, 1024, FFN, W_FGU, 1024, 0, map_gate, scr, lane, gw, NGW, off);
          cvt_matrix(ffn_w_up, 1024, FFN, W_FGU, 1024, 0, map_up, scr, lane, gw, NGW, off);
          cvt_matrix(ffn_w_down, FFN, 1024, W_FD, FFN, 0, map_id, scr, lane, gw, NGW, off);
          cvt_matrix(w_qkv_c, 1024, 3072, W_QKV, 1024, 0, map_id, scr, lane, gw, NGW, off);
          cvt_matrix(w_out_c, 1024, 1024, W_OC, 1024, 0, map_id, scr, lane, gw, NGW, off);
          const uint4 z = make_uint4(0u, 0u, 0u, 0u);
          for (int e = blockIdx.x * 512 + tid; e < 32 * 128; e += G * 512) *(uint4*)(W_IN + (size_t)IN_A * 1024 + (size_t)e * 8) = z;
          for (int e = blockIdx.x * 512 + tid; e < 768 * 16; e += G * 512) { const int r = e >> 4, c8 = e & 15; *(uint4*)(W_UP + (size_t)r * 384 + 256 + c8 * 8) = z; }
          for (int e = blockIdx.x * 512 + tid; e < 1024 * 32; e += G * 512) { const int r = 768 + (e >> 5), c8 = e & 31; *(uint4*)(W_UP + (size_t)r * 384 + c8 * 8) = z; } }
#endif
        GRID_BAR();
    }
    if (IN(1)) {
        for (int row = gw; row < M; row += NGW) {
            const float* src = row < ML ? x_in + (size_t)row * 1024 : ctx_in + (size_t)(row - ML) * 1024;
            const int mr = row < ML ? (row >> 11) : 16;
            f32x4 xv[4], hv[4]; ld_row_f32(src, lane, xv);
            premod(xv, hv, g_pre_mix, modp(ws, 0, mr, 0), modp(ws, 0, mr, 1), lane);
            st_row_bf16(H0 + (size_t)row * 1024, lane, hv);
        }
        GRID_BAR();
    }
    if (IN(2)) {
#if FAST_GEMM
        { pg8::Gemm g{H0, W_IN, 1024, 1024}; pg8::DenseOrder S; S.init(M / 256, IN_AP / 256, G, (int)blockIdx.x); pg8::EpiStore E{PARTS, IN_AP};
          pg8::gemm_phase<pg8::EpiStore, pg8::DenseOrder, PG8_ALIGN, PG8_SP2>(lds, g, S, E); }
#else
        auto epi = [&](int r, int c, float a, float) { PARTS[(size_t)r * IN_AP + c] = (u16)f2bf(a); };
        naive_gemm<false>(lds, H0, 1024, M / 128, w_in_a, nullptr, 1024, IN_A, IN_A, nullptr, 0, epi);
#endif
        GRID_BAR();
    }
    if (IN(3)) {
        for (int row = gw; row < M; row += NGW) {
            const u16* pr = PARTS + (size_t)row * IN_AP;
            { const uint2 w = *(const uint2*)(pr + C_CQ + 4 * lane); float v[4] = {bf2f(w.x & 0xffffu), bf2f(w.x >> 16), bf2f(w.y & 0xffffu), bf2f(w.y >> 16)};
              float s = wave_sum(v[0] * v[0] + v[1] * v[1] + v[2] * v[2] + v[3] * v[3]); const float r = 1.0f / sqrtf(s * (1.0f / 256.0f) + EPS);
              const f32x4 g = *(const f32x4*)(mla_g_q + 4 * lane);
              uint2 o; o.x = f2bf(v[0] * r * g.x) | (f2bf(v[1] * r * g.y) << 16); o.y = f2bf(v[2] * r * g.z) | (f2bf(v[3] * r * g.w) << 16);
              *(uint2*)(A2 + (size_t)row * 384 + 4 * lane) = o; }
            { const unsigned w = *(const unsigned*)(pr + C_CKV + 2 * lane); float v0 = bf2f(w & 0xffffu), v1 = bf2f(w >> 16);
              float s = wave_sum(v0 * v0 + v1 * v1); const float r = 1.0f / sqrtf(s * (1.0f / 128.0f) + EPS);
              const float2 g = *(const float2*)(mla_g_kv + 2 * lane);
              *(unsigned*)(A2 + (size_t)row * 384 + 256 + 2 * lane) = f2bf(v0 * r * g.x) | (f2bf(v1 * r * g.y) << 16); }
            if (lane < 32) { float x1 = bf2f(pr[C_KR + lane]), x2 = bf2f(pr[C_KR + 32 + lane]);
              if (row < ML) { const int t = row & 2047; const float cs = ROPEC[t * 32 + lane], sn = ROPES[t * 32 + lane]; const float n1 = x1 * cs - x2 * sn, n2 = x2 * cs + x1 * sn; x1 = n1; x2 = n2; }
              KROPE[(size_t)row * 64 + lane] = (u16)f2bf(x1); KROPE[(size_t)row * 64 + 32 + lane] = (u16)f2bf(x2); }
        }
        GRID_BAR();
    }
    if (IN(4)) {
        LAS float* qs = (LAS float*)lds;
        LAS float* ks = qs + 16 * 64;
        LAS float* as = ks + 16 * 64;
        LAS float* vs = as + 16 * 64;
        LAS float* opart = vs + 16 * 128;
        for (int u = blockIdx.x; u < 128; u += G) {
            const int dir = u & 1, h = (u >> 1) & 3, b = u >> 3;
            const float* wg = dir ? gla_w_gb : gla_w_gf; const float* bg = dir ? gla_b_gb : gla_b_gf; const int caf = dir ? C_AB : C_AF;
            float* Od = dir ? OB : OF;
            const int kg = tid >> 7, v = tid & 127;
            float S[16];
#pragma unroll
            for (int i = 0; i < 16; ++i) S[i] = 0.f;
            for (int sb = 0; sb < (CTXL + SEQ) / 16; ++sb) {
                __syncthreads();
                for (int e = tid; e < 16 * 64; e += 512) { const int tok = e >> 6, k = e & 63; const int n = sb * 16 + tok;
                    const int row = n < CTXL ? (ML + b * CTXL + (dir ? CTXL - 1 - n : n)) : (b * SEQ + (dir ? SEQ - 1 - (n - CTXL) : (n - CTXL)));
                    const u16* pr = PARTS + (size_t)row * IN_AP;
                    float pre = bg[h * 64 + k];
#pragma unroll
                    for (int jj = 0; jj < 16; ++jj) pre += bf2f(pr[caf + jj]) * wg[jj * 256 + h * 64 + k];
                    const float ls = fminf(pre, 0.f) - log1pf(__expf(-fabsf(pre)));
                    qs[e] = bf2f(pr[C_GQ + h * 64 + k]) * 0.125f; ks[e] = bf2f(pr[C_GK + h * 64 + k]); as[e] = __expf(ls * (1.0f / 16.0f)); }
                for (int e = tid; e < 16 * 128; e += 512) { const int tok = e >> 7, vv = e & 127; const int n = sb * 16 + tok;
                    const int row = n < CTXL ? (ML + b * CTXL + (dir ? CTXL - 1 - n : n)) : (b * SEQ + (dir ? SEQ - 1 - (n - CTXL) : (n - CTXL)));
                    vs[e] = bf2f(PARTS[(size_t)row * IN_AP + C_GV + h * 128 + vv]); }
                __syncthreads();
                for (int tok = 0; tok < 16; ++tok) { const float vv = vs[tok * 128 + v]; float po = 0.f;
#pragma unroll
                    for (int i = 0; i < 16; ++i) { const int k = kg * 16 + i; S[i] = as[tok * 64 + k] * S[i] + ks[tok * 64 + k] * vv; po += qs[tok * 64 + k] * S[i]; }
                    opart[(tok * 4 + kg) * 128 + v] = po; }
                __syncthreads();
                for (int e = tid; e < 16 * 128; e += 512) { const int tok = e >> 7, vv = e & 127; const int n = sb * 16 + tok;
                    const int row = n < CTXL ? (ML + b * CTXL + (dir ? CTXL - 1 - n : n)) : (b * SEQ + (dir ? SEQ - 1 - (n - CTXL) : (n - CTXL)));
                    Od[(size_t)row * 512 + h * 128 + vv] = (opart[(tok * 4 + 0) * 128 + vv] + opart[(tok * 4 + 1) * 128 + vv]) + (opart[(tok * 4 + 2) * 128 + vv] + opart[(tok * 4 + 3) * 128 + vv]); }
            }
        }
        GRID_BAR();
    }
    if (IN(5)) {
        for (int row = gw; row < M; row += NGW) {
            const int h = lane >> 4, v0 = (lane & 15) * 8;
            const float* pf = OF + (size_t)row * 512 + h * 128 + v0; const float* pb = OB + (size_t)row * 512 + h * 128 + v0;
            float o[8]; float s = 0.f;
#pragma unroll
            for (int i = 0; i < 8; ++i) { o[i] = pf[i] + pb[i]; s += o[i] * o[i]; }
#pragma unroll
            for (int off = 1; off < 16; off <<= 1) s += __shfl_xor(s, off);
            const float r = 1.0f / sqrtf(s * (1.0f / 128.0f) + EPS);
            const u16* pr = PARTS + (size_t)row * IN_AP + C_GR + h * 128 + v0;
            u16* po = CAT + (size_t)row * 1024 + 512 + h * 128 + v0;
#pragma unroll
            for (int i = 0; i < 8; ++i) po[i] = (u16)f2bf(o[i] * r * gla_g_out[v0 + i] * silu_f(bf2f(pr[i])));
        }
        GRID_BAR();
    }
    if (IN(6)) {
#if FAST_GEMM
        { pg8::Gemm g{A2, W_UP, 384, 384}; pg8::DenseOrder S; S.init(M / 256, UPN / 256, G, (int)blockIdx.x); pg8::EpiStore E{QKVUP, UPN};
          pg8::gemm_phase<pg8::EpiStore, pg8::DenseOrder, PG8_ALIGN, PG8_SP2>(lds, g, S, E); }
#else
        auto epiq = [&](int r, int c, float a, float) { QKVUP[(size_t)r * UPN + c] = (u16)f2bf(a); };
        naive_gemm<false>(lds, A2, 384, M / 128, mla_w_uq, nullptr, 256, 768, 768, nullptr, 0, epiq);
        auto epik = [&](int r, int c, float a, float) { QKVUP[(size_t)r * UPN + 768 + c] = (u16)f2bf(a); };
        naive_gemm<false>(lds, A2 + 256, 384, M / 128, mla_w_ukv, nullptr, 128, 1024, 1024, nullptr, 0, epik);
#endif
        GRID_BAR();
    }
    if (IN(7)) {
        for (int row = gw; row < ML; row += NGW) {
            const int t = row & 2047;
#pragma unroll
            for (int jj = 0; jj < 2; ++jj) { const int p = lane + 64 * jj, h = p >> 5, i = p & 31;
                u16* q = QKVUP + (size_t)row * UPN + h * 192 + 128;
                const float x1 = bf2f(q[i]), x2 = bf2f(q[32 + i]), cs = ROPEC[t * 32 + i], sn = ROPES[t * 32 + i];
                q[i] = (u16)f2bf(x1 * cs - x2 * sn); q[32 + i] = (u16)f2bf(x2 * cs + x1 * sn); }
        }
        GRID_BAR();
    }
    if (IN(8)) {
#if FAST_ATTN
        { const int NU_L = NB * 4 * 8, NU_X = NB * 4;
          for (int u = blockIdx.x; u < NU_L + NU_X; u += G) {
            const bool isx = u >= NU_L; const int uu = isx ? u - NU_L : u;
            const int qb = isx ? 0 : (uu & 7), h = isx ? (uu & 3) : ((uu >> 3) & 3), b = isx ? (uu >> 2) : (uu >> 5);
            const int r0 = isx ? (ML + b * CTXL) : (b * SEQ + qb * 256);
            fa::KVSrc S; S.k0 = QKVUP + 768 + h * 256; S.kst0 = UPN; S.k1 = KROPE; S.kst1 = 64; S.split8 = 16; S.v = QKVUP + 768 + h * 256 + 128; S.vst = UPN;
            S.xrow0 = ML + b * CTXL; S.lrow0 = b * SEQ;
            __syncthreads();
            fa::attn_unit_sp<192, 16>(QKVUP + (size_t)r0 * UPN + h * 192, UPN, S, CAT + (size_t)r0 * 1024 + h * 128, 1024, isx ? 4 : 36, (char*)lds_raw);
          } }
#else
        const float scale = 0.07216878364870322f;
        const int NU_L = NB * 4 * 64, NU_X = NB * 4 * 8;
        for (int u = blockIdx.x; u < NU_L + NU_X; u += G) {
            const bool isx = u >= NU_L; const int uu = isx ? u - NU_L : u;
            const int nqb = isx ? 8 : 64;
            const int qb = uu % nqb, h = (uu / nqb) & 3, b = uu / (nqb * 4);
            const int r0 = isx ? (ML + b * CTXL + qb * 32) : (b * SEQ + qb * 32);
            const int nkeys = isx ? CTXL : (CTXL + SEQ);
            auto krow = [&](int key) { return key < CTXL ? (ML + b * CTXL + key) : (b * SEQ + key - CTXL); };
            auto ql = [&](int r, int d) { return bf2f(QKVUP[(size_t)(r0 + r) * UPN + h * 192 + d]); };
            auto kl = [&](int key, int d) { const int row = krow(key); return d < 128 ? bf2f(QKVUP[(size_t)row * UPN + 768 + h * 256 + d]) : bf2f(KROPE[(size_t)row * 64 + d - 128]); };
            auto vl = [&](int key, int d) { const int row = krow(key); return bf2f(QKVUP[(size_t)row * UPN + 768 + h * 256 + 128 + d]); };
            auto os = [&](int r, int d, float val) { CAT[(size_t)(r0 + r) * 1024 + h * 128 + d] = (u16)f2bf(val); };
            naive_attn_unit<192>(lds, nkeys, scale, ql, kl, vl, os);
        }
#endif
        GRID_BAR();
    }
    if (IN(9)) {
#if FAST_GEMM
        { pg8::Gemm g{CAT, W_OA, 1024, 1024}; pg8::DenseOrder S; S.init(M / 256, 4, G, (int)blockIdx.x); pg8::EpiStore E{YB, 1024};
          pg8::gemm_phase<pg8::EpiStore, pg8::DenseOrder, PG8_ALIGN, PG8_SP2>(lds, g, S, E); }
#else
        auto epi = [&](int r, int c, float a, float) { YB[(size_t)r * 1024 + c] = (u16)f2bf(a); };
        naive_gemm<false>(lds, CAT, 1024, M / 128, w_out_a, nullptr, 1024, 1024, 1024, nullptr, 0, epi);
#endif
        GRID_BAR();
    }
    if (IN(10)) {
        for (int row = gw; row < M; row += NGW) {
            const float* src = row < ML ? x_in + (size_t)row * 1024 : ctx_in + (size_t)(row - ML) * 1024;
            float* dst = row < ML ? out + (size_t)row * 1024 : CTXS + (size_t)(row - ML) * 1024;
            const int mr = row < ML ? (row >> 11) : 16;
            f32x4 xv[4], tv[4], hv[4]; ld_row_f32(src, lane, xv); ld_row_bf16(YB + (size_t)row * 1024, lane, tv);
            rms_apply(tv, g_post_mix, lane);
            const float* gate = modp(ws, 0, mr, 2);
#pragma unroll
            for (int j = 0; j < 4; ++j) xv[j] = xv[j] + *(const f32x4*)(gate + 4 * lane + 256 * j) * tv[j];
            st_row_f32(dst, lane, xv);
            premod(xv, hv, g_pre_ffn, modp(ws, 0, mr, 3), modp(ws, 0, mr, 4), lane);
            st_row_bf16(H1 + (size_t)row * 1024, lane, hv);
        }
        GRID_BAR();
    }
    if (IN(11)) {
#if FAST_GEMM
        { pg8::Gemm g{H1, W_FGU, 1024, 1024}; pg8::DenseOrder S; S.init(M / 256, 2 * FFN / 256, G, (int)blockIdx.x); pg8::EpiSwiglu E{HID, FFN};
          pg8::gemm_phase<pg8::EpiSwiglu, pg8::DenseOrder, PG8_ALIGN, PG8_SP2>(lds, g, S, E); }
#else
        auto epi = [&](int r, int c, float a, float b2) { HID[(size_t)r * FFN + c] = (u16)f2bf(silu_f(a) * b2); };
        naive_gemm<true>(lds, H1, 1024, M / 128, ffn_w_gate, ffn_w_up, 1024, FFN, FFN, nullptr, 0, epi);
#endif
        GRID_BAR();
    }
    if (IN(12)) {
#if FAST_GEMM
        { pg8::Gemm g{HID, W_FD, FFN, FFN}; pg8::DenseOrder S; S.init(M / 256, 4, G, (int)blockIdx.x); pg8::EpiStore E{FB, 1024};
          pg8::gemm_phase<pg8::EpiStore, pg8::DenseOrder, PG8_ALIGN, PG8_SP2>(lds, g, S, E); }
#else
        auto epi = [&](int r, int c, float a, float) { FB[(size_t)r * 1024 + c] = (u16)f2bf(a); };
        naive_gemm<false>(lds, HID, FFN, M / 128, ffn_w_down, nullptr, FFN, 1024, 1024, nullptr, 0, epi);
#endif
        GRID_BAR();
    }
    if (IN(13)) {
        for (int row = gw; row < M; row += NGW) {
            float* dst = row < ML ? out + (size_t)row * 1024 : CTXS + (size_t)(row - ML) * 1024;
            const int mr = row < ML ? (row >> 11) : 16;
            f32x4 xv[4], tv[4], hv[4]; ld_row_f32(dst, lane, xv); ld_row_bf16(FB + (size_t)row * 1024, lane, tv);
            rms_apply(tv, g_post_ffn, lane);
            const float* gate = modp(ws, 0, mr, 5);
#pragma unroll
            for (int j = 0; j < 4; ++j) xv[j] = xv[j] + *(const f32x4*)(gate + 4 * lane + 256 * j) * tv[j];
            st_row_f32(dst, lane, xv);
            premod(xv, hv, g_pre_mix + 1024, modp(ws, 1, mr, 0), modp(ws, 1, mr, 1), lane);
            st_row_bf16(HB + (size_t)row * 1024, lane, hv);
        }
        GRID_BAR();
    }
    if (IN(14)) {
#if FAST_GEMM
        { pg8::Gemm g{HB, W_QKV, 1024, 1024}; pg8::DenseOrder S; S.init(M / 256, 12, G, (int)blockIdx.x); pg8::EpiStore E{QKVC, 3072};
          pg8::gemm_phase<pg8::EpiStore, pg8::DenseOrder, PG8_ALIGN, PG8_SP2>(lds, g, S, E); }
#else
        auto epi = [&](int r, int c, float a, float) { QKVC[(size_t)r * 3072 + c] = (u16)f2bf(a); };
        naive_gemm<false>(lds, HB, 1024, M / 128, w_qkv_c, nullptr, 1024, 3072, 3072, nullptr, 0, epi);
#endif
        GRID_BAR();
    }
    if (IN(15)) {
        for (int row = gw; row < ML; row += NGW) {
            const int t = row & 2047;
#pragma unroll 4
            for (int jj = 0; jj < 16; ++jj) { const int p = lane + 64 * jj, which = p >> 9, hh = (p & 511) >> 5, i = p & 31;
                u16* q = QKVC + (size_t)row * 3072 + which * 1024 + hh * 64;
                const float x1 = bf2f(q[i]), x2 = bf2f(q[32 + i]), cs = ROPEC[t * 32 + i], sn = ROPES[t * 32 + i];
                q[i] = (u16)f2bf(x1 * cs - x2 * sn); q[32 + i] = (u16)f2bf(x2 * cs + x1 * sn); }
        }
        GRID_BAR();
    }
    if (IN(16)) {
#if FAST_ATTN
        { const int NU = NB * 16 * 8;
          for (int u = blockIdx.x; u < NU; u += G) {
            const int qb = u & 7, j = (u >> 3) & 15, b = u >> 7;
            const int r0 = b * SEQ + qb * 256;
            fa::KVSrc S; S.k0 = QKVC + 1024 + j * 64; S.kst0 = 3072; S.k1 = QKVC; S.kst1 = 3072; S.split8 = 8; S.v = QKVC + 2048 + (j >> 1) * 128; S.vst = 3072;
            S.xrow0 = ML + b * CTXL; S.lrow0 = b * SEQ;
            __syncthreads();
            fa::attn_unit<64>(QKVC + (size_t)r0 * 3072 + j * 64, 3072, S, O16 + (size_t)r0 * 2048 + j * 128, 2048, 36, (char*)lds_raw);
          } }
#else
        const int NU = NB * 16 * 64;
        for (int u = blockIdx.x; u < NU; u += G) {
            const int qb = u & 63, j = (u >> 6) & 15, b = u >> 10;
            const int r0 = b * SEQ + qb * 32;
            auto krow = [&](int key) { return key < CTXL ? (ML + b * CTXL + key) : (b * SEQ + key - CTXL); };
            auto ql = [&](int r, int d) { return bf2f(QKVC[(size_t)(r0 + r) * 3072 + j * 64 + d]); };
            auto kl = [&](int key, int d) { return bf2f(QKVC[(size_t)krow(key) * 3072 + 1024 + j * 64 + d]); };
            auto vl = [&](int key, int d) { return bf2f(QKVC[(size_t)krow(key) * 3072 + 2048 + (j >> 1) * 128 + d]); };
            auto os = [&](int r, int d, float val) { O16[(size_t)(r0 + r) * 2048 + j * 128 + d] = (u16)f2bf(val); };
            naive_attn_unit<64>(lds, CTXL + SEQ, 0.125f, ql, kl, vl, os);
        }
#endif
        GRID_BAR();
    }
    if (IN(17)) {
#if FAST_GEMM
        { LAS float* scr = (LAS float*)(lds + wave * 8448); int off = 0;
#pragma unroll 1
          for (int e = 0; e < NE; ++e) {
              cvt_matrix(moe_w_gate + (size_t)e * 1024 * ED, 1024, ED, W_MGU + (size_t)e * 2 * ED * 1024, 1024, 0, map_gate, scr, lane, gw, NGW, off);
              cvt_matrix(moe_w_up + (size_t)e * 1024 * ED, 1024, ED, W_MGU + (size_t)e * 2 * ED * 1024, 1024, 0, map_up, scr, lane, gw, NGW, off);
              cvt_matrix(moe_w_down + (size_t)e * ED * 1024, ED, 1024, W_MD + (size_t)e * 1024 * ED, ED, 0, map_id, scr, lane, gw, NGW, off); } }
#endif
        const float s1 = wave_sum(diff_lq1[lane] * diff_lk1[lane]), s2 = wave_sum(diff_lq2[lane] * diff_lk2[lane]);
        const float lam = expf(s1) - expf(s2) + LAM_INIT;
        for (int row = gw; row < ML; row += NGW) {
            const int h = lane >> 3, v0 = (lane & 7) * 16;
            const u16* p1 = O16 + (size_t)row * 2048 + (2 * h) * 128 + v0; const u16* p2 = p1 + 128;
            float o[16]; float s = 0.f;
#pragma unroll
            for (int i = 0; i < 16; ++i) { o[i] = bf2f(p1[i]) - lam * bf2f(p2[i]); s += o[i] * o[i]; }
#pragma unroll
            for (int off = 1; off < 8; off <<= 1) s += __shfl_xor(s, off);
            const float r = 1.0f / sqrtf(s * (1.0f / 128.0f) + EPS);
            u16* po = CAT2 + (size_t)row * 1024 + h * 128 + v0;
#pragma unroll
            for (int i = 0; i < 16; ++i) po[i] = (u16)f2bf(o[i] * r * diff_g_out[v0 + i] * (1.0f - LAM_INIT));
        }
        GRID_BAR();
    }
    if (IN(18)) {
#if FAST_GEMM
        { pg8::Gemm g{CAT2, W_OC, 1024, 1024}; pg8::DenseOrder S; S.init(ML / 256, 4, G, (int)blockIdx.x); pg8::EpiStore E{Y2, 1024};
          pg8::gemm_phase<pg8::EpiStore, pg8::DenseOrder, PG8_ALIGN, PG8_SP2>(lds, g, S, E); }
#else
        auto epi = [&](int r, int c, float a, float) { Y2[(size_t)r * 1024 + c] = (u16)f2bf(a); };
        naive_gemm<false>(lds, CAT2, 1024, ML / 128, w_out_c, nullptr, 1024, 1024, 1024, nullptr, 0, epi);
#endif
        GRID_BAR();
    }
    if (IN(19)) {
        LAS int* lcnt = (LAS int*)lds;
        LAS int* gbase = lcnt + 8;
        LAS int* le = gbase + 8;
        LAS int* lr = le + 256;
        LAS float* lg = (LAS float*)(lr + 256);
        for (int base = blockIdx.x * 128; base < ML; base += G * 128) {
            __syncthreads();
            if (tid < 8) lcnt[tid] = 0;
            __syncthreads();
            for (int i = 0; i < 16; ++i) {
                const int lrow = wave * 16 + i, row = base + lrow;
                float* dst = out + (size_t)row * 1024;
                const int mr = row >> 11;
                f32x4 xv[4], tv[4], hv[4]; ld_row_f32(dst, lane, xv); ld_row_bf16(Y2 + (size_t)row * 1024, lane, tv);
                rms_apply(tv, g_post_mix + 1024, lane);
                const float* gate = modp(ws, 1, mr, 2);
#pragma unroll
                for (int j = 0; j < 4; ++j) xv[j] = xv[j] + *(const f32x4*)(gate + 4 * lane + 256 * j) * tv[j];
                st_row_f32(dst, lane, xv);
                premod(xv, hv, g_pre_ffn + 1024, modp(ws, 1, mr, 3), modp(ws, 1, mr, 4), lane);
                st_row_bf16(HC + (size_t)row * 1024, lane, hv);
                float lg8[8];
#pragma unroll
                for (int e = 0; e < 8; ++e) lg8[e] = 0.f;
#pragma unroll
                for (int j = 0; j < 4; ++j)
#pragma unroll
                    for (int q = 0; q < 4; ++q) { const int k = 4 * lane + 256 * j + q; const float hvv = hv[j][q];
                        const f32x4 wa = *(const f32x4*)(moe_w_router + (size_t)k * 8), wb = *(const f32x4*)(moe_w_router + (size_t)k * 8 + 4);
                        lg8[0] += hvv * wa.x; lg8[1] += hvv * wa.y; lg8[2] += hvv * wa.z; lg8[3] += hvv * wa.w;
                        lg8[4] += hvv * wb.x; lg8[5] += hvv * wb.y; lg8[6] += hvv * wb.z; lg8[7] += hvv * wb.w; }
#pragma unroll
                for (int e = 0; e < 8; ++e) lg8[e] = wave_sum(lg8[e]);
                if (lane == 0) {
                    int e0 = 0; float v0 = lg8[0];
#pragma unroll
                    for (int e = 1; e < 8; ++e) if (lg8[e] > v0) { v0 = lg8[e]; e0 = e; }
                    int e1 = -1; float v1 = -3.0e38f;
#pragma unroll
                    for (int e = 0; e < 8; ++e) if (e != e0 && lg8[e] > v1) { v1 = lg8[e]; e1 = e; }
                    const float g0 = 1.0f / (1.0f + expf(v1 - v0));
                    le[lrow * 2] = e0; le[lrow * 2 + 1] = e1; lg[lrow * 2] = g0; lg[lrow * 2 + 1] = 1.0f - g0;
                    lr[lrow * 2] = __hip_atomic_fetch_add(&lcnt[e0], 1, __ATOMIC_RELAXED, __HIP_MEMORY_SCOPE_WORKGROUP); lr[lrow * 2 + 1] = __hip_atomic_fetch_add(&lcnt[e1], 1, __ATOMIC_RELAXED, __HIP_MEMORY_SCOPE_WORKGROUP);
                }
            }
            __syncthreads();
            if (tid < 8) gbase[tid] = (int)atomicAdd(ctl + CW_ECNT + 64 * tid, (unsigned)lcnt[tid]);
            __syncthreads();
            if (tid < 256) { const int e = le[tid]; TOKE[(size_t)base * 2 + tid] = e; TOKG[(size_t)base * 2 + tid] = lg[tid]; TOKP[(size_t)base * 2 + tid] = gbase[e] + lr[tid]; }
        }
        GRID_BAR();
    }
    if (IN(20)) {
        LAS int* pst = (LAS int*)lds;
        if (tid == 0) { int acc = 0; for (int e = 0; e < 8; ++e) { pst[e] = acc; const int c = (int)ctl[CW_ECNT + 64 * e]; acc += (c + 255) / 256 * 256; } pst[8] = acc; }
        __syncthreads();
        if (blockIdx.x == 0) {
            if (tid == 0) ctl[CW_MOET] = (unsigned)(pst[8] / 256);
            for (int t = tid; t < pst[8] / 256; t += 512) { int e = 0; for (int q = 1; q < 8; ++q) if (t * 256 >= pst[q]) e = q; ctl[CW_TILEE + t] = (unsigned)e; }
        }
        for (int s = gw; s < 2 * ML; s += NGW) {
            const int e = TOKE[s], pos = pst[e] + TOKP[s];
            const uint4* src = (const uint4*)(HC + (size_t)(s >> 1) * 1024); uint4* dstp = (uint4*)(XS + (size_t)pos * 1024);
            const uint4 a = src[lane], b2 = src[lane + 64];
            dstp[lane] = a; dstp[lane + 64] = b2;
            if (lane == 0) TOKP[s] = pos;
        }
        GRID_BAR();
    }
    if (IN(21)) {
        const int T = (int)ctl[CW_MOET];
        for (int c0 = 0; c0 < T; c0 += CHUNK_T) {
            const int nt = (T - c0) < CHUNK_T ? (T - c0) : CHUNK_T;
#if FAST_GEMM
            { pg8::Gemm g{XS, W_MGU, 1024, 1024}; pg8::MoeOrder S; S.init(nt, 2 * ED / 256, G, (int)blockIdx.x); S.tile_e = ctl + CW_TILEE + c0; S.nper = 2 * ED / 256; S.a_off = c0; S.o_off = 0;
              pg8::EpiSwiglu E{HIDC, ED};
              pg8::gemm_phase<pg8::EpiSwiglu, pg8::MoeOrder, PG8_ALIGN, PG8_SP2>(lds, g, S, E); }
#else
            { auto epi = [&](int r, int c, float a, float b2) { HIDC[(size_t)r * ED + c] = (u16)f2bf(silu_f(a) * b2); };
              naive_gemm<true>(lds, XS + (size_t)c0 * 256 * 1024, 1024, nt * 2, moe_w_gate, moe_w_up, 1024, ED, ED, ctl + CW_TILEE + c0, (size_t)1024 * ED, epi); }
#endif
            GRID_BAR();
#if FAST_GEMM
            { pg8::Gemm g{HIDC, W_MD, ED, ED}; pg8::MoeOrder S; S.init(nt, 4, G, (int)blockIdx.x); S.tile_e = ctl + CW_TILEE + c0; S.nper = 4; S.a_off = 0; S.o_off = c0;
              pg8::EpiStore E{XS, 1024};
              pg8::gemm_phase<pg8::EpiStore, pg8::MoeOrder, PG8_ALIGN, PG8_SP2>(lds, g, S, E); }
#else
            { u16* ys = XS + (size_t)c0 * 256 * 1024;
              auto epi = [&](int r, int c, float a, float) { ys[(size_t)r * 1024 + c] = (u16)f2bf(a); };
              naive_gemm<false>(lds, HIDC, ED, nt * 2, moe_w_down, nullptr, ED, 1024, 1024, ctl + CW_TILEE + c0, (size_t)ED * 1024, epi); }
#endif
            GRID_BAR();
        }
    }
    if (IN(22)) {
        for (int row = gw; row < ML; row += NGW) {
            float* dst = out + (size_t)row * 1024;
            const int mr = row >> 11;
            const int p0 = TOKP[row * 2], p1 = TOKP[row * 2 + 1]; const float g0 = TOKG[row * 2], g1 = TOKG[row * 2 + 1];
            f32x4 xv[4], a[4], b2[4]; ld_row_f32(dst, lane, xv); ld_row_bf16(XS + (size_t)p0 * 1024, lane, a); ld_row_bf16(XS + (size_t)p1 * 1024, lane, b2);
#pragma unroll
            for (int j = 0; j < 4; ++j) a[j] = a[j] * g0 + b2[j] * g1;
            rms_apply(a, g_post_ffn + 1024, lane);
            const float* gate = modp(ws, 1, mr, 5);
#pragma unroll
            for (int j = 0; j < 4; ++j) xv[j] = xv[j] + *(const f32x4*)(gate + 4 * lane + 256 * j) * a[j];
            st_row_f32(dst, lane, xv);
        }
    }
#undef IN
#undef GRID_BAR
}

extern "C" void kernel_launch(void* const* d_in, const int* in_sizes, int n_in, void* d_out, int out_size, void* d_ws, size_t ws_size, hipStream_t stream) {
    static int grid = 0;
    if (grid == 0) {
        if (n_in != 35 || in_sizes[0] != ML * D || out_size != ML * D || ws_size < WS_END) {
            fprintf(stderr, "kernel_launch: shape mismatch n_in %d in0 %d out %d ws %zu (need %zu)\n", n_in, n_in > 0 ? in_sizes[0] : -1, out_size, ws_size, (size_t)WS_END); grid = -1; return; }
        int dev = 0, cus = 0, per_cu = 0;
        if (hipGetDevice(&dev) != hipSuccess || hipDeviceGetAttribute(&cus, hipDeviceAttributeMultiprocessorCount, dev) != hipSuccess) { grid = -1; return; }
        if (hipFuncSetAttribute((const void*)fwd_kernel, hipFuncAttributeMaxDynamicSharedMemorySize, LDS_BYTES) != hipSuccess) { fprintf(stderr, "kernel_launch: hipFuncSetAttribute failed\n"); grid = -1; return; }
        if (hipOccupancyMaxActiveBlocksPerMultiprocessor(&per_cu, (const void*)fwd_kernel, 512, LDS_BYTES) != hipSuccess || per_cu < 1)
            fprintf(stderr, "kernel_launch: occupancy query reports %d\n", per_cu);
        (void)hipGetLastError();
        grid = cus;
    }
    if (grid < 0) return;
    if (hipMemsetAsync((char*)d_ws + WS_CTL, 0, CTL_ZERO_BYTES, stream) != hipSuccess) return;
    Args a{};
    for (int i = 0; i < 35; ++i) a.in[i] = (const float*)d_in[i];
    a.out = (float*)d_out; a.ws = (unsigned char*)d_ws; a.ph_lo = 0; a.ph_hi = 100;
    hipLaunchKernelGGL(fwd_kernel, dim3(grid), dim3(512), LDS_BYTES, stream, a);
}
```

```cpp
#include <hip/hip_runtime.h>
#include <cstdio>
#include <cstdint>

constexpr int D = 1024, NB = 16, SEQ = 2048, CTXL = 256;
constexpr int ML = NB * SEQ, MX = NB * CTXL, M = ML + MX;
constexpr int IN_A = 2016, IN_AP = 2048;
constexpr int C_CQ = 0, C_CKV = 256, C_KR = 384, C_GQ = 448, C_GK = 704, C_GV = 960, C_GR = 1472, C_AF = 1984, C_AB = 2000;
constexpr int UPN = 1792;
constexpr int FFN = 2816, NE = 8, ED = 3584;
constexpr int CAP = 2 * ML + NE * 256, MAXT = CAP / 256;
constexpr int CHUNK_T = 64;
constexpr float EPS = 1e-6f;
constexpr float LAM_INIT = 0.35550906759f;

constexpr size_t MiB = 1u << 20;
constexpr size_t WS_CTL = 0, CTL_ZERO_BYTES = 1 * MiB;
constexpr size_t WS_MOD = 1 * MiB;
constexpr size_t WS_ROPE = 2 * MiB;
constexpr size_t WS_TOKE = 2 * MiB + 512 * 1024;
constexpr size_t WS_TOKG = WS_TOKE + 256 * 1024;
constexpr size_t WS_TOKP = WS_TOKG + 256 * 1024;
constexpr size_t WS_CTXS = 4 * MiB;
constexpr size_t WS_W = 20 * MiB;
constexpr size_t WS_R0 = 52 * MiB;
constexpr size_t WS_PARTS = 124 * MiB;
constexpr size_t WS_Y = 124 * MiB;
constexpr size_t WS_H1 = 196 * MiB;
constexpr size_t WS_HC = 116 * MiB;
constexpr size_t WS_XS = 180 * MiB;
constexpr size_t WS_A2 = 268 * MiB;
constexpr size_t WS_KROPE = 295 * MiB;
constexpr size_t WS_R3 = 300 * MiB;
constexpr size_t WS_MOEW = 332 * MiB;
constexpr size_t WS_END = 516 * MiB;
constexpr int CW_BAR = 4096;
constexpr int CW_ECNT = 8192;
constexpr int CW_MOET = 9000;
constexpr int CW_TILEE = 9216;

typedef unsigned short u16;
typedef float f32x4 __attribute__((ext_vector_type(4)));
#define LAS __attribute__((address_space(3)))
constexpr int LDS_BYTES = 147456;
constexpr int MISC_OFF = 131072 + 320;

#define XB_TMO      128
#define XB_XCNT(j)  (256  + 64 * (j))
#define XB_XSUB(j)  (1280 + 64 * (j))
#define XB_XGEN(j)  (2304 + 64 * (j))
#define XB_TOP      3328
#define XB_TOPGEN   3392
#define XCD_BAR_WORDS 3456
#define XB_SPIN_CAP (1u << 23)
__device__ __forceinline__ unsigned xb_ld(unsigned* p)              { return __hip_atomic_load(p, __ATOMIC_RELAXED, __HIP_MEMORY_SCOPE_AGENT); }
__device__ __forceinline__ unsigned xb_add(unsigned* p, unsigned v) { return __hip_atomic_fetch_add(p, v, __ATOMIC_RELAXED, __HIP_MEMORY_SCOPE_AGENT); }
__device__ __forceinline__ unsigned xb_xcc_id() { return (unsigned)__builtin_amdgcn_s_getreg((3 << 11) | 20) & 0xFu; }
#define XB_SPIN(cond, bar) do { unsigned _sp = 0; while (cond) { __builtin_amdgcn_s_sleep(1); \
    if ((++_sp & 255u) == 0u) { if (xb_ld(&(bar)[XB_TMO])) break; if (_sp > XB_SPIN_CAP) { atomicAdd(&(bar)[XB_TMO], 1u); break; } } } } while (0)
struct XcdBarrier { unsigned* bar; unsigned x; volatile LAS unsigned* st; };
__device__ __forceinline__ XcdBarrier xcd_barrier_post(unsigned* bar, volatile LAS unsigned* st) {
    XcdBarrier b; b.bar = bar; b.x = xb_xcc_id(); b.st = st;
    if (threadIdx.x == 0) (void)xb_add(&bar[XB_XCNT(b.x)], 1u);
    return b;
}
__device__ __forceinline__ void xcd_barrier_complete(unsigned* bar, unsigned x, unsigned& nloc, unsigned& nx) {
    const unsigned G = gridDim.x * gridDim.y * gridDim.z;
    unsigned sum, cnt, mine, sp = 0u;
    for (;;) {
        sum = 0u; cnt = 0u; mine = 0u;
#pragma unroll
        for (unsigned j = 0; j < 16; ++j) { const unsigned c = xb_ld(&bar[XB_XCNT(j)]); sum += c; cnt += (c > 0u) ? 1u : 0u; mine = (j == x) ? c : mine; }
        if (sum == G) break;
        __builtin_amdgcn_s_sleep(1);
        if ((++sp & 255u) == 0u) { if (xb_ld(&bar[XB_TMO])) break; if (sp > XB_SPIN_CAP) { atomicAdd(&bar[XB_TMO], 1u); break; } }
    }
    nloc = mine > 0u ? mine : 1u; nx = cnt > 0u ? cnt : 1u;
}
__device__ __forceinline__ void xcd_barrier(const XcdBarrier& b) {
    asm volatile("s_waitcnt vmcnt(0)" ::: "memory");
    __syncthreads();
    if (threadIdx.x == 0) {
        unsigned* bar = b.bar;
        __builtin_amdgcn_s_waitcnt(0);
        unsigned nloc = b.st[0], nx = b.st[1];
        if (nloc == 0u) { xcd_barrier_complete(bar, b.x, nloc, nx); b.st[0] = nloc; b.st[1] = nx; }
        const unsigned old = xb_add(&bar[XB_XSUB(b.x)], 1u);
        const unsigned gen = old / nloc;
        if (old + 1u == (gen + 1u) * nloc) {
            __builtin_amdgcn_fence(__ATOMIC_RELEASE, "agent");
            asm volatile("s_waitcnt vmcnt(0)" ::: "memory");
            const unsigned og = xb_add(&bar[XB_TOP], 1u);
            const unsigned tg = og / nx;
            if (og + 1u == (tg + 1u) * nx) xb_add(&bar[XB_TOPGEN], 1u);
            else XB_SPIN(xb_ld(&bar[XB_TOPGEN]) == tg, bar);
            __builtin_amdgcn_fence(__ATOMIC_ACQUIRE, "agent");
            xb_add(&bar[XB_XGEN(b.x)], 1u);
            asm volatile("s_waitcnt vmcnt(0)" ::: "memory");
        } else {
            XB_SPIN(xb_ld(&bar[XB_XGEN(b.x)]) == gen, bar);
            __builtin_amdgcn_fence(__ATOMIC_ACQUIRE, "agent");
            asm volatile("s_waitcnt vmcnt(0)" ::: "memory");
        }
    }
    __syncthreads();
}

__device__ __forceinline__ float bf2f(unsigned h) { return __uint_as_float(h << 16); }
__device__ __forceinline__ unsigned f2bf(float f) { unsigned u = __float_as_uint(f); return (u + 0x7fffu + ((u >> 16) & 1u)) >> 16; }
__device__ __forceinline__ float wave_sum(float v) {
#pragma unroll
    for (int o = 1; o < 64; o <<= 1) v += __shfl_xor(v, o);
    return v;
}
__device__ __forceinline__ float silu_f(float x) { return x / (1.0f + __expf(-x)); }
__device__ __forceinline__ void ld_row_f32(const float* p, int lane, f32x4 (&v)[4]) {
#pragma unroll
    for (int j = 0; j < 4; ++j) v[j] = *(const f32x4*)(p + 4 * lane + 256 * j);
}
__device__ __forceinline__ void ld_row_bf16(const u16* p, int lane, f32x4 (&v)[4]) {
#pragma unroll
    for (int j = 0; j < 4; ++j) { const uint2 w = *(const uint2*)(p + 4 * lane + 256 * j);
        v[j] = (f32x4){bf2f(w.x & 0xffffu), bf2f(w.x >> 16), bf2f(w.y & 0xffffu), bf2f(w.y >> 16)}; }
}
__device__ __forceinline__ void st_row_f32(float* p, int lane, const f32x4 (&v)[4]) {
#pragma unroll
    for (int j = 0; j < 4; ++j) *(f32x4*)(p + 4 * lane + 256 * j) = v[j];
}
__device__ __forceinline__ void st_row_bf16(u16* p, int lane, const f32x4 (&v)[4]) {
#pragma unroll
    for (int j = 0; j < 4; ++j) { uint2 w; w.x = f2bf(v[j].x) | (f2bf(v[j].y) << 16); w.y = f2bf(v[j].z) | (f2bf(v[j].w) << 16);
        *(uint2*)(p + 4 * lane + 256 * j) = w; }
}
__device__ __forceinline__ float row_rstd(const f32x4 (&v)[4]) {
    float s = 0.f;
#pragma unroll
    for (int j = 0; j < 4; ++j) s += (v[j].x * v[j].x + v[j].y * v[j].y) + (v[j].z * v[j].z + v[j].w * v[j].w);
    s = wave_sum(s);
    return 1.0f / sqrtf(s * (1.0f / 1024.0f) + EPS);
}
__device__ __forceinline__ void rms_apply(f32x4 (&v)[4], const float* g, int lane) {
    const float r = row_rstd(v);
#pragma unroll
    for (int j = 0; j < 4; ++j) { const f32x4 gg = *(const f32x4*)(g + 4 * lane + 256 * j); v[j] = v[j] * r * gg; }
}
__device__ __forceinline__ void premod(const f32x4 (&x)[4], f32x4 (&h)[4], const float* g, const float* shift, const float* scale, int lane) {
    const float r = row_rstd(x);
#pragma unroll
    for (int j = 0; j < 4; ++j) { const int c = 4 * lane + 256 * j; const f32x4 gg = *(const f32x4*)(g + c), sh = *(const f32x4*)(shift + c), sc = *(const f32x4*)(scale + c);
        h[j] = x[j] * r * gg * (1.0f + sc) + sh; }
}

struct Args { const float* in[35]; float* out; unsigned char* ws; int ph_lo, ph_hi; };

__device__ __forceinline__ const float* modp(const unsigned char* ws, int l, int r, int which) { return (const float*)(ws + WS_MOD) + ((size_t)(l * 17 + r) * 6 + which) * 1024; }

template <bool DUAL, class Epi>
__device__ __forceinline__ void naive_gemm(LAS unsigned char* lds, const u16* A, int lda, int ntiles_m, const float* W0, const float* W1, int K, int N, int ldw,
                                           const unsigned* tile_e, size_t estride, const Epi& epi) {
    LAS float* As = (LAS float*)lds;
    LAS float* Ws0 = As + 16 * 132;
    LAS float* Ws1 = Ws0 + 16 * 64;
    const int tid = threadIdx.x, ty = tid >> 4, tx = tid & 15;
    const int ntn = (N + 63) / 64;
    const int total = ntiles_m * ntn;
    for (int u = blockIdx.x; u < total; u += gridDim.x) {
        const int tm = u / ntn, tn = u % ntn;
        const int row0 = tm * 128, col0 = tn * 64;
        const float* w0 = W0; const float* w1 = W1;
        if (tile_e) { const unsigned e = tile_e[tm >> 1]; w0 += (size_t)e * estride; if (DUAL) w1 += (size_t)e * estride; }
        float acc0[4][4], acc1[4][4];
#pragma unroll
        for (int i = 0; i < 4; ++i)
#pragma unroll
            for (int j = 0; j < 4; ++j) { acc0[i][j] = 0.f; acc1[i][j] = 0.f; }
        for (int k0 = 0; k0 < K; k0 += 16) {
            { const int r = tid >> 2, kq = (tid & 3) * 4; const uint2 w = *(const uint2*)(A + (size_t)(row0 + r) * lda + k0 + kq);
              As[(kq + 0) * 132 + r] = bf2f(w.x & 0xffffu); As[(kq + 1) * 132 + r] = bf2f(w.x >> 16);
              As[(kq + 2) * 132 + r] = bf2f(w.y & 0xffffu); As[(kq + 3) * 132 + r] = bf2f(w.y >> 16); }
            { const int kk = tid >> 5, n = (tid & 31) * 2, c = col0 + n;
              float a = 0.f, b = 0.f;
              if (c < N) { const float2 t = *(const float2*)(w0 + (size_t)(k0 + kk) * ldw + c); a = t.x; b = t.y; }
              Ws0[kk * 64 + n] = a; Ws0[kk * 64 + n + 1] = b;
              if (DUAL) { float a1 = 0.f, b1 = 0.f;
                  if (c < N) { const float2 t = *(const float2*)(w1 + (size_t)(k0 + kk) * ldw + c); a1 = t.x; b1 = t.y; }
                  Ws1[kk * 64 + n] = a1; Ws1[kk * 64 + n + 1] = b1; } }
            __syncthreads();
#pragma unroll
            for (int kk = 0; kk < 16; ++kk) {
                const f32x4 a = *(const LAS f32x4*)(As + kk * 132 + ty * 4);
                const f32x4 b = *(const LAS f32x4*)(Ws0 + kk * 64 + tx * 4);
#pragma unroll
                for (int i = 0; i < 4; ++i)
#pragma unroll
                    for (int j = 0; j < 4; ++j) acc0[i][j] += a[i] * b[j];
                if (DUAL) { const f32x4 b1 = *(const LAS f32x4*)(Ws1 + kk * 64 + tx * 4);
#pragma unroll
                    for (int i = 0; i < 4; ++i)
#pragma unroll
                        for (int j = 0; j < 4; ++j) acc1[i][j] += a[i] * b1[j]; }
            }
            __syncthreads();
        }
#pragma unroll
        for (int i = 0; i < 4; ++i)
#pragma unroll
            for (int j = 0; j < 4; ++j) { const int r = row0 + ty * 4 + i, c = col0 + tx * 4 + j; if (c < N) epi(r, c, acc0[i][j], acc1[i][j]); }
    }
}

template <int DQ, class QL, class KL, class VL, class OS>
__device__ __forceinline__ void naive_attn_unit(LAS unsigned char* lds, int nkeys, float scale, const QL& ql, const KL& kl, const VL& vl, const OS& os) {
    LAS float* Qs = (LAS float*)lds;
    LAS float* Ks = Qs + 32 * (DQ + 1);
    LAS float* Vs = Ks + 64 * (DQ + 1);
    LAS float* Ps = Vs + 64 * 128;
    const int tid = threadIdx.x, r = tid >> 4, j = tid & 15;
    __syncthreads();
    for (int e = tid; e < 32 * DQ; e += 512) { const int rr = e / DQ, d = e % DQ; Qs[rr * (DQ + 1) + d] = ql(rr, d); }
    float m = -1e30f, l = 0.f, o[8];
#pragma unroll
    for (int dd = 0; dd < 8; ++dd) o[dd] = 0.f;
    for (int k0 = 0; k0 < nkeys; k0 += 64) {
        __syncthreads();
        for (int e = tid; e < 64 * DQ; e += 512) { const int key = e / DQ, d = e % DQ; Ks[key * (DQ + 1) + d] = kl(k0 + key, d); }
        for (int e = tid; e < 64 * 128; e += 512) { const int key = e >> 7, d = e & 127; Vs[key * 128 + d] = vl(k0 + key, d); }
        __syncthreads();
        float s[4];
#pragma unroll
        for (int c = 0; c < 4; ++c) { const LAS float* kp = Ks + (j + 16 * c) * (DQ + 1); const LAS float* qp = Qs + r * (DQ + 1); float a = 0.f;
            for (int d = 0; d < DQ; ++d) a += qp[d] * kp[d];
            s[c] = a * scale; }
        float tmax = fmaxf(fmaxf(s[0], s[1]), fmaxf(s[2], s[3]));
#pragma unroll
        for (int off = 1; off < 16; off <<= 1) tmax = fmaxf(tmax, __shfl_xor(tmax, off));
        const float mn = fmaxf(m, tmax), alpha = __expf(m - mn);
        float ps = 0.f;
#pragma unroll
        for (int c = 0; c < 4; ++c) { const float p = __expf(s[c] - mn); Ps[r * 64 + j + 16 * c] = p; ps += p; }
#pragma unroll
        for (int off = 1; off < 16; off <<= 1) ps += __shfl_xor(ps, off);
        l = l * alpha + ps; m = mn;
#pragma unroll
        for (int dd = 0; dd < 8; ++dd) o[dd] *= alpha;
        __syncthreads();
        for (int key = 0; key < 64; ++key) { const float p = Ps[r * 64 + key]; const LAS float* vp = Vs + key * 128 + j * 8;
#pragma unroll
            for (int dd = 0; dd < 8; ++dd) o[dd] += p * vp[dd]; }
    }
    const float il = 1.0f / l;
#pragma unroll
    for (int dd = 0; dd < 8; ++dd) os(r, j * 8 + dd, o[dd] * il);
}


#ifndef FAST_GEMM
#define FAST_GEMM 1
#endif
#ifndef PG8_SP2
#define PG8_SP2 true
#endif
#ifndef PG8_ALIGN
#define PG8_ALIGN true
#endif
namespace pg8 {
typedef short bf16x8 __attribute__((ext_vector_type(8)));
typedef unsigned u32x4 __attribute__((ext_vector_type(4)));
constexpr int BM = 256, BK = 64, HALF = 128, HTB = HALF * BK * 2, STAGE_BYTES = 8 * HTB, NXCD = 8, WGM = 8;
__host__ __device__ __forceinline__ int lds_byte(int r, int c) { const int st = (r >> 4) * 2 + (c >> 5), rr = r & 15, cc = c & 31, ob = rr * 64 + cc * 2; return st * 1024 + (ob ^ (((ob >> 9) & 1) << 5)); }
__host__ __device__ __forceinline__ void stage_rc(int b, int& R, int& C) { const int st = b / 1024, sb = b % 1024, swz = sb ^ (((sb >> 9) & 1) << 5); R = (st >> 1) * 16 + swz / 64; C = (st & 1) * 32 + (swz % 64) / 2; }
__host__ __device__ __forceinline__ int perm32(int rho) { const int n = rho >> 4, i = rho & 15; return 8 * (i >> 2) + 4 * n + (i & 3); }

struct Unit { int pm, pn, po, pc; };
struct Gemm { const u16* A; const u16* Bt; int lda; int K; };

struct DenseOrder {
    int nM, nN, nwg, G, c;
    __device__ __forceinline__ void init(int nM_, int nN_, int G_, int c_) { nM = nM_; nN = nN_; nwg = nM * nN; G = G_; c = c_; }
    __device__ __forceinline__ bool next2(int i, int& pm, int& pn) const {
        const long L = (long)i * G + c; if (L >= nwg) return false;
        int wgid = (int)L; { const int q = nwg / NXCD, r = nwg % NXCD, xcd = wgid % NXCD, off = wgid / NXCD; wgid = (xcd < r ? xcd * (q + 1) : r * (q + 1) + (xcd - r) * q) + off; }
        const int nig = WGM * nN, gid = wgid / nig, fm = gid * WGM, gsz = (nM - fm) < WGM ? (nM - fm) : WGM;
        pm = fm + ((wgid % nig) % gsz); pn = (wgid % nig) / gsz; return true;
    }
    __device__ __forceinline__ bool next(int i, Unit& u) const { int pm, pn; if (!next2(i, pm, pn)) return false; u.pm = pm; u.pn = pn; u.po = pm; u.pc = pn; return true; }
    __device__ __forceinline__ void a_ready(const Unit&) const {}
    __device__ __forceinline__ void done(const Unit&) const {}
};
struct MoeOrder : DenseOrder {
    const unsigned* tile_e; int nper, a_off, o_off;
    __device__ __forceinline__ bool next(int i, Unit& u) const { int pm, pn; if (!next2(i, pm, pn)) return false;
        const int e = (int)tile_e[pm]; u.pm = a_off + pm; u.pn = e * nper + pn; u.po = o_off + pm; u.pc = pn; return true; }
};

__device__ __forceinline__ unsigned cvt_pk_bf16(float lo, float hi) { unsigned r; asm volatile("v_cvt_pk_bf16_f32 %0, %1, %2" : "=v"(r) : "v"(lo), "v"(hi)); return r; }

struct EpiStore {
    static constexpr bool PERM = true, AFTER_DRAIN = false;
    u16* O; int ldc;
    __device__ __forceinline__ void operator()(const f32x4 (&acc)[2][2][4][2], const Unit& u, int wr, int wc, int fr, int fq) const {
        const int row0 = u.po * BM + wr * 64 + fr, col0 = u.pc * BM + wc * 32 + 8 * fq;
#pragma unroll
        for (int ai = 0; ai < 2; ++ai)
#pragma unroll
            for (int m = 0; m < 4; ++m) { u16* rowp = O + (size_t)(row0 + ai * HALF + m * 16) * ldc + col0;
#pragma unroll
                for (int bj = 0; bj < 2; ++bj) { const f32x4 v0 = acc[ai][bj][m][0], v1 = acc[ai][bj][m][1];
                    u32x4 w; w.x = cvt_pk_bf16(v0[0], v0[1]); w.y = cvt_pk_bf16(v0[2], v0[3]); w.z = cvt_pk_bf16(v1[0], v1[1]); w.w = cvt_pk_bf16(v1[2], v1[3]);
                    *(u32x4*)(rowp + bj * HALF) = w; } }
    }
};
struct EpiSwiglu {
    static constexpr bool PERM = true, AFTER_DRAIN = false;
    u16* O; int ldc;
    __device__ __forceinline__ void operator()(const f32x4 (&acc)[2][2][4][2], const Unit& u, int wr, int wc, int fr, int fq) const {
        const int row0 = u.po * BM + wr * 64 + fr, col0 = u.pc * HALF + wc * 32 + 8 * fq;
#pragma unroll
        for (int ai = 0; ai < 2; ++ai)
#pragma unroll
            for (int m = 0; m < 4; ++m) { u16* rowp = O + (size_t)(row0 + ai * HALF + m * 16) * ldc + col0;
                float hv[8];
#pragma unroll
                for (int n = 0; n < 2; ++n)
#pragma unroll
                    for (int q = 0; q < 4; ++q) { const float g = acc[ai][0][m][n][q], up = acc[ai][1][m][n][q]; hv[n * 4 + q] = g * __builtin_amdgcn_rcpf(1.0f + __expf(-g)) * up; }
                u32x4 w; w.x = cvt_pk_bf16(hv[0], hv[1]); w.y = cvt_pk_bf16(hv[2], hv[3]); w.z = cvt_pk_bf16(hv[4], hv[5]); w.w = cvt_pk_bf16(hv[6], hv[7]);
                *(u32x4*)rowp = w; }
    }
};

template <class Epi, class Sched, bool ALIGN_EPI = false, bool SP2 = false>
__device__ __forceinline__ void gemm_phase(LAS unsigned char* lds, const Gemm g, const Sched& S, const Epi& E) {
    const int tid = threadIdx.x, wid = __builtin_amdgcn_readfirstlane(tid >> 6), lane = tid & 63, wr = wid >> 2, wc = wid & 3, fr = lane & 15, fq = lane >> 4;
    const int K = g.K, nt = K / BK, lda = g.lda;
    unsigned voffA[2], voffB[2];
#pragma unroll
    for (int i = 0; i < 2; ++i) { int R, C; stage_rc(tid * 16 + i * 8192, R, C); const int Rb = Epi::PERM ? ((R & ~31) + perm32(R & 31)) : R;
        voffA[i] = (unsigned)(R * lda + C) * 2u; voffB[i] = (unsigned)(Rb * K + C) * 2u; }
    const size_t kstep = (size_t)(BK * 2);
    const size_t hA = (size_t)HALF * lda * 2, hB = (size_t)HALF * K * 2;
    const size_t tA = 2 * hA, tB = 2 * hB;
    const unsigned ldsw = (unsigned)wid * 1024u;
    const int aoff = lds_byte(wr * 64 + fr, fq * 8), boff = lds_byte(wc * 32 + fr, fq * 8);
#define PG8_SA(b, h) (((b) * 2 + (h)) * HTB)
#define PG8_SB(b, h) ((4 + (b) * 2 + (h)) * HTB)
#define PG8_STAGE(bufoff, gbase, voff) do { _Pragma("unroll") for (int _i = 0; _i < 2; ++_i) \
        __builtin_amdgcn_global_load_lds((const unsigned*)((const char*)(gbase) + (voff)[_i]), (LAS unsigned*)(lds + (bufoff) + ldsw + _i * 8192), 16, 0, 0); } while (0)
#define PG8_LDA(dst, b, h) do { _Pragma("unroll") for (int m = 0; m < 4; ++m) _Pragma("unroll") for (int k = 0; k < 2; ++k) dst[m][k] = *(const LAS bf16x8*)(lds + PG8_SA(b, h) + aoff + m * 2048 + k * 1024); } while (0)
#define PG8_LDB(dst, b, h) do { _Pragma("unroll") for (int n = 0; n < 2; ++n) _Pragma("unroll") for (int k = 0; k < 2; ++k) dst[n][k] = *(const LAS bf16x8*)(lds + PG8_SB(b, h) + boff + n * 2048 + k * 1024); } while (0)
#define PG8_MMA(ai, bj, At, Bt) do { __builtin_amdgcn_s_setprio(1); _Pragma("unroll") for (int m = 0; m < 4; ++m) _Pragma("unroll") for (int n = 0; n < 2; ++n) _Pragma("unroll") for (int k = 0; k < 2; ++k) \
        acc[ai][bj][m][n] = __builtin_amdgcn_mfma_f32_16x16x32_bf16(Bt[n][k], At[m][k], acc[ai][bj][m][n], 0, 0, 0); __builtin_amdgcn_s_setprio(0); } while (0)
#define PG8_WAIT_V(n) asm volatile("s_waitcnt vmcnt(" #n ")" ::: "memory")
#define PG8_WAIT_L(n) asm volatile("s_waitcnt lgkmcnt(" #n ")" ::: "memory")
#define PG8_BAR __builtin_amdgcn_s_barrier()
#define PG8_SCHED __builtin_amdgcn_sched_barrier(0)
    Unit cur, nxt; int ui = 0;
    if (!S.next(0, cur)) return;
    f32x4 acc[2][2][4][2];
#pragma unroll
    for (int a = 0; a < 2; ++a)
#pragma unroll
        for (int b = 0; b < 2; ++b)
#pragma unroll
            for (int m = 0; m < 4; ++m)
#pragma unroll
                for (int n = 0; n < 2; ++n) acc[a][b][m][n] = (f32x4){0.f, 0.f, 0.f, 0.f};
    bf16x8 At[4][2], B0[2][2], B1[2][2];
    const char* cA = (const char*)g.A + (size_t)cur.pm * tA; const char* cB = (const char*)g.Bt + (size_t)cur.pn * tB;
    S.a_ready(cur);
    if constexpr (SP2) {
        PG8_STAGE(PG8_SB(0, 0), cB, voffB); PG8_STAGE(PG8_SB(0, 1), cB + hB, voffB); PG8_STAGE(PG8_SA(0, 0), cA, voffA); PG8_STAGE(PG8_SA(0, 1), cA + hA, voffA);
        if (wr == 1) PG8_BAR;
        PG8_WAIT_V(2); PG8_BAR;
        PG8_STAGE(PG8_SB(1, 0), cB + kstep, voffB); PG8_STAGE(PG8_SA(1, 0), cA + kstep, voffA); PG8_STAGE(PG8_SB(1, 1), cB + hB + kstep, voffB);
        PG8_WAIT_V(6); PG8_BAR;
    } else {
        PG8_STAGE(PG8_SB(0, 0), cB, voffB); PG8_STAGE(PG8_SA(0, 0), cA, voffA); PG8_STAGE(PG8_SB(0, 1), cB + hB, voffB); PG8_STAGE(PG8_SA(0, 1), cA + hA, voffA);
        if (wr == 1) PG8_BAR;
        PG8_WAIT_V(4); PG8_BAR;
        PG8_STAGE(PG8_SB(1, 0), cB + kstep, voffB); PG8_STAGE(PG8_SA(1, 0), cA + kstep, voffA); PG8_STAGE(PG8_SB(1, 1), cB + hB + kstep, voffB);
        PG8_WAIT_V(6); PG8_BAR;
    }
    for (;;) {
        const bool has_next = S.next(ui + 1, nxt);
        const char* nA = has_next ? (const char*)g.A + (size_t)nxt.pm * tA : cA; const char* nB = has_next ? (const char*)g.Bt + (size_t)nxt.pn * tB : cB;
        for (int t = 0; t < nt; t += 2) {
            const bool last = (t == nt - 2);
            const char* a1 = cA + (size_t)(t + 1) * kstep;
            const char* a2 = last ? nA : cA + (size_t)(t + 2) * kstep; const char* b2 = last ? nB : cB + (size_t)(t + 2) * kstep;
            const char* a3 = a2 + kstep; const char* b3 = b2 + kstep;
            if (last && has_next) S.a_ready(nxt);
            if constexpr (SP2) {
            PG8_LDB(B0, 0, 0); PG8_LDB(B1, 0, 1); PG8_SCHED; PG8_LDA(At, 0, 0); PG8_STAGE(PG8_SA(1, 1), a1 + hA, voffA);
            PG8_WAIT_V(8); PG8_WAIT_L(0); PG8_BAR; PG8_MMA(0, 0, At, B0); PG8_MMA(0, 1, At, B1); PG8_BAR; PG8_SCHED;
            PG8_LDA(At, 0, 1); PG8_STAGE(PG8_SB(0, 0), b2, voffB); PG8_STAGE(PG8_SB(0, 1), b2 + hB, voffB); PG8_STAGE(PG8_SA(0, 0), a2, voffA);
            PG8_WAIT_V(8); PG8_WAIT_L(0); PG8_BAR; PG8_MMA(1, 0, At, B0); PG8_MMA(1, 1, At, B1); PG8_BAR; PG8_SCHED;
            PG8_LDB(B0, 1, 0); PG8_LDB(B1, 1, 1); PG8_SCHED; PG8_LDA(At, 1, 0); PG8_STAGE(PG8_SA(0, 1), a2 + hA, voffA);
            PG8_WAIT_V(8); PG8_WAIT_L(0); PG8_BAR; PG8_MMA(0, 0, At, B0); PG8_MMA(0, 1, At, B1); PG8_BAR; PG8_SCHED;
            PG8_LDA(At, 1, 1); PG8_STAGE(PG8_SB(1, 0), b3, voffB); PG8_STAGE(PG8_SB(1, 1), b3 + hB, voffB); PG8_STAGE(PG8_SA(1, 0), a3, voffA);
            PG8_WAIT_V(8); PG8_WAIT_L(0); PG8_BAR; PG8_MMA(1, 0, At, B0); PG8_MMA(1, 1, At, B1); PG8_BAR; PG8_SCHED;
            } else {
            PG8_LDB(B0, 0, 0); PG8_SCHED; PG8_LDA(At, 0, 0); PG8_STAGE(PG8_SA(1, 1), a1 + hA, voffA);
            PG8_WAIT_L(8); PG8_BAR; PG8_WAIT_L(0); PG8_MMA(0, 0, At, B0); PG8_BAR; PG8_SCHED;
            PG8_LDB(B1, 0, 1); PG8_STAGE(PG8_SB(0, 0), b2, voffB);
            PG8_BAR; PG8_WAIT_L(0); PG8_MMA(0, 1, At, B1); PG8_BAR;
            PG8_LDA(At, 0, 1); PG8_STAGE(PG8_SA(0, 0), a2, voffA);
            PG8_BAR; PG8_WAIT_L(0); PG8_MMA(1, 0, At, B0); PG8_BAR; PG8_SCHED;
            PG8_STAGE(PG8_SB(0, 1), b2 + hB, voffB);
            PG8_WAIT_V(6); PG8_BAR; PG8_MMA(1, 1, At, B1); PG8_BAR;
            PG8_LDB(B0, 1, 0); PG8_SCHED; PG8_LDA(At, 1, 0); PG8_STAGE(PG8_SA(0, 1), a2 + hA, voffA);
            PG8_WAIT_L(8); PG8_BAR; PG8_WAIT_L(0); PG8_MMA(0, 0, At, B0); PG8_BAR; PG8_SCHED;
            PG8_LDB(B1, 1, 1); PG8_STAGE(PG8_SB(1, 0), b3, voffB);
            PG8_BAR; PG8_WAIT_L(0); PG8_MMA(0, 1, At, B1); PG8_BAR;
            PG8_LDA(At, 1, 1); PG8_STAGE(PG8_SA(1, 0), a3, voffA);
            PG8_BAR; PG8_WAIT_L(0); PG8_MMA(1, 0, At, B0); PG8_BAR; PG8_SCHED;
            PG8_STAGE(PG8_SB(1, 1), b3 + hB, voffB);
            PG8_WAIT_V(6); PG8_BAR; PG8_MMA(1, 1, At, B1); PG8_BAR;
            }
        }
        if constexpr (ALIGN_EPI) { if (wr == 0) PG8_BAR; }
        E(acc, cur, wr, wc, fr, fq); S.done(cur);
        if (!has_next) break;
#pragma unroll
        for (int a = 0; a < 2; ++a)
#pragma unroll
            for (int b = 0; b < 2; ++b)
#pragma unroll
                for (int m = 0; m < 4; ++m)
#pragma unroll
                    for (int n = 0; n < 2; ++n) acc[a][b][m][n] = (f32x4){0.f, 0.f, 0.f, 0.f};
        cur = nxt; cA = nA; cB = nB; ++ui;
        if constexpr (ALIGN_EPI) { if (wr == 1) PG8_BAR; }
    }
    PG8_WAIT_V(0);
    if constexpr (!ALIGN_EPI) { if (wr == 0) PG8_BAR; }
    PG8_BAR;
#undef PG8_SA
#undef PG8_SB
#undef PG8_STAGE
#undef PG8_LDA
#undef PG8_LDB
#undef PG8_MMA
#undef PG8_WAIT_V
#undef PG8_WAIT_L
#undef PG8_BAR
#undef PG8_SCHED
}
}

__device__ __forceinline__ void cvt_item(const float* W, int ldw, u16* WT, int ldt, int k0, int n0, int drow0, int dcol0, LAS float* scr, int lane) {
#pragma unroll 8
    for (int i = 0; i < 32; ++i) { const int kk = 2 * i + (lane >> 5); scr[kk * 33 + (lane & 31)] = W[(size_t)(k0 + kk) * ldw + n0 + (lane & 31)]; }
    asm volatile("s_waitcnt lgkmcnt(0)" ::: "memory");
    const int c = lane & 7;
#pragma unroll
    for (int j = 0; j < 4; ++j) { const int n = (lane >> 3) + 8 * j; const LAS float* s = scr + (8 * c) * 33 + n;
        uint4 o; o.x = f2bf(s[0 * 33]) | (f2bf(s[1 * 33]) << 16); o.y = f2bf(s[2 * 33]) | (f2bf(s[3 * 33]) << 16); o.z = f2bf(s[4 * 33]) | (f2bf(s[5 * 33]) << 16); o.w = f2bf(s[6 * 33]) | (f2bf(s[7 * 33]) << 16);
        *(uint4*)(WT + (size_t)(drow0 + n) * ldt + dcol0 + k0 + 8 * c) = o; }
    asm volatile("s_waitcnt lgkmcnt(0)" ::: "memory");
}
template <class RowMap>
__device__ __forceinline__ void cvt_matrix(const float* W, int K, int N, u16* WT, int ldt, int dcol0, const RowMap& rowmap, LAS float* scr, int lane, int gw, int NGW, int& off) {
    const int nblk = N / 32, nitems = (K / 64) * nblk;
    int it = (gw - off) % NGW; if (it < 0) it += NGW;
    for (; it < nitems; it += NGW) { const int kb = it / nblk, nb = it % nblk; cvt_item(W, N, WT, ldt, kb * 64, nb * 32, rowmap(nb * 32), dcol0, scr, lane); }
    off = (off + nitems) % NGW;
}


#ifndef FAST_ATTN
#define FAST_ATTN 1
#endif
namespace fa {
using bf16x8 = __attribute__((ext_vector_type(8))) short;
using s16x4  = __attribute__((ext_vector_type(4))) short;
using f32x16 = __attribute__((ext_vector_type(16))) float;
using u32x4  = __attribute__((ext_vector_type(4))) unsigned;
constexpr int NW = 8, QBLK = 32, KVBLK = 64, DV = 128;
constexpr float THR = 8.f;
constexpr size_t SHM_V = KVBLK * DV * 2;
#define FA_SBAR() __builtin_amdgcn_sched_barrier(0)
__device__ __forceinline__ int crow(int r, int hi) { return (r & 3) + 8 * (r >> 2) + 4 * hi; }
__device__ __forceinline__ unsigned cvtpk(float lo, float hi) { unsigned r; asm volatile("v_cvt_pk_bf16_f32 %0, %1, %2" : "=v"(r) : "v"(lo), "v"(hi)); return r; }
template <int DQ> struct Cfg {
    static constexpr int NK = DQ / 16, NCH = DQ / 8, KPT = NCH / 8;
    static constexpr size_t SHM_K = (size_t)KVBLK * DQ * 2;
    static constexpr float SCALE = DQ == 192 ? 0.07216878364870322f : (DQ == 64 ? 0.125f : 0.08838834764831845f);
    __device__ static __forceinline__ int kswz(int row, int colB) { return row * (DQ * 2) + (colB ^ ((row & 7) << 4)); }
};
template <int DQ> __device__ __forceinline__ void partialSM(f32x16& p0, f32x16& p1, float& m_reg, float& mn, float& alpha) {
    constexpr float SCALE = Cfg<DQ>::SCALE, C = SCALE * 1.4426950408889634f;
    float pmax = p0[0];
#pragma unroll
    for (int r = 1; r < 16; ++r) pmax = fmaxf(pmax, p0[r]);
#pragma unroll
    for (int r = 0; r < 16; ++r) pmax = fmaxf(pmax, p1[r]);
    { auto rr = __builtin_amdgcn_permlane32_swap(__float_as_uint(pmax), __float_as_uint(pmax), false, false);
      pmax = fmaxf(__uint_as_float(rr[0]), __uint_as_float(rr[1])); }
    if (__builtin_expect(__all(pmax - m_reg <= THR / SCALE), 1)) { mn = m_reg; alpha = 1.f; }
    else { mn = fmaxf(m_reg, pmax); alpha = __builtin_amdgcn_exp2f((m_reg - mn) * C); m_reg = mn; }
    const float mnC = -mn * C;
#pragma unroll
    for (int r = 0; r < 16; ++r) p0[r] = fmaf(p0[r], C, mnC);
#pragma unroll
    for (int r = 0; r < 16; ++r) p1[r] = fmaf(p1[r], C, mnC);
#pragma unroll
    for (int r = 0; r < 16; ++r) p0[r] = __builtin_amdgcn_exp2f(p0[r]);
}
__device__ __forceinline__ void finishSM(f32x16& p0, f32x16& p1, float alpha, float& l_reg, bf16x8& pa0, bf16x8& pa1, bf16x8& pa2, bf16x8& pa3) {
#pragma unroll
    for (int r = 0; r < 16; ++r) p1[r] = __builtin_amdgcn_exp2f(p1[r]);
    float ps = 0;
#pragma unroll
    for (int r = 0; r < 16; ++r) ps += p0[r];
#pragma unroll
    for (int r = 0; r < 16; ++r) ps += p1[r];
    { auto rr = __builtin_amdgcn_permlane32_swap(__float_as_uint(ps), __float_as_uint(ps), false, false);
      ps = __uint_as_float(rr[0]) + __uint_as_float(rr[1]); }
    l_reg = l_reg * alpha + ps;
#define FA_PK4(P, BASE, OUT) do { unsigned a0 = cvtpk(P[BASE + 0], P[BASE + 1]), a1 = cvtpk(P[BASE + 2], P[BASE + 3]);   \
    unsigned b0 = cvtpk(P[BASE + 4], P[BASE + 5]), b1 = cvtpk(P[BASE + 6], P[BASE + 7]);                              \
    auto r0 = __builtin_amdgcn_permlane32_swap(a0, b0, false, false); auto r1 = __builtin_amdgcn_permlane32_swap(a1, b1, false, false); \
    u32x4 w = {r0[0], r1[0], r0[1], r1[1]}; OUT = *reinterpret_cast<bf16x8*>(&w); } while (0)
    FA_PK4(p0, 0, pa0); FA_PK4(p0, 8, pa1); FA_PK4(p1, 0, pa2); FA_PK4(p1, 8, pa3);
#undef FA_PK4
}
template <int DQ> __device__ __forceinline__ void qkt(f32x16& p0, f32x16& p1, const char* Ks, const bf16x8* qr, int r32, int hi) {
    p0 = f32x16{}; p1 = f32x16{};
#pragma unroll
    for (int d0 = 0; d0 < Cfg<DQ>::NK; ++d0) { const int cb = (d0 * 16 + hi * 8) * 2;
        const bf16x8 b0 = *reinterpret_cast<const bf16x8*>(Ks + Cfg<DQ>::kswz(r32, cb));
        const bf16x8 b1 = *reinterpret_cast<const bf16x8*>(Ks + Cfg<DQ>::kswz(32 + r32, cb));
        p0 = __builtin_amdgcn_mfma_f32_32x32x16_bf16(b0, qr[d0], p0, 0, 0, 0);
        p1 = __builtin_amdgcn_mfma_f32_32x32x16_bf16(b1, qr[d0], p1, 0, 0, 0); }
}
__device__ __forceinline__ int v_st(int k, int c) { const int kk = (k & ~0xC) | ((k & 4) << 1) | ((k & 8) >> 1); return ((kk >> 3) * 4 + (c >> 5)) * 512 + ((kk & 7) * 32 + (c & 31)) * 2; }
__device__ __forceinline__ int v_rd_base(int lane) { return ((lane & 3) << 3) | (((lane >> 2) & 3) << 6) | (((lane >> 4) & 1) << 5) | (((lane >> 5) & 1) << 8); }
constexpr int v_rd_off(int d0, int ks, int half) { return d0 * 512 + ks * 4096 + half * 2048; }
template <int OFF> __device__ __forceinline__ s16x4 tr_read(int vb) {
    s16x4 r; asm volatile("ds_read_b64_tr_b16 %0, %1 offset:%2" : "=&v"(r) : "v"(vb), "i"(OFF) : "memory"); return r;
}
template <int D0> __device__ __forceinline__ void pv_one(f32x16& od, int vb, bf16x8 pa0, bf16x8 pa1, bf16x8 pa2, bf16x8 pa3) {
    const s16x4 l0 = tr_read<v_rd_off(D0, 0, 0)>(vb), h0 = tr_read<v_rd_off(D0, 0, 1)>(vb), l1 = tr_read<v_rd_off(D0, 1, 0)>(vb), h1 = tr_read<v_rd_off(D0, 1, 1)>(vb);
    const s16x4 l2 = tr_read<v_rd_off(D0, 2, 0)>(vb), h2 = tr_read<v_rd_off(D0, 2, 1)>(vb), l3 = tr_read<v_rd_off(D0, 3, 0)>(vb), h3 = tr_read<v_rd_off(D0, 3, 1)>(vb);
    asm volatile("s_waitcnt lgkmcnt(0)" ::: "memory"); FA_SBAR();
#define FA_PK(L, H) (bf16x8){L[0], L[1], L[2], L[3], H[0], H[1], H[2], H[3]}
    od = __builtin_amdgcn_mfma_f32_32x32x16_bf16(pa0, FA_PK(l0, h0), od, 0, 0, 0);
    od = __builtin_amdgcn_mfma_f32_32x32x16_bf16(pa1, FA_PK(l1, h1), od, 0, 0, 0);
    od = __builtin_amdgcn_mfma_f32_32x32x16_bf16(pa2, FA_PK(l2, h2), od, 0, 0, 0);
    od = __builtin_amdgcn_mfma_f32_32x32x16_bf16(pa3, FA_PK(l3, h3), od, 0, 0, 0);
#undef FA_PK
}
__device__ __forceinline__ void pv_d0(f32x16* o, int vb, bf16x8 pa0, bf16x8 pa1, bf16x8 pa2, bf16x8 pa3) {
    pv_one<0>(o[0], vb, pa0, pa1, pa2, pa3); pv_one<1>(o[1], vb, pa0, pa1, pa2, pa3); pv_one<2>(o[2], vb, pa0, pa1, pa2, pa3); pv_one<3>(o[3], vb, pa0, pa1, pa2, pa3);
}
struct KVSrc { const u16* k0; int kst0; const u16* k1; int kst1; int split8; const u16* v; int vst; int xrow0, lrow0; };
constexpr size_t shm_bytes(int DQ) { return 2 * SHM_V + 2 * (size_t)KVBLK * DQ * 2 + NW * 64 * 4; }

template <int DQ>
__device__ __forceinline__ void attn_unit(const u16* __restrict__ Qb, int LDQ, const KVSrc S, u16* __restrict__ Ob, int LDO, int NT, char* lds) {
    using C = Cfg<DQ>;
    constexpr int NK = C::NK, NCH = C::NCH, KPT = C::KPT;
    constexpr size_t SHM_K = C::SHM_K;
    const int tid = threadIdx.x, wid = tid >> 6, lane = tid & 63, r32 = lane & 31, hi = lane >> 5;
    char* V_lds = lds; char* K_lds = lds + 2 * SHM_V;
    float* wsf = (float*)(lds + 2 * SHM_V + 2 * SHM_K) + wid * 64; float* li_l = wsf; float* al_l = wsf + 32;
    float m_reg = -1e30f, l_reg = 0; f32x16 o[4] = {}; bf16x8 qr[NK];
    const u16* Qw = Qb + (long)(wid * QBLK + r32) * LDQ + hi * 8;
#pragma unroll
    for (int d0 = 0; d0 < NK; ++d0) qr[d0] = *reinterpret_cast<const bf16x8*>(Qw + d0 * 16);
    const int sr = tid >> 4, sc = (tid & 15) * 8, vst0 = v_st(sr, sc), vst1 = v_st(32 + sr, sc);
    const int vb0 = (int)(uintptr_t)V_lds + v_rd_base(lane);
    const u16* kp[KPT]; int kst[KPT]; int kw[KPT];
#pragma unroll
    for (int i = 0; i < KPT; ++i) { const int c = tid + 512 * i, row = c / NCH, c8 = c % NCH;
        if (c8 < S.split8) { kp[i] = S.k0 + (long)row * S.kst0 + c8 * 8; kst[i] = S.kst0; } else { kp[i] = S.k1 + (long)row * S.kst1 + (c8 - S.split8) * 8; kst[i] = S.kst1; }
        kw[i] = C::kswz(row, c8 * 16); }
    const u16* vp0 = S.v + (long)sr * S.vst + sc; const u16* vp1 = S.v + (long)(32 + sr) * S.vst + sc;
    struct { bf16x8 vs0, vs1, ks[KPT]; } sr_[2];
#define FA_ROW0(kt) ((kt) < 4 ? S.xrow0 + 64 * (kt) : S.lrow0 + 64 * ((kt) - 4))
#define FA_SLOAD(i, kt) do { const long _r = FA_ROW0(kt); sr_[i].vs0 = *reinterpret_cast<const bf16x8*>(vp0 + _r * S.vst); sr_[i].vs1 = *reinterpret_cast<const bf16x8*>(vp1 + _r * S.vst); \
    _Pragma("unroll") for (int _q = 0; _q < KPT; ++_q) sr_[i].ks[_q] = *reinterpret_cast<const bf16x8*>(kp[_q] + _r * kst[_q]); } while (0)
#define FA_SWRITE(b, i) do { *(bf16x8*)(V_lds + (b) * SHM_V + vst0) = sr_[i].vs0; *(bf16x8*)(V_lds + (b) * SHM_V + vst1) = sr_[i].vs1; \
    _Pragma("unroll") for (int _q = 0; _q < KPT; ++_q) *(bf16x8*)(K_lds + (b) * SHM_K + kw[_q]) = sr_[i].ks[_q]; } while (0)
#define FA_SWAIT() asm volatile("s_waitcnt vmcnt(%0)" :: "n"(2 + KPT) : "memory")
#define FA_RESC(a) do { if (__any((a) < 1.f)) { if (hi == 0) al_l[r32] = (a); asm volatile("s_waitcnt lgkmcnt(0)" ::: "memory"); \
    _Pragma("unroll") for (int d = 0; d < 4; ++d) _Pragma("unroll") for (int r = 0; r < 16; ++r) o[d][r] *= al_l[crow(r, hi)]; } } while (0)
    f32x16 pA0, pA1, pB0, pB1; float mnA, mnB, alA, alB; bf16x8 pa0, pa1, pa2, pa3;
    constexpr int SE = 0, SO = 1;
    FA_SLOAD(SE, 0); asm volatile("s_waitcnt vmcnt(0)" ::: "memory"); FA_SWRITE(0, SE); __syncthreads();
    qkt<DQ>(pA0, pA1, K_lds, qr, r32, hi); partialSM<DQ>(pA0, pA1, m_reg, mnA, alA);
    FA_SLOAD(SO, 1); if (2 < NT) FA_SLOAD(SE, 2);
    FA_SWAIT(); FA_SWRITE(1, SO); __syncthreads();
    for (int j = 1; j + 1 < NT; j += 2) {
        FA_SBAR(); qkt<DQ>(pB0, pB1, K_lds + SHM_K, qr, r32, hi);
        finishSM(pA0, pA1, alA, l_reg, pa0, pa1, pa2, pa3); FA_SBAR();
        FA_SLOAD(SO, j + 2); FA_SBAR();
        pv_d0(o, vb0, pa0, pa1, pa2, pa3); partialSM<DQ>(pB0, pB1, m_reg, mnB, alB);
        __syncthreads(); FA_SWAIT(); FA_SWRITE(0, SE);
        FA_RESC(alB); __syncthreads();
        FA_SBAR(); qkt<DQ>(pA0, pA1, K_lds, qr, r32, hi);
        finishSM(pB0, pB1, alB, l_reg, pa0, pa1, pa2, pa3); FA_SBAR();
        if (j + 3 < NT) FA_SLOAD(SE, j + 3); FA_SBAR();
        pv_d0(o, vb0 + (int)SHM_V, pa0, pa1, pa2, pa3); partialSM<DQ>(pA0, pA1, m_reg, mnA, alA);
        __syncthreads(); FA_SWAIT(); FA_SWRITE(1, SO);
        FA_RESC(alA); __syncthreads();
    }
    FA_SBAR(); qkt<DQ>(pB0, pB1, K_lds + SHM_K, qr, r32, hi);
    finishSM(pA0, pA1, alA, l_reg, pa0, pa1, pa2, pa3); FA_SBAR();
    pv_d0(o, vb0, pa0, pa1, pa2, pa3); partialSM<DQ>(pB0, pB1, m_reg, mnB, alB);
    __syncthreads(); FA_RESC(alB);
    finishSM(pB0, pB1, alB, l_reg, pa0, pa1, pa2, pa3); FA_SBAR();
    pv_d0(o, vb0 + (int)SHM_V, pa0, pa1, pa2, pa3);
    if (hi == 0) li_l[r32] = l_reg; asm volatile("s_waitcnt lgkmcnt(0)" ::: "memory");
    float rli[16];
#pragma unroll
    for (int r = 0; r < 16; ++r) rli[r] = __builtin_amdgcn_rcpf(li_l[crow(r, hi)]);
    u16* Ow = Ob + (long)(wid * QBLK) * LDO;
#pragma unroll
    for (int r = 0; r < 16; ++r) { const int orow = crow(r, hi);
#pragma unroll
        for (int d0 = 0; d0 < 4; ++d0) Ow[(long)orow * LDO + d0 * 32 + r32] = (u16)f2bf(o[d0][r] * rli[r]); }
#undef FA_ROW0
#undef FA_SLOAD
#undef FA_SWRITE
#undef FA_SWAIT
#undef FA_RESC
}

template <int DQ, int SPLIT8>
__device__ __forceinline__ void attn_unit_sp(const u16* __restrict__ Qb, int LDQ, const KVSrc S, u16* __restrict__ Ob, int LDO, int NT, char* lds) {
    using C = Cfg<DQ>;
    constexpr int NK = C::NK, NCH = C::NCH, KPT = C::KPT, KPT0 = SPLIT8 / 8, NCH1 = NCH - SPLIT8;
    constexpr size_t SHM_K = C::SHM_K;
    const int tid = threadIdx.x, wid = tid >> 6, lane = tid & 63, r32 = lane & 31, hi = lane >> 5;
    char* V_lds = lds; char* K_lds = lds + 2 * SHM_V;
    float* wsf = (float*)(lds + 2 * SHM_V + 2 * SHM_K) + wid * 64; float* li_l = wsf; float* al_l = wsf + 32;
    float m_reg = -1e30f, l_reg = 0; f32x16 o[4] = {}; bf16x8 qr[NK];
    { const u16* Qw = Qb + (long)(wid * QBLK + r32) * LDQ + hi * 8;
#pragma unroll
      for (int d0 = 0; d0 < NK; ++d0) qr[d0] = *reinterpret_cast<const bf16x8*>(Qw + d0 * 16); }
    const int sr = tid >> 4, sc = (tid & 15) * 8, vst0 = v_st(sr, sc), vst1 = v_st(32 + sr, sc);
    const int vb0 = (int)(uintptr_t)V_lds + v_rd_base(lane);
    int koff[KPT], kw[KPT];
#pragma unroll
    for (int i = 0; i < KPT; ++i) {
        if (i < KPT0) { const int c = tid + 512 * i, row = c / SPLIT8, c8 = c % SPLIT8; koff[i] = row * S.kst0 + c8 * 8; kw[i] = C::kswz(row, c8 * 16); }
        else { const int c = tid + 512 * (i - KPT0), row = c / (NCH1 > 0 ? NCH1 : 1), c8 = c % (NCH1 > 0 ? NCH1 : 1); koff[i] = row * S.kst1 + c8 * 8; kw[i] = C::kswz(row, (SPLIT8 + c8) * 16); } }
    const int voff0 = sr * S.vst + sc, voff1 = (32 + sr) * S.vst + sc;
    bf16x8 vs0, vs1, ks[KPT];
#define FA_ROW0(kt) ((kt) < 4 ? S.xrow0 + 64 * (kt) : S.lrow0 + 64 * ((kt) - 4))
#define FA_SLOAD(kt) do { const long _r = FA_ROW0(kt); const u16* _v = S.v + _r * S.vst; const u16* _k0 = S.k0 + _r * S.kst0; const u16* _k1 = S.k1 + _r * S.kst1; \
    vs0 = *reinterpret_cast<const bf16x8*>(_v + voff0); vs1 = *reinterpret_cast<const bf16x8*>(_v + voff1); \
    _Pragma("unroll") for (int _q = 0; _q < KPT; ++_q) ks[_q] = *reinterpret_cast<const bf16x8*>((_q < KPT0 ? _k0 : _k1) + koff[_q]); } while (0)
#define FA_SWRITE(b) do { *(bf16x8*)(V_lds + (b) * SHM_V + vst0) = vs0; *(bf16x8*)(V_lds + (b) * SHM_V + vst1) = vs1; \
    _Pragma("unroll") for (int _q = 0; _q < KPT; ++_q) *(bf16x8*)(K_lds + (b) * SHM_K + kw[_q]) = ks[_q]; } while (0)
    f32x16 p0, p1; float mn, al; bf16x8 pa0, pa1, pa2, pa3;
    FA_SLOAD(0); asm volatile("s_waitcnt vmcnt(0)" ::: "memory"); FA_SWRITE(0); __syncthreads();
    for (int j = 0; j < NT; ++j) {
        const int b = j & 1;
        FA_SBAR(); qkt<DQ>(p0, p1, K_lds + b * SHM_K, qr, r32, hi);
        partialSM<DQ>(p0, p1, m_reg, mn, al);
        if (__any(al < 1.f)) { if (hi == 0) al_l[r32] = al; asm volatile("s_waitcnt lgkmcnt(0)" ::: "memory");
#pragma unroll
            for (int d = 0; d < 4; ++d)
#pragma unroll
                for (int r = 0; r < 16; ++r) o[d][r] *= al_l[crow(r, hi)]; }
        finishSM(p0, p1, al, l_reg, pa0, pa1, pa2, pa3); FA_SBAR();
        if (j + 1 < NT) FA_SLOAD(j + 1);
        FA_SBAR();
        pv_d0(o, vb0 + b * (int)SHM_V, pa0, pa1, pa2, pa3);
        if (j + 1 < NT) { asm volatile("s_waitcnt vmcnt(0)" ::: "memory"); FA_SWRITE(b ^ 1); }
        __syncthreads();
    }
    if (hi == 0) li_l[r32] = l_reg; asm volatile("s_waitcnt lgkmcnt(0)" ::: "memory");
    float rli[16];
#pragma unroll
    for (int r = 0; r < 16; ++r) rli[r] = __builtin_amdgcn_rcpf(li_l[crow(r, hi)]);
    u16* Ow = Ob + (long)(wid * QBLK) * LDO;
#pragma unroll
    for (int r = 0; r < 16; ++r) { const int orow = crow(r, hi);
#pragma unroll
        for (int d0 = 0; d0 < 4; ++d0) Ow[(long)orow * LDO + d0 * 32 + r32] = (u16)f2bf(o[d0][r] * rli[r]); }
#undef FA_ROW0
#undef FA_SLOAD
#undef FA_SWRITE
}
}


#ifndef FAST_GLA
#define FAST_GLA 1
#endif
namespace gla {
typedef short bf16x8 __attribute__((ext_vector_type(8)));
typedef unsigned u32x2 __attribute__((ext_vector_type(2)));
constexpr int P = 72;
constexpr int ARR = 64 * P * 2;
constexpr int OFF_SET = 4 * ARR;
constexpr int OFF_ATT = 2 * OFF_SET, OFF_ST = OFF_ATT + ARR, OFF_SEG = OFF_ST + ARR, OFF_DEC = OFF_SEG + 8 * 64 * 4, LDS_END = OFF_DEC + 2 * 64 * 4;
__device__ __forceinline__ bf16x8 ldfrag(const LAS unsigned char* arr, int row, int colb) { return *(const LAS bf16x8*)(arr + row * (P * 2) + colb); }
__device__ __forceinline__ void unit(LAS unsigned char* lds, const u16* PARTS, const float* wg, const float* bg, int caf, float* Od, int b, int h, int dir, int vh) {
    const int tid = threadIdx.x, lane = tid & 63, w = __builtin_amdgcn_readfirstlane(tid >> 6);
    const int r16 = lane & 15, fq = lane >> 4;
    const int it = w & 3, jt0 = 2 * (w >> 2);
    float wgr[16];
#pragma unroll
    for (int j = 0; j < 16; ++j) wgr[j] = wg[j * 256 + h * 64 + lane];
    const float bgr = bg[h * 64 + lane];
    f32x4 S0 = {0.f, 0.f, 0.f, 0.f}, S1 = {0.f, 0.f, 0.f, 0.f};
    for (int e = tid; e < ARR / 4; e += 512) ((LAS unsigned*)(lds + OFF_ST))[e] = 0u;
    auto rowof = [&](int pos) { return pos < CTXL ? (ML + b * CTXL + (dir ? CTXL - 1 - pos : pos)) : (b * SEQ + (dir ? SEQ - 1 - (pos - CTXL) : (pos - CTXL))); };
    unsigned short qv[8], kv[8], vv[8]; float afv[8];
#define GLA_LOAD(n) do { _Pragma("unroll") for (int i = 0; i < 8; ++i) { const int row = rowof((n) * 64 + 8 * w + i); const u16* pr = PARTS + (size_t)row * IN_AP; \
        qv[i] = pr[C_GQ + h * 64 + lane]; kv[i] = pr[C_GK + h * 64 + lane]; vv[i] = pr[C_GV + h * 128 + vh * 64 + lane]; afv[i] = bf2f(pr[caf + (lane & 15)]); } } while (0)
    GLA_LOAD(0);
    constexpr int NCHUNK = (CTXL + SEQ) / 64;
    for (int n = 0; n < NCHUNK; ++n) {
        LAS unsigned char* Qt = lds + (n & 1) * OFF_SET; LAS unsigned char* Kt = Qt + ARR; LAS unsigned char* KhT = Kt + ARR; LAS unsigned char* Vt = KhT + ARR;
        LAS float* seg = (LAS float*)(lds + OFF_SEG); LAS float* dec = (LAS float*)(lds + OFF_DEC) + (n & 1) * 64;
        float c[8]; float run = 0.f;
#pragma unroll
        for (int i = 0; i < 8; ++i) { float pre = bgr;
#pragma unroll
            for (int j = 0; j < 16; ++j) pre += __int_as_float(__builtin_amdgcn_readlane(__float_as_int(afv[i]), j)) * wgr[j];
            const float ls = fminf(pre, 0.f) - __logf(1.0f + __expf(-fabsf(pre)));
            run += ls * (1.0f / 16.0f); c[i] = run; }
        seg[w * 64 + lane] = run;
        __syncthreads();
        float prefix = 0.f, last = 0.f;
#pragma unroll
        for (int ww = 0; ww < 8; ++ww) { const float t = seg[ww * 64 + lane]; last += t; prefix += (ww < w) ? t : 0.f; }
#pragma unroll
        for (int i = 0; i < 8; ++i) { const int s = 8 * w + i; const float cum = prefix + c[i]; const float e = __expf(cum), kf = bf2f(kv[i]);
            ((LAS u16*)Qt)[s * P + lane] = (u16)f2bf(bf2f(qv[i]) * 0.125f * e);
            ((LAS u16*)Kt)[s * P + lane] = (u16)f2bf(kf * __expf(-cum));
            ((LAS u16*)KhT)[lane * P + s] = (u16)f2bf(kf * __expf(last - cum));
            ((LAS u16*)Vt)[lane * P + s] = vv[i]; }
        if (w == 0) dec[lane] = __expf(last);
        __syncthreads();
        if (n + 1 < NCHUNK) GLA_LOAD(n + 1);
        f32x4 a0 = {0.f, 0.f, 0.f, 0.f}, a1 = a0, o0 = a0, o1 = a0;
#pragma unroll
        for (int ks = 0; ks < 2; ++ks) { const int cb = ks * 64 + fq * 16;
            const bf16x8 A = ldfrag(Kt, 16 * it + r16, cb), Bq0 = ldfrag(Qt, 16 * jt0 + r16, cb), Bq1 = ldfrag(Qt, 16 * (jt0 + 1) + r16, cb), As = ldfrag(lds + OFF_ST, 16 * it + r16, cb);
            a0 = __builtin_amdgcn_mfma_f32_16x16x32_bf16(A, Bq0, a0, 0, 0, 0); a1 = __builtin_amdgcn_mfma_f32_16x16x32_bf16(A, Bq1, a1, 0, 0, 0);
            o0 = __builtin_amdgcn_mfma_f32_16x16x32_bf16(As, Bq0, o0, 0, 0, 0); o1 = __builtin_amdgcn_mfma_f32_16x16x32_bf16(As, Bq1, o1, 0, 0, 0); }
        { const int s0 = 16 * it + 4 * fq; const int t0 = 16 * jt0 + r16, t1 = t0 + 16;
          u32x2 p0, p1;
          p0.x = f2bf(s0 + 0 <= t0 ? a0[0] : 0.f) | (f2bf(s0 + 1 <= t0 ? a0[1] : 0.f) << 16); p0.y = f2bf(s0 + 2 <= t0 ? a0[2] : 0.f) | (f2bf(s0 + 3 <= t0 ? a0[3] : 0.f) << 16);
          p1.x = f2bf(s0 + 0 <= t1 ? a1[0] : 0.f) | (f2bf(s0 + 1 <= t1 ? a1[1] : 0.f) << 16); p1.y = f2bf(s0 + 2 <= t1 ? a1[2] : 0.f) | (f2bf(s0 + 3 <= t1 ? a1[3] : 0.f) << 16);
          *(LAS u32x2*)(lds + OFF_ATT + (t0 * P + s0) * 2) = p0; *(LAS u32x2*)(lds + OFF_ATT + (t1 * P + s0) * 2) = p1; }
        __syncthreads();
        const f32x4 d4 = *(const LAS f32x4*)(dec + 16 * it + 4 * fq);
        S0 = S0 * d4; S1 = S1 * d4;
#pragma unroll
        for (int ks = 0; ks < 2; ++ks) { const int cb = ks * 64 + fq * 16;
            const bf16x8 Av = ldfrag(Vt, 16 * it + r16, cb), Ba0 = ldfrag(lds + OFF_ATT, 16 * jt0 + r16, cb), Ba1 = ldfrag(lds + OFF_ATT, 16 * (jt0 + 1) + r16, cb);
            const bf16x8 Ak = ldfrag(KhT, 16 * it + r16, cb), Bv0 = ldfrag(Vt, 16 * jt0 + r16, cb), Bv1 = ldfrag(Vt, 16 * (jt0 + 1) + r16, cb);
            o0 = __builtin_amdgcn_mfma_f32_16x16x32_bf16(Av, Ba0, o0, 0, 0, 0); o1 = __builtin_amdgcn_mfma_f32_16x16x32_bf16(Av, Ba1, o1, 0, 0, 0);
            S0 = __builtin_amdgcn_mfma_f32_16x16x32_bf16(Ak, Bv0, S0, 0, 0, 0); S1 = __builtin_amdgcn_mfma_f32_16x16x32_bf16(Ak, Bv1, S1, 0, 0, 0); }
        { const int v0 = 16 * it + 4 * fq; const int t0 = 16 * jt0 + r16;
          *(f32x4*)(Od + (size_t)rowof(n * 64 + t0) * 512 + h * 128 + vh * 64 + v0) = o0;
          *(f32x4*)(Od + (size_t)rowof(n * 64 + t0 + 16) * 512 + h * 128 + vh * 64 + v0) = o1;
          const int k0 = 16 * it + 4 * fq, vc0 = 16 * jt0 + r16;
          u32x2 q0, q1; q0.x = f2bf(S0[0]) | (f2bf(S0[1]) << 16); q0.y = f2bf(S0[2]) | (f2bf(S0[3]) << 16); q1.x = f2bf(S1[0]) | (f2bf(S1[1]) << 16); q1.y = f2bf(S1[2]) | (f2bf(S1[3]) << 16);
          *(LAS u32x2*)(lds + OFF_ST + (vc0 * P + k0) * 2) = q0; *(LAS u32x2*)(lds + OFF_ST + ((vc0 + 16) * P + k0) * 2) = q1; }
    }
#undef GLA_LOAD
}
}

__global__ void __launch_bounds__(512, 2) fwd_kernel(Args args) {
    extern __shared__ __attribute__((aligned(16))) unsigned char lds_raw[];
    LAS unsigned char* lds = (LAS unsigned char*)lds_raw;
    const int tid = threadIdx.x, lane = tid & 63, wave = __builtin_amdgcn_readfirstlane(tid >> 6);
    const int G = gridDim.x, gw = blockIdx.x * 8 + wave, NGW = G * 8;
    unsigned char* ws = args.ws;
    unsigned* ctl = (unsigned*)(ws + WS_CTL);
    volatile LAS unsigned* MISC = (volatile LAS unsigned*)(lds + MISC_OFF);
    for (int u = tid; u < (LDS_BYTES - 131072) / 4; u += 512) ((LAS unsigned*)(lds + 131072))[u] = 0u;
    __syncthreads();
    XcdBarrier bar = xcd_barrier_post(ctl + CW_BAR, MISC + 8);
    const int lo = args.ph_lo, hi = args.ph_hi;
#define IN(k) (lo <= (k) && (k) < hi)
#define GRID_BAR() xcd_barrier(bar)

    const float* x_in = args.in[0]; const float* c_in = args.in[1]; const float* ctx_in = args.in[2]; const float* cctx_in = args.in[3];
    const float* w_mod = args.in[4]; const float* b_mod = args.in[5];
    const float* g_pre_mix = args.in[6]; const float* g_post_mix = args.in[7]; const float* g_pre_ffn = args.in[8]; const float* g_post_ffn = args.in[9];
    const float* w_in_a = args.in[10]; const float* mla_g_q = args.in[11]; const float* mla_w_uq = args.in[12]; const float* mla_g_kv = args.in[13]; const float* mla_w_ukv = args.in[14];
    const float* gla_w_gf = args.in[15]; const float* gla_b_gf = args.in[16]; const float* gla_w_gb = args.in[17]; const float* gla_b_gb = args.in[18]; const float* gla_g_out = args.in[19];
    const float* w_out_a = args.in[20]; const float* w_qkv_c = args.in[21];
    const float* diff_lq1 = args.in[22]; const float* diff_lk1 = args.in[23]; const float* diff_lq2 = args.in[24]; const float* diff_lk2 = args.in[25]; const float* diff_g_out = args.in[26];
    const float* w_out_c = args.in[27]; const float* ffn_w_gate = args.in[28]; const float* ffn_w_up = args.in[29]; const float* ffn_w_down = args.in[30];
    const float* moe_w_router = args.in[31]; const float* moe_w_gate = args.in[32]; const float* moe_w_up = args.in[33]; const float* moe_w_down = args.in[34];
    float* out = args.out;
    float* MODB = (float*)(ws + WS_MOD);
    float* ROPEC = (float*)(ws + WS_ROPE); float* ROPES = ROPEC + 2048 * 32;
    int* TOKE = (int*)(ws + WS_TOKE); float* TOKG = (float*)(ws + WS_TOKG); int* TOKP = (int*)(ws + WS_TOKP);
    float* CTXS = (float*)(ws + WS_CTXS);
    u16* H0 = (u16*)(ws + WS_R0); u16* CAT = (u16*)(ws + WS_R0); u16* FB = (u16*)(ws + WS_R0); u16* O16 = (u16*)(ws + WS_R0); u16* Y2 = (u16*)(ws + WS_R0); u16* HIDC = (u16*)(ws + WS_R0);
    u16* PARTS = (u16*)(ws + WS_PARTS); u16* YB = (u16*)(ws + WS_Y); u16* HB = (u16*)(ws + WS_Y);
    u16* H1 = (u16*)(ws + WS_H1); u16* CAT2 = (u16*)(ws + WS_H1);
    u16* HC = (u16*)(ws + WS_HC); u16* XS = (u16*)(ws + WS_XS);
    u16* A2 = (u16*)(ws + WS_A2); u16* KROPE = (u16*)(ws + WS_KROPE);
    float* OF = (float*)(ws + WS_R3); float* OB = OF + (size_t)M * 512;
    u16* QKVUP = (u16*)(ws + WS_R3); u16* HID = (u16*)(ws + WS_R3); u16* QKVC = (u16*)(ws + WS_R3);
    u16* W_IN = (u16*)(ws + WS_W);
    u16* W_UP = (u16*)(ws + WS_W + 4 * MiB);
    u16* W_OA = (u16*)(ws + WS_W + 4 * MiB + 1536 * 1024);
    u16* W_FGU = (u16*)(ws + WS_W + 7 * MiB + 512 * 1024);
    u16* W_FD = (u16*)(ws + WS_W + 18 * MiB + 512 * 1024);
    u16* W_QKV = (u16*)(ws + WS_W + 24 * MiB);
    u16* W_OC = (u16*)(ws + WS_W + 30 * MiB);
    u16* W_MGU = (u16*)(ws + WS_MOEW);
    u16* W_MD = (u16*)(ws + WS_MOEW + 112 * MiB);
    auto map_id = [](int n0) { return n0; };
    auto map_gate = [](int n0) { return (n0 >> 7) * 256 + (n0 & 127); };
    auto map_up = [](int n0) { return (n0 >> 7) * 256 + 128 + (n0 & 127); };

    if (IN(0)) {
        LAS float* sT = (LAS float*)lds;
        LAS float* red = sT + 1024 * 20;
        for (int e = tid; e < 17 * 1024; e += 512) { const int r = e >> 10, k = e & 1023; const float v = r < 16 ? c_in[r * 1024 + k] : cctx_in[k]; sT[k * 20 + r] = silu_f(v); }
        __syncthreads();
        for (int g = blockIdx.x; g < 192; g += G) {
            const int l = g / 96, n = (g % 96) * 64 + lane;
            const float* wp = w_mod + (size_t)l * 1024 * 6144 + n;
            float acc[17];
#pragma unroll
            for (int r = 0; r < 17; ++r) acc[r] = 0.f;
            const int kb = wave * 128;
#pragma unroll 4
            for (int kk = 0; kk < 128; ++kk) { const int k = kb + kk; const float w = wp[(size_t)k * 6144];
                const LAS float* sp = sT + k * 20;
#pragma unroll
                for (int r = 0; r < 17; ++r) acc[r] += sp[r] * w; }
#pragma unroll
            for (int r = 0; r < 17; ++r) red[(wave * 17 + r) * 64 + lane] = acc[r];
            __syncthreads();
            for (int e = tid; e < 17 * 64; e += 512) { const int r = e >> 6, ln = e & 63; float s = 0.f;
#pragma unroll
                for (int w8 = 0; w8 < 8; ++w8) s += red[(w8 * 17 + r) * 64 + ln];
                const int nn = (g % 96) * 64 + ln;
                MODB[(size_t)(l * 17 + r) * 6144 + nn] = s + b_mod[l * 6144 + nn]; }
            __syncthreads();
        }
        for (int e = blockIdx.x * 512 + tid; e < 2048 * 32; e += G * 512) { const int t = e >> 5, i = e & 31; const int pos = i < 16 ? (t >> 6) : (t & 63);
            const float freq = powf(10000.0f, -(float)(i & 15) / 16.0f); const float ang = (float)pos * freq;
            ROPEC[e] = cosf(ang); ROPES[e] = sinf(ang); }
#if FAST_GEMM
        __syncthreads();
        { LAS float* scr = (LAS float*)(lds + wave * 8448); int off = 0;
          cvt_matrix(w_in_a, 1024, IN_A, W_IN, 1024, 0, map_id, scr, lane, gw, NGW, off);
          cvt_matrix(mla_w_uq, 256, 768, W_UP, 384, 0, map_id, scr, lane, gw, NGW, off);
          cvt_matrix(mla_w_ukv, 128, 1024, W_UP, 384, 256, [](int n0) { return 768 + n0; }, scr, lane, gw, NGW, off);
          cvt_matrix(w_out_a, 1024, 1024, W_OA, 1024, 0, map_id, scr, lane, gw, NGW, off);
          cvt_matrix(ffn_w_gate, 1024, FFN, W_FGU, 1024, 0, map_gate, scr, lane, gw, NGW, off);
          cvt_matrix(ffn_w_up, 1024, FFN, W_FGU, 1024, 0, map_up, scr, lane, gw, NGW, off);
          cvt_matrix(ffn_w_down, FFN, 1024, W_FD, FFN, 0, map_id, scr, lane, gw, NGW, off);
          cvt_matrix(w_qkv_c, 1024, 3072, W_QKV, 1024, 0, map_id, scr, lane, gw, NGW, off);
          cvt_matrix(w_out_c, 1024, 1024, W_OC, 1024, 0, map_id, scr, lane, gw, NGW, off);
          const uint4 z = make_uint4(0u, 0u, 0u, 0u);
          for (int e = blockIdx.x * 512 + tid; e < 32 * 128; e += G * 512) *(uint4*)(W_IN + (size_t)IN_A * 1024 + (size_t)e * 8) = z;
          for (int e = blockIdx.x * 512 + tid; e < 768 * 16; e += G * 512) { const int r = e >> 4, c8 = e & 15; *(uint4*)(W_UP + (size_t)r * 384 + 256 + c8 * 8) = z; }
          for (int e = blockIdx.x * 512 + tid; e < 1024 * 32; e += G * 512) { const int r = 768 + (e >> 5), c8 = e & 31; *(uint4*)(W_UP + (size_t)r * 384 + c8 * 8) = z; } }
#endif
        GRID_BAR();
    }
    if (IN(1)) {
        for (int row = gw; row < M; row += NGW) {
            const float* src = row < ML ? x_in + (size_t)row * 1024 : ctx_in + (size_t)(row - ML) * 1024;
            const int mr = row < ML ? (row >> 11) : 16;
            f32x4 xv[4], hv[4]; ld_row_f32(src, lane, xv);
            premod(xv, hv, g_pre_mix, modp(ws, 0, mr, 0), modp(ws, 0, mr, 1), lane);
            st_row_bf16(H0 + (size_t)row * 1024, lane, hv);
        }
        GRID_BAR();
    }
    if (IN(2)) {
#if FAST_GEMM
        { pg8::Gemm g{H0, W_IN, 1024, 1024}; pg8::DenseOrder S; S.init(M / 256, IN_AP / 256, G, (int)blockIdx.x); pg8::EpiStore E{PARTS, IN_AP};
          pg8::gemm_phase<pg8::EpiStore, pg8::DenseOrder, PG8_ALIGN, PG8_SP2>(lds, g, S, E); }
#else
        auto epi = [&](int r, int c, float a, float) { PARTS[(size_t)r * IN_AP + c] = (u16)f2bf(a); };
        naive_gemm<false>(lds, H0, 1024, M / 128, w_in_a, nullptr, 1024, IN_A, IN_A, nullptr, 0, epi);
#endif
        GRID_BAR();
    }
    if (IN(3)) {
        for (int row = gw; row < M; row += NGW) {
            const u16* pr = PARTS + (size_t)row * IN_AP;
            { const uint2 w = *(const uint2*)(pr + C_CQ + 4 * lane); float v[4] = {bf2f(w.x & 0xffffu), bf2f(w.x >> 16), bf2f(w.y & 0xffffu), bf2f(w.y >> 16)};
              float s = wave_sum(v[0] * v[0] + v[1] * v[1] + v[2] * v[2] + v[3] * v[3]); const float r = 1.0f / sqrtf(s * (1.0f / 256.0f) + EPS);
              const f32x4 g = *(const f32x4*)(mla_g_q + 4 * lane);
              uint2 o; o.x = f2bf(v[0] * r * g.x) | (f2bf(v[1] * r * g.y) << 16); o.y = f2bf(v[2] * r * g.z) | (f2bf(v[3] * r * g.w) << 16);
              *(uint2*)(A2 + (size_t)row * 384 + 4 * lane) = o; }
            { const unsigned w = *(const unsigned*)(pr + C_CKV + 2 * lane); float v0 = bf2f(w & 0xffffu), v1 = bf2f(w >> 16);
              float s = wave_sum(v0 * v0 + v1 * v1); const float r = 1.0f / sqrtf(s * (1.0f / 128.0f) + EPS);
              const float2 g = *(const float2*)(mla_g_kv + 2 * lane);
              *(unsigned*)(A2 + (size_t)row * 384 + 256 + 2 * lane) = f2bf(v0 * r * g.x) | (f2bf(v1 * r * g.y) << 16); }
            if (lane < 32) { float x1 = bf2f(pr[C_KR + lane]), x2 = bf2f(pr[C_KR + 32 + lane]);
              if (row < ML) { const int t = row & 2047; const float cs = ROPEC[t * 32 + lane], sn = ROPES[t * 32 + lane]; const float n1 = x1 * cs - x2 * sn, n2 = x2 * cs + x1 * sn; x1 = n1; x2 = n2; }
              KROPE[(size_t)row * 64 + lane] = (u16)f2bf(x1); KROPE[(size_t)row * 64 + 32 + lane] = (u16)f2bf(x2); }
        }
        GRID_BAR();
    }
    if (IN(4)) {
#if FAST_GLA
        for (int u = blockIdx.x; u < 256; u += G) {
            const int vh = u & 1, dir = (u >> 1) & 1, h = (u >> 2) & 3, b = u >> 4;
            __syncthreads();
            gla::unit(lds, PARTS, dir ? gla_w_gb : gla_w_gf, dir ? gla_b_gb : gla_b_gf, dir ? C_AB : C_AF, dir ? OB : OF, b, h, dir, vh);
        }
#else
        LAS float* qs = (LAS float*)lds;
        LAS float* ks = qs + 16 * 64;
        LAS float* as = ks + 16 * 64;
        LAS float* vs = as + 16 * 64;
        LAS float* opart = vs + 16 * 128;
        for (int u = blockIdx.x; u < 128; u += G) {
            const int dir = u & 1, h = (u >> 1) & 3, b = u >> 3;
            const float* wg = dir ? gla_w_gb : gla_w_gf; const float* bg = dir ? gla_b_gb : gla_b_gf; const int caf = dir ? C_AB : C_AF;
            float* Od = dir ? OB : OF;
            const int kg = tid >> 7, v = tid & 127;
            float S[16];
#pragma unroll
            for (int i = 0; i < 16; ++i) S[i] = 0.f;
            for (int sb = 0; sb < (CTXL + SEQ) / 16; ++sb) {
                __syncthreads();
                for (int e = tid; e < 16 * 64; e += 512) { const int tok = e >> 6, k = e & 63; const int n = sb * 16 + tok;
                    const int row = n < CTXL ? (ML + b * CTXL + (dir ? CTXL - 1 - n : n)) : (b * SEQ + (dir ? SEQ - 1 - (n - CTXL) : (n - CTXL)));
                    const u16* pr = PARTS + (size_t)row * IN_AP;
                    float pre = bg[h * 64 + k];
#pragma unroll
                    for (int jj = 0; jj < 16; ++jj) pre += bf2f(pr[caf + jj]) * wg[jj * 256 + h * 64 + k];
                    const float ls = fminf(pre, 0.f) - log1pf(__expf(-fabsf(pre)));
                    qs[e] = bf2f(pr[C_GQ + h * 64 + k]) * 0.125f; ks[e] = bf2f(pr[C_GK + h * 64 + k]); as[e] = __expf(ls * (1.0f / 16.0f)); }
                for (int e = tid; e < 16 * 128; e += 512) { const int tok = e >> 7, vv = e & 127; const int n = sb * 16 + tok;
                    const int row = n < CTXL ? (ML + b * CTXL + (dir ? CTXL - 1 - n : n)) : (b * SEQ + (dir ? SEQ - 1 - (n - CTXL) : (n - CTXL)));
                    vs[e] = bf2f(PARTS[(size_t)row * IN_AP + C_GV + h * 128 + vv]); }
                __syncthreads();
                for (int tok = 0; tok < 16; ++tok) { const float vv = vs[tok * 128 + v]; float po = 0.f;
#pragma unroll
                    for (int i = 0; i < 16; ++i) { const int k = kg * 16 + i; S[i] = as[tok * 64 + k] * S[i] + ks[tok * 64 + k] * vv; po += qs[tok * 64 + k] * S[i]; }
                    opart[(tok * 4 + kg) * 128 + v] = po; }
                __syncthreads();
                for (int e = tid; e < 16 * 128; e += 512) { const int tok = e >> 7, vv = e & 127; const int n = sb * 16 + tok;
                    const int row = n < CTXL ? (ML + b * CTXL + (dir ? CTXL - 1 - n : n)) : (b * SEQ + (dir ? SEQ - 1 - (n - CTXL) : (n - CTXL)));
                    Od[(size_t)row * 512 + h * 128 + vv] = (opart[(tok * 4 + 0) * 128 + vv] + opart[(tok * 4 + 1) * 128 + vv]) + (opart[(tok * 4 + 2) * 128 + vv] + opart[(tok * 4 + 3) * 128 + vv]); }
            }
        }
#endif
        GRID_BAR();
    }
    if (IN(5)) {
        for (int row = gw; row < M; row += NGW) {
            const int h = lane >> 4, v0 = (lane & 15) * 8;
            const float* pf = OF + (size_t)row * 512 + h * 128 + v0; const float* pb = OB + (size_t)row * 512 + h * 128 + v0;
            float o[8]; float s = 0.f;
#pragma unroll
            for (int i = 0; i < 8; ++i) { o[i] = pf[i] + pb[i]; s += o[i] * o[i]; }
#pragma unroll
            for (int off = 1; off < 16; off <<= 1) s += __shfl_xor(s, off);
            const float r = 1.0f / sqrtf(s * (1.0f / 128.0f) + EPS);
            const u16* pr = PARTS + (size_t)row * IN_AP + C_GR + h * 128 + v0;
            u16* po = CAT + (size_t)row * 1024 + 512 + h * 128 + v0;
#pragma unroll
            for (int i = 0; i < 8; ++i) po[i] = (u16)f2bf(o[i] * r * gla_g_out[v0 + i] * silu_f(bf2f(pr[i])));
        }
        GRID_BAR();
    }
    if (IN(6)) {
#if FAST_GEMM
        { pg8::Gemm g{A2, W_UP, 384, 384}; pg8::DenseOrder S; S.init(M / 256, UPN / 256, G, (int)blockIdx.x); pg8::EpiStore E{QKVUP, UPN};
          pg8::gemm_phase<pg8::EpiStore, pg8::DenseOrder, PG8_ALIGN, PG8_SP2>(lds, g, S, E); }
#else
        auto epiq = [&](int r, int c, float a, float) { QKVUP[(size_t)r * UPN + c] = (u16)f2bf(a); };
        naive_gemm<false>(lds, A2, 384, M / 128, mla_w_uq, nullptr, 256, 768, 768, nullptr, 0, epiq);
        auto epik = [&](int r, int c, float a, float) { QKVUP[(size_t)r * UPN + 768 + c] = (u16)f2bf(a); };
        naive_gemm<false>(lds, A2 + 256, 384, M / 128, mla_w_ukv, nullptr, 128, 1024, 1024, nullptr, 0, epik);
#endif
        GRID_BAR();
    }
    if (IN(7)) {
        for (int row = gw; row < ML; row += NGW) {
            const int t = row & 2047;
#pragma unroll
            for (int jj = 0; jj < 2; ++jj) { const int p = lane + 64 * jj, h = p >> 5, i = p & 31;
                u16* q = QKVUP + (size_t)row * UPN + h * 192 + 128;
                const float x1 = bf2f(q[i]), x2 = bf2f(q[32 + i]), cs = ROPEC[t * 32 + i], sn = ROPES[t * 32 + i];
                q[i] = (u16)f2bf(x1 * cs - x2 * sn); q[32 + i] = (u16)f2bf(x2 * cs + x1 * sn); }
        }
        GRID_BAR();
    }
    if (IN(8)) {
#if FAST_ATTN
        { const int NU_L = NB * 4 * 8, NU_X = NB * 4;
          for (int u = blockIdx.x; u < NU_L + NU_X; u += G) {
            const bool isx = u >= NU_L; const int uu = isx ? u - NU_L : u;
            const int qb = isx ? 0 : (uu & 7), h = isx ? (uu & 3) : ((uu >> 3) & 3), b = isx ? (uu >> 2) : (uu >> 5);
            const int r0 = isx ? (ML + b * CTXL) : (b * SEQ + qb * 256);
            fa::KVSrc S; S.k0 = QKVUP + 768 + h * 256; S.kst0 = UPN; S.k1 = KROPE; S.kst1 = 64; S.split8 = 16; S.v = QKVUP + 768 + h * 256 + 128; S.vst = UPN;
            S.xrow0 = ML + b * CTXL; S.lrow0 = b * SEQ;
            __syncthreads();
            fa::attn_unit_sp<192, 16>(QKVUP + (size_t)r0 * UPN + h * 192, UPN, S, CAT + (size_t)r0 * 1024 + h * 128, 1024, isx ? 4 : 36, (char*)lds_raw);
          } }
#else
        const float scale = 0.07216878364870322f;
        const int NU_L = NB * 4 * 64, NU_X = NB * 4 * 8;
        for (int u = blockIdx.x; u < NU_L + NU_X; u += G) {
            const bool isx = u >= NU_L; const int uu = isx ? u - NU_L : u;
            const int nqb = isx ? 8 : 64;
            const int qb = uu % nqb, h = (uu / nqb) & 3, b = uu / (nqb * 4);
            const int r0 = isx ? (ML + b * CTXL + qb * 32) : (b * SEQ + qb * 32);
            const int nkeys = isx ? CTXL : (CTXL + SEQ);
            auto krow = [&](int key) { return key < CTXL ? (ML + b * CTXL + key) : (b * SEQ + key - CTXL); };
            auto ql = [&](int r, int d) { return bf2f(QKVUP[(size_t)(r0 + r) * UPN + h * 192 + d]); };
            auto kl = [&](int key, int d) { const int row = krow(key); return d < 128 ? bf2f(QKVUP[(size_t)row * UPN + 768 + h * 256 + d]) : bf2f(KROPE[(size_t)row * 64 + d - 128]); };
            auto vl = [&](int key, int d) { const int row = krow(key); return bf2f(QKVUP[(size_t)row * UPN + 768 + h * 256 + 128 + d]); };
            auto os = [&](int r, int d, float val) { CAT[(size_t)(r0 + r) * 1024 + h * 128 + d] = (u16)f2bf(val); };
            naive_attn_unit<192>(lds, nkeys, scale, ql, kl, vl, os);
        }
#endif
        GRID_BAR();
    }
    if (IN(9)) {
#if FAST_GEMM
        { pg8::Gemm g{CAT, W_OA, 1024, 1024}; pg8::DenseOrder S; S.init(M / 256, 4, G, (int)blockIdx.x); pg8::EpiStore E{YB, 1024};
          pg8::gemm_phase<pg8::EpiStore, pg8::DenseOrder, PG8_ALIGN, PG8_SP2>(lds, g, S, E); }
#else
        auto epi = [&](int r, int c, float a, float) { YB[(size_t)r * 1024 + c] = (u16)f2bf(a); };
        naive_gemm<false>(lds, CAT, 1024, M / 128, w_out_a, nullptr, 1024, 1024, 1024, nullptr, 0, epi);
#endif
        GRID_BAR();
    }
    if (IN(10)) {
        for (int row = gw; row < M; row += NGW) {
            const float* src = row < ML ? x_in + (size_t)row * 1024 : ctx_in + (size_t)(row - ML) * 1024;
            float* dst = row < ML ? out + (size_t)row * 1024 : CTXS + (size_t)(row - ML) * 1024;
            const int mr = row < ML ? (row >> 11) : 16;
            f32x4 xv[4], tv[4], hv[4]; ld_row_f32(src, lane, xv); ld_row_bf16(YB + (size_t)row * 1024, lane, tv);
            rms_apply(tv, g_post_mix, lane);
            const float* gate = modp(ws, 0, mr, 2);
#pragma unroll
            for (int j = 0; j < 4; ++j) xv[j] = xv[j] + *(const f32x4*)(gate + 4 * lane + 256 * j) * tv[j];
            st_row_f32(dst, lane, xv);
            premod(xv, hv, g_pre_ffn, modp(ws, 0, mr, 3), modp(ws, 0, mr, 4), lane);
            st_row_bf16(H1 + (size_t)row * 1024, lane, hv);
        }
        GRID_BAR();
    }
    if (IN(11)) {
#if FAST_GEMM
        { pg8::Gemm g{H1, W_FGU, 1024, 1024}; pg8::DenseOrder S; S.init(M / 256, 2 * FFN / 256, G, (int)blockIdx.x); pg8::EpiSwiglu E{HID, FFN};
          pg8::gemm_phase<pg8::EpiSwiglu, pg8::DenseOrder, PG8_ALIGN, PG8_SP2>(lds, g, S, E); }
#else
        auto epi = [&](int r, int c, float a, float b2) { HID[(size_t)r * FFN + c] = (u16)f2bf(silu_f(a) * b2); };
        naive_gemm<true>(lds, H1, 1024, M / 128, ffn_w_gate, ffn_w_up, 1024, FFN, FFN, nullptr, 0, epi);
#endif
        GRID_BAR();
    }
    if (IN(12)) {
#if FAST_GEMM
        { pg8::Gemm g{HID, W_FD, FFN, FFN}; pg8::DenseOrder S; S.init(M / 256, 4, G, (int)blockIdx.x); pg8::EpiStore E{FB, 1024};
          pg8::gemm_phase<pg8::EpiStore, pg8::DenseOrder, PG8_ALIGN, PG8_SP2>(lds, g, S, E); }
#else
        auto epi = [&](int r, int c, float a, float) { FB[(size_t)r * 1024 + c] = (u16)f2bf(a); };
        naive_gemm<false>(lds, HID, FFN, M / 128, ffn_w_down, nullptr, FFN, 1024, 1024, nullptr, 0, epi);
#endif
        GRID_BAR();
    }
    if (IN(13)) {
        for (int row = gw; row < M; row += NGW) {
            float* dst = row < ML ? out + (size_t)row * 1024 : CTXS + (size_t)(row - ML) * 1024;
            const int mr = row < ML ? (row >> 11) : 16;
            f32x4 xv[4], tv[4], hv[4]; ld_row_f32(dst, lane, xv); ld_row_bf16(FB + (size_t)row * 1024, lane, tv);
            rms_apply(tv, g_post_ffn, lane);
            const float* gate = modp(ws, 0, mr, 5);
#pragma unroll
            for (int j = 0; j < 4; ++j) xv[j] = xv[j] + *(const f32x4*)(gate + 4 * lane + 256 * j) * tv[j];
            st_row_f32(dst, lane, xv);
            premod(xv, hv, g_pre_mix + 1024, modp(ws, 1, mr, 0), modp(ws, 1, mr, 1), lane);
            st_row_bf16(HB + (size_t)row * 1024, lane, hv);
        }
        GRID_BAR();
    }
    if (IN(14)) {
#if FAST_GEMM
        { pg8::Gemm g{HB, W_QKV, 1024, 1024}; pg8::DenseOrder S; S.init(M / 256, 12, G, (int)blockIdx.x); pg8::EpiStore E{QKVC, 3072};
          pg8::gemm_phase<pg8::EpiStore, pg8::DenseOrder, PG8_ALIGN, PG8_SP2>(lds, g, S, E); }
#else
        auto epi = [&](int r, int c, float a, float) { QKVC[(size_t)r * 3072 + c] = (u16)f2bf(a); };
        naive_gemm<false>(lds, HB, 1024, M / 128, w_qkv_c, nullptr, 1024, 3072, 3072, nullptr, 0, epi);
#endif
        GRID_BAR();
    }
    if (IN(15)) {
        for (int row = gw; row < ML; row += NGW) {
            const int t = row & 2047;
#pragma unroll 4
            for (int jj = 0; jj < 16; ++jj) { const int p = lane + 64 * jj, which = p >> 9, hh = (p & 511) >> 5, i = p & 31;
                u16* q = QKVC + (size_t)row * 3072 + which * 1024 + hh * 64;
                const float x1 = bf2f(q[i]), x2 = bf2f(q[32 + i]), cs = ROPEC[t * 32 + i], sn = ROPES[t * 32 + i];
                q[i] = (u16)f2bf(x1 * cs - x2 * sn); q[32 + i] = (u16)f2bf(x2 * cs + x1 * sn); }
        }
        GRID_BAR();
    }
    if (IN(16)) {
#if FAST_ATTN
        { const int NU = NB * 16 * 8;
          for (int u = blockIdx.x; u < NU; u += G) {
            const int qb = u & 7, j = (u >> 3) & 15, b = u >> 7;
            const int r0 = b * SEQ + qb * 256;
            fa::KVSrc S; S.k0 = QKVC + 1024 + j * 64; S.kst0 = 3072; S.k1 = QKVC; S.kst1 = 3072; S.split8 = 8; S.v = QKVC + 2048 + (j >> 1) * 128; S.vst = 3072;
            S.xrow0 = ML + b * CTXL; S.lrow0 = b * SEQ;
            __syncthreads();
            fa::attn_unit<64>(QKVC + (size_t)r0 * 3072 + j * 64, 3072, S, O16 + (size_t)r0 * 2048 + j * 128, 2048, 36, (char*)lds_raw);
          } }
#else
        const int NU = NB * 16 * 64;
        for (int u = blockIdx.x; u < NU; u += G) {
            const int qb = u & 63, j = (u >> 6) & 15, b = u >> 10;
            const int r0 = b * SEQ + qb * 32;
            auto krow = [&](int key) { return key < CTXL ? (ML + b * CTXL + key) : (b * SEQ + key - CTXL); };
            auto ql = [&](int r, int d) { return bf2f(QKVC[(size_t)(r0 + r) * 3072 + j * 64 + d]); };
            auto kl = [&](int key, int d) { return bf2f(QKVC[(size_t)krow(key) * 3072 + 1024 + j * 64 + d]); };
            auto vl = [&](int key, int d) { return bf2f(QKVC[(size_t)krow(key) * 3072 + 2048 + (j >> 1) * 128 + d]); };
            auto os = [&](int r, int d, float val) { O16[(size_t)(r0 + r) * 2048 + j * 128 + d] = (u16)f2bf(val); };
            naive_attn_unit<64>(lds, CTXL + SEQ, 0.125f, ql, kl, vl, os);
        }
#endif
        GRID_BAR();
    }
    if (IN(17)) {
#if FAST_GEMM
        { LAS float* scr = (LAS float*)(lds + wave * 8448); int off = 0;
#pragma unroll 1
          for (int e = 0; e < NE; ++e) {
              cvt_matrix(moe_w_gate + (size_t)e * 1024 * ED, 1024, ED, W_MGU + (size_t)e * 2 * ED * 1024, 1024, 0, map_gate, scr, lane, gw, NGW, off);
              cvt_matrix(moe_w_up + (size_t)e * 1024 * ED, 1024, ED, W_MGU + (size_t)e * 2 * ED * 1024, 1024, 0, map_up, scr, lane, gw, NGW, off);
              cvt_matrix(moe_w_down + (size_t)e * ED * 1024, ED, 1024, W_MD + (size_t)e * 1024 * ED, ED, 0, map_id, scr, lane, gw, NGW, off); } }
#endif
        const float s1 = wave_sum(diff_lq1[lane] * diff_lk1[lane]), s2 = wave_sum(diff_lq2[lane] * diff_lk2[lane]);
        const float lam = expf(s1) - expf(s2) + LAM_INIT;
        for (int row = gw; row < ML; row += NGW) {
            const int h = lane >> 3, v0 = (lane & 7) * 16;
            const u16* p1 = O16 + (size_t)row * 2048 + (2 * h) * 128 + v0; const u16* p2 = p1 + 128;
            float o[16]; float s = 0.f;
#pragma unroll
            for (int i = 0; i < 16; ++i) { o[i] = bf2f(p1[i]) - lam * bf2f(p2[i]); s += o[i] * o[i]; }
#pragma unroll
            for (int off = 1; off < 8; off <<= 1) s += __shfl_xor(s, off);
            const float r = 1.0f / sqrtf(s * (1.0f / 128.0f) + EPS);
            u16* po = CAT2 + (size_t)row * 1024 + h * 128 + v0;
#pragma unroll
            for (int i = 0; i < 16; ++i) po[i] = (u16)f2bf(o[i] * r * diff_g_out[v0 + i] * (1.0f - LAM_INIT));
        }
        GRID_BAR();
    }
    if (IN(18)) {
#if FAST_GEMM
        { pg8::Gemm g{CAT2, W_OC, 1024, 1024}; pg8::DenseOrder S; S.init(ML / 256, 4, G, (int)blockIdx.x); pg8::EpiStore E{Y2, 1024};
          pg8::gemm_phase<pg8::EpiStore, pg8::DenseOrder, PG8_ALIGN, PG8_SP2>(lds, g, S, E); }
#else
        auto epi = [&](int r, int c, float a, float) { Y2[(size_t)r * 1024 + c] = (u16)f2bf(a); };
        naive_gemm<false>(lds, CAT2, 1024, ML / 128, w_out_c, nullptr, 1024, 1024, 1024, nullptr, 0, epi);
#endif
        GRID_BAR();
    }
    if (IN(19)) {
        LAS int* lcnt = (LAS int*)lds;
        LAS int* gbase = lcnt + 8;
        LAS int* le = gbase + 8;
        LAS int* lr = le + 256;
        LAS float* lg = (LAS float*)(lr + 256);
        for (int base = blockIdx.x * 128; base < ML; base += G * 128) {
            __syncthreads();
            if (tid < 8) lcnt[tid] = 0;
            __syncthreads();
            for (int i = 0; i < 16; ++i) {
                const int lrow = wave * 16 + i, row = base + lrow;
                float* dst = out + (size_t)row * 1024;
                const int mr = row >> 11;
                f32x4 xv[4], tv[4], hv[4]; ld_row_f32(dst, lane, xv); ld_row_bf16(Y2 + (size_t)row * 1024, lane, tv);
                rms_apply(tv, g_post_mix + 1024, lane);
                const float* gate = modp(ws, 1, mr, 2);
#pragma unroll
                for (int j = 0; j < 4; ++j) xv[j] = xv[j] + *(const f32x4*)(gate + 4 * lane + 256 * j) * tv[j];
                st_row_f32(dst, lane, xv);
                premod(xv, hv, g_pre_ffn + 1024, modp(ws, 1, mr, 3), modp(ws, 1, mr, 4), lane);
                st_row_bf16(HC + (size_t)row * 1024, lane, hv);
                float lg8[8];
#pragma unroll
                for (int e = 0; e < 8; ++e) lg8[e] = 0.f;
#pragma unroll
                for (int j = 0; j < 4; ++j)
#pragma unroll
                    for (int q = 0; q < 4; ++q) { const int k = 4 * lane + 256 * j + q; const float hvv = hv[j][q];
                        const f32x4 wa = *(const f32x4*)(moe_w_router + (size_t)k * 8), wb = *(const f32x4*)(moe_w_router + (size_t)k * 8 + 4);
                        lg8[0] += hvv * wa.x; lg8[1] += hvv * wa.y; lg8[2] += hvv * wa.z; lg8[3] += hvv * wa.w;
                        lg8[4] += hvv * wb.x; lg8[5] += hvv * wb.y; lg8[6] += hvv * wb.z; lg8[7] += hvv * wb.w; }
#pragma unroll
                for (int e = 0; e < 8; ++e) lg8[e] = wave_sum(lg8[e]);
                if (lane == 0) {
                    int e0 = 0; float v0 = lg8[0];
#pragma unroll
                    for (int e = 1; e < 8; ++e) if (lg8[e] > v0) { v0 = lg8[e]; e0 = e; }
                    int e1 = -1; float v1 = -3.0e38f;
#pragma unroll
                    for (int e = 0; e < 8; ++e) if (e != e0 && lg8[e] > v1) { v1 = lg8[e]; e1 = e; }
                    const float g0 = 1.0f / (1.0f + expf(v1 - v0));
                    le[lrow * 2] = e0; le[lrow * 2 + 1] = e1; lg[lrow * 2] = g0; lg[lrow * 2 + 1] = 1.0f - g0;
                    lr[lrow * 2] = __hip_atomic_fetch_add(&lcnt[e0], 1, __ATOMIC_RELAXED, __HIP_MEMORY_SCOPE_WORKGROUP); lr[lrow * 2 + 1] = __hip_atomic_fetch_add(&lcnt[e1], 1, __ATOMIC_RELAXED, __HIP_MEMORY_SCOPE_WORKGROUP);
                }
            }
            __syncthreads();
            if (tid < 8) gbase[tid] = (int)atomicAdd(ctl + CW_ECNT + 64 * tid, (unsigned)lcnt[tid]);
            __syncthreads();
            if (tid < 256) { const int e = le[tid]; TOKE[(size_t)base * 2 + tid] = e; TOKG[(size_t)base * 2 + tid] = lg[tid]; TOKP[(size_t)base * 2 + tid] = gbase[e] + lr[tid]; }
        }
        GRID_BAR();
    }
    if (IN(20)) {
        LAS int* pst = (LAS int*)lds;
        if (tid == 0) { int acc = 0; for (int e = 0; e < 8; ++e) { pst[e] = acc; const int c = (int)ctl[CW_ECNT + 64 * e]; acc += (c + 255) / 256 * 256; } pst[8] = acc; }
        __syncthreads();
        if (blockIdx.x == 0) {
            if (tid == 0) ctl[CW_MOET] = (unsigned)(pst[8] / 256);
            for (int t = tid; t < pst[8] / 256; t += 512) { int e = 0; for (int q = 1; q < 8; ++q) if (t * 256 >= pst[q]) e = q; ctl[CW_TILEE + t] = (unsigned)e; }
        }
        for (int s = gw; s < 2 * ML; s += NGW) {
            const int e = TOKE[s], pos = pst[e] + TOKP[s];
            const uint4* src = (const uint4*)(HC + (size_t)(s >> 1) * 1024); uint4* dstp = (uint4*)(XS + (size_t)pos * 1024);
            const uint4 a = src[lane], b2 = src[lane + 64];
            dstp[lane] = a; dstp[lane + 64] = b2;
            if (lane == 0) TOKP[s] = pos;
        }
        GRID_BAR();
    }
    if (IN(21)) {
        const int T = (int)ctl[CW_MOET];
        for (int c0 = 0; c0 < T; c0 += CHUNK_T) {
            const int nt = (T - c0) < CHUNK_T ? (T - c0) : CHUNK_T;
#if FAST_GEMM
            { pg8::Gemm g{XS, W_MGU, 1024, 1024}; pg8::MoeOrder S; S.init(nt, 2 * ED / 256, G, (int)blockIdx.x); S.tile_e = ctl + CW_TILEE + c0; S.nper = 2 * ED / 256; S.a_off = c0; S.o_off = 0;
              pg8::EpiSwiglu E{HIDC, ED};
              pg8::gemm_phase<pg8::EpiSwiglu, pg8::MoeOrder, PG8_ALIGN, PG8_SP2>(lds, g, S, E); }
#else
            { auto epi = [&](int r, int c, float a, float b2) { HIDC[(size_t)r * ED + c] = (u16)f2bf(silu_f(a) * b2); };
              naive_gemm<true>(lds, XS + (size_t)c0 * 256 * 1024, 1024, nt * 2, moe_w_gate, moe_w_up, 1024, ED, ED, ctl + CW_TILEE + c0, (size_t)1024 * ED, epi); }
#endif
            GRID_BAR();
#if FAST_GEMM
            { pg8::Gemm g{HIDC, W_MD, ED, ED}; pg8::MoeOrder S; S.init(nt, 4, G, (int)blockIdx.x); S.tile_e = ctl + CW_TILEE + c0; S.nper = 4; S.a_off = 0; S.o_off = c0;
              pg8::EpiStore E{XS, 1024};
              pg8::gemm_phase<pg8::EpiStore, pg8::MoeOrder, PG8_ALIGN, PG8_SP2>(lds, g, S, E); }
#else
            { u16* ys = XS + (size_t)c0 * 256 * 1024;
              auto epi = [&](int r, int c, float a, float) { ys[(size_t)r * 1024 + c] = (u16)f2bf(a); };
              naive_gemm<false>(lds, HIDC, ED, nt * 2, moe_w_down, nullptr, ED, 1024, 1024, ctl + CW_TILEE + c0, (size_t)ED * 1024, epi); }
#endif
            GRID_BAR();
        }
    }
    if (IN(22)) {
        for (int row = gw; row < ML; row += NGW) {
            float* dst = out + (size_t)row * 1024;
            const int mr = row >> 11;
            const int p0 = TOKP[row * 2], p1 = TOKP[row * 2 + 1]; const float g0 = TOKG[row * 2], g1 = TOKG[row * 2 + 1];
            f32x4 xv[4], a[4], b2[4]; ld_row_f32(dst, lane, xv); ld_row_bf16(XS + (size_t)p0 * 1024, lane, a); ld_row_bf16(XS + (size_t)p1 * 1024, lane, b2);
#pragma unroll
            for (int j = 0; j < 4; ++j) a[j] = a[j] * g0 + b2[j] * g1;
            rms_apply(a, g_post_ffn + 1024, lane);
            const float* gate = modp(ws, 1, mr, 5);
#pragma unroll
            for (int j = 0; j < 4; ++j) xv[j] = xv[j] + *(const f32x4*)(gate + 4 * lane + 256 * j) * a[j];
            st_row_f32(dst, lane, xv);
        }
    }
#undef IN
#undef GRID_BAR
}

extern "C" void kernel_launch(void* const* d_in, const int* in_sizes, int n_in, void* d_out, int out_size, void* d_ws, size_t ws_size, hipStream_t stream) {
    static int grid = 0;
    if (grid == 0) {
        if (n_in != 35 || in_sizes[0] != ML * D || out_size != ML * D || ws_size < WS_END) {
            fprintf(stderr, "kernel_launch: shape mismatch n_in %d in0 %d out %d ws %zu (need %zu)\n", n_in, n_in > 0 ? in_sizes[0] : -1, out_size, ws_size, (size_t)WS_END); grid = -1; return; }
        int dev = 0, cus = 0, per_cu = 0;
        if (hipGetDevice(&dev) != hipSuccess || hipDeviceGetAttribute(&cus, hipDeviceAttributeMultiprocessorCount, dev) != hipSuccess) { grid = -1; return; }
        if (hipFuncSetAttribute((const void*)fwd_kernel, hipFuncAttributeMaxDynamicSharedMemorySize, LDS_BYTES) != hipSuccess) { fprintf(stderr, "kernel_launch: hipFuncSetAttribute failed\n"); grid = -1; return; }
        if (hipOccupancyMaxActiveBlocksPerMultiprocessor(&per_cu, (const void*)fwd_kernel, 512, LDS_BYTES) != hipSuccess || per_cu < 1)
            fprintf(stderr, "kernel_launch: occupancy query reports %d\n", per_cu);
        (void)hipGetLastError();
        grid = cus;
    }
    if (grid < 0) return;
    if (hipMemsetAsync((char*)d_ws + WS_CTL, 0, CTL_ZERO_BYTES, stream) != hipSuccess) return;
    Args a{};
    for (int i = 0; i < 35; ++i) a.in[i] = (const float*)d_in[i];
    a.out = (float*)d_out; a.ws = (unsigned char*)d_ws; a.ph_lo = 0; a.ph_hi = 100;
    hipLaunchKernelGGL(fwd_kernel, dim3(grid), dim3(512), LDS_BYTES, stream, a);
}
```

```cpp
#include <hip/hip_runtime.h>
#include <cstdio>
#include <cstdint>

constexpr int D = 1024, NB = 16, SEQ = 2048, CTXL = 256;
constexpr int ML = NB * SEQ, MX = NB * CTXL, M = ML + MX;
constexpr int IN_A = 2016, IN_AP = 2048;
constexpr int C_CQ = 0, C_CKV = 256, C_KR = 384, C_GQ = 448, C_GK = 704, C_GV = 960, C_GR = 1472, C_AF = 1984, C_AB = 2000;
constexpr int UPN = 1792;
constexpr int FFN = 2816, NE = 8, ED = 3584;
constexpr int CAP = 2 * ML + NE * 256, MAXT = CAP / 256;
constexpr int CHUNK_T = 128;
constexpr float EPS = 1e-6f;
constexpr float LAM_INIT = 0.35550906759f;

constexpr size_t MiB = 1u << 20;
constexpr size_t WS_CTL = 0, CTL_ZERO_BYTES = 1 * MiB;
constexpr size_t WS_MOD = 1 * MiB;
constexpr size_t WS_ROPE = 2 * MiB;
constexpr size_t WS_TOKE = 2 * MiB + 512 * 1024;
constexpr size_t WS_TOKG = WS_TOKE + 256 * 1024;
constexpr size_t WS_TOKP = WS_TOKG + 256 * 1024;
constexpr size_t WS_CTXS = 4 * MiB;
constexpr size_t WS_W = 20 * MiB;
constexpr size_t WS_R0 = 52 * MiB;
constexpr size_t WS_PARTS = 124 * MiB;
constexpr size_t WS_Y = 124 * MiB;
constexpr size_t WS_H1 = 196 * MiB;
constexpr size_t WS_HC = 116 * MiB;
constexpr size_t WS_XS = 180 * MiB;
constexpr size_t WS_A2 = 268 * MiB;
constexpr size_t WS_KROPE = 295 * MiB;
constexpr size_t WS_R3 = 300 * MiB;
constexpr size_t WS_MOEW = 332 * MiB;
constexpr size_t WS_XS8 = 416 * MiB;
constexpr size_t WS_END = 516 * MiB;
constexpr int CW_BAR = 16384;
constexpr int CW_ECNT = 8192;
constexpr int CW_MOET = 9000;
constexpr int CW_TILEE = 9216;

typedef unsigned short u16;
typedef float f32x4 __attribute__((ext_vector_type(4)));
#define LAS __attribute__((address_space(3)))
constexpr int LDS_BYTES = 147456;
constexpr int MISC_OFF = 131072 + 320;

#define XB_TMO      128
#define XB_XCNT(j)  (256  + 64 * (j))
#define XB_XSUB(j)  (1280 + 64 * (j))
#define XB_XGEN(j)  (2304 + 64 * (j))
#define XB_TOP      3328
#define XB_TOPGEN   3392
#define XCD_BAR_WORDS 3456
#define XB_SPIN_CAP (1u << 23)
__device__ __forceinline__ unsigned xb_ld(unsigned* p)              { return __hip_atomic_load(p, __ATOMIC_RELAXED, __HIP_MEMORY_SCOPE_AGENT); }
__device__ __forceinline__ unsigned xb_add(unsigned* p, unsigned v) { return __hip_atomic_fetch_add(p, v, __ATOMIC_RELAXED, __HIP_MEMORY_SCOPE_AGENT); }
__device__ __forceinline__ unsigned xb_xcc_id() { return (unsigned)__builtin_amdgcn_s_getreg((3 << 11) | 20) & 0xFu; }
#define XB_SPIN(cond, bar) do { unsigned _sp = 0; while (cond) { __builtin_amdgcn_s_sleep(1); \
    if ((++_sp & 255u) == 0u) { if (xb_ld(&(bar)[XB_TMO])) break; if (_sp > XB_SPIN_CAP) { atomicAdd(&(bar)[XB_TMO], 1u); break; } } } } while (0)
struct XcdBarrier { unsigned* bar; unsigned x; volatile LAS unsigned* st; };
__device__ __forceinline__ XcdBarrier xcd_barrier_post(unsigned* bar, volatile LAS unsigned* st) {
    XcdBarrier b; b.bar = bar; b.x = xb_xcc_id(); b.st = st;
    if (threadIdx.x == 0) (void)xb_add(&bar[XB_XCNT(b.x)], 1u);
    return b;
}
__device__ __forceinline__ void xcd_barrier_complete(unsigned* bar, unsigned x, unsigned& nloc, unsigned& nx) {
    const unsigned G = gridDim.x * gridDim.y * gridDim.z;
    unsigned sum, cnt, mine, sp = 0u;
    for (;;) {
        sum = 0u; cnt = 0u; mine = 0u;
#pragma unroll
        for (unsigned j = 0; j < 16; ++j) { const unsigned c = xb_ld(&bar[XB_XCNT(j)]); sum += c; cnt += (c > 0u) ? 1u : 0u; mine = (j == x) ? c : mine; }
        if (sum == G) break;
        __builtin_amdgcn_s_sleep(1);
        if ((++sp & 255u) == 0u) { if (xb_ld(&bar[XB_TMO])) break; if (sp > XB_SPIN_CAP) { atomicAdd(&bar[XB_TMO], 1u); break; } }
    }
    nloc = mine > 0u ? mine : 1u; nx = cnt > 0u ? cnt : 1u;
}
__device__ __forceinline__ void xcd_barrier(const XcdBarrier& b) {
    asm volatile("s_waitcnt vmcnt(0)" ::: "memory");
    __syncthreads();
    if (threadIdx.x == 0) {
        unsigned* bar = b.bar;
        __builtin_amdgcn_s_waitcnt(0);
        unsigned nloc = b.st[0], nx = b.st[1];
        if (nloc == 0u) { xcd_barrier_complete(bar, b.x, nloc, nx); b.st[0] = nloc; b.st[1] = nx; }
        const unsigned old = xb_add(&bar[XB_XSUB(b.x)], 1u);
        const unsigned gen = old / nloc;
        if (old + 1u == (gen + 1u) * nloc) {
            __builtin_amdgcn_fence(__ATOMIC_RELEASE, "agent");
            asm volatile("s_waitcnt vmcnt(0)" ::: "memory");
            const unsigned og = xb_add(&bar[XB_TOP], 1u);
            const unsigned tg = og / nx;
            if (og + 1u == (tg + 1u) * nx) xb_add(&bar[XB_TOPGEN], 1u);
            else XB_SPIN(xb_ld(&bar[XB_TOPGEN]) == tg, bar);
            __builtin_amdgcn_fence(__ATOMIC_ACQUIRE, "agent");
            xb_add(&bar[XB_XGEN(b.x)], 1u);
            asm volatile("s_waitcnt vmcnt(0)" ::: "memory");
        } else {
            XB_SPIN(xb_ld(&bar[XB_XGEN(b.x)]) == gen, bar);
            __builtin_amdgcn_fence(__ATOMIC_ACQUIRE, "agent");
            asm volatile("s_waitcnt vmcnt(0)" ::: "memory");
        }
    }
    __syncthreads();
}

__device__ __forceinline__ float bf2f(unsigned h) { return __uint_as_float(h << 16); }
__device__ __forceinline__ unsigned f2bf(float f) { unsigned u = __float_as_uint(f); return (u + 0x7fffu + ((u >> 16) & 1u)) >> 16; }
__device__ __forceinline__ float wave_sum(float v) {
#pragma unroll
    for (int o = 1; o < 64; o <<= 1) v += __shfl_xor(v, o);
    return v;
}
__device__ __forceinline__ float silu_f(float x) { return x / (1.0f + __expf(-x)); }
__device__ __forceinline__ void ld_row_f32(const float* p, int lane, f32x4 (&v)[4]) {
#pragma unroll
    for (int j = 0; j < 4; ++j) v[j] = *(const f32x4*)(p + 4 * lane + 256 * j);
}
__device__ __forceinline__ void ld_row_bf16(const u16* p, int lane, f32x4 (&v)[4]) {
#pragma unroll
    for (int j = 0; j < 4; ++j) { const uint2 w = *(const uint2*)(p + 4 * lane + 256 * j);
        v[j] = (f32x4){bf2f(w.x & 0xffffu), bf2f(w.x >> 16), bf2f(w.y & 0xffffu), bf2f(w.y >> 16)}; }
}
__device__ __forceinline__ void st_row_f32(float* p, int lane, const f32x4 (&v)[4]) {
#pragma unroll
    for (int j = 0; j < 4; ++j) *(f32x4*)(p + 4 * lane + 256 * j) = v[j];
}
__device__ __forceinline__ void st_row_bf16(u16* p, int lane, const f32x4 (&v)[4]) {
#pragma unroll
    for (int j = 0; j < 4; ++j) { uint2 w; w.x = f2bf(v[j].x) | (f2bf(v[j].y) << 16); w.y = f2bf(v[j].z) | (f2bf(v[j].w) << 16);
        *(uint2*)(p + 4 * lane + 256 * j) = w; }
}
__device__ __forceinline__ float row_rstd(const f32x4 (&v)[4]) {
    float s = 0.f;
#pragma unroll
    for (int j = 0; j < 4; ++j) s += (v[j].x * v[j].x + v[j].y * v[j].y) + (v[j].z * v[j].z + v[j].w * v[j].w);
    s = wave_sum(s);
    return 1.0f / sqrtf(s * (1.0f / 1024.0f) + EPS);
}
__device__ __forceinline__ void rms_apply(f32x4 (&v)[4], const float* g, int lane) {
    const float r = row_rstd(v);
#pragma unroll
    for (int j = 0; j < 4; ++j) { const f32x4 gg = *(const f32x4*)(g + 4 * lane + 256 * j); v[j] = v[j] * r * gg; }
}
__device__ __forceinline__ void premod(const f32x4 (&x)[4], f32x4 (&h)[4], const float* g, const float* shift, const float* scale, int lane) {
    const float r = row_rstd(x);
#pragma unroll
    for (int j = 0; j < 4; ++j) { const int c = 4 * lane + 256 * j; const f32x4 gg = *(const f32x4*)(g + c), sh = *(const f32x4*)(shift + c), sc = *(const f32x4*)(scale + c);
        h[j] = x[j] * r * gg * (1.0f + sc) + sh; }
}

struct Args { const float* in[35]; float* out; unsigned char* ws; int ph_lo, ph_hi, li, pad; };

__device__ __forceinline__ const float* modp(const unsigned char* ws, int l, int r, int which) { return (const float*)(ws + WS_MOD) + ((size_t)(l * 17 + r) * 6 + which) * 1024; }

template <bool DUAL, class Epi>
__device__ __forceinline__ void naive_gemm(LAS unsigned char* lds, const u16* A, int lda, int ntiles_m, const float* W0, const float* W1, int K, int N, int ldw,
                                           const unsigned* tile_e, size_t estride, const Epi& epi) {
    LAS float* As = (LAS float*)lds;
    LAS float* Ws0 = As + 16 * 132;
    LAS float* Ws1 = Ws0 + 16 * 64;
    const int tid = threadIdx.x, ty = tid >> 4, tx = tid & 15;
    const int ntn = (N + 63) / 64;
    const int total = ntiles_m * ntn;
    for (int u = blockIdx.x; u < total; u += gridDim.x) {
        const int tm = u / ntn, tn = u % ntn;
        const int row0 = tm * 128, col0 = tn * 64;
        const float* w0 = W0; const float* w1 = W1;
        if (tile_e) { const unsigned e = tile_e[tm >> 1]; w0 += (size_t)e * estride; if (DUAL) w1 += (size_t)e * estride; }
        float acc0[4][4], acc1[4][4];
#pragma unroll
        for (int i = 0; i < 4; ++i)
#pragma unroll
            for (int j = 0; j < 4; ++j) { acc0[i][j] = 0.f; acc1[i][j] = 0.f; }
        for (int k0 = 0; k0 < K; k0 += 16) {
            { const int r = tid >> 2, kq = (tid & 3) * 4; const uint2 w = *(const uint2*)(A + (size_t)(row0 + r) * lda + k0 + kq);
              As[(kq + 0) * 132 + r] = bf2f(w.x & 0xffffu); As[(kq + 1) * 132 + r] = bf2f(w.x >> 16);
              As[(kq + 2) * 132 + r] = bf2f(w.y & 0xffffu); As[(kq + 3) * 132 + r] = bf2f(w.y >> 16); }
            { const int kk = tid >> 5, n = (tid & 31) * 2, c = col0 + n;
              float a = 0.f, b = 0.f;
              if (c < N) { const float2 t = *(const float2*)(w0 + (size_t)(k0 + kk) * ldw + c); a = t.x; b = t.y; }
              Ws0[kk * 64 + n] = a; Ws0[kk * 64 + n + 1] = b;
              if (DUAL) { float a1 = 0.f, b1 = 0.f;
                  if (c < N) { const float2 t = *(const float2*)(w1 + (size_t)(k0 + kk) * ldw + c); a1 = t.x; b1 = t.y; }
                  Ws1[kk * 64 + n] = a1; Ws1[kk * 64 + n + 1] = b1; } }
            __syncthreads();
#pragma unroll
            for (int kk = 0; kk < 16; ++kk) {
                const f32x4 a = *(const LAS f32x4*)(As + kk * 132 + ty * 4);
                const f32x4 b = *(const LAS f32x4*)(Ws0 + kk * 64 + tx * 4);
#pragma unroll
                for (int i = 0; i < 4; ++i)
#pragma unroll
                    for (int j = 0; j < 4; ++j) acc0[i][j] += a[i] * b[j];
                if (DUAL) { const f32x4 b1 = *(const LAS f32x4*)(Ws1 + kk * 64 + tx * 4);
#pragma unroll
                    for (int i = 0; i < 4; ++i)
#pragma unroll
                        for (int j = 0; j < 4; ++j) acc1[i][j] += a[i] * b1[j]; }
            }
            __syncthreads();
        }
#pragma unroll
        for (int i = 0; i < 4; ++i)
#pragma unroll
            for (int j = 0; j < 4; ++j) { const int r = row0 + ty * 4 + i, c = col0 + tx * 4 + j; if (c < N) epi(r, c, acc0[i][j], acc1[i][j]); }
    }
}

template <int DQ, class QL, class KL, class VL, class OS>
__device__ __forceinline__ void naive_attn_unit(LAS unsigned char* lds, int nkeys, float scale, const QL& ql, const KL& kl, const VL& vl, const OS& os) {
    LAS float* Qs = (LAS float*)lds;
    LAS float* Ks = Qs + 32 * (DQ + 1);
    LAS float* Vs = Ks + 64 * (DQ + 1);
    LAS float* Ps = Vs + 64 * 128;
    const int tid = threadIdx.x, r = tid >> 4, j = tid & 15;
    __syncthreads();
    for (int e = tid; e < 32 * DQ; e += 512) { const int rr = e / DQ, d = e % DQ; Qs[rr * (DQ + 1) + d] = ql(rr, d); }
    float m = -1e30f, l = 0.f, o[8];
#pragma unroll
    for (int dd = 0; dd < 8; ++dd) o[dd] = 0.f;
    for (int k0 = 0; k0 < nkeys; k0 += 64) {
        __syncthreads();
        for (int e = tid; e < 64 * DQ; e += 512) { const int key = e / DQ, d = e % DQ; Ks[key * (DQ + 1) + d] = kl(k0 + key, d); }
        for (int e = tid; e < 64 * 128; e += 512) { const int key = e >> 7, d = e & 127; Vs[key * 128 + d] = vl(k0 + key, d); }
        __syncthreads();
        float s[4];
#pragma unroll
        for (int c = 0; c < 4; ++c) { const LAS float* kp = Ks + (j + 16 * c) * (DQ + 1); const LAS float* qp = Qs + r * (DQ + 1); float a = 0.f;
            for (int d = 0; d < DQ; ++d) a += qp[d] * kp[d];
            s[c] = a * scale; }
        float tmax = fmaxf(fmaxf(s[0], s[1]), fmaxf(s[2], s[3]));
#pragma unroll
        for (int off = 1; off < 16; off <<= 1) tmax = fmaxf(tmax, __shfl_xor(tmax, off));
        const float mn = fmaxf(m, tmax), alpha = __expf(m - mn);
        float ps = 0.f;
#pragma unroll
        for (int c = 0; c < 4; ++c) { const float p = __expf(s[c] - mn); Ps[r * 64 + j + 16 * c] = p; ps += p; }
#pragma unroll
        for (int off = 1; off < 16; off <<= 1) ps += __shfl_xor(ps, off);
        l = l * alpha + ps; m = mn;
#pragma unroll
        for (int dd = 0; dd < 8; ++dd) o[dd] *= alpha;
        __syncthreads();
        for (int key = 0; key < 64; ++key) { const float p = Ps[r * 64 + key]; const LAS float* vp = Vs + key * 128 + j * 8;
#pragma unroll
            for (int dd = 0; dd < 8; ++dd) o[dd] += p * vp[dd]; }
    }
    const float il = 1.0f / l;
#pragma unroll
    for (int dd = 0; dd < 8; ++dd) os(r, j * 8 + dd, o[dd] * il);
}


#ifndef FAST_GEMM
#define FAST_GEMM 1
#endif
#ifndef PG8_SP2
#define PG8_SP2 true
#endif
#ifndef PG8_ALIGN
#define PG8_ALIGN true
#endif
namespace pg8 {
typedef short bf16x8 __attribute__((ext_vector_type(8)));
typedef unsigned u32x4 __attribute__((ext_vector_type(4)));
typedef int v8i __attribute__((ext_vector_type(8)));
typedef int v4i __attribute__((ext_vector_type(4)));
typedef unsigned u32x2 __attribute__((ext_vector_type(2)));
constexpr int BM = 256, BK = 64, HALF = 128, HTB = HALF * BK * 2, STAGE_BYTES = 8 * HTB, NXCD = 8, WGM = 8;
__host__ __device__ __forceinline__ int lds_byte(int r, int c) { const int st = (r >> 4) * 2 + (c >> 5), rr = r & 15, cc = c & 31, ob = rr * 64 + cc * 2; return st * 1024 + (ob ^ (((ob >> 9) & 1) << 5)); }
__host__ __device__ __forceinline__ void stage_rc(int b, int& R, int& C) { const int st = b / 1024, sb = b % 1024, swz = sb ^ (((sb >> 9) & 1) << 5); R = (st >> 1) * 16 + swz / 64; C = (st & 1) * 32 + (swz % 64) / 2; }
__host__ __device__ __forceinline__ int perm32(int rho) { const int n = rho >> 4, i = rho & 15; return 8 * (i >> 2) + 4 * n + (i & 3); }

struct Unit { int pm, pn, po, pc; };
struct Gemm { const void* A; const void* Bt; int lda; int K; int sa, sb; };

struct DenseOrder {
    int nM, nN, nwg, G, c;
    __device__ __forceinline__ void init(int nM_, int nN_, int G_, int c_) { nM = nM_; nN = nN_; nwg = nM * nN; G = G_; c = c_; }
    __device__ __forceinline__ bool next2(int i, int& pm, int& pn) const {
        const long L = (long)i * G + c; if (L >= nwg) return false;
        int wgid = (int)L; { const int q = nwg / NXCD, r = nwg % NXCD, xcd = wgid % NXCD, off = wgid / NXCD; wgid = (xcd < r ? xcd * (q + 1) : r * (q + 1) + (xcd - r) * q) + off; }
        const int nig = WGM * nN, gid = wgid / nig, fm = gid * WGM, gsz = (nM - fm) < WGM ? (nM - fm) : WGM;
        pm = fm + ((wgid % nig) % gsz); pn = (wgid % nig) / gsz; return true;
    }
    __device__ __forceinline__ bool next(int i, Unit& u) const { int pm, pn; if (!next2(i, pm, pn)) return false; u.pm = pm; u.pn = pn; u.po = pm; u.pc = pn; return true; }
    __device__ __forceinline__ void a_ready(const Unit&) const {}
    __device__ __forceinline__ void done(const Unit&) const {}
};
struct MoeOrder : DenseOrder {
    const unsigned* tile_e; int nper, a_off, o_off;
    __device__ __forceinline__ bool next(int i, Unit& u) const { int pm, pn; if (!next2(i, pm, pn)) return false;
        const int e = (int)tile_e[pm]; u.pm = a_off + pm; u.pn = e * nper + pn; u.po = o_off + pm; u.pc = pn; return true; }
};

__device__ __forceinline__ unsigned cvt_pk_bf16(float lo, float hi) { unsigned r; asm volatile("v_cvt_pk_bf16_f32 %0, %1, %2" : "=v"(r) : "v"(lo), "v"(hi)); return r; }

struct EpiStore {
    static constexpr bool PERM = true, AFTER_DRAIN = false;
    u16* O; int ldc;
    __device__ __forceinline__ void operator()(const f32x4 (&acc)[2][2][4][2], const Unit& u, int wr, int wc, int fr, int fq) const {
        const int row0 = u.po * BM + wr * 64 + fr, col0 = u.pc * BM + wc * 32 + 8 * fq;
#pragma unroll
        for (int ai = 0; ai < 2; ++ai)
#pragma unroll
            for (int m = 0; m < 4; ++m) { u16* rowp = O + (size_t)(row0 + ai * HALF + m * 16) * ldc + col0;
#pragma unroll
                for (int bj = 0; bj < 2; ++bj) { const f32x4 v0 = acc[ai][bj][m][0], v1 = acc[ai][bj][m][1];
                    u32x4 w; w.x = cvt_pk_bf16(v0[0], v0[1]); w.y = cvt_pk_bf16(v0[2], v0[3]); w.z = cvt_pk_bf16(v1[0], v1[1]); w.w = cvt_pk_bf16(v1[2], v1[3]);
                    *(u32x4*)(rowp + bj * HALF) = w; } }
    }
};
struct EpiSwiglu {
    static constexpr bool PERM = true, AFTER_DRAIN = false;
    u16* O; int ldc;
    __device__ __forceinline__ void operator()(const f32x4 (&acc)[2][2][4][2], const Unit& u, int wr, int wc, int fr, int fq) const {
        const int row0 = u.po * BM + wr * 64 + fr, col0 = u.pc * HALF + wc * 32 + 8 * fq;
#pragma unroll
        for (int ai = 0; ai < 2; ++ai)
#pragma unroll
            for (int m = 0; m < 4; ++m) { u16* rowp = O + (size_t)(row0 + ai * HALF + m * 16) * ldc + col0;
                float hv[8];
#pragma unroll
                for (int n = 0; n < 2; ++n)
#pragma unroll
                    for (int q = 0; q < 4; ++q) { const float g = acc[ai][0][m][n][q], up = acc[ai][1][m][n][q]; hv[n * 4 + q] = g * __builtin_amdgcn_rcpf(1.0f + __expf(-g)) * up; }
                u32x4 w; w.x = cvt_pk_bf16(hv[0], hv[1]); w.y = cvt_pk_bf16(hv[2], hv[3]); w.z = cvt_pk_bf16(hv[4], hv[5]); w.w = cvt_pk_bf16(hv[6], hv[7]);
                *(u32x4*)rowp = w; }
    }
};

__device__ __forceinline__ float clamp8(float x) { return fminf(fmaxf(x, -448.0f), 448.0f); }
__device__ __forceinline__ unsigned cvt_pk4_fp8(float a, float b, float c, float d) { unsigned r;
    asm volatile("v_cvt_pk_fp8_f32 %0, %1, %2\n\tv_cvt_pk_fp8_f32 %0, %3, %4 op_sel:[0,0,1]" : "=&v"(r) : "v"(a), "v"(b), "v"(c), "v"(d)); return r; }
struct EpiSwiglu8 {
    static constexpr bool PERM = true, AFTER_DRAIN = false;
    unsigned char* O; int ldc; float gs, oscale;
    __device__ __forceinline__ void operator()(const f32x4 (&acc)[2][2][4][2], const Unit& u, int wr, int wc, int fr, int fq) const {
        const int row0 = u.po * BM + wr * 64 + fr, col0 = u.pc * HALF + wc * 32 + 8 * fq;
#pragma unroll
        for (int ai = 0; ai < 2; ++ai)
#pragma unroll
            for (int m = 0; m < 4; ++m) { unsigned char* rowp = O + (size_t)(row0 + ai * HALF + m * 16) * ldc + col0;
                float hv[8];
#pragma unroll
                for (int n = 0; n < 2; ++n)
#pragma unroll
                    for (int q = 0; q < 4; ++q) { const float gt = acc[ai][0][m][n][q] * gs, up = acc[ai][1][m][n][q] * gs; hv[n * 4 + q] = clamp8(gt * __builtin_amdgcn_rcpf(1.0f + __expf(-gt)) * up * oscale); }
                u32x2 w; w.x = cvt_pk4_fp8(hv[0], hv[1], hv[2], hv[3]); w.y = cvt_pk4_fp8(hv[4], hv[5], hv[6], hv[7]); *(u32x2*)rowp = w; }
    }
};
template <class Epi, class Sched, bool ALIGN_EPI = false, bool SP2 = false, int EB = 2>
__device__ __forceinline__ void gemm_phase(LAS unsigned char* lds, const Gemm g, const Sched& S, const Epi& E) {
    const int tid = threadIdx.x, wid = __builtin_amdgcn_readfirstlane(tid >> 6), lane = tid & 63, wr = wid >> 2, wc = wid & 3, fr = lane & 15, fq = lane >> 4;
    const int K = g.K, nt = K * EB / (BK * 2), lda = g.lda;
    const auto rsA = __builtin_amdgcn_make_buffer_rsrc((void*)g.A, 0, 0x7fffffff, 0x00020000);
    const auto rsB = __builtin_amdgcn_make_buffer_rsrc((void*)g.Bt, 0, 0x7fffffff, 0x00020000);
    unsigned voffA, voffB;
    { int R, C; stage_rc(tid * 16, R, C); const int Rb = Epi::PERM ? ((R & ~31) + perm32(R & 31)) : R;
      voffA = (unsigned)(R * lda * EB + C * 2); voffB = (unsigned)(Rb * K * EB + C * 2); }
    const unsigned kstep = (unsigned)(BK * 2);
    const unsigned hA = (unsigned)(HALF * lda * EB), hB = (unsigned)(HALF * K * EB);
    const unsigned qA = hA >> 1, qB = hB >> 1;
    const unsigned tA = 2 * hA, tB = 2 * hB;
    const unsigned ldsw = (unsigned)wid * 1024u;
    const int aoff = lds_byte(wr * 64 + fr, fq * (EB == 2 ? 8 : 16)), boff = lds_byte(wc * 32 + fr, fq * (EB == 2 ? 8 : 16));
#define PG8_SA(b, h) (((b) * 2 + (h)) * HTB)
#define PG8_SB(b, h) ((4 + (b) * 2 + (h)) * HTB)
#define PG8_STAGE_A(bufoff, soff) do { __builtin_amdgcn_raw_ptr_buffer_load_lds(rsA, (LAS unsigned*)(lds + (bufoff) + ldsw), 16, voffA, (soff), 0, 0); \
        __builtin_amdgcn_raw_ptr_buffer_load_lds(rsA, (LAS unsigned*)(lds + (bufoff) + ldsw + 8192), 16, voffA, (soff) + qA, 0, 0); } while (0)
#define PG8_STAGE_B(bufoff, soff) do { __builtin_amdgcn_raw_ptr_buffer_load_lds(rsB, (LAS unsigned*)(lds + (bufoff) + ldsw), 16, voffB, (soff), 0, 0); \
        __builtin_amdgcn_raw_ptr_buffer_load_lds(rsB, (LAS unsigned*)(lds + (bufoff) + ldsw + 8192), 16, voffB, (soff) + qB, 0, 0); } while (0)
#define PG8_LDA(dst, b, h) do { if constexpr (EB == 2) { _Pragma("unroll") for (int m = 0; m < 4; ++m) _Pragma("unroll") for (int k = 0; k < 2; ++k) dst[m][k] = *(const LAS bf16x8*)(lds + PG8_SA(b, h) + aoff + m * 2048 + k * 1024); } \
        else { _Pragma("unroll") for (int m = 0; m < 4; ++m) dst##8[m] = __builtin_shufflevector(*(const LAS v4i*)(lds + PG8_SA(b, h) + aoff + m * 2048), *(const LAS v4i*)(lds + PG8_SA(b, h) + aoff + m * 2048 + 16), 0, 1, 2, 3, 4, 5, 6, 7); } } while (0)
#define PG8_LDB(dst, b, h) do { if constexpr (EB == 2) { _Pragma("unroll") for (int n = 0; n < 2; ++n) _Pragma("unroll") for (int k = 0; k < 2; ++k) dst[n][k] = *(const LAS bf16x8*)(lds + PG8_SB(b, h) + boff + n * 2048 + k * 1024); } \
        else { _Pragma("unroll") for (int n = 0; n < 2; ++n) dst##8[n] = __builtin_shufflevector(*(const LAS v4i*)(lds + PG8_SB(b, h) + boff + n * 2048), *(const LAS v4i*)(lds + PG8_SB(b, h) + boff + n * 2048 + 16), 0, 1, 2, 3, 4, 5, 6, 7); } } while (0)
#define PG8_MMA(ai, bj, At, Bt) do { __builtin_amdgcn_s_setprio(1); _Pragma("unroll") for (int m = 0; m < 4; ++m) _Pragma("unroll") for (int n = 0; n < 2; ++n) { \
        if constexpr (EB == 2) { _Pragma("unroll") for (int k = 0; k < 2; ++k) acc[ai][bj][m][n] = __builtin_amdgcn_mfma_f32_16x16x32_bf16(Bt[n][k], At[m][k], acc[ai][bj][m][n], 0, 0, 0); } \
        else { asm volatile("v_mfma_scale_f32_16x16x128_f8f6f4 %0, %1, %2, %0, %3, %4 op_sel_hi:[0,0,0]" : "+v"(acc[ai][bj][m][n]) : "v"(Bt##8[n]), "v"(At##8[m]), "v"(vsb), "v"(vsa)); } } \
        __builtin_amdgcn_s_setprio(0); } while (0)
#define PG8_WAIT_V(n) asm volatile("s_waitcnt vmcnt(" #n ")" ::: "memory")
#define PG8_WAIT_L(n) asm volatile("s_waitcnt lgkmcnt(" #n ")" ::: "memory")
#define PG8_BAR __builtin_amdgcn_s_barrier()
#define PG8_SCHED __builtin_amdgcn_sched_barrier(0)
    Unit cur, nxt; int ui = 0;
    if (!S.next(0, cur)) return;
    int vsa = g.sa, vsb = g.sb; asm volatile("" : "+v"(vsa), "+v"(vsb));
    f32x4 acc[2][2][4][2];
#pragma unroll
    for (int a = 0; a < 2; ++a)
#pragma unroll
        for (int b = 0; b < 2; ++b)
#pragma unroll
            for (int m = 0; m < 4; ++m)
#pragma unroll
                for (int n = 0; n < 2; ++n) acc[a][b][m][n] = (f32x4){0.f, 0.f, 0.f, 0.f};
    bf16x8 At[4][2], B0[2][2], B1[2][2]; v8i At8[4], B08[2], B18[2];
    unsigned cA = (unsigned)cur.pm * tA, cB = (unsigned)cur.pn * tB;
    S.a_ready(cur);
    if constexpr (SP2) {
        PG8_STAGE_B(PG8_SB(0, 0), cB); PG8_STAGE_B(PG8_SB(0, 1), cB + hB); PG8_STAGE_A(PG8_SA(0, 0), cA); PG8_STAGE_A(PG8_SA(0, 1), cA + hA);
        if (wr == 1) PG8_BAR;
        PG8_WAIT_V(2); PG8_BAR;
        PG8_STAGE_B(PG8_SB(1, 0), cB + kstep); PG8_STAGE_A(PG8_SA(1, 0), cA + kstep); PG8_STAGE_B(PG8_SB(1, 1), cB + hB + kstep);
        PG8_WAIT_V(6); PG8_BAR;
    } else {
        PG8_STAGE_B(PG8_SB(0, 0), cB); PG8_STAGE_A(PG8_SA(0, 0), cA); PG8_STAGE_B(PG8_SB(0, 1), cB + hB); PG8_STAGE_A(PG8_SA(0, 1), cA + hA);
        if (wr == 1) PG8_BAR;
        PG8_WAIT_V(4); PG8_BAR;
        PG8_STAGE_B(PG8_SB(1, 0), cB + kstep); PG8_STAGE_A(PG8_SA(1, 0), cA + kstep); PG8_STAGE_B(PG8_SB(1, 1), cB + hB + kstep);
        PG8_WAIT_V(6); PG8_BAR;
    }
    for (;;) {
        const bool has_next = S.next(ui + 1, nxt);
        const unsigned nA = has_next ? (unsigned)nxt.pm * tA : cA, nB = has_next ? (unsigned)nxt.pn * tB : cB;
#pragma unroll 1
        for (int t = 0; t < nt; t += 2) {
            const bool last = (t == nt - 2);
            const unsigned a1 = cA + (unsigned)(t + 1) * kstep;
            const unsigned a2 = last ? nA : cA + (unsigned)(t + 2) * kstep, b2 = last ? nB : cB + (unsigned)(t + 2) * kstep;
            const unsigned a3 = a2 + kstep, b3 = b2 + kstep;
            if (last && has_next) S.a_ready(nxt);
            if constexpr (SP2) {
            PG8_LDB(B0, 0, 0); PG8_LDB(B1, 0, 1); PG8_SCHED; PG8_LDA(At, 0, 0); PG8_STAGE_A(PG8_SA(1, 1), a1 + hA);
            PG8_WAIT_V(8); PG8_WAIT_L(0); PG8_BAR; PG8_MMA(0, 0, At, B0); PG8_MMA(0, 1, At, B1); PG8_BAR; PG8_SCHED;
            PG8_LDA(At, 0, 1); PG8_STAGE_B(PG8_SB(0, 0), b2); PG8_STAGE_B(PG8_SB(0, 1), b2 + hB); PG8_STAGE_A(PG8_SA(0, 0), a2);
            PG8_WAIT_V(8); PG8_WAIT_L(0); PG8_BAR; PG8_MMA(1, 0, At, B0); PG8_MMA(1, 1, At, B1); PG8_BAR; PG8_SCHED;
            PG8_LDB(B0, 1, 0); PG8_LDB(B1, 1, 1); PG8_SCHED; PG8_LDA(At, 1, 0); PG8_STAGE_A(PG8_SA(0, 1), a2 + hA);
            PG8_WAIT_V(8); PG8_WAIT_L(0); PG8_BAR; PG8_MMA(0, 0, At, B0); PG8_MMA(0, 1, At, B1); PG8_BAR; PG8_SCHED;
            PG8_LDA(At, 1, 1); PG8_STAGE_B(PG8_SB(1, 0), b3); PG8_STAGE_B(PG8_SB(1, 1), b3 + hB); PG8_STAGE_A(PG8_SA(1, 0), a3);
            PG8_WAIT_V(8); PG8_WAIT_L(0); PG8_BAR; PG8_MMA(1, 0, At, B0); PG8_MMA(1, 1, At, B1); PG8_BAR; PG8_SCHED;
            } else {
            PG8_LDB(B0, 0, 0); PG8_SCHED; PG8_LDA(At, 0, 0); PG8_STAGE_A(PG8_SA(1, 1), a1 + hA);
            PG8_WAIT_L(8); PG8_BAR; PG8_WAIT_L(0); PG8_MMA(0, 0, At, B0); PG8_BAR; PG8_SCHED;
            PG8_LDB(B1, 0, 1); PG8_STAGE_B(PG8_SB(0, 0), b2);
            PG8_BAR; PG8_WAIT_L(0); PG8_MMA(0, 1, At, B1); PG8_BAR;
            PG8_LDA(At, 0, 1); PG8_STAGE_A(PG8_SA(0, 0), a2);
            PG8_BAR; PG8_WAIT_L(0); PG8_MMA(1, 0, At, B0); PG8_BAR; PG8_SCHED;
            PG8_STAGE_B(PG8_SB(0, 1), b2 + hB);
            PG8_WAIT_V(6); PG8_BAR; PG8_MMA(1, 1, At, B1); PG8_BAR;
            PG8_LDB(B0, 1, 0); PG8_SCHED; PG8_LDA(At, 1, 0); PG8_STAGE_A(PG8_SA(0, 1), a2 + hA);
            PG8_WAIT_L(8); PG8_BAR; PG8_WAIT_L(0); PG8_MMA(0, 0, At, B0); PG8_BAR; PG8_SCHED;
            PG8_LDB(B1, 1, 1); PG8_STAGE_B(PG8_SB(1, 0), b3);
            PG8_BAR; PG8_WAIT_L(0); PG8_MMA(0, 1, At, B1); PG8_BAR;
            PG8_LDA(At, 1, 1); PG8_STAGE_A(PG8_SA(1, 0), a3);
            PG8_BAR; PG8_WAIT_L(0); PG8_MMA(1, 0, At, B0); PG8_BAR; PG8_SCHED;
            PG8_STAGE_B(PG8_SB(1, 1), b3 + hB);
            PG8_WAIT_V(6); PG8_BAR; PG8_MMA(1, 1, At, B1); PG8_BAR;
            }
        }
        if constexpr (ALIGN_EPI) { if (wr == 0) PG8_BAR; }
        if constexpr (EB == 1) asm volatile("s_nop 15\n\ts_nop 15" ::: "memory");
        E(acc, cur, wr, wc, fr, fq); S.done(cur);
        if (!has_next) break;
#pragma unroll
        for (int a = 0; a < 2; ++a)
#pragma unroll
            for (int b = 0; b < 2; ++b)
#pragma unroll
                for (int m = 0; m < 4; ++m)
#pragma unroll
                    for (int n = 0; n < 2; ++n) acc[a][b][m][n] = (f32x4){0.f, 0.f, 0.f, 0.f};
        cur = nxt; cA = nA; cB = nB; ++ui;
        if constexpr (EB == 1) asm volatile("s_nop 7" ::: "memory");
        if constexpr (ALIGN_EPI) { if (wr == 1) PG8_BAR; }
    }
    PG8_WAIT_V(0);
    if constexpr (!ALIGN_EPI) { if (wr == 0) PG8_BAR; }
    PG8_BAR;
#undef PG8_SA
#undef PG8_SB
#undef PG8_STAGE_A
#undef PG8_STAGE_B
#undef PG8_LDA
#undef PG8_LDB
#undef PG8_MMA
#undef PG8_WAIT_V
#undef PG8_WAIT_L
#undef PG8_BAR
#undef PG8_SCHED
}
}

__device__ __forceinline__ void cvt_item(const float* W, int ldw, u16* WT, int ldt, int k0, int n0, int drow0, int dcol0, LAS float* scr, int lane) {
#pragma unroll 8
    for (int i = 0; i < 32; ++i) { const int kk = 2 * i + (lane >> 5); scr[kk * 33 + (lane & 31)] = W[(size_t)(k0 + kk) * ldw + n0 + (lane & 31)]; }
    asm volatile("s_waitcnt lgkmcnt(0)" ::: "memory");
    const int c = lane & 7;
#pragma unroll
    for (int j = 0; j < 4; ++j) { const int n = (lane >> 3) + 8 * j; const LAS float* s = scr + (8 * c) * 33 + n;
        uint4 o; o.x = f2bf(s[0 * 33]) | (f2bf(s[1 * 33]) << 16); o.y = f2bf(s[2 * 33]) | (f2bf(s[3 * 33]) << 16); o.z = f2bf(s[4 * 33]) | (f2bf(s[5 * 33]) << 16); o.w = f2bf(s[6 * 33]) | (f2bf(s[7 * 33]) << 16);
        *(uint4*)(WT + (size_t)(drow0 + n) * ldt + dcol0 + k0 + 8 * c) = o; }
    asm volatile("s_waitcnt lgkmcnt(0)" ::: "memory");
}
__device__ __forceinline__ void cvt_item8(const float* W, int ldw, unsigned char* WT, int ldt, int k0, int n0, int drow0, float scale, LAS float* scr, int lane) {
#pragma unroll 8
    for (int i = 0; i < 32; ++i) { const int kk = 2 * i + (lane >> 5); scr[kk * 33 + (lane & 31)] = W[(size_t)(k0 + kk) * ldw + n0 + (lane & 31)]; }
    asm volatile("s_waitcnt lgkmcnt(0)" ::: "memory");
    const int c = lane & 3;
#pragma unroll
    for (int j = 0; j < 2; ++j) { const int n = (lane >> 2) + 16 * j; const LAS float* s = scr + (16 * c) * 33 + n;
        unsigned w[4];
#pragma unroll
        for (int q = 0; q < 4; ++q) { unsigned t = 0u; t = __builtin_amdgcn_cvt_pk_fp8_f32(s[(4 * q + 0) * 33] * scale, s[(4 * q + 1) * 33] * scale, t, false);
            t = __builtin_amdgcn_cvt_pk_fp8_f32(s[(4 * q + 2) * 33] * scale, s[(4 * q + 3) * 33] * scale, t, true); w[q] = t; }
        *(uint4*)(WT + (size_t)(drow0 + n) * ldt + k0 + 16 * c) = make_uint4(w[0], w[1], w[2], w[3]); }
    asm volatile("s_waitcnt lgkmcnt(0)" ::: "memory");
}
template <class RowMap>
__device__ __forceinline__ void cvt_matrix8(const float* W, int K, int N, unsigned char* WT, int ldt, float scale, const RowMap& rowmap, LAS float* scr, int lane, int gw, int NGW, int& off) {
    const int nblk = N / 32, nitems = (K / 64) * nblk;
    int it = (gw - off) % NGW; if (it < 0) it += NGW;
    for (; it < nitems; it += NGW) { const int kb = it / nblk, nb = it % nblk; cvt_item8(W, N, WT, ldt, kb * 64, nb * 32, rowmap(nb * 32), scale, scr, lane); }
    off = (off + nitems) % NGW;
}
template <class RowMap>
__device__ __forceinline__ void cvt_matrix(const float* W, int K, int N, u16* WT, int ldt, int dcol0, const RowMap& rowmap, LAS float* scr, int lane, int gw, int NGW, int& off) {
    const int nblk = N / 32, nitems = (K / 64) * nblk;
    int it = (gw - off) % NGW; if (it < 0) it += NGW;
    for (; it < nitems; it += NGW) { const int kb = it / nblk, nb = it % nblk; cvt_item(W, N, WT, ldt, kb * 64, nb * 32, rowmap(nb * 32), dcol0, scr, lane); }
    off = (off + nitems) % NGW;
}


#ifndef FAST_ATTN
#define FAST_ATTN 1
#endif
namespace fa {
using bf16x8 = __attribute__((ext_vector_type(8))) short;
using s16x4  = __attribute__((ext_vector_type(4))) short;
using f32x16 = __attribute__((ext_vector_type(16))) float;
using u32x4  = __attribute__((ext_vector_type(4))) unsigned;
constexpr int NW = 8, QBLK = 32, KVBLK = 64, DV = 128;
constexpr float THR = 8.f;
constexpr size_t SHM_V = KVBLK * DV * 2;
#define FA_SBAR() __builtin_amdgcn_sched_barrier(0)
__device__ __forceinline__ int crow(int r, int hi) { return (r & 3) + 8 * (r >> 2) + 4 * hi; }
__device__ __forceinline__ unsigned cvtpk(float lo, float hi) { unsigned r; asm volatile("v_cvt_pk_bf16_f32 %0, %1, %2" : "=v"(r) : "v"(lo), "v"(hi)); return r; }
template <int DQ> struct Cfg {
    static constexpr int NK = DQ / 16, NCH = DQ / 8, KPT = NCH / 8;
    static constexpr size_t SHM_K = (size_t)KVBLK * DQ * 2;
    static constexpr float SCALE = DQ == 192 ? 0.07216878364870322f : (DQ == 64 ? 0.125f : 0.08838834764831845f);
    __device__ static __forceinline__ int kswz(int row, int colB) { return row * (DQ * 2) + (colB ^ ((row & 7) << 4)); }
};
template <int DQ> __device__ __forceinline__ void partialSM(f32x16& p0, f32x16& p1, float& m_reg, float& mn, float& alpha) {
    constexpr float SCALE = Cfg<DQ>::SCALE, C = SCALE * 1.4426950408889634f;
    float pmax = p0[0];
#pragma unroll
    for (int r = 1; r < 16; ++r) pmax = fmaxf(pmax, p0[r]);
#pragma unroll
    for (int r = 0; r < 16; ++r) pmax = fmaxf(pmax, p1[r]);
    { auto rr = __builtin_amdgcn_permlane32_swap(__float_as_uint(pmax), __float_as_uint(pmax), false, false);
      pmax = fmaxf(__uint_as_float(rr[0]), __uint_as_float(rr[1])); }
    if (__builtin_expect(__all(pmax - m_reg <= THR / SCALE), 1)) { mn = m_reg; alpha = 1.f; }
    else { mn = fmaxf(m_reg, pmax); alpha = __builtin_amdgcn_exp2f((m_reg - mn) * C); m_reg = mn; }
    const float mnC = -mn * C;
#pragma unroll
    for (int r = 0; r < 16; ++r) p0[r] = fmaf(p0[r], C, mnC);
#pragma unroll
    for (int r = 0; r < 16; ++r) p1[r] = fmaf(p1[r], C, mnC);
#pragma unroll
    for (int r = 0; r < 16; ++r) p0[r] = __builtin_amdgcn_exp2f(p0[r]);
}
__device__ __forceinline__ void finishSM(f32x16& p0, f32x16& p1, float alpha, float& l_reg, bf16x8& pa0, bf16x8& pa1, bf16x8& pa2, bf16x8& pa3) {
#pragma unroll
    for (int r = 0; r < 16; ++r) p1[r] = __builtin_amdgcn_exp2f(p1[r]);
    float ps = 0;
#pragma unroll
    for (int r = 0; r < 16; ++r) ps += p0[r];
#pragma unroll
    for (int r = 0; r < 16; ++r) ps += p1[r];
    { auto rr = __builtin_amdgcn_permlane32_swap(__float_as_uint(ps), __float_as_uint(ps), false, false);
      ps = __uint_as_float(rr[0]) + __uint_as_float(rr[1]); }
    l_reg = l_reg * alpha + ps;
#define FA_PK4(P, BASE, OUT) do { unsigned a0 = cvtpk(P[BASE + 0], P[BASE + 1]), a1 = cvtpk(P[BASE + 2], P[BASE + 3]);   \
    unsigned b0 = cvtpk(P[BASE + 4], P[BASE + 5]), b1 = cvtpk(P[BASE + 6], P[BASE + 7]);                              \
    auto r0 = __builtin_amdgcn_permlane32_swap(a0, b0, false, false); auto r1 = __builtin_amdgcn_permlane32_swap(a1, b1, false, false); \
    u32x4 w = {r0[0], r1[0], r0[1], r1[1]}; OUT = *reinterpret_cast<bf16x8*>(&w); } while (0)
    FA_PK4(p0, 0, pa0); FA_PK4(p0, 8, pa1); FA_PK4(p1, 0, pa2); FA_PK4(p1, 8, pa3);
#undef FA_PK4
}
template <int DQ> __device__ __forceinline__ void qkt(f32x16& p0, f32x16& p1, const char* Ks, const bf16x8* qr, int r32, int hi) {
    p0 = f32x16{}; p1 = f32x16{};
#pragma unroll
    for (int d0 = 0; d0 < Cfg<DQ>::NK; ++d0) { const int cb = (d0 * 16 + hi * 8) * 2;
        const bf16x8 b0 = *reinterpret_cast<const bf16x8*>(Ks + Cfg<DQ>::kswz(r32, cb));
        const bf16x8 b1 = *reinterpret_cast<const bf16x8*>(Ks + Cfg<DQ>::kswz(32 + r32, cb));
        p0 = __builtin_amdgcn_mfma_f32_32x32x16_bf16(b0, qr[d0], p0, 0, 0, 0);
        p1 = __builtin_amdgcn_mfma_f32_32x32x16_bf16(b1, qr[d0], p1, 0, 0, 0); }
}
__device__ __forceinline__ int v_st(int k, int c) { const int kk = (k & ~0xC) | ((k & 4) << 1) | ((k & 8) >> 1); return ((kk >> 3) * 4 + (c >> 5)) * 512 + ((kk & 7) * 32 + (c & 31)) * 2; }
__device__ __forceinline__ int v_rd_base(int lane) { return ((lane & 3) << 3) | (((lane >> 2) & 3) << 6) | (((lane >> 4) & 1) << 5) | (((lane >> 5) & 1) << 8); }
constexpr int v_rd_off(int d0, int ks, int half) { return d0 * 512 + ks * 4096 + half * 2048; }
template <int OFF> __device__ __forceinline__ s16x4 tr_read(int vb) {
    s16x4 r; asm volatile("ds_read_b64_tr_b16 %0, %1 offset:%2" : "=&v"(r) : "v"(vb), "i"(OFF) : "memory"); return r;
}
template <int D0> __device__ __forceinline__ void pv_one(f32x16& od, int vb, bf16x8 pa0, bf16x8 pa1, bf16x8 pa2, bf16x8 pa3) {
    const s16x4 l0 = tr_read<v_rd_off(D0, 0, 0)>(vb), h0 = tr_read<v_rd_off(D0, 0, 1)>(vb), l1 = tr_read<v_rd_off(D0, 1, 0)>(vb), h1 = tr_read<v_rd_off(D0, 1, 1)>(vb);
    const s16x4 l2 = tr_read<v_rd_off(D0, 2, 0)>(vb), h2 = tr_read<v_rd_off(D0, 2, 1)>(vb), l3 = tr_read<v_rd_off(D0, 3, 0)>(vb), h3 = tr_read<v_rd_off(D0, 3, 1)>(vb);
    asm volatile("s_waitcnt lgkmcnt(0)" ::: "memory"); FA_SBAR();
#define FA_PK(L, H) (bf16x8){L[0], L[1], L[2], L[3], H[0], H[1], H[2], H[3]}
    od = __builtin_amdgcn_mfma_f32_32x32x16_bf16(pa0, FA_PK(l0, h0), od, 0, 0, 0);
    od = __builtin_amdgcn_mfma_f32_32x32x16_bf16(pa1, FA_PK(l1, h1), od, 0, 0, 0);
    od = __builtin_amdgcn_mfma_f32_32x32x16_bf16(pa2, FA_PK(l2, h2), od, 0, 0, 0);
    od = __builtin_amdgcn_mfma_f32_32x32x16_bf16(pa3, FA_PK(l3, h3), od, 0, 0, 0);
#undef FA_PK
}
__device__ __forceinline__ void pv_d0(f32x16* o, int vb, bf16x8 pa0, bf16x8 pa1, bf16x8 pa2, bf16x8 pa3) {
    pv_one<0>(o[0], vb, pa0, pa1, pa2, pa3); pv_one<1>(o[1], vb, pa0, pa1, pa2, pa3); pv_one<2>(o[2], vb, pa0, pa1, pa2, pa3); pv_one<3>(o[3], vb, pa0, pa1, pa2, pa3);
}
struct KVSrc { const u16* k0; int kst0; const u16* k1; int kst1; int split8; const u16* v; int vst; int xrow0, lrow0; };
constexpr size_t shm_bytes(int DQ) { return 2 * SHM_V + 2 * (size_t)KVBLK * DQ * 2 + NW * 64 * 4; }

template <int DQ>
__device__ __forceinline__ void attn_unit(const u16* __restrict__ Qb, int LDQ, const KVSrc S, u16* __restrict__ Ob, int LDO, int NT, char* lds) {
    using C = Cfg<DQ>;
    constexpr int NK = C::NK, NCH = C::NCH, KPT = C::KPT;
    constexpr size_t SHM_K = C::SHM_K;
    const int tid = threadIdx.x, wid = tid >> 6, lane = tid & 63, r32 = lane & 31, hi = lane >> 5;
    char* V_lds = lds; char* K_lds = lds + 2 * SHM_V;
    float* wsf = (float*)(lds + 2 * SHM_V + 2 * SHM_K) + wid * 64; float* li_l = wsf; float* al_l = wsf + 32;
    float m_reg = -1e30f, l_reg = 0; f32x16 o[4] = {}; bf16x8 qr[NK];
    const u16* Qw = Qb + (long)(wid * QBLK + r32) * LDQ + hi * 8;
#pragma unroll
    for (int d0 = 0; d0 < NK; ++d0) qr[d0] = *reinterpret_cast<const bf16x8*>(Qw + d0 * 16);
    const int sr = tid >> 4, sc = (tid & 15) * 8, vst0 = v_st(sr, sc), vst1 = v_st(32 + sr, sc);
    const int vb0 = (int)(uintptr_t)V_lds + v_rd_base(lane);
    const u16* kp[KPT]; int kst[KPT]; int kw[KPT];
#pragma unroll
    for (int i = 0; i < KPT; ++i) { const int c = tid + 512 * i, row = c / NCH, c8 = c % NCH;
        if (c8 < S.split8) { kp[i] = S.k0 + (long)row * S.kst0 + c8 * 8; kst[i] = S.kst0; } else { kp[i] = S.k1 + (long)row * S.kst1 + (c8 - S.split8) * 8; kst[i] = S.kst1; }
        kw[i] = C::kswz(row, c8 * 16); }
    const u16* vp0 = S.v + (long)sr * S.vst + sc; const u16* vp1 = S.v + (long)(32 + sr) * S.vst + sc;
    struct { bf16x8 vs0, vs1, ks[KPT]; } sr_[2];
#define FA_ROW0(kt) ((kt) < 4 ? S.xrow0 + 64 * (kt) : S.lrow0 + 64 * ((kt) - 4))
#define FA_SLOAD(i, kt) do { const long _r = FA_ROW0(kt); sr_[i].vs0 = *reinterpret_cast<const bf16x8*>(vp0 + _r * S.vst); sr_[i].vs1 = *reinterpret_cast<const bf16x8*>(vp1 + _r * S.vst); \
    _Pragma("unroll") for (int _q = 0; _q < KPT; ++_q) sr_[i].ks[_q] = *reinterpret_cast<const bf16x8*>(kp[_q] + _r * kst[_q]); } while (0)
#define FA_SWRITE(b, i) do { *(bf16x8*)(V_lds + (b) * SHM_V + vst0) = sr_[i].vs0; *(bf16x8*)(V_lds + (b) * SHM_V + vst1) = sr_[i].vs1; \
    _Pragma("unroll") for (int _q = 0; _q < KPT; ++_q) *(bf16x8*)(K_lds + (b) * SHM_K + kw[_q]) = sr_[i].ks[_q]; } while (0)
#define FA_SWAIT() asm volatile("s_waitcnt vmcnt(%0)" :: "n"(2 + KPT) : "memory")
#define FA_RESC(a) do { if (__any((a) < 1.f)) { if (hi == 0) al_l[r32] = (a); asm volatile("s_waitcnt lgkmcnt(0)" ::: "memory"); \
    _Pragma("unroll") for (int d = 0; d < 4; ++d) _Pragma("unroll") for (int r = 0; r < 16; ++r) o[d][r] *= al_l[crow(r, hi)]; } } while (0)
    f32x16 pA0, pA1, pB0, pB1; float mnA, mnB, alA, alB; bf16x8 pa0, pa1, pa2, pa3;
    constexpr int SE = 0, SO = 1;
    FA_SLOAD(SE, 0); asm volatile("s_waitcnt vmcnt(0)" ::: "memory"); FA_SWRITE(0, SE); __syncthreads();
    qkt<DQ>(pA0, pA1, K_lds, qr, r32, hi); partialSM<DQ>(pA0, pA1, m_reg, mnA, alA);
    FA_SLOAD(SO, 1); if (2 < NT) FA_SLOAD(SE, 2);
    FA_SWAIT(); FA_SWRITE(1, SO); __syncthreads();
    for (int j = 1; j + 1 < NT; j += 2) {
        FA_SBAR(); qkt<DQ>(pB0, pB1, K_lds + SHM_K, qr, r32, hi);
        finishSM(pA0, pA1, alA, l_reg, pa0, pa1, pa2, pa3); FA_SBAR();
        FA_SLOAD(SO, j + 2); FA_SBAR();
        pv_d0(o, vb0, pa0, pa1, pa2, pa3); partialSM<DQ>(pB0, pB1, m_reg, mnB, alB);
        __syncthreads(); FA_SWAIT(); FA_SWRITE(0, SE);
        FA_RESC(alB); __syncthreads();
        FA_SBAR(); qkt<DQ>(pA0, pA1, K_lds, qr, r32, hi);
        finishSM(pB0, pB1, alB, l_reg, pa0, pa1, pa2, pa3); FA_SBAR();
        if (j + 3 < NT) FA_SLOAD(SE, j + 3); FA_SBAR();
        pv_d0(o, vb0 + (int)SHM_V, pa0, pa1, pa2, pa3); partialSM<DQ>(pA0, pA1, m_reg, mnA, alA);
        __syncthreads(); FA_SWAIT(); FA_SWRITE(1, SO);
        FA_RESC(alA); __syncthreads();
    }
    FA_SBAR(); qkt<DQ>(pB0, pB1, K_lds + SHM_K, qr, r32, hi);
    finishSM(pA0, pA1, alA, l_reg, pa0, pa1, pa2, pa3); FA_SBAR();
    pv_d0(o, vb0, pa0, pa1, pa2, pa3); partialSM<DQ>(pB0, pB1, m_reg, mnB, alB);
    __syncthreads(); FA_RESC(alB);
    finishSM(pB0, pB1, alB, l_reg, pa0, pa1, pa2, pa3); FA_SBAR();
    pv_d0(o, vb0 + (int)SHM_V, pa0, pa1, pa2, pa3);
    if (hi == 0) li_l[r32] = l_reg; asm volatile("s_waitcnt lgkmcnt(0)" ::: "memory");
    float rli[16];
#pragma unroll
    for (int r = 0; r < 16; ++r) rli[r] = __builtin_amdgcn_rcpf(li_l[crow(r, hi)]);
    u16* Ow = Ob + (long)(wid * QBLK) * LDO;
#pragma unroll
    for (int r = 0; r < 16; ++r) { const int orow = crow(r, hi);
#pragma unroll
        for (int d0 = 0; d0 < 4; ++d0) Ow[(long)orow * LDO + d0 * 32 + r32] = (u16)f2bf(o[d0][r] * rli[r]); }
#undef FA_ROW0
#undef FA_SLOAD
#undef FA_SWRITE
#undef FA_SWAIT
#undef FA_RESC
}

template <int DQ, int SPLIT8>
__device__ __forceinline__ void attn_unit_sp(const u16* __restrict__ Qb, int LDQ, const KVSrc S, u16* __restrict__ Ob, int LDO, int NT, char* lds) {
    using C = Cfg<DQ>;
    constexpr int NK = C::NK, NCH = C::NCH, KPT = C::KPT, KPT0 = SPLIT8 / 8, NCH1 = NCH - SPLIT8;
    constexpr size_t SHM_K = C::SHM_K;
    const int tid = threadIdx.x, wid = tid >> 6, lane = tid & 63, r32 = lane & 31, hi = lane >> 5;
    char* V_lds = lds; char* K_lds = lds + 2 * SHM_V;
    float* wsf = (float*)(lds + 2 * SHM_V + 2 * SHM_K) + wid * 64; float* li_l = wsf; float* al_l = wsf + 32;
    float m_reg = -1e30f, l_reg = 0; f32x16 o[4] = {}; bf16x8 qr[NK];
    { const u16* Qw = Qb + (long)(wid * QBLK + r32) * LDQ + hi * 8;
#pragma unroll
      for (int d0 = 0; d0 < NK; ++d0) qr[d0] = *reinterpret_cast<const bf16x8*>(Qw + d0 * 16); }
    const int sr = tid >> 4, sc = (tid & 15) * 8, vst0 = v_st(sr, sc), vst1 = v_st(32 + sr, sc);
    const int vb0 = (int)(uintptr_t)V_lds + v_rd_base(lane);
    int koff[KPT], kw[KPT];
#pragma unroll
    for (int i = 0; i < KPT; ++i) {
        if (i < KPT0) { const int c = tid + 512 * i, row = c / SPLIT8, c8 = c % SPLIT8; koff[i] = row * S.kst0 + c8 * 8; kw[i] = C::kswz(row, c8 * 16); }
        else { const int c = tid + 512 * (i - KPT0), row = c / (NCH1 > 0 ? NCH1 : 1), c8 = c % (NCH1 > 0 ? NCH1 : 1); koff[i] = row * S.kst1 + c8 * 8; kw[i] = C::kswz(row, (SPLIT8 + c8) * 16); } }
    const int voff0 = sr * S.vst + sc, voff1 = (32 + sr) * S.vst + sc;
    bf16x8 vs0, vs1, ks[KPT];
#define FA_ROW0(kt) ((kt) < 4 ? S.xrow0 + 64 * (kt) : S.lrow0 + 64 * ((kt) - 4))
#define FA_SLOAD(kt) do { const long _r = FA_ROW0(kt); const u16* _v = S.v + _r * S.vst; const u16* _k0 = S.k0 + _r * S.kst0; const u16* _k1 = S.k1 + _r * S.kst1; \
    vs0 = *reinterpret_cast<const bf16x8*>(_v + voff0); vs1 = *reinterpret_cast<const bf16x8*>(_v + voff1); \
    _Pragma("unroll") for (int _q = 0; _q < KPT; ++_q) ks[_q] = *reinterpret_cast<const bf16x8*>((_q < KPT0 ? _k0 : _k1) + koff[_q]); } while (0)
#define FA_SWRITE(b) do { *(bf16x8*)(V_lds + (b) * SHM_V + vst0) = vs0; *(bf16x8*)(V_lds + (b) * SHM_V + vst1) = vs1; \
    _Pragma("unroll") for (int _q = 0; _q < KPT; ++_q) *(bf16x8*)(K_lds + (b) * SHM_K + kw[_q]) = ks[_q]; } while (0)
    f32x16 p0, p1; float mn, al; bf16x8 pa0, pa1, pa2, pa3;
    FA_SLOAD(0); asm volatile("s_waitcnt vmcnt(0)" ::: "memory"); FA_SWRITE(0); __syncthreads();
    for (int j = 0; j < NT; ++j) {
        const int b = j & 1;
        FA_SBAR(); qkt<DQ>(p0, p1, K_lds + b * SHM_K, qr, r32, hi);
        partialSM<DQ>(p0, p1, m_reg, mn, al);
        if (__any(al < 1.f)) { if (hi == 0) al_l[r32] = al; asm volatile("s_waitcnt lgkmcnt(0)" ::: "memory");
#pragma unroll
            for (int d = 0; d < 4; ++d)
#pragma unroll
                for (int r = 0; r < 16; ++r) o[d][r] *= al_l[crow(r, hi)]; }
        finishSM(p0, p1, al, l_reg, pa0, pa1, pa2, pa3); FA_SBAR();
        if (j + 1 < NT) FA_SLOAD(j + 1);
        FA_SBAR();
        pv_d0(o, vb0 + b * (int)SHM_V, pa0, pa1, pa2, pa3);
        if (j + 1 < NT) { asm volatile("s_waitcnt vmcnt(0)" ::: "memory"); FA_SWRITE(b ^ 1); }
        __syncthreads();
    }
    if (hi == 0) li_l[r32] = l_reg; asm volatile("s_waitcnt lgkmcnt(0)" ::: "memory");
    float rli[16];
#pragma unroll
    for (int r = 0; r < 16; ++r) rli[r] = __builtin_amdgcn_rcpf(li_l[crow(r, hi)]);
    u16* Ow = Ob + (long)(wid * QBLK) * LDO;
#pragma unroll
    for (int r = 0; r < 16; ++r) { const int orow = crow(r, hi);
#pragma unroll
        for (int d0 = 0; d0 < 4; ++d0) Ow[(long)orow * LDO + d0 * 32 + r32] = (u16)f2bf(o[d0][r] * rli[r]); }
#undef FA_ROW0
#undef FA_SLOAD
#undef FA_SWRITE
}
}


#ifndef FAST_GLA
#define FAST_GLA 1
#endif
namespace gla {
typedef short bf16x8 __attribute__((ext_vector_type(8)));
typedef unsigned u32x2 __attribute__((ext_vector_type(2)));
constexpr int P = 72;
constexpr int ARR = 64 * P * 2;
constexpr int OFF_SET = 4 * ARR;
constexpr int OFF_ATT = 2 * OFF_SET, OFF_ST = OFF_ATT + ARR, OFF_SEG = OFF_ST + ARR, OFF_DEC = OFF_SEG + 8 * 64 * 4, LDS_END = OFF_DEC + 2 * 64 * 4;
__device__ __forceinline__ bf16x8 ldfrag(const LAS unsigned char* arr, int row, int colb) { return *(const LAS bf16x8*)(arr + row * (P * 2) + colb); }
__device__ __forceinline__ void unit(LAS unsigned char* lds, const u16* PARTS, const float* wg, const float* bg, int caf, float* Od, int b, int h, int dir, int vh) {
    const int tid = threadIdx.x, lane = tid & 63, w = __builtin_amdgcn_readfirstlane(tid >> 6);
    const int r16 = lane & 15, fq = lane >> 4;
    const int it = w & 3, jt0 = 2 * (w >> 2);
    float wgr[16];
#pragma unroll
    for (int j = 0; j < 16; ++j) wgr[j] = wg[j * 256 + h * 64 + lane];
    const float bgr = bg[h * 64 + lane];
    f32x4 S0 = {0.f, 0.f, 0.f, 0.f}, S1 = {0.f, 0.f, 0.f, 0.f};
    for (int e = tid; e < ARR / 4; e += 512) ((LAS unsigned*)(lds + OFF_ST))[e] = 0u;
    auto rowof = [&](int pos) { return pos < CTXL ? (ML + b * CTXL + (dir ? CTXL - 1 - pos : pos)) : (b * SEQ + (dir ? SEQ - 1 - (pos - CTXL) : (pos - CTXL))); };
    unsigned short qv[8], kv[8], vv[8]; float afv[8];
#define GLA_LOAD(n) do { _Pragma("unroll") for (int i = 0; i < 8; ++i) { const int row = rowof((n) * 64 + 8 * w + i); const u16* pr = PARTS + (size_t)row * IN_AP; \
        qv[i] = pr[C_GQ + h * 64 + lane]; kv[i] = pr[C_GK + h * 64 + lane]; vv[i] = pr[C_GV + h * 128 + vh * 64 + lane]; afv[i] = bf2f(pr[caf + (lane & 15)]); } } while (0)
    GLA_LOAD(0);
    constexpr int NCHUNK = (CTXL + SEQ) / 64;
    for (int n = 0; n < NCHUNK; ++n) {
        LAS unsigned char* Qt = lds + (n & 1) * OFF_SET; LAS unsigned char* Kt = Qt + ARR; LAS unsigned char* KhT = Kt + ARR; LAS unsigned char* Vt = KhT + ARR;
        LAS float* seg = (LAS float*)(lds + OFF_SEG); LAS float* dec = (LAS float*)(lds + OFF_DEC) + (n & 1) * 64;
        float c[8]; float run = 0.f;
#pragma unroll
        for (int i = 0; i < 8; ++i) { float pre = bgr;
#pragma unroll
            for (int j = 0; j < 16; ++j) pre += __int_as_float(__builtin_amdgcn_readlane(__float_as_int(afv[i]), j)) * wgr[j];
            const float ls = fminf(pre, 0.f) - __logf(1.0f + __expf(-fabsf(pre)));
            run += ls * (1.0f / 16.0f); c[i] = run; }
        seg[w * 64 + lane] = run;
        __syncthreads();
        float prefix = 0.f, last = 0.f;
#pragma unroll
        for (int ww = 0; ww < 8; ++ww) { const float t = seg[ww * 64 + lane]; last += t; prefix += (ww < w) ? t : 0.f; }
#pragma unroll
        for (int i = 0; i < 8; ++i) { const int s = 8 * w + i; const float cum = prefix + c[i]; const float e = __expf(cum), kf = bf2f(kv[i]);
            ((LAS u16*)Qt)[s * P + lane] = (u16)f2bf(bf2f(qv[i]) * 0.125f * e);
            ((LAS u16*)Kt)[s * P + lane] = (u16)f2bf(kf * __expf(-cum));
            ((LAS u16*)KhT)[lane * P + s] = (u16)f2bf(kf * __expf(last - cum));
            ((LAS u16*)Vt)[lane * P + s] = vv[i]; }
        if (w == 0) dec[lane] = __expf(last);
        __syncthreads();
        if (n + 1 < NCHUNK) GLA_LOAD(n + 1);
        f32x4 a0 = {0.f, 0.f, 0.f, 0.f}, a1 = a0, o0 = a0, o1 = a0;
#pragma unroll
        for (int ks = 0; ks < 2; ++ks) { const int cb = ks * 64 + fq * 16;
            const bf16x8 A = ldfrag(Kt, 16 * it + r16, cb), Bq0 = ldfrag(Qt, 16 * jt0 + r16, cb), Bq1 = ldfrag(Qt, 16 * (jt0 + 1) + r16, cb), As = ldfrag(lds + OFF_ST, 16 * it + r16, cb);
            a0 = __builtin_amdgcn_mfma_f32_16x16x32_bf16(A, Bq0, a0, 0, 0, 0); a1 = __builtin_amdgcn_mfma_f32_16x16x32_bf16(A, Bq1, a1, 0, 0, 0);
            o0 = __builtin_amdgcn_mfma_f32_16x16x32_bf16(As, Bq0, o0, 0, 0, 0); o1 = __builtin_amdgcn_mfma_f32_16x16x32_bf16(As, Bq1, o1, 0, 0, 0); }
        { const int s0 = 16 * it + 4 * fq; const int t0 = 16 * jt0 + r16, t1 = t0 + 16;
          u32x2 p0, p1;
          p0.x = f2bf(s0 + 0 <= t0 ? a0[0] : 0.f) | (f2bf(s0 + 1 <= t0 ? a0[1] : 0.f) << 16); p0.y = f2bf(s0 + 2 <= t0 ? a0[2] : 0.f) | (f2bf(s0 + 3 <= t0 ? a0[3] : 0.f) << 16);
          p1.x = f2bf(s0 + 0 <= t1 ? a1[0] : 0.f) | (f2bf(s0 + 1 <= t1 ? a1[1] : 0.f) << 16); p1.y = f2bf(s0 + 2 <= t1 ? a1[2] : 0.f) | (f2bf(s0 + 3 <= t1 ? a1[3] : 0.f) << 16);
          *(LAS u32x2*)(lds + OFF_ATT + (t0 * P + s0) * 2) = p0; *(LAS u32x2*)(lds + OFF_ATT + (t1 * P + s0) * 2) = p1; }
        __syncthreads();
        const f32x4 d4 = *(const LAS f32x4*)(dec + 16 * it + 4 * fq);
        S0 = S0 * d4; S1 = S1 * d4;
#pragma unroll
        for (int ks = 0; ks < 2; ++ks) { const int cb = ks * 64 + fq * 16;
            const bf16x8 Av = ldfrag(Vt, 16 * it + r16, cb), Ba0 = ldfrag(lds + OFF_ATT, 16 * jt0 + r16, cb), Ba1 = ldfrag(lds + OFF_ATT, 16 * (jt0 + 1) + r16, cb);
            const bf16x8 Ak = ldfrag(KhT, 16 * it + r16, cb), Bv0 = ldfrag(Vt, 16 * jt0 + r16, cb), Bv1 = ldfrag(Vt, 16 * (jt0 + 1) + r16, cb);
            o0 = __builtin_amdgcn_mfma_f32_16x16x32_bf16(Av, Ba0, o0, 0, 0, 0); o1 = __builtin_amdgcn_mfma_f32_16x16x32_bf16(Av, Ba1, o1, 0, 0, 0);
            S0 = __builtin_amdgcn_mfma_f32_16x16x32_bf16(Ak, Bv0, S0, 0, 0, 0); S1 = __builtin_amdgcn_mfma_f32_16x16x32_bf16(Ak, Bv1, S1, 0, 0, 0); }
        { const int v0 = 16 * it + 4 * fq; const int t0 = 16 * jt0 + r16;
          *(f32x4*)(Od + (size_t)rowof(n * 64 + t0) * 512 + h * 128 + vh * 64 + v0) = o0;
          *(f32x4*)(Od + (size_t)rowof(n * 64 + t0 + 16) * 512 + h * 128 + vh * 64 + v0) = o1;
          const int k0 = 16 * it + 4 * fq, vc0 = 16 * jt0 + r16;
          u32x2 q0, q1; q0.x = f2bf(S0[0]) | (f2bf(S0[1]) << 16); q0.y = f2bf(S0[2]) | (f2bf(S0[3]) << 16); q1.x = f2bf(S1[0]) | (f2bf(S1[1]) << 16); q1.y = f2bf(S1[2]) | (f2bf(S1[3]) << 16);
          *(LAS u32x2*)(lds + OFF_ST + (vc0 * P + k0) * 2) = q0; *(LAS u32x2*)(lds + OFF_ST + ((vc0 + 16) * P + k0) * 2) = q1; }
    }
#undef GLA_LOAD
}
}

__global__ void __launch_bounds__(512, 2) fwd_kernel(Args args) {
    extern __shared__ __attribute__((aligned(16))) unsigned char lds_raw[];
    LAS unsigned char* lds = (LAS unsigned char*)lds_raw;
    const int tid = threadIdx.x, lane = tid & 63, wave = __builtin_amdgcn_readfirstlane(tid >> 6);
    const int G = gridDim.x, gw = blockIdx.x * 8 + wave, NGW = G * 8;
    unsigned char* ws = args.ws;
    unsigned* ctl = (unsigned*)(ws + WS_CTL);
    volatile LAS unsigned* MISC = (volatile LAS unsigned*)(lds + MISC_OFF);
    for (int u = tid; u < (LDS_BYTES - 131072) / 4; u += 512) ((LAS unsigned*)(lds + 131072))[u] = 0u;
    __syncthreads();
    XcdBarrier bar = xcd_barrier_post(ctl + CW_BAR + args.li * 4096, MISC + 8);
    const int lo = args.ph_lo, hi = args.ph_hi;
#define IN(k) (lo <= (k) && (k) < hi)
#define GRID_BAR() xcd_barrier(bar)

    const float* x_in = args.in[0]; const float* c_in = args.in[1]; const float* ctx_in = args.in[2]; const float* cctx_in = args.in[3];
    const float* w_mod = args.in[4]; const float* b_mod = args.in[5];
    const float* g_pre_mix = args.in[6]; const float* g_post_mix = args.in[7]; const float* g_pre_ffn = args.in[8]; const float* g_post_ffn = args.in[9];
    const float* w_in_a = args.in[10]; const float* mla_g_q = args.in[11]; const float* mla_w_uq = args.in[12]; const float* mla_g_kv = args.in[13]; const float* mla_w_ukv = args.in[14];
    const float* gla_w_gf = args.in[15]; const float* gla_b_gf = args.in[16]; const float* gla_w_gb = args.in[17]; const float* gla_b_gb = args.in[18]; const float* gla_g_out = args.in[19];
    const float* w_out_a = args.in[20]; const float* w_qkv_c = args.in[21];
    const float* diff_lq1 = args.in[22]; const float* diff_lk1 = args.in[23]; const float* diff_lq2 = args.in[24]; const float* diff_lk2 = args.in[25]; const float* diff_g_out = args.in[26];
    const float* w_out_c = args.in[27]; const float* ffn_w_gate = args.in[28]; const float* ffn_w_up = args.in[29]; const float* ffn_w_down = args.in[30];
    const float* moe_w_router = args.in[31]; const float* moe_w_gate = args.in[32]; const float* moe_w_up = args.in[33]; const float* moe_w_down = args.in[34];
    float* out = args.out;
    float* MODB = (float*)(ws + WS_MOD);
    float* ROPEC = (float*)(ws + WS_ROPE); float* ROPES = ROPEC + 2048 * 32;
    int* TOKE = (int*)(ws + WS_TOKE); float* TOKG = (float*)(ws + WS_TOKG); int* TOKP = (int*)(ws + WS_TOKP);
    float* CTXS = (float*)(ws + WS_CTXS);
    u16* H0 = (u16*)(ws + WS_R0); u16* CAT = (u16*)(ws + WS_R0); u16* FB = (u16*)(ws + WS_R0); u16* O16 = (u16*)(ws + WS_R0); u16* Y2 = (u16*)(ws + WS_R0); u16* HIDC = (u16*)(ws + WS_R0);
    u16* PARTS = (u16*)(ws + WS_PARTS); u16* YB = (u16*)(ws + WS_Y); u16* HB = (u16*)(ws + WS_Y);
    u16* H1 = (u16*)(ws + WS_H1); u16* CAT2 = (u16*)(ws + WS_H1);
    u16* HC = (u16*)(ws + WS_HC); u16* XS = (u16*)(ws + WS_XS);
    u16* A2 = (u16*)(ws + WS_A2); u16* KROPE = (u16*)(ws + WS_KROPE);
    float* OF = (float*)(ws + WS_R3); float* OB = OF + (size_t)M * 512;
    u16* QKVUP = (u16*)(ws + WS_R3); u16* HID = (u16*)(ws + WS_R3); u16* QKVC = (u16*)(ws + WS_R3);
    u16* W_IN = (u16*)(ws + WS_W);
    u16* W_UP = (u16*)(ws + WS_W + 4 * MiB);
    u16* W_OA = (u16*)(ws + WS_W + 4 * MiB + 1536 * 1024);
    u16* W_FGU = (u16*)(ws + WS_W + 7 * MiB + 512 * 1024);
    u16* W_FD = (u16*)(ws + WS_W + 18 * MiB + 512 * 1024);
    u16* W_QKV = (u16*)(ws + WS_W + 24 * MiB);
    u16* W_OC = (u16*)(ws + WS_W + 30 * MiB);
    unsigned char* W_MGU = ws + WS_MOEW;
    unsigned char* W_MD = ws + WS_MOEW + 56 * MiB;
    unsigned char* XS8 = ws + WS_XS8; unsigned char* HIDC8 = ws + WS_R0;
    auto map_id = [](int n0) { return n0; };
    auto map_gate = [](int n0) { return (n0 >> 7) * 256 + (n0 & 127); };
    auto map_up = [](int n0) { return (n0 >> 7) * 256 + 128 + (n0 & 127); };

    if (IN(0)) {
        LAS float* sT = (LAS float*)lds;
        LAS float* red = sT + 1024 * 20;
        for (int e = tid; e < 17 * 1024; e += 512) { const int r = e >> 10, k = e & 1023; const float v = r < 16 ? c_in[r * 1024 + k] : cctx_in[k]; sT[k * 20 + r] = silu_f(v); }
        __syncthreads();
        for (int g = blockIdx.x; g < 192; g += G) {
            const int l = g / 96, n = (g % 96) * 64 + lane;
            const float* wp = w_mod + (size_t)l * 1024 * 6144 + n;
            float acc[17];
#pragma unroll
            for (int r = 0; r < 17; ++r) acc[r] = 0.f;
            const int kb = wave * 128;
#pragma unroll 4
            for (int kk = 0; kk < 128; ++kk) { const int k = kb + kk; const float w = wp[(size_t)k * 6144];
                const LAS float* sp = sT + k * 20;
#pragma unroll
                for (int r = 0; r < 17; ++r) acc[r] += sp[r] * w; }
#pragma unroll
            for (int r = 0; r < 17; ++r) red[(wave * 17 + r) * 64 + lane] = acc[r];
            __syncthreads();
            for (int e = tid; e < 17 * 64; e += 512) { const int r = e >> 6, ln = e & 63; float s = 0.f;
#pragma unroll
                for (int w8 = 0; w8 < 8; ++w8) s += red[(w8 * 17 + r) * 64 + ln];
                const int nn = (g % 96) * 64 + ln;
                MODB[(size_t)(l * 17 + r) * 6144 + nn] = s + b_mod[l * 6144 + nn]; }
            __syncthreads();
        }
        for (int e = blockIdx.x * 512 + tid; e < 2048 * 32; e += G * 512) { const int t = e >> 5, i = e & 31; const int pos = i < 16 ? (t >> 6) : (t & 63);
            const float freq = powf(10000.0f, -(float)(i & 15) / 16.0f); const float ang = (float)pos * freq;
            ROPEC[e] = cosf(ang); ROPES[e] = sinf(ang); }
#if FAST_GEMM
        __syncthreads();
        { LAS float* scr = (LAS float*)(lds + wave * 8448); int off = 0;
          cvt_matrix(w_in_a, 1024, IN_A, W_IN, 1024, 0, map_id, scr, lane, gw, NGW, off);
          cvt_matrix(mla_w_uq, 256, 768, W_UP, 384, 0, map_id, scr, lane, gw, NGW, off);
          cvt_matrix(mla_w_ukv, 128, 1024, W_UP, 384, 256, [](int n0) { return 768 + n0; }, scr, lane, gw, NGW, off);
          cvt_matrix(w_out_a, 1024, 1024, W_OA, 1024, 0, map_id, scr, lane, gw, NGW, off);
          cvt_matrix(ffn_w_gate, 1024, FFN, W_FGU, 1024, 0, map_gate, scr, lane, gw, NGW, off);
          cvt_matrix(ffn_w_up, 1024, FFN, W_FGU, 1024, 0, map_up, scr, lane, gw, NGW, off);
          cvt_matrix(ffn_w_down, FFN, 1024, W_FD, FFN, 0, map_id, scr, lane, gw, NGW, off);
          cvt_matrix(w_qkv_c, 1024, 3072, W_QKV, 1024, 0, map_id, scr, lane, gw, NGW, off);
          cvt_matrix(w_out_c, 1024, 1024, W_OC, 1024, 0, map_id, scr, lane, gw, NGW, off);
          const uint4 z = make_uint4(0u, 0u, 0u, 0u);
          for (int e = blockIdx.x * 512 + tid; e < 32 * 128; e += G * 512) *(uint4*)(W_IN + (size_t)IN_A * 1024 + (size_t)e * 8) = z;
          for (int e = blockIdx.x * 512 + tid; e < 768 * 16; e += G * 512) { const int r = e >> 4, c8 = e & 15; *(uint4*)(W_UP + (size_t)r * 384 + 256 + c8 * 8) = z; }
          for (int e = blockIdx.x * 512 + tid; e < 1024 * 32; e += G * 512) { const int r = 768 + (e >> 5), c8 = e & 31; *(uint4*)(W_UP + (size_t)r * 384 + c8 * 8) = z; } }
#endif
        GRID_BAR();
    }
    if (IN(1)) {
        for (int row = gw; row < M; row += NGW) {
            const float* src = row < ML ? x_in + (size_t)row * 1024 : ctx_in + (size_t)(row - ML) * 1024;
            const int mr = row < ML ? (row >> 11) : 16;
            f32x4 xv[4], hv[4]; ld_row_f32(src, lane, xv);
            premod(xv, hv, g_pre_mix, modp(ws, 0, mr, 0), modp(ws, 0, mr, 1), lane);
            st_row_bf16(H0 + (size_t)row * 1024, lane, hv);
        }
        GRID_BAR();
    }
    if (IN(2)) {
#if FAST_GEMM
        { pg8::Gemm g{H0, W_IN, 1024, 1024, 0, 0}; pg8::DenseOrder S; S.init(M / 256, IN_AP / 256, G, (int)blockIdx.x); pg8::EpiStore E{PARTS, IN_AP};
          pg8::gemm_phase<pg8::EpiStore, pg8::DenseOrder, PG8_ALIGN, PG8_SP2>(lds, g, S, E); }
#else
        auto epi = [&](int r, int c, float a, float) { PARTS[(size_t)r * IN_AP + c] = (u16)f2bf(a); };
        naive_gemm<false>(lds, H0, 1024, M / 128, w_in_a, nullptr, 1024, IN_A, IN_A, nullptr, 0, epi);
#endif
        GRID_BAR();
    }
    if (IN(3)) {
        for (int row = gw; row < M; row += NGW) {
            const u16* pr = PARTS + (size_t)row * IN_AP;
            { const uint2 w = *(const uint2*)(pr + C_CQ + 4 * lane); float v[4] = {bf2f(w.x & 0xffffu), bf2f(w.x >> 16), bf2f(w.y & 0xffffu), bf2f(w.y >> 16)};
              float s = wave_sum(v[0] * v[0] + v[1] * v[1] + v[2] * v[2] + v[3] * v[3]); const float r = 1.0f / sqrtf(s * (1.0f / 256.0f) + EPS);
              const f32x4 g = *(const f32x4*)(mla_g_q + 4 * lane);
              uint2 o; o.x = f2bf(v[0] * r * g.x) | (f2bf(v[1] * r * g.y) << 16); o.y = f2bf(v[2] * r * g.z) | (f2bf(v[3] * r * g.w) << 16);
              *(uint2*)(A2 + (size_t)row * 384 + 4 * lane) = o; }
            { const unsigned w = *(const unsigned*)(pr + C_CKV + 2 * lane); float v0 = bf2f(w & 0xffffu), v1 = bf2f(w >> 16);
              float s = wave_sum(v0 * v0 + v1 * v1); const float r = 1.0f / sqrtf(s * (1.0f / 128.0f) + EPS);
              const float2 g = *(const float2*)(mla_g_kv + 2 * lane);
              *(unsigned*)(A2 + (size_t)row * 384 + 256 + 2 * lane) = f2bf(v0 * r * g.x) | (f2bf(v1 * r * g.y) << 16); }
            if (lane < 32) { float x1 = bf2f(pr[C_KR + lane]), x2 = bf2f(pr[C_KR + 32 + lane]);
              if (row < ML) { const int t = row & 2047; const float cs = ROPEC[t * 32 + lane], sn = ROPES[t * 32 + lane]; const float n1 = x1 * cs - x2 * sn, n2 = x2 * cs + x1 * sn; x1 = n1; x2 = n2; }
              KROPE[(size_t)row * 64 + lane] = (u16)f2bf(x1); KROPE[(size_t)row * 64 + 32 + lane] = (u16)f2bf(x2); }
        }
        GRID_BAR();
    }
    if (IN(4)) {
#if FAST_GLA
        for (int u = blockIdx.x; u < 256; u += G) {
            const int vh = u & 1, dir = (u >> 1) & 1, h = (u >> 2) & 3, b = u >> 4;
            __syncthreads();
            gla::unit(lds, PARTS, dir ? gla_w_gb : gla_w_gf, dir ? gla_b_gb : gla_b_gf, dir ? C_AB : C_AF, dir ? OB : OF, b, h, dir, vh);
        }
#else
        LAS float* qs = (LAS float*)lds;
        LAS float* ks = qs + 16 * 64;
        LAS float* as = ks + 16 * 64;
        LAS float* vs = as + 16 * 64;
        LAS float* opart = vs + 16 * 128;
        for (int u = blockIdx.x; u < 128; u += G) {
            const int dir = u & 1, h = (u >> 1) & 3, b = u >> 3;
            const float* wg = dir ? gla_w_gb : gla_w_gf; const float* bg = dir ? gla_b_gb : gla_b_gf; const int caf = dir ? C_AB : C_AF;
            float* Od = dir ? OB : OF;
            const int kg = tid >> 7, v = tid & 127;
            float S[16];
#pragma unroll
            for (int i = 0; i < 16; ++i) S[i] = 0.f;
            for (int sb = 0; sb < (CTXL + SEQ) / 16; ++sb) {
                __syncthreads();
                for (int e = tid; e < 16 * 64; e += 512) { const int tok = e >> 6, k = e & 63; const int n = sb * 16 + tok;
                    const int row = n < CTXL ? (ML + b * CTXL + (dir ? CTXL - 1 - n : n)) : (b * SEQ + (dir ? SEQ - 1 - (n - CTXL) : (n - CTXL)));
                    const u16* pr = PARTS + (size_t)row * IN_AP;
                    float pre = bg[h * 64 + k];
#pragma unroll
                    for (int jj = 0; jj < 16; ++jj) pre += bf2f(pr[caf + jj]) * wg[jj * 256 + h * 64 + k];
                    const float ls = fminf(pre, 0.f) - log1pf(__expf(-fabsf(pre)));
                    qs[e] = bf2f(pr[C_GQ + h * 64 + k]) * 0.125f; ks[e] = bf2f(pr[C_GK + h * 64 + k]); as[e] = __expf(ls * (1.0f / 16.0f)); }
                for (int e = tid; e < 16 * 128; e += 512) { const int tok = e >> 7, vv = e & 127; const int n = sb * 16 + tok;
                    const int row = n < CTXL ? (ML + b * CTXL + (dir ? CTXL - 1 - n : n)) : (b * SEQ + (dir ? SEQ - 1 - (n - CTXL) : (n - CTXL)));
                    vs[e] = bf2f(PARTS[(size_t)row * IN_AP + C_GV + h * 128 + vv]); }
                __syncthreads();
                for (int tok = 0; tok < 16; ++tok) { const float vv = vs[tok * 128 + v]; float po = 0.f;
#pragma unroll
                    for (int i = 0; i < 16; ++i) { const int k = kg * 16 + i; S[i] = as[tok * 64 + k] * S[i] + ks[tok * 64 + k] * vv; po += qs[tok * 64 + k] * S[i]; }
                    opart[(tok * 4 + kg) * 128 + v] = po; }
                __syncthreads();
                for (int e = tid; e < 16 * 128; e += 512) { const int tok = e >> 7, vv = e & 127; const int n = sb * 16 + tok;
                    const int row = n < CTXL ? (ML + b * CTXL + (dir ? CTXL - 1 - n : n)) : (b * SEQ + (dir ? SEQ - 1 - (n - CTXL) : (n - CTXL)));
                    Od[(size_t)row * 512 + h * 128 + vv] = (opart[(tok * 4 + 0) * 128 + vv] + opart[(tok * 4 + 1) * 128 + vv]) + (opart[(tok * 4 + 2) * 128 + vv] + opart[(tok * 4 + 3) * 128 + vv]); }
            }
        }
#endif
        GRID_BAR();
    }
    if (IN(5)) {
        for (int row = gw; row < M; row += NGW) {
            const int h = lane >> 4, v0 = (lane & 15) * 8;
            const float* pf = OF + (size_t)row * 512 + h * 128 + v0; const float* pb = OB + (size_t)row * 512 + h * 128 + v0;
            float o[8]; float s = 0.f;
#pragma unroll
            for (int i = 0; i < 8; ++i) { o[i] = pf[i] + pb[i]; s += o[i] * o[i]; }
#pragma unroll
            for (int off = 1; off < 16; off <<= 1) s += __shfl_xor(s, off);
            const float r = 1.0f / sqrtf(s * (1.0f / 128.0f) + EPS);
            const u16* pr = PARTS + (size_t)row * IN_AP + C_GR + h * 128 + v0;
            u16* po = CAT + (size_t)row * 1024 + 512 + h * 128 + v0;
#pragma unroll
            for (int i = 0; i < 8; ++i) po[i] = (u16)f2bf(o[i] * r * gla_g_out[v0 + i] * silu_f(bf2f(pr[i])));
        }
        GRID_BAR();
    }
    if (IN(6)) {
#if FAST_GEMM
        { pg8::Gemm g{A2, W_UP, 384, 384, 0, 0}; pg8::DenseOrder S; S.init(M / 256, UPN / 256, G, (int)blockIdx.x); pg8::EpiStore E{QKVUP, UPN};
          pg8::gemm_phase<pg8::EpiStore, pg8::DenseOrder, PG8_ALIGN, PG8_SP2>(lds, g, S, E); }
#else
        auto epiq = [&](int r, int c, float a, float) { QKVUP[(size_t)r * UPN + c] = (u16)f2bf(a); };
        naive_gemm<false>(lds, A2, 384, M / 128, mla_w_uq, nullptr, 256, 768, 768, nullptr, 0, epiq);
        auto epik = [&](int r, int c, float a, float) { QKVUP[(size_t)r * UPN + 768 + c] = (u16)f2bf(a); };
        naive_gemm<false>(lds, A2 + 256, 384, M / 128, mla_w_ukv, nullptr, 128, 1024, 1024, nullptr, 0, epik);
#endif
        GRID_BAR();
    }
    if (IN(7)) {
        for (int row = gw; row < ML; row += NGW) {
            const int t = row & 2047;
#pragma unroll
            for (int jj = 0; jj < 2; ++jj) { const int p = lane + 64 * jj, h = p >> 5, i = p & 31;
                u16* q = QKVUP + (size_t)row * UPN + h * 192 + 128;
                const float x1 = bf2f(q[i]), x2 = bf2f(q[32 + i]), cs = ROPEC[t * 32 + i], sn = ROPES[t * 32 + i];
                q[i] = (u16)f2bf(x1 * cs - x2 * sn); q[32 + i] = (u16)f2bf(x2 * cs + x1 * sn); }
        }
        GRID_BAR();
    }
    if (IN(8)) {
#if FAST_ATTN
        { const int NU_L = NB * 4 * 8, NU_X = NB * 4;
          for (int u = blockIdx.x; u < NU_L + NU_X; u += G) {
            const bool isx = u >= NU_L; const int uu = isx ? u - NU_L : u;
            const int qb = isx ? 0 : (uu & 7), h = isx ? (uu & 3) : ((uu >> 3) & 3), b = isx ? (uu >> 2) : (uu >> 5);
            const int r0 = isx ? (ML + b * CTXL) : (b * SEQ + qb * 256);
            fa::KVSrc S; S.k0 = QKVUP + 768 + h * 256; S.kst0 = UPN; S.k1 = KROPE; S.kst1 = 64; S.split8 = 16; S.v = QKVUP + 768 + h * 256 + 128; S.vst = UPN;
            S.xrow0 = ML + b * CTXL; S.lrow0 = b * SEQ;
            __syncthreads();
            fa::attn_unit_sp<192, 16>(QKVUP + (size_t)r0 * UPN + h * 192, UPN, S, CAT + (size_t)r0 * 1024 + h * 128, 1024, isx ? 4 : 36, (char*)lds_raw);
          } }
#else
        const float scale = 0.07216878364870322f;
        const int NU_L = NB * 4 * 64, NU_X = NB * 4 * 8;
        for (int u = blockIdx.x; u < NU_L + NU_X; u += G) {
            const bool isx = u >= NU_L; const int uu = isx ? u - NU_L : u;
            const int nqb = isx ? 8 : 64;
            const int qb = uu % nqb, h = (uu / nqb) & 3, b = uu / (nqb * 4);
            const int r0 = isx ? (ML + b * CTXL + qb * 32) : (b * SEQ + qb * 32);
            const int nkeys = isx ? CTXL : (CTXL + SEQ);
            auto krow = [&](int key) { return key < CTXL ? (ML + b * CTXL + key) : (b * SEQ + key - CTXL); };
            auto ql = [&](int r, int d) { return bf2f(QKVUP[(size_t)(r0 + r) * UPN + h * 192 + d]); };
            auto kl = [&](int key, int d) { const int row = krow(key); return d < 128 ? bf2f(QKVUP[(size_t)row * UPN + 768 + h * 256 + d]) : bf2f(KROPE[(size_t)row * 64 + d - 128]); };
            auto vl = [&](int key, int d) { const int row = krow(key); return bf2f(QKVUP[(size_t)row * UPN + 768 + h * 256 + 128 + d]); };
            auto os = [&](int r, int d, float val) { CAT[(size_t)(r0 + r) * 1024 + h * 128 + d] = (u16)f2bf(val); };
            naive_attn_unit<192>(lds, nkeys, scale, ql, kl, vl, os);
        }
#endif
        GRID_BAR();
    }
    if (IN(9)) {
#if FAST_GEMM
        { pg8::Gemm g{CAT, W_OA, 1024, 1024, 0, 0}; pg8::DenseOrder S; S.init(M / 256, 4, G, (int)blockIdx.x); pg8::EpiStore E{YB, 1024};
          pg8::gemm_phase<pg8::EpiStore, pg8::DenseOrder, PG8_ALIGN, PG8_SP2>(lds, g, S, E); }
#else
        auto epi = [&](int r, int c, float a, float) { YB[(size_t)r * 1024 + c] = (u16)f2bf(a); };
        naive_gemm<false>(lds, CAT, 1024, M / 128, w_out_a, nullptr, 1024, 1024, 1024, nullptr, 0, epi);
#endif
        GRID_BAR();
    }
    if (IN(10)) {
        for (int row = gw; row < M; row += NGW) {
            const float* src = row < ML ? x_in + (size_t)row * 1024 : ctx_in + (size_t)(row - ML) * 1024;
            float* dst = row < ML ? out + (size_t)row * 1024 : CTXS + (size_t)(row - ML) * 1024;
            const int mr = row < ML ? (row >> 11) : 16;
            f32x4 xv[4], tv[4], hv[4]; ld_row_f32(src, lane, xv); ld_row_bf16(YB + (size_t)row * 1024, lane, tv);
            rms_apply(tv, g_post_mix, lane);
            const float* gate = modp(ws, 0, mr, 2);
#pragma unroll
            for (int j = 0; j < 4; ++j) xv[j] = xv[j] + *(const f32x4*)(gate + 4 * lane + 256 * j) * tv[j];
            st_row_f32(dst, lane, xv);
            premod(xv, hv, g_pre_ffn, modp(ws, 0, mr, 3), modp(ws, 0, mr, 4), lane);
            st_row_bf16(H1 + (size_t)row * 1024, lane, hv);
        }
        GRID_BAR();
    }
    if (IN(11)) {
#if FAST_GEMM
        { pg8::Gemm g{H1, W_FGU, 1024, 1024, 0, 0}; pg8::DenseOrder S; S.init(M / 256, 2 * FFN / 256, G, (int)blockIdx.x); pg8::EpiSwiglu E{HID, FFN};
          pg8::gemm_phase<pg8::EpiSwiglu, pg8::DenseOrder, PG8_ALIGN, PG8_SP2>(lds, g, S, E); }
#else
        auto epi = [&](int r, int c, float a, float b2) { HID[(size_t)r * FFN + c] = (u16)f2bf(silu_f(a) * b2); };
        naive_gemm<true>(lds, H1, 1024, M / 128, ffn_w_gate, ffn_w_up, 1024, FFN, FFN, nullptr, 0, epi);
#endif
        GRID_BAR();
    }
    if (IN(12)) {
#if FAST_GEMM
        { pg8::Gemm g{HID, W_FD, FFN, FFN, 0, 0}; pg8::DenseOrder S; S.init(M / 256, 4, G, (int)blockIdx.x); pg8::EpiStore E{FB, 1024};
          pg8::gemm_phase<pg8::EpiStore, pg8::DenseOrder, PG8_ALIGN, PG8_SP2>(lds, g, S, E); }
#else
        auto epi = [&](int r, int c, float a, float) { FB[(size_t)r * 1024 + c] = (u16)f2bf(a); };
        naive_gemm<false>(lds, HID, FFN, M / 128, ffn_w_down, nullptr, FFN, 1024, 1024, nullptr, 0, epi);
#endif
        GRID_BAR();
    }
    if (IN(13)) {
        for (int row = gw; row < M; row += NGW) {
            float* dst = row < ML ? out + (size_t)row * 1024 : CTXS + (size_t)(row - ML) * 1024;
            const int mr = row < ML ? (row >> 11) : 16;
            f32x4 xv[4], tv[4], hv[4]; ld_row_f32(dst, lane, xv); ld_row_bf16(FB + (size_t)row * 1024, lane, tv);
            rms_apply(tv, g_post_ffn, lane);
            const float* gate = modp(ws, 0, mr, 5);
#pragma unroll
            for (int j = 0; j < 4; ++j) xv[j] = xv[j] + *(const f32x4*)(gate + 4 * lane + 256 * j) * tv[j];
            st_row_f32(dst, lane, xv);
            premod(xv, hv, g_pre_mix + 1024, modp(ws, 1, mr, 0), modp(ws, 1, mr, 1), lane);
            st_row_bf16(HB + (size_t)row * 1024, lane, hv);
        }
        GRID_BAR();
    }
    if (IN(14)) {
#if FAST_GEMM
        { pg8::Gemm g{HB, W_QKV, 1024, 1024, 0, 0}; pg8::DenseOrder S; S.init(M / 256, 12, G, (int)blockIdx.x); pg8::EpiStore E{QKVC, 3072};
          pg8::gemm_phase<pg8::EpiStore, pg8::DenseOrder, PG8_ALIGN, PG8_SP2>(lds, g, S, E); }
#else
        auto epi = [&](int r, int c, float a, float) { QKVC[(size_t)r * 3072 + c] = (u16)f2bf(a); };
        naive_gemm<false>(lds, HB, 1024, M / 128, w_qkv_c, nullptr, 1024, 3072, 3072, nullptr, 0, epi);
#endif
        GRID_BAR();
    }
    if (IN(15)) {
        for (int row = gw; row < ML; row += NGW) {
            const int t = row & 2047;
#pragma unroll 4
            for (int jj = 0; jj < 16; ++jj) { const int p = lane + 64 * jj, which = p >> 9, hh = (p & 511) >> 5, i = p & 31;
                u16* q = QKVC + (size_t)row * 3072 + which * 1024 + hh * 64;
                const float x1 = bf2f(q[i]), x2 = bf2f(q[32 + i]), cs = ROPEC[t * 32 + i], sn = ROPES[t * 32 + i];
                q[i] = (u16)f2bf(x1 * cs - x2 * sn); q[32 + i] = (u16)f2bf(x2 * cs + x1 * sn); }
        }
        GRID_BAR();
    }
    if (IN(16)) {
#if FAST_ATTN
        { const int NU = NB * 16 * 8;
          for (int u = blockIdx.x; u < NU; u += G) {
            const int qb = u & 7, j = (u >> 3) & 15, b = u >> 7;
            const int r0 = b * SEQ + qb * 256;
            fa::KVSrc S; S.k0 = QKVC + 1024 + j * 64; S.kst0 = 3072; S.k1 = QKVC; S.kst1 = 3072; S.split8 = 8; S.v = QKVC + 2048 + (j >> 1) * 128; S.vst = 3072;
            S.xrow0 = ML + b * CTXL; S.lrow0 = b * SEQ;
            __syncthreads();
            fa::attn_unit<64>(QKVC + (size_t)r0 * 3072 + j * 64, 3072, S, O16 + (size_t)r0 * 2048 + j * 128, 2048, 36, (char*)lds_raw);
          } }
#else
        const int NU = NB * 16 * 64;
        for (int u = blockIdx.x; u < NU; u += G) {
            const int qb = u & 63, j = (u >> 6) & 15, b = u >> 10;
            const int r0 = b * SEQ + qb * 32;
            auto krow = [&](int key) { return key < CTXL ? (ML + b * CTXL + key) : (b * SEQ + key - CTXL); };
            auto ql = [&](int r, int d) { return bf2f(QKVC[(size_t)(r0 + r) * 3072 + j * 64 + d]); };
            auto kl = [&](int key, int d) { return bf2f(QKVC[(size_t)krow(key) * 3072 + 1024 + j * 64 + d]); };
            auto vl = [&](int key, int d) { return bf2f(QKVC[(size_t)krow(key) * 3072 + 2048 + (j >> 1) * 128 + d]); };
            auto os = [&](int r, int d, float val) { O16[(size_t)(r0 + r) * 2048 + j * 128 + d] = (u16)f2bf(val); };
            naive_attn_unit<64>(lds, CTXL + SEQ, 0.125f, ql, kl, vl, os);
        }
#endif
        GRID_BAR();
    }
    if (IN(17)) {
#if FAST_GEMM
        { LAS float* scr = (LAS float*)(lds + wave * 8448); int off = 0;
#pragma unroll 1
          for (int e = 0; e < NE; ++e) {
              cvt_matrix8(moe_w_gate + (size_t)e * 1024 * ED, 1024, ED, W_MGU + (size_t)e * 2 * ED * 1024, 1024, 64.0f, map_gate, scr, lane, gw, NGW, off);
              cvt_matrix8(moe_w_up + (size_t)e * 1024 * ED, 1024, ED, W_MGU + (size_t)e * 2 * ED * 1024, 1024, 64.0f, map_up, scr, lane, gw, NGW, off);
              cvt_matrix8(moe_w_down + (size_t)e * ED * 1024, ED, 1024, W_MD + (size_t)e * 1024 * ED, ED, 64.0f, map_id, scr, lane, gw, NGW, off); } }
#endif
        const float s1 = wave_sum(diff_lq1[lane] * diff_lk1[lane]), s2 = wave_sum(diff_lq2[lane] * diff_lk2[lane]);
        const float lam = expf(s1) - expf(s2) + LAM_INIT;
        for (int row = gw; row < ML; row += NGW) {
            const int h = lane >> 3, v0 = (lane & 7) * 16;
            const u16* p1 = O16 + (size_t)row * 2048 + (2 * h) * 128 + v0; const u16* p2 = p1 + 128;
            float o[16]; float s = 0.f;
#pragma unroll
            for (int i = 0; i < 16; ++i) { o[i] = bf2f(p1[i]) - lam * bf2f(p2[i]); s += o[i] * o[i]; }
#pragma unroll
            for (int off = 1; off < 8; off <<= 1) s += __shfl_xor(s, off);
            const float r = 1.0f / sqrtf(s * (1.0f / 128.0f) + EPS);
            u16* po = CAT2 + (size_t)row * 1024 + h * 128 + v0;
#pragma unroll
            for (int i = 0; i < 16; ++i) po[i] = (u16)f2bf(o[i] * r * diff_g_out[v0 + i] * (1.0f - LAM_INIT));
        }
        GRID_BAR();
    }
    if (IN(18)) {
#if FAST_GEMM
        { pg8::Gemm g{CAT2, W_OC, 1024, 1024, 0, 0}; pg8::DenseOrder S; S.init(ML / 256, 4, G, (int)blockIdx.x); pg8::EpiStore E{Y2, 1024};
          pg8::gemm_phase<pg8::EpiStore, pg8::DenseOrder, PG8_ALIGN, PG8_SP2>(lds, g, S, E); }
#else
        auto epi = [&](int r, int c, float a, float) { Y2[(size_t)r * 1024 + c] = (u16)f2bf(a); };
        naive_gemm<false>(lds, CAT2, 1024, ML / 128, w_out_c, nullptr, 1024, 1024, 1024, nullptr, 0, epi);
#endif
        GRID_BAR();
    }
    if (IN(19)) {
        LAS int* lcnt = (LAS int*)lds;
        LAS int* gbase = lcnt + 8;
        LAS int* le = gbase + 8;
        LAS int* lr = le + 256;
        LAS float* lg = (LAS float*)(lr + 256);
        for (int base = blockIdx.x * 128; base < ML; base += G * 128) {
            __syncthreads();
            if (tid < 8) lcnt[tid] = 0;
            __syncthreads();
            for (int i = 0; i < 16; ++i) {
                const int lrow = wave * 16 + i, row = base + lrow;
                float* dst = out + (size_t)row * 1024;
                const int mr = row >> 11;
                f32x4 xv[4], tv[4], hv[4]; ld_row_f32(dst, lane, xv); ld_row_bf16(Y2 + (size_t)row * 1024, lane, tv);
                rms_apply(tv, g_post_mix + 1024, lane);
                const float* gate = modp(ws, 1, mr, 2);
#pragma unroll
                for (int j = 0; j < 4; ++j) xv[j] = xv[j] + *(const f32x4*)(gate + 4 * lane + 256 * j) * tv[j];
                st_row_f32(dst, lane, xv);
                premod(xv, hv, g_pre_ffn + 1024, modp(ws, 1, mr, 3), modp(ws, 1, mr, 4), lane);
                st_row_bf16(HC + (size_t)row * 1024, lane, hv);
                float lg8[8];
#pragma unroll
                for (int e = 0; e < 8; ++e) lg8[e] = 0.f;
#pragma unroll
                for (int j = 0; j < 4; ++j)
#pragma unroll
                    for (int q = 0; q < 4; ++q) { const int k = 4 * lane + 256 * j + q; const float hvv = hv[j][q];
                        const f32x4 wa = *(const f32x4*)(moe_w_router + (size_t)k * 8), wb = *(const f32x4*)(moe_w_router + (size_t)k * 8 + 4);
                        lg8[0] += hvv * wa.x; lg8[1] += hvv * wa.y; lg8[2] += hvv * wa.z; lg8[3] += hvv * wa.w;
                        lg8[4] += hvv * wb.x; lg8[5] += hvv * wb.y; lg8[6] += hvv * wb.z; lg8[7] += hvv * wb.w; }
#pragma unroll
                for (int e = 0; e < 8; ++e) lg8[e] = wave_sum(lg8[e]);
                if (lane == 0) {
                    int e0 = 0; float v0 = lg8[0];
#pragma unroll
                    for (int e = 1; e < 8; ++e) if (lg8[e] > v0) { v0 = lg8[e]; e0 = e; }
                    int e1 = -1; float v1 = -3.0e38f;
#pragma unroll
                    for (int e = 0; e < 8; ++e) if (e != e0 && lg8[e] > v1) { v1 = lg8[e]; e1 = e; }
                    const float g0 = 1.0f / (1.0f + expf(v1 - v0));
                    le[lrow * 2] = e0; le[lrow * 2 + 1] = e1; lg[lrow * 2] = g0; lg[lrow * 2 + 1] = 1.0f - g0;
                    lr[lrow * 2] = __hip_atomic_fetch_add(&lcnt[e0], 1, __ATOMIC_RELAXED, __HIP_MEMORY_SCOPE_WORKGROUP); lr[lrow * 2 + 1] = __hip_atomic_fetch_add(&lcnt[e1], 1, __ATOMIC_RELAXED, __HIP_MEMORY_SCOPE_WORKGROUP);
                }
            }
            __syncthreads();
            if (tid < 8) gbase[tid] = (int)atomicAdd(ctl + CW_ECNT + 64 * tid, (unsigned)lcnt[tid]);
            __syncthreads();
            if (tid < 256) { const int e = le[tid]; TOKE[(size_t)base * 2 + tid] = e; TOKG[(size_t)base * 2 + tid] = lg[tid]; TOKP[(size_t)base * 2 + tid] = gbase[e] + lr[tid]; }
        }
        GRID_BAR();
    }
    if (IN(20)) {
        LAS int* pst = (LAS int*)lds;
        if (tid == 0) { int acc = 0; for (int e = 0; e < 8; ++e) { pst[e] = acc; const int c = (int)ctl[CW_ECNT + 64 * e]; acc += (c + 255) / 256 * 256; } pst[8] = acc; }
        __syncthreads();
        if (blockIdx.x == 0) {
            if (tid == 0) ctl[CW_MOET] = (unsigned)(pst[8] / 256);
            for (int t = tid; t < pst[8] / 256; t += 512) { int e = 0; for (int q = 1; q < 8; ++q) if (t * 256 >= pst[q]) e = q; ctl[CW_TILEE + t] = (unsigned)e; }
        }
        for (int s = gw; s < 2 * ML; s += NGW) {
            const int e = TOKE[s], pos = pst[e] + TOKP[s];
#if FAST_GEMM
            { const uint4* src = (const uint4*)(HC + (size_t)(s >> 1) * 1024 + lane * 16); const uint4 a = src[0], b2 = src[1];
              const unsigned wv[8] = {a.x, a.y, a.z, a.w, b2.x, b2.y, b2.z, b2.w}; unsigned o4[4];
#pragma unroll
              for (int q = 0; q < 4; ++q) { unsigned t = 0u;
                  t = __builtin_amdgcn_cvt_pk_fp8_f32(pg8::clamp8(bf2f(wv[2 * q] & 0xffffu)), pg8::clamp8(bf2f(wv[2 * q] >> 16)), t, false);
                  t = __builtin_amdgcn_cvt_pk_fp8_f32(pg8::clamp8(bf2f(wv[2 * q + 1] & 0xffffu)), pg8::clamp8(bf2f(wv[2 * q + 1] >> 16)), t, true); o4[q] = t; }
              *(uint4*)(XS8 + (size_t)pos * 1024 + lane * 16) = make_uint4(o4[0], o4[1], o4[2], o4[3]); }
#else
            const uint4* src = (const uint4*)(HC + (size_t)(s >> 1) * 1024); uint4* dstp = (uint4*)(XS + (size_t)pos * 1024);
            const uint4 a = src[lane], b2 = src[lane + 64];
            dstp[lane] = a; dstp[lane + 64] = b2;
#endif
            if (lane == 0) TOKP[s] = pos;
        }
        GRID_BAR();
    }
    if (IN(21)) {
        const int T = (int)ctl[CW_MOET];
        for (int c0 = 0; c0 < T; c0 += CHUNK_T) {
            const int nt = (T - c0) < CHUNK_T ? (T - c0) : CHUNK_T;
#if FAST_GEMM
            { pg8::Gemm g{XS8, W_MGU, 1024, 1024, 0x7f7f7f7f, 0x79797979}; pg8::MoeOrder S; S.init(nt, 2 * ED / 256, G, (int)blockIdx.x); S.tile_e = ctl + CW_TILEE + c0; S.nper = 2 * ED / 256; S.a_off = c0; S.o_off = 0;
              pg8::EpiSwiglu8 E{HIDC8, ED, 1.0f, 8.0f};
              pg8::gemm_phase<pg8::EpiSwiglu8, pg8::MoeOrder, PG8_ALIGN, PG8_SP2, 1>(lds, g, S, E); }
#else
            { auto epi = [&](int r, int c, float a, float b2) { HIDC[(size_t)r * ED + c] = (u16)f2bf(silu_f(a) * b2); };
              naive_gemm<true>(lds, XS + (size_t)c0 * 256 * 1024, 1024, nt * 2, moe_w_gate, moe_w_up, 1024, ED, ED, ctl + CW_TILEE + c0, (size_t)1024 * ED, epi); }
#endif
            GRID_BAR();
#if FAST_GEMM
            { pg8::Gemm g{HIDC8, W_MD, ED, ED, 0x7c7c7c7c, 0x79797979}; pg8::MoeOrder S; S.init(nt, 4, G, (int)blockIdx.x); S.tile_e = ctl + CW_TILEE + c0; S.nper = 4; S.a_off = 0; S.o_off = c0;
              pg8::EpiStore E{XS, 1024};
              pg8::gemm_phase<pg8::EpiStore, pg8::MoeOrder, PG8_ALIGN, PG8_SP2, 1>(lds, g, S, E); }
#else
            { u16* ys = XS + (size_t)c0 * 256 * 1024;
              auto epi = [&](int r, int c, float a, float) { ys[(size_t)r * 1024 + c] = (u16)f2bf(a); };
              naive_gemm<false>(lds, HIDC, ED, nt * 2, moe_w_down, nullptr, ED, 1024, 1024, ctl + CW_TILEE + c0, (size_t)ED * 1024, epi); }
#endif
            GRID_BAR();
        }
    }
    if (IN(22)) {
        for (int row = gw; row < ML; row += NGW) {
            float* dst = out + (size_t)row * 1024;
            const int mr = row >> 11;
            const int p0 = TOKP[row * 2], p1 = TOKP[row * 2 + 1]; const float g0 = TOKG[row * 2], g1 = TOKG[row * 2 + 1];
            f32x4 xv[4], a[4], b2[4]; ld_row_f32(dst, lane, xv); ld_row_bf16(XS + (size_t)p0 * 1024, lane, a); ld_row_bf16(XS + (size_t)p1 * 1024, lane, b2);
#pragma unroll
            for (int j = 0; j < 4; ++j) a[j] = a[j] * g0 + b2[j] * g1;
            rms_apply(a, g_post_ffn + 1024, lane);
            const float* gate = modp(ws, 1, mr, 5);
#pragma unroll
            for (int j = 0; j < 4; ++j) xv[j] = xv[j] + *(const f32x4*)(gate + 4 * lane + 256 * j) * a[j];
            st_row_f32(dst, lane, xv);
        }
    }
#undef IN
#undef GRID_BAR
}

extern "C" void kernel_launch(void* const* d_in, const int* in_sizes, int n_in, void* d_out, int out_size, void* d_ws, size_t ws_size, hipStream_t stream) {
    static int grid = 0;
    if (grid == 0) {
        if (n_in != 35 || in_sizes[0] != ML * D || out_size != ML * D || ws_size < WS_END) {
            fprintf(stderr, "kernel_launch: shape mismatch n_in %d in0 %d out %d ws %zu (need %zu)\n", n_in, n_in > 0 ? in_sizes[0] : -1, out_size, ws_size, (size_t)WS_END); grid = -1; return; }
        int dev = 0, cus = 0, per_cu = 0;
        if (hipGetDevice(&dev) != hipSuccess || hipDeviceGetAttribute(&cus, hipDeviceAttributeMultiprocessorCount, dev) != hipSuccess) { grid = -1; return; }
        if (hipFuncSetAttribute((const void*)fwd_kernel, hipFuncAttributeMaxDynamicSharedMemorySize, LDS_BYTES) != hipSuccess) { fprintf(stderr, "kernel_launch: hipFuncSetAttribute failed\n"); grid = -1; return; }
        if (hipOccupancyMaxActiveBlocksPerMultiprocessor(&per_cu, (const void*)fwd_kernel, 512, LDS_BYTES) != hipSuccess || per_cu < 1)
            fprintf(stderr, "kernel_launch: occupancy query reports %d\n", per_cu);
        (void)hipGetLastError();
        grid = cus;
    }
    if (grid < 0) return;
    if (hipMemsetAsync((char*)d_ws + WS_CTL, 0, CTL_ZERO_BYTES, stream) != hipSuccess) return;
    Args a{};
    for (int i = 0; i < 35; ++i) a.in[i] = (const float*)d_in[i];
    a.out = (float*)d_out; a.ws = (unsigned char*)d_ws; a.ph_lo = 0; a.ph_hi = 100; a.li = 0; a.pad = 0;
    hipLaunchKernelGGL(fwd_kernel, dim3(grid), dim3(512), LDS_BYTES, stream, a);
#ifdef PROBE_PHASES
    { const int pp[] = {PROBE_PHASES}; int li = 1;
      for (int k : pp) { a.ph_lo = k; a.ph_hi = k + 1; a.li = li++; hipLaunchKernelGGL(fwd_kernel, dim3(grid), dim3(512), LDS_BYTES, stream, a); } }
#endif
}
```

```cpp
#include <hip/hip_runtime.h>
#include <cstdio>
#include <cstdint>

constexpr int D = 1024, NB = 16, SEQ = 2048, CTXL = 256;
constexpr int ML = NB * SEQ, MX = NB * CTXL, M = ML + MX;
constexpr int IN_A = 2016, IN_AP = 2048;
constexpr int C_CQ = 0, C_CKV = 256, C_KR = 384, C_GQ = 448, C_GK = 704, C_GV = 960, C_GR = 1472, C_AF = 1984, C_AB = 2000;
constexpr int UPN = 1792;
constexpr int FFN = 2816, NE = 8, ED = 3584;
constexpr int CAP = 2 * ML + NE * 256, MAXT = CAP / 256;
constexpr float EPS = 1e-6f;
constexpr float LAM_INIT = 0.35550906759f;

constexpr size_t MiB = 1u << 20;
constexpr size_t WS_CTL = 0, CTL_ZERO_BYTES = 1 * MiB;
constexpr size_t WS_MOD = 1 * MiB;
constexpr size_t WS_ROPE = 2 * MiB;
constexpr size_t WS_TOKE = 2 * MiB + 512 * 1024;
constexpr size_t WS_TOKG = WS_TOKE + 256 * 1024;
constexpr size_t WS_TOKP = WS_TOKG + 256 * 1024;
constexpr size_t WS_CTXS = 4 * MiB;
constexpr size_t WS_W = 20 * MiB;
constexpr size_t WS_R0 = 52 * MiB;
constexpr size_t WS_PARTS = 124 * MiB;
constexpr size_t WS_Y = 124 * MiB;
constexpr size_t WS_H1 = 196 * MiB;
constexpr size_t WS_HC = 116 * MiB;
constexpr size_t WS_A2 = 268 * MiB;
constexpr size_t WS_KROPE = 295 * MiB;
constexpr size_t WS_R3 = 300 * MiB;
constexpr size_t WS_QKVUP = 372 * MiB;
constexpr size_t WS_WMD = 332 * MiB;
constexpr size_t WS_WMGU = 360 * MiB;
constexpr size_t WS_XS8 = 416 * MiB;
constexpr size_t WS_YS = 360 * MiB;
constexpr size_t WS_END = 516 * MiB;
constexpr int CW_BAR = 16384;
constexpr int CW_ECNT = 8192;
constexpr int CW_MOET = 9000;
constexpr int CW_TILEE = 9216;

typedef unsigned short u16;
typedef float f32x4 __attribute__((ext_vector_type(4)));
#define LAS __attribute__((address_space(3)))
constexpr int LDS_BYTES = 147456;
constexpr int MISC_OFF = 131072 + 320;

#define XB_TMO      128
#define XB_XCNT(j)  (256  + 64 * (j))
#define XB_XSUB(j)  (1280 + 64 * (j))
#define XB_XGEN(j)  (2304 + 64 * (j))
#define XB_TOP      3328
#define XB_TOPGEN   3392
#define XCD_BAR_WORDS 3456
#define XB_SPIN_CAP (1u << 23)
__device__ __forceinline__ unsigned xb_ld(unsigned* p)              { return __hip_atomic_load(p, __ATOMIC_RELAXED, __HIP_MEMORY_SCOPE_AGENT); }
__device__ __forceinline__ unsigned xb_add(unsigned* p, unsigned v) { return __hip_atomic_fetch_add(p, v, __ATOMIC_RELAXED, __HIP_MEMORY_SCOPE_AGENT); }
__device__ __forceinline__ unsigned xb_xcc_id() { return (unsigned)__builtin_amdgcn_s_getreg((3 << 11) | 20) & 0xFu; }
#define XB_SPIN(cond, bar) do { unsigned _sp = 0; while (cond) { __builtin_amdgcn_s_sleep(1); \
    if ((++_sp & 255u) == 0u) { if (xb_ld(&(bar)[XB_TMO])) break; if (_sp > XB_SPIN_CAP) { atomicAdd(&(bar)[XB_TMO], 1u); break; } } } } while (0)
struct XcdBarrier { unsigned* bar; unsigned x; volatile LAS unsigned* st; };
__device__ __forceinline__ XcdBarrier xcd_barrier_post(unsigned* bar, volatile LAS unsigned* st) {
    XcdBarrier b; b.bar = bar; b.x = xb_xcc_id(); b.st = st;
    if (threadIdx.x == 0) (void)xb_add(&bar[XB_XCNT(b.x)], 1u);
    return b;
}
__device__ __forceinline__ void xcd_barrier_complete(unsigned* bar, unsigned x, unsigned& nloc, unsigned& nx) {
    const unsigned G = gridDim.x * gridDim.y * gridDim.z;
    unsigned sum, cnt, mine, sp = 0u;
    for (;;) {
        sum = 0u; cnt = 0u; mine = 0u;
#pragma unroll
        for (unsigned j = 0; j < 16; ++j) { const unsigned c = xb_ld(&bar[XB_XCNT(j)]); sum += c; cnt += (c > 0u) ? 1u : 0u; mine = (j == x) ? c : mine; }
        if (sum == G) break;
        __builtin_amdgcn_s_sleep(1);
        if ((++sp & 255u) == 0u) { if (xb_ld(&bar[XB_TMO])) break; if (sp > XB_SPIN_CAP) { atomicAdd(&bar[XB_TMO], 1u); break; } }
    }
    nloc = mine > 0u ? mine : 1u; nx = cnt > 0u ? cnt : 1u;
}
__device__ __forceinline__ void xcd_barrier(const XcdBarrier& b) {
    asm volatile("s_waitcnt vmcnt(0)" ::: "memory");
    __syncthreads();
    if (threadIdx.x == 0) {
        unsigned* bar = b.bar;
        __builtin_amdgcn_s_waitcnt(0);
        unsigned nloc = b.st[0], nx = b.st[1];
        if (nloc == 0u) { xcd_barrier_complete(bar, b.x, nloc, nx); b.st[0] = nloc; b.st[1] = nx; }
        const unsigned old = xb_add(&bar[XB_XSUB(b.x)], 1u);
        const unsigned gen = old / nloc;
        if (old + 1u == (gen + 1u) * nloc) {
            __builtin_amdgcn_fence(__ATOMIC_RELEASE, "agent");
            asm volatile("s_waitcnt vmcnt(0)" ::: "memory");
            const unsigned og = xb_add(&bar[XB_TOP], 1u);
            const unsigned tg = og / nx;
            if (og + 1u == (tg + 1u) * nx) xb_add(&bar[XB_TOPGEN], 1u);
            else XB_SPIN(xb_ld(&bar[XB_TOPGEN]) == tg, bar);
            __builtin_amdgcn_fence(__ATOMIC_ACQUIRE, "agent");
            xb_add(&bar[XB_XGEN(b.x)], 1u);
            asm volatile("s_waitcnt vmcnt(0)" ::: "memory");
        } else {
            XB_SPIN(xb_ld(&bar[XB_XGEN(b.x)]) == gen, bar);
            __builtin_amdgcn_fence(__ATOMIC_ACQUIRE, "agent");
            asm volatile("s_waitcnt vmcnt(0)" ::: "memory");
        }
    }
    __syncthreads();
}

__device__ __forceinline__ float bf2f(unsigned h) { return __uint_as_float(h << 16); }
__device__ __forceinline__ unsigned f2bf(float f) { unsigned u = __float_as_uint(f); return (u + 0x7fffu + ((u >> 16) & 1u)) >> 16; }
__device__ __forceinline__ float wave_sum(float v) {
#pragma unroll
    for (int o = 1; o < 64; o <<= 1) v += __shfl_xor(v, o);
    return v;
}
__device__ __forceinline__ float silu_f(float x) { return x / (1.0f + __expf(-x)); }
__device__ __forceinline__ void ld_row_f32(const float* p, int lane, f32x4 (&v)[4]) {
#pragma unroll
    for (int j = 0; j < 4; ++j) v[j] = *(const f32x4*)(p + 4 * lane + 256 * j);
}
__device__ __forceinline__ void ld_row_bf16(const u16* p, int lane, f32x4 (&v)[4]) {
#pragma unroll
    for (int j = 0; j < 4; ++j) { const uint2 w = *(const uint2*)(p + 4 * lane + 256 * j);
        v[j] = (f32x4){bf2f(w.x & 0xffffu), bf2f(w.x >> 16), bf2f(w.y & 0xffffu), bf2f(w.y >> 16)}; }
}
__device__ __forceinline__ void st_row_f32(float* p, int lane, const f32x4 (&v)[4]) {
#pragma unroll
    for (int j = 0; j < 4; ++j) *(f32x4*)(p + 4 * lane + 256 * j) = v[j];
}
__device__ __forceinline__ void st_row_bf16(u16* p, int lane, const f32x4 (&v)[4]) {
#pragma unroll
    for (int j = 0; j < 4; ++j) { uint2 w; w.x = f2bf(v[j].x) | (f2bf(v[j].y) << 16); w.y = f2bf(v[j].z) | (f2bf(v[j].w) << 16);
        *(uint2*)(p + 4 * lane + 256 * j) = w; }
}
__device__ __forceinline__ float row_rstd(const f32x4 (&v)[4]) {
    float s = 0.f;
#pragma unroll
    for (int j = 0; j < 4; ++j) s += (v[j].x * v[j].x + v[j].y * v[j].y) + (v[j].z * v[j].z + v[j].w * v[j].w);
    s = wave_sum(s);
    return 1.0f / sqrtf(s * (1.0f / 1024.0f) + EPS);
}
__device__ __forceinline__ void rms_apply(f32x4 (&v)[4], const float* g, int lane) {
    const float r = row_rstd(v);
#pragma unroll
    for (int j = 0; j < 4; ++j) { const f32x4 gg = *(const f32x4*)(g + 4 * lane + 256 * j); v[j] = v[j] * r * gg; }
}
__device__ __forceinline__ void premod(const f32x4 (&x)[4], f32x4 (&h)[4], const float* g, const float* shift, const float* scale, int lane) {
    const float r = row_rstd(x);
#pragma unroll
    for (int j = 0; j < 4; ++j) { const int c = 4 * lane + 256 * j; const f32x4 gg = *(const f32x4*)(g + c), sh = *(const f32x4*)(shift + c), sc = *(const f32x4*)(scale + c);
        h[j] = x[j] * r * gg * (1.0f + sc) + sh; }
}

struct Args { const float* in[35]; float* out; unsigned char* ws; int ph_lo, ph_hi, li, pad; };

__device__ __forceinline__ const float* modp(const unsigned char* ws, int l, int r, int which) { return (const float*)(ws + WS_MOD) + ((size_t)(l * 17 + r) * 6 + which) * 1024; }

#ifndef PG8_SP2
#define PG8_SP2 true
#endif
#ifndef PG8_ALIGN
#define PG8_ALIGN true
#endif
namespace pg8 {
typedef short bf16x8 __attribute__((ext_vector_type(8)));
typedef unsigned u32x4 __attribute__((ext_vector_type(4)));
typedef int v8i __attribute__((ext_vector_type(8)));
typedef int v4i __attribute__((ext_vector_type(4)));
typedef unsigned u32x2 __attribute__((ext_vector_type(2)));
constexpr int BM = 256, BK = 64, HALF = 128, HTB = HALF * BK * 2, STAGE_BYTES = 8 * HTB, NXCD = 8, WGM = 8;
__host__ __device__ __forceinline__ int lds_byte(int r, int c) { const int st = (r >> 4) * 2 + (c >> 5), rr = r & 15, cc = c & 31, ob = rr * 64 + cc * 2; return st * 1024 + (ob ^ (((ob >> 9) & 1) << 5)); }
__host__ __device__ __forceinline__ void stage_rc(int b, int& R, int& C) { const int st = b / 1024, sb = b % 1024, swz = sb ^ (((sb >> 9) & 1) << 5); R = (st >> 1) * 16 + swz / 64; C = (st & 1) * 32 + (swz % 64) / 2; }
__host__ __device__ __forceinline__ int perm32(int rho) { const int n = rho >> 4, i = rho & 15; return 8 * (i >> 2) + 4 * n + (i & 3); }

struct Unit { int pm, pn, po, pc; };
struct Gemm { const void* A; const void* Bt; int lda; int K; int sa, sb; };

struct DenseOrder {
    int nM, nN, nwg, G, c;
    __device__ __forceinline__ void init(int nM_, int nN_, int G_, int c_) { nM = nM_; nN = nN_; nwg = nM * nN; G = G_; c = c_; }
    __device__ __forceinline__ bool next2(int i, int& pm, int& pn) const {
        const long L = (long)i * G + c; if (L >= nwg) return false;
        int wgid = (int)L; { const int q = nwg / NXCD, r = nwg % NXCD, xcd = wgid % NXCD, off = wgid / NXCD; wgid = (xcd < r ? xcd * (q + 1) : r * (q + 1) + (xcd - r) * q) + off; }
        const int nig = WGM * nN, gid = wgid / nig, fm = gid * WGM, gsz = (nM - fm) < WGM ? (nM - fm) : WGM;
        pm = fm + ((wgid % nig) % gsz); pn = (wgid % nig) / gsz; return true;
    }
    __device__ __forceinline__ bool next(int i, Unit& u) const { int pm, pn; if (!next2(i, pm, pn)) return false; u.pm = pm; u.pn = pn; u.po = pm; u.pc = pn; return true; }
    __device__ __forceinline__ void a_ready(const Unit&) const {}
    __device__ __forceinline__ void done(const Unit&) const {}
};
struct MoeOrder : DenseOrder {
    const unsigned* tile_e; int nper, a_off, o_off;
    __device__ __forceinline__ bool next(int i, Unit& u) const { int pm, pn; if (!next2(i, pm, pn)) return false;
        const int e = (int)tile_e[pm]; u.pm = a_off + pm; u.pn = e * nper + pn; u.po = o_off + pm; u.pc = pn; return true; }
};

__device__ __forceinline__ unsigned cvt_pk_bf16(float lo, float hi) { unsigned r; asm volatile("v_cvt_pk_bf16_f32 %0, %1, %2" : "=v"(r) : "v"(lo), "v"(hi)); return r; }

struct EpiStore {
    static constexpr bool PERM = true, AFTER_DRAIN = false;
    u16* O; int ldc;
    __device__ __forceinline__ void operator()(const f32x4 (&acc)[2][2][4][2], const Unit& u, int wr, int wc, int fr, int fq) const {
        const int row0 = u.po * BM + wr * 64 + fr, col0 = u.pc * BM + wc * 32 + 8 * fq;
#pragma unroll
        for (int ai = 0; ai < 2; ++ai)
#pragma unroll
            for (int m = 0; m < 4; ++m) { u16* rowp = O + (size_t)(row0 + ai * HALF + m * 16) * ldc + col0;
#pragma unroll
                for (int bj = 0; bj < 2; ++bj) { const f32x4 v0 = acc[ai][bj][m][0], v1 = acc[ai][bj][m][1];
                    u32x4 w; w.x = cvt_pk_bf16(v0[0], v0[1]); w.y = cvt_pk_bf16(v0[2], v0[3]); w.z = cvt_pk_bf16(v1[0], v1[1]); w.w = cvt_pk_bf16(v1[2], v1[3]);
                    *(u32x4*)(rowp + bj * HALF) = w; } }
    }
};
template <int MODE> struct EpiStoreRope {
    static constexpr bool PERM = true, AFTER_DRAIN = false;
    u16* O; int ldc; const float* rc; const float* rs;
    __device__ __forceinline__ void operator()(const f32x4 (&acc)[2][2][4][2], const Unit& u, int wr, int wc, int fr, int fq) const {
        const int row0 = u.po * BM + wr * 64 + fr, col0 = u.pc * BM + wc * 32 + 8 * fq;
        const bool lat = u.po * BM < ML;
#pragma unroll
        for (int ai = 0; ai < 2; ++ai)
#pragma unroll
            for (int m = 0; m < 4; ++m) { const int row = row0 + ai * HALF + m * 16; u16* rowp = O + (size_t)row * ldc + col0; const int t = row & (SEQ - 1);
#pragma unroll
                for (int bj = 0; bj < 2; ++bj) { f32x4 v0 = acc[ai][bj][m][0], v1 = acc[ai][bj][m][1];
                    const int c8 = col0 + bj * HALF;
                    const bool rope = lat && (MODE == 0 ? (c8 < 2048) : (c8 < 768 && (c8 % 192) >= 128));
                    if (rope) { const int i0 = (c8 & 63) >> 1; const f32x4 cs = *(const f32x4*)(rc + t * 32 + i0), sn = *(const f32x4*)(rs + t * 32 + i0);
                        const f32x4 a = v0, b = v1;
                        v0[0] = a[0] * cs[0] - a[1] * sn[0]; v0[1] = a[1] * cs[0] + a[0] * sn[0]; v0[2] = a[2] * cs[1] - a[3] * sn[1]; v0[3] = a[3] * cs[1] + a[2] * sn[1];
                        v1[0] = b[0] * cs[2] - b[1] * sn[2]; v1[1] = b[1] * cs[2] + b[0] * sn[2]; v1[2] = b[2] * cs[3] - b[3] * sn[3]; v1[3] = b[3] * cs[3] + b[2] * sn[3]; }
                    u32x4 w; w.x = cvt_pk_bf16(v0[0], v0[1]); w.y = cvt_pk_bf16(v0[2], v0[3]); w.z = cvt_pk_bf16(v1[0], v1[1]); w.w = cvt_pk_bf16(v1[2], v1[3]);
                    *(u32x4*)(rowp + bj * HALF) = w; } }
    }
};
struct EpiSwiglu {
    static constexpr bool PERM = true, AFTER_DRAIN = false;
    u16* O; int ldc;
    __device__ __forceinline__ void operator()(const f32x4 (&acc)[2][2][4][2], const Unit& u, int wr, int wc, int fr, int fq) const {
        const int row0 = u.po * BM + wr * 64 + fr, col0 = u.pc * HALF + wc * 32 + 8 * fq;
#pragma unroll
        for (int ai = 0; ai < 2; ++ai)
#pragma unroll
            for (int m = 0; m < 4; ++m) { u16* rowp = O + (size_t)(row0 + ai * HALF + m * 16) * ldc + col0;
                float hv[8];
#pragma unroll
                for (int n = 0; n < 2; ++n)
#pragma unroll
                    for (int q = 0; q < 4; ++q) { const float g = acc[ai][0][m][n][q], up = acc[ai][1][m][n][q]; hv[n * 4 + q] = g * __builtin_amdgcn_rcpf(1.0f + __expf(-g)) * up; }
                u32x4 w; w.x = cvt_pk_bf16(hv[0], hv[1]); w.y = cvt_pk_bf16(hv[2], hv[3]); w.z = cvt_pk_bf16(hv[4], hv[5]); w.w = cvt_pk_bf16(hv[6], hv[7]);
                *(u32x4*)rowp = w; }
    }
};

__device__ __forceinline__ float clamp8(float x) { return fminf(fmaxf(x, -448.0f), 448.0f); }
__device__ __forceinline__ unsigned cvt_pk4_fp8(float a, float b, float c, float d) { unsigned r;
    asm volatile("v_cvt_pk_fp8_f32 %0, %1, %2\n\tv_cvt_pk_fp8_f32 %0, %3, %4 op_sel:[0,0,1]" : "=&v"(r) : "v"(a), "v"(b), "v"(c), "v"(d)); return r; }
struct EpiSwiglu8 {
    static constexpr bool PERM = true, AFTER_DRAIN = false;
    unsigned char* O; int ldc; float gs, oscale;
    __device__ __forceinline__ void operator()(const f32x4 (&acc)[2][2][4][2], const Unit& u, int wr, int wc, int fr, int fq) const {
        const int row0 = u.po * BM + wr * 64 + fr, col0 = u.pc * HALF + wc * 32 + 8 * fq;
#pragma unroll
        for (int ai = 0; ai < 2; ++ai)
#pragma unroll
            for (int m = 0; m < 4; ++m) { unsigned char* rowp = O + (size_t)(row0 + ai * HALF + m * 16) * ldc + col0;
                float hv[8];
#pragma unroll
                for (int n = 0; n < 2; ++n)
#pragma unroll
                    for (int q = 0; q < 4; ++q) { const float gt = acc[ai][0][m][n][q] * gs, up = acc[ai][1][m][n][q] * gs; hv[n * 4 + q] = clamp8(gt * __builtin_amdgcn_rcpf(1.0f + __expf(-gt)) * up * oscale); }
                u32x2 w; w.x = cvt_pk4_fp8(hv[0], hv[1], hv[2], hv[3]); w.y = cvt_pk4_fp8(hv[4], hv[5], hv[6], hv[7]); *(u32x2*)rowp = w; }
    }
};
template <class Epi, class Sched, bool ALIGN_EPI = false, bool SP2 = false, int EB = 2>
__device__ __forceinline__ void gemm_phase(LAS unsigned char* lds, const Gemm g, const Sched& S, const Epi& E) {
    const int tid = threadIdx.x, wid = __builtin_amdgcn_readfirstlane(tid >> 6), lane = tid & 63, wr = wid >> 2, wc = wid & 3, fr = lane & 15, fq = lane >> 4;
    const int K = g.K, nt = K * EB / (BK * 2), lda = g.lda;
    const auto rsA = __builtin_amdgcn_make_buffer_rsrc((void*)g.A, 0, 0x7fffffff, 0x00020000);
    const auto rsB = __builtin_amdgcn_make_buffer_rsrc((void*)g.Bt, 0, 0x7fffffff, 0x00020000);
    unsigned voffA, voffB;
    { int R, C; stage_rc(tid * 16, R, C); const int Rb = Epi::PERM ? ((R & ~31) + perm32(R & 31)) : R;
      voffA = (unsigned)(R * lda * EB + C * 2); voffB = (unsigned)(Rb * K * EB + C * 2); }
    const unsigned kstep = (unsigned)(BK * 2);
    const unsigned hA = (unsigned)(HALF * lda * EB), hB = (unsigned)(HALF * K * EB);
    const unsigned qA = hA >> 1, qB = hB >> 1;
    const unsigned tA = 2 * hA, tB = 2 * hB;
    const unsigned ldsw = (unsigned)wid * 1024u;
    const int aoff = lds_byte(wr * 64 + fr, fq * (EB == 2 ? 8 : 16)), boff = lds_byte(wc * 32 + fr, fq * (EB == 2 ? 8 : 16));
#define PG8_SA(b, h) (((b) * 2 + (h)) * HTB)
#define PG8_SB(b, h) ((4 + (b) * 2 + (h)) * HTB)
#define PG8_STAGE_A(bufoff, soff) do { __builtin_amdgcn_raw_ptr_buffer_load_lds(rsA, (LAS unsigned*)(lds + (bufoff) + ldsw), 16, voffA, (soff), 0, 0); \
        __builtin_amdgcn_raw_ptr_buffer_load_lds(rsA, (LAS unsigned*)(lds + (bufoff) + ldsw + 8192), 16, voffA, (soff) + qA, 0, 0); } while (0)
#define PG8_STAGE_B(bufoff, soff) do { __builtin_amdgcn_raw_ptr_buffer_load_lds(rsB, (LAS unsigned*)(lds + (bufoff) + ldsw), 16, voffB, (soff), 0, 0); \
        __builtin_amdgcn_raw_ptr_buffer_load_lds(rsB, (LAS unsigned*)(lds + (bufoff) + ldsw + 8192), 16, voffB, (soff) + qB, 0, 0); } while (0)
#define PG8_LDA(dst, b, h) do { if constexpr (EB == 2) { _Pragma("unroll") for (int m = 0; m < 4; ++m) _Pragma("unroll") for (int k = 0; k < 2; ++k) dst[m][k] = *(const LAS bf16x8*)(lds + PG8_SA(b, h) + aoff + m * 2048 + k * 1024); } \
        else { _Pragma("unroll") for (int m = 0; m < 4; ++m) dst##8[m] = __builtin_shufflevector(*(const LAS v4i*)(lds + PG8_SA(b, h) + aoff + m * 2048), *(const LAS v4i*)(lds + PG8_SA(b, h) + aoff + m * 2048 + 16), 0, 1, 2, 3, 4, 5, 6, 7); } } while (0)
#define PG8_LDB(dst, b, h) do { if constexpr (EB == 2) { _Pragma("unroll") for (int n = 0; n < 2; ++n) _Pragma("unroll") for (int k = 0; k < 2; ++k) dst[n][k] = *(const LAS bf16x8*)(lds + PG8_SB(b, h) + boff + n * 2048 + k * 1024); } \
        else { _Pragma("unroll") for (int n = 0; n < 2; ++n) dst##8[n] = __builtin_shufflevector(*(const LAS v4i*)(lds + PG8_SB(b, h) + boff + n * 2048), *(const LAS v4i*)(lds + PG8_SB(b, h) + boff + n * 2048 + 16), 0, 1, 2, 3, 4, 5, 6, 7); } } while (0)
#define PG8_MMA(ai, bj, At, Bt) do { __builtin_amdgcn_s_setprio(1); _Pragma("unroll") for (int m = 0; m < 4; ++m) _Pragma("unroll") for (int n = 0; n < 2; ++n) { \
        if constexpr (EB == 2) { _Pragma("unroll") for (int k = 0; k < 2; ++k) acc[ai][bj][m][n] = __builtin_amdgcn_mfma_f32_16x16x32_bf16(Bt[n][k], At[m][k], acc[ai][bj][m][n], 0, 0, 0); } \
        else { asm volatile("v_mfma_scale_f32_16x16x128_f8f6f4 %0, %1, %2, %0, %3, %4 op_sel_hi:[0,0,0]" : "+v"(acc[ai][bj][m][n]) : "v"(Bt##8[n]), "v"(At##8[m]), "v"(vsb), "v"(vsa)); } } \
        __builtin_amdgcn_s_setprio(0); } while (0)
#define PG8_WAIT_V(n) asm volatile("s_waitcnt vmcnt(" #n ")" ::: "memory")
#define PG8_WAIT_L(n) asm volatile("s_waitcnt lgkmcnt(" #n ")" ::: "memory")
#define PG8_BAR __builtin_amdgcn_s_barrier()
#define PG8_SCHED __builtin_amdgcn_sched_barrier(0)
    Unit cur, nxt; int ui = 0;
    if (!S.next(0, cur)) return;
    int vsa = g.sa, vsb = g.sb; asm volatile("" : "+v"(vsa), "+v"(vsb));
    f32x4 acc[2][2][4][2];
#pragma unroll
    for (int a = 0; a < 2; ++a)
#pragma unroll
        for (int b = 0; b < 2; ++b)
#pragma unroll
            for (int m = 0; m < 4; ++m)
#pragma unroll
                for (int n = 0; n < 2; ++n) acc[a][b][m][n] = (f32x4){0.f, 0.f, 0.f, 0.f};
    bf16x8 At[4][2], B0[2][2], B1[2][2]; v8i At8[4], B08[2], B18[2];
    unsigned cA = (unsigned)cur.pm * tA, cB = (unsigned)cur.pn * tB;
    S.a_ready(cur);
    if constexpr (SP2) {
        PG8_STAGE_B(PG8_SB(0, 0), cB); PG8_STAGE_B(PG8_SB(0, 1), cB + hB); PG8_STAGE_A(PG8_SA(0, 0), cA); PG8_STAGE_A(PG8_SA(0, 1), cA + hA);
        if (wr == 1) PG8_BAR;
        PG8_WAIT_V(2); PG8_BAR;
        PG8_STAGE_B(PG8_SB(1, 0), cB + kstep); PG8_STAGE_A(PG8_SA(1, 0), cA + kstep); PG8_STAGE_B(PG8_SB(1, 1), cB + hB + kstep);
        PG8_WAIT_V(6); PG8_BAR;
    } else {
        PG8_STAGE_B(PG8_SB(0, 0), cB); PG8_STAGE_A(PG8_SA(0, 0), cA); PG8_STAGE_B(PG8_SB(0, 1), cB + hB); PG8_STAGE_A(PG8_SA(0, 1), cA + hA);
        if (wr == 1) PG8_BAR;
        PG8_WAIT_V(4); PG8_BAR;
        PG8_STAGE_B(PG8_SB(1, 0), cB + kstep); PG8_STAGE_A(PG8_SA(1, 0), cA + kstep); PG8_STAGE_B(PG8_SB(1, 1), cB + hB + kstep);
        PG8_WAIT_V(6); PG8_BAR;
    }
    for (;;) {
        const bool has_next = S.next(ui + 1, nxt);
        const unsigned nA = has_next ? (unsigned)nxt.pm * tA : cA, nB = has_next ? (unsigned)nxt.pn * tB : cB;
#pragma unroll 1
        for (int t = 0; t < nt; t += 2) {
            const bool last = (t == nt - 2);
            const unsigned a1 = cA + (unsigned)(t + 1) * kstep;
            const unsigned a2 = last ? nA : cA + (unsigned)(t + 2) * kstep, b2 = last ? nB : cB + (unsigned)(t + 2) * kstep;
            const unsigned a3 = a2 + kstep, b3 = b2 + kstep;
            if (last && has_next) S.a_ready(nxt);
            if constexpr (SP2) {
            PG8_LDB(B0, 0, 0); PG8_LDB(B1, 0, 1); PG8_SCHED; PG8_LDA(At, 0, 0); PG8_STAGE_A(PG8_SA(1, 1), a1 + hA);
            PG8_WAIT_V(8); PG8_WAIT_L(0); PG8_BAR; PG8_MMA(0, 0, At, B0); PG8_MMA(0, 1, At, B1); PG8_BAR; PG8_SCHED;
            PG8_LDA(At, 0, 1); PG8_STAGE_B(PG8_SB(0, 0), b2); PG8_STAGE_B(PG8_SB(0, 1), b2 + hB); PG8_STAGE_A(PG8_SA(0, 0), a2);
            PG8_WAIT_V(8); PG8_WAIT_L(0); PG8_BAR; PG8_MMA(1, 0, At, B0); PG8_MMA(1, 1, At, B1); PG8_BAR; PG8_SCHED;
            PG8_LDB(B0, 1, 0); PG8_LDB(B1, 1, 1); PG8_SCHED; PG8_LDA(At, 1, 0); PG8_STAGE_A(PG8_SA(0, 1), a2 + hA);
            PG8_WAIT_V(8); PG8_WAIT_L(0); PG8_BAR; PG8_MMA(0, 0, At, B0); PG8_MMA(0, 1, At, B1); PG8_BAR; PG8_SCHED;
            PG8_LDA(At, 1, 1); PG8_STAGE_B(PG8_SB(1, 0), b3); PG8_STAGE_B(PG8_SB(1, 1), b3 + hB); PG8_STAGE_A(PG8_SA(1, 0), a3);
            PG8_WAIT_V(8); PG8_WAIT_L(0); PG8_BAR; PG8_MMA(1, 0, At, B0); PG8_MMA(1, 1, At, B1); PG8_BAR; PG8_SCHED;
            } else {
            PG8_LDB(B0, 0, 0); PG8_SCHED; PG8_LDA(At, 0, 0); PG8_STAGE_A(PG8_SA(1, 1), a1 + hA);
            PG8_WAIT_L(8); PG8_BAR; PG8_WAIT_L(0); PG8_MMA(0, 0, At, B0); PG8_BAR; PG8_SCHED;
            PG8_LDB(B1, 0, 1); PG8_STAGE_B(PG8_SB(0, 0), b2);
            PG8_BAR; PG8_WAIT_L(0); PG8_MMA(0, 1, At, B1); PG8_BAR;
            PG8_LDA(At, 0, 1); PG8_STAGE_A(PG8_SA(0, 0), a2);
            PG8_BAR; PG8_WAIT_L(0); PG8_MMA(1, 0, At, B0); PG8_BAR; PG8_SCHED;
            PG8_STAGE_B(PG8_SB(0, 1), b2 + hB);
            PG8_WAIT_V(6); PG8_BAR; PG8_MMA(1, 1, At, B1); PG8_BAR;
            PG8_LDB(B0, 1, 0); PG8_SCHED; PG8_LDA(At, 1, 0); PG8_STAGE_A(PG8_SA(0, 1), a2 + hA);
            PG8_WAIT_L(8); PG8_BAR; PG8_WAIT_L(0); PG8_MMA(0, 0, At, B0); PG8_BAR; PG8_SCHED;
            PG8_LDB(B1, 1, 1); PG8_STAGE_B(PG8_SB(1, 0), b3);
            PG8_BAR; PG8_WAIT_L(0); PG8_MMA(0, 1, At, B1); PG8_BAR;
            PG8_LDA(At, 1, 1); PG8_STAGE_A(PG8_SA(1, 0), a3);
            PG8_BAR; PG8_WAIT_L(0); PG8_MMA(1, 0, At, B0); PG8_BAR; PG8_SCHED;
            PG8_STAGE_B(PG8_SB(1, 1), b3 + hB);
            PG8_WAIT_V(6); PG8_BAR; PG8_MMA(1, 1, At, B1); PG8_BAR;
            }
        }
        if constexpr (ALIGN_EPI) { if (wr == 0) PG8_BAR; }
        if constexpr (EB == 1) asm volatile("s_nop 15\n\ts_nop 15" ::: "memory");
        E(acc, cur, wr, wc, fr, fq); S.done(cur);
        if (!has_next) break;
#pragma unroll
        for (int a = 0; a < 2; ++a)
#pragma unroll
            for (int b = 0; b < 2; ++b)
#pragma unroll
                for (int m = 0; m < 4; ++m)
#pragma unroll
                    for (int n = 0; n < 2; ++n) acc[a][b][m][n] = (f32x4){0.f, 0.f, 0.f, 0.f};
        cur = nxt; cA = nA; cB = nB; ++ui;
        if constexpr (EB == 1) asm volatile("s_nop 7" ::: "memory");
        if constexpr (ALIGN_EPI) { if (wr == 1) PG8_BAR; }
    }
    PG8_WAIT_V(0);
    if constexpr (!ALIGN_EPI) { if (wr == 0) PG8_BAR; }
    PG8_BAR;
#undef PG8_SA
#undef PG8_SB
#undef PG8_STAGE_A
#undef PG8_STAGE_B
#undef PG8_LDA
#undef PG8_LDB
#undef PG8_MMA
#undef PG8_WAIT_V
#undef PG8_WAIT_L
#undef PG8_BAR
#undef PG8_SCHED
}
}

struct RowMap2 { int r0, st; };
__device__ __forceinline__ void cvt_item(const float* W, int ldw, u16* WT, int ldt, int k0, int n0, int drow0, int dstr, int dcol0, LAS float* scr, int lane) {
#pragma unroll 8
    for (int i = 0; i < 32; ++i) { const int kk = 2 * i + (lane >> 5); scr[kk * 33 + (lane & 31)] = W[(size_t)(k0 + kk) * ldw + n0 + (lane & 31)]; }
    asm volatile("s_waitcnt lgkmcnt(0)" ::: "memory");
    const int c = lane & 7;
#pragma unroll
    for (int j = 0; j < 4; ++j) { const int n = (lane >> 3) + 8 * j; const LAS float* s = scr + (8 * c) * 33 + n;
        uint4 o; o.x = f2bf(s[0 * 33]) | (f2bf(s[1 * 33]) << 16); o.y = f2bf(s[2 * 33]) | (f2bf(s[3 * 33]) << 16); o.z = f2bf(s[4 * 33]) | (f2bf(s[5 * 33]) << 16); o.w = f2bf(s[6 * 33]) | (f2bf(s[7 * 33]) << 16);
        *(uint4*)(WT + (size_t)(drow0 + n * dstr) * ldt + dcol0 + k0 + 8 * c) = o; }
    asm volatile("s_waitcnt lgkmcnt(0)" ::: "memory");
}
__device__ __forceinline__ void cvt_item8(const float* W, int ldw, unsigned char* WT, int ldt, int k0, int n0, int drow0, float scale, LAS float* scr, int lane) {
#pragma unroll 8
    for (int i = 0; i < 32; ++i) { const int kk = 2 * i + (lane >> 5); scr[kk * 33 + (lane & 31)] = W[(size_t)(k0 + kk) * ldw + n0 + (lane & 31)]; }
    asm volatile("s_waitcnt lgkmcnt(0)" ::: "memory");
    const int c = lane & 3;
#pragma unroll
    for (int j = 0; j < 2; ++j) { const int n = (lane >> 2) + 16 * j; const LAS float* s = scr + (16 * c) * 33 + n;
        unsigned w[4];
#pragma unroll
        for (int q = 0; q < 4; ++q) { unsigned t = 0u; t = __builtin_amdgcn_cvt_pk_fp8_f32(s[(4 * q + 0) * 33] * scale, s[(4 * q + 1) * 33] * scale, t, false);
            t = __builtin_amdgcn_cvt_pk_fp8_f32(s[(4 * q + 2) * 33] * scale, s[(4 * q + 3) * 33] * scale, t, true); w[q] = t; }
        *(uint4*)(WT + (size_t)(drow0 + n) * ldt + k0 + 16 * c) = make_uint4(w[0], w[1], w[2], w[3]); }
    asm volatile("s_waitcnt lgkmcnt(0)" ::: "memory");
}
template <class RowMap>
__device__ __forceinline__ void cvt_matrix8(const float* W, int K, int N, unsigned char* WT, int ldt, float scale, const RowMap& rowmap, LAS float* scr, int lane, int gw, int NGW, int& off) {
    const int nblk = N / 32, nitems = (K / 64) * nblk;
    int it = (gw - off) % NGW; if (it < 0) it += NGW;
    for (; it < nitems; it += NGW) { const int kb = it / nblk, nb = it % nblk; cvt_item8(W, N, WT, ldt, kb * 64, nb * 32, rowmap(nb * 32), scale, scr, lane); }
    off = (off + nitems) % NGW;
}
template <class RowMap>
__device__ __forceinline__ void cvt_matrix(const float* W, int K, int N, u16* WT, int ldt, int dcol0, const RowMap& rowmap, LAS float* scr, int lane, int gw, int NGW, int& off) {
    const int nblk = N / 32, nitems = (K / 64) * nblk;
    int it = (gw - off) % NGW; if (it < 0) it += NGW;
    for (; it < nitems; it += NGW) { const int kb = it / nblk, nb = it % nblk; const RowMap2 rm = rowmap(nb * 32); cvt_item(W, N, WT, ldt, kb * 64, nb * 32, rm.r0, rm.st, dcol0, scr, lane); }
    off = (off + nitems) % NGW;
}


namespace fa {
using bf16x8 = __attribute__((ext_vector_type(8))) short;
using s16x4  = __attribute__((ext_vector_type(4))) short;
using f32x16 = __attribute__((ext_vector_type(16))) float;
using u32x4  = __attribute__((ext_vector_type(4))) unsigned;
constexpr int NW = 8, QBLK = 32, KVBLK = 64, DV = 128;
constexpr float THR = 8.f;
constexpr size_t SHM_V = KVBLK * DV * 2;
#define FA_SBAR() __builtin_amdgcn_sched_barrier(0)
__device__ __forceinline__ int crow(int r, int hi) { return (r & 3) + 8 * (r >> 2) + 4 * hi; }
__device__ __forceinline__ unsigned cvtpk(float lo, float hi) { unsigned r; asm volatile("v_cvt_pk_bf16_f32 %0, %1, %2" : "=v"(r) : "v"(lo), "v"(hi)); return r; }
template <int DQ> struct Cfg {
    static constexpr int NK = DQ / 16, NCH = DQ / 8, KPT = NCH / 8;
    static constexpr size_t SHM_K = (size_t)KVBLK * DQ * 2;
    static constexpr float SCALE = DQ == 192 ? 0.07216878364870322f : (DQ == 64 ? 0.125f : 0.08838834764831845f);
    __device__ static __forceinline__ int kswz(int row, int colB) { return row * (DQ * 2) + (colB ^ ((row & 7) << 4)); }
};
template <int DQ> __device__ __forceinline__ void partialSM(f32x16& p0, f32x16& p1, float& m_reg, float& mn, float& alpha) {
    constexpr float SCALE = Cfg<DQ>::SCALE, C = SCALE * 1.4426950408889634f;
    float pmax = p0[0];
#pragma unroll
    for (int r = 1; r < 16; ++r) pmax = fmaxf(pmax, p0[r]);
#pragma unroll
    for (int r = 0; r < 16; ++r) pmax = fmaxf(pmax, p1[r]);
    { auto rr = __builtin_amdgcn_permlane32_swap(__float_as_uint(pmax), __float_as_uint(pmax), false, false);
      pmax = fmaxf(__uint_as_float(rr[0]), __uint_as_float(rr[1])); }
    if (__builtin_expect(__all(pmax - m_reg <= THR / SCALE), 1)) { mn = m_reg; alpha = 1.f; }
    else { mn = fmaxf(m_reg, pmax); alpha = __builtin_amdgcn_exp2f((m_reg - mn) * C); m_reg = mn; }
    const float mnC = -mn * C;
#pragma unroll
    for (int r = 0; r < 16; ++r) p0[r] = fmaf(p0[r], C, mnC);
#pragma unroll
    for (int r = 0; r < 16; ++r) p1[r] = fmaf(p1[r], C, mnC);
#pragma unroll
    for (int r = 0; r < 16; ++r) p0[r] = __builtin_amdgcn_exp2f(p0[r]);
}
__device__ __forceinline__ void finishSM(f32x16& p0, f32x16& p1, float alpha, float& l_reg, bf16x8& pa0, bf16x8& pa1, bf16x8& pa2, bf16x8& pa3) {
#pragma unroll
    for (int r = 0; r < 16; ++r) p1[r] = __builtin_amdgcn_exp2f(p1[r]);
    float ps = 0;
#pragma unroll
    for (int r = 0; r < 16; ++r) ps += p0[r];
#pragma unroll
    for (int r = 0; r < 16; ++r) ps += p1[r];
    { auto rr = __builtin_amdgcn_permlane32_swap(__float_as_uint(ps), __float_as_uint(ps), false, false);
      ps = __uint_as_float(rr[0]) + __uint_as_float(rr[1]); }
    l_reg = l_reg * alpha + ps;
#define FA_PK4(P, BASE, OUT) do { unsigned a0 = cvtpk(P[BASE + 0], P[BASE + 1]), a1 = cvtpk(P[BASE + 2], P[BASE + 3]);   \
    unsigned b0 = cvtpk(P[BASE + 4], P[BASE + 5]), b1 = cvtpk(P[BASE + 6], P[BASE + 7]);                              \
    auto r0 = __builtin_amdgcn_permlane32_swap(a0, b0, false, false); auto r1 = __builtin_amdgcn_permlane32_swap(a1, b1, false, false); \
    u32x4 w = {r0[0], r1[0], r0[1], r1[1]}; OUT = *reinterpret_cast<bf16x8*>(&w); } while (0)
    FA_PK4(p0, 0, pa0); FA_PK4(p0, 8, pa1); FA_PK4(p1, 0, pa2); FA_PK4(p1, 8, pa3);
#undef FA_PK4
}
template <int DQ> __device__ __forceinline__ void qkt(f32x16& p0, f32x16& p1, const char* Ks, const bf16x8* qr, int r32, int hi) {
    p0 = f32x16{}; p1 = f32x16{};
#pragma unroll
    for (int d0 = 0; d0 < Cfg<DQ>::NK; ++d0) { const int cb = (d0 * 16 + hi * 8) * 2;
        const bf16x8 b0 = *reinterpret_cast<const bf16x8*>(Ks + Cfg<DQ>::kswz(r32, cb));
        const bf16x8 b1 = *reinterpret_cast<const bf16x8*>(Ks + Cfg<DQ>::kswz(32 + r32, cb));
        p0 = __builtin_amdgcn_mfma_f32_32x32x16_bf16(b0, qr[d0], p0, 0, 0, 0);
        p1 = __builtin_amdgcn_mfma_f32_32x32x16_bf16(b1, qr[d0], p1, 0, 0, 0); }
}
__device__ __forceinline__ int v_st(int k, int c) { const int kk = (k & ~0xC) | ((k & 4) << 1) | ((k & 8) >> 1); return ((kk >> 3) * 4 + (c >> 5)) * 512 + ((kk & 7) * 32 + (c & 31)) * 2; }
__device__ __forceinline__ int v_rd_base(int lane) { return ((lane & 3) << 3) | (((lane >> 2) & 3) << 6) | (((lane >> 4) & 1) << 5) | (((lane >> 5) & 1) << 8); }
constexpr int v_rd_off(int d0, int ks, int half) { return d0 * 512 + ks * 4096 + half * 2048; }
template <int OFF> __device__ __forceinline__ s16x4 tr_read(int vb) {
    s16x4 r; asm volatile("ds_read_b64_tr_b16 %0, %1 offset:%2" : "=&v"(r) : "v"(vb), "i"(OFF) : "memory"); return r;
}
template <int D0> __device__ __forceinline__ void pv_one(f32x16& od, int vb, bf16x8 pa0, bf16x8 pa1, bf16x8 pa2, bf16x8 pa3) {
    const s16x4 l0 = tr_read<v_rd_off(D0, 0, 0)>(vb), h0 = tr_read<v_rd_off(D0, 0, 1)>(vb), l1 = tr_read<v_rd_off(D0, 1, 0)>(vb), h1 = tr_read<v_rd_off(D0, 1, 1)>(vb);
    const s16x4 l2 = tr_read<v_rd_off(D0, 2, 0)>(vb), h2 = tr_read<v_rd_off(D0, 2, 1)>(vb), l3 = tr_read<v_rd_off(D0, 3, 0)>(vb), h3 = tr_read<v_rd_off(D0, 3, 1)>(vb);
    asm volatile("s_waitcnt lgkmcnt(0)" ::: "memory"); FA_SBAR();
#define FA_PK(L, H) (bf16x8){L[0], L[1], L[2], L[3], H[0], H[1], H[2], H[3]}
    od = __builtin_amdgcn_mfma_f32_32x32x16_bf16(pa0, FA_PK(l0, h0), od, 0, 0, 0);
    od = __builtin_amdgcn_mfma_f32_32x32x16_bf16(pa1, FA_PK(l1, h1), od, 0, 0, 0);
    od = __builtin_amdgcn_mfma_f32_32x32x16_bf16(pa2, FA_PK(l2, h2), od, 0, 0, 0);
    od = __builtin_amdgcn_mfma_f32_32x32x16_bf16(pa3, FA_PK(l3, h3), od, 0, 0, 0);
#undef FA_PK
}
__device__ __forceinline__ void pv_d0(f32x16* o, int vb, bf16x8 pa0, bf16x8 pa1, bf16x8 pa2, bf16x8 pa3) {
    pv_one<0>(o[0], vb, pa0, pa1, pa2, pa3); pv_one<1>(o[1], vb, pa0, pa1, pa2, pa3); pv_one<2>(o[2], vb, pa0, pa1, pa2, pa3); pv_one<3>(o[3], vb, pa0, pa1, pa2, pa3);
}
struct KVSrc { const u16* k0; int kst0; const u16* k1; int kst1; int split8; const u16* v; int vst; int xrow0, lrow0; };
constexpr size_t shm_bytes(int DQ) { return 2 * SHM_V + 2 * (size_t)KVBLK * DQ * 2 + NW * 64 * 4; }

template <int DQ>
__device__ __forceinline__ void attn_unit(const u16* __restrict__ Qb, int LDQ, const KVSrc S, u16* __restrict__ Ob, int LDO, int NT, char* lds) {
    using C = Cfg<DQ>;
    constexpr int NK = C::NK, NCH = C::NCH, KPT = C::KPT;
    constexpr size_t SHM_K = C::SHM_K;
    const int tid = threadIdx.x, wid = tid >> 6, lane = tid & 63, r32 = lane & 31, hi = lane >> 5;
    char* V_lds = lds; char* K_lds = lds + 2 * SHM_V;
    float* wsf = (float*)(lds + 2 * SHM_V + 2 * SHM_K) + wid * 64; float* li_l = wsf; float* al_l = wsf + 32;
    float m_reg = -1e30f, l_reg = 0; f32x16 o[4] = {}; bf16x8 qr[NK];
    const u16* Qw = Qb + (long)(wid * QBLK + r32) * LDQ + hi * 8;
#pragma unroll
    for (int d0 = 0; d0 < NK; ++d0) qr[d0] = *reinterpret_cast<const bf16x8*>(Qw + d0 * 16);
    const int sr = tid >> 4, sc = (tid & 15) * 8, vst0 = v_st(sr, sc), vst1 = v_st(32 + sr, sc);
    const int vb0 = (int)(uintptr_t)V_lds + v_rd_base(lane);
    const u16* kp[KPT]; int kst[KPT]; int kw[KPT];
#pragma unroll
    for (int i = 0; i < KPT; ++i) { const int c = tid + 512 * i, row = c / NCH, c8 = c % NCH;
        if (c8 < S.split8) { kp[i] = S.k0 + (long)row * S.kst0 + c8 * 8; kst[i] = S.kst0; } else { kp[i] = S.k1 + (long)row * S.kst1 + (c8 - S.split8) * 8; kst[i] = S.kst1; }
        kw[i] = C::kswz(row, c8 * 16); }
    const u16* vp0 = S.v + (long)sr * S.vst + sc; const u16* vp1 = S.v + (long)(32 + sr) * S.vst + sc;
    struct { bf16x8 vs0, vs1, ks[KPT]; } sr_[2];
#define FA_ROW0(kt) ((kt) < 4 ? S.xrow0 + 64 * (kt) : S.lrow0 + 64 * ((kt) - 4))
#define FA_SLOAD(i, kt) do { const long _r = FA_ROW0(kt); sr_[i].vs0 = *reinterpret_cast<const bf16x8*>(vp0 + _r * S.vst); sr_[i].vs1 = *reinterpret_cast<const bf16x8*>(vp1 + _r * S.vst); \
    _Pragma("unroll") for (int _q = 0; _q < KPT; ++_q) sr_[i].ks[_q] = *reinterpret_cast<const bf16x8*>(kp[_q] + _r * kst[_q]); } while (0)
#define FA_SWRITE(b, i) do { *(bf16x8*)(V_lds + (b) * SHM_V + vst0) = sr_[i].vs0; *(bf16x8*)(V_lds + (b) * SHM_V + vst1) = sr_[i].vs1; \
    _Pragma("unroll") for (int _q = 0; _q < KPT; ++_q) *(bf16x8*)(K_lds + (b) * SHM_K + kw[_q]) = sr_[i].ks[_q]; } while (0)
#define FA_SWAIT() asm volatile("s_waitcnt vmcnt(%0)" :: "n"(2 + KPT) : "memory")
#define FA_RESC(a) do { if (__any((a) < 1.f)) { if (hi == 0) al_l[r32] = (a); asm volatile("s_waitcnt lgkmcnt(0)" ::: "memory"); \
    _Pragma("unroll") for (int d = 0; d < 4; ++d) _Pragma("unroll") for (int r = 0; r < 16; ++r) o[d][r] *= al_l[crow(r, hi)]; } } while (0)
    f32x16 pA0, pA1, pB0, pB1; float mnA, mnB, alA, alB; bf16x8 pa0, pa1, pa2, pa3;
    constexpr int SE = 0, SO = 1;
    FA_SLOAD(SE, 0); asm volatile("s_waitcnt vmcnt(0)" ::: "memory"); FA_SWRITE(0, SE); __syncthreads();
    qkt<DQ>(pA0, pA1, K_lds, qr, r32, hi); partialSM<DQ>(pA0, pA1, m_reg, mnA, alA);
    FA_SLOAD(SO, 1); if (2 < NT) FA_SLOAD(SE, 2);
    FA_SWAIT(); FA_SWRITE(1, SO); __syncthreads();
    for (int j = 1; j + 1 < NT; j += 2) {
        FA_SBAR(); qkt<DQ>(pB0, pB1, K_lds + SHM_K, qr, r32, hi);
        finishSM(pA0, pA1, alA, l_reg, pa0, pa1, pa2, pa3); FA_SBAR();
        FA_SLOAD(SO, j + 2); FA_SBAR();
        pv_d0(o, vb0, pa0, pa1, pa2, pa3); partialSM<DQ>(pB0, pB1, m_reg, mnB, alB);
        __syncthreads(); FA_SWAIT(); FA_SWRITE(0, SE);
        FA_RESC(alB); __syncthreads();
        FA_SBAR(); qkt<DQ>(pA0, pA1, K_lds, qr, r32, hi);
        finishSM(pB0, pB1, alB, l_reg, pa0, pa1, pa2, pa3); FA_SBAR();
        if (j + 3 < NT) FA_SLOAD(SE, j + 3); FA_SBAR();
        pv_d0(o, vb0 + (int)SHM_V, pa0, pa1, pa2, pa3); partialSM<DQ>(pA0, pA1, m_reg, mnA, alA);
        __syncthreads(); FA_SWAIT(); FA_SWRITE(1, SO);
        FA_RESC(alA); __syncthreads();
    }
    FA_SBAR(); qkt<DQ>(pB0, pB1, K_lds + SHM_K, qr, r32, hi);
    finishSM(pA0, pA1, alA, l_reg, pa0, pa1, pa2, pa3); FA_SBAR();
    pv_d0(o, vb0, pa0, pa1, pa2, pa3); partialSM<DQ>(pB0, pB1, m_reg, mnB, alB);
    __syncthreads(); FA_RESC(alB);
    finishSM(pB0, pB1, alB, l_reg, pa0, pa1, pa2, pa3); FA_SBAR();
    pv_d0(o, vb0 + (int)SHM_V, pa0, pa1, pa2, pa3);
    if (hi == 0) li_l[r32] = l_reg; asm volatile("s_waitcnt lgkmcnt(0)" ::: "memory");
    float rli[16];
#pragma unroll
    for (int r = 0; r < 16; ++r) rli[r] = __builtin_amdgcn_rcpf(li_l[crow(r, hi)]);
    u16* Ow = Ob + (long)(wid * QBLK) * LDO;
#pragma unroll
    for (int r = 0; r < 16; ++r) { const int orow = crow(r, hi);
#pragma unroll
        for (int d0 = 0; d0 < 4; ++d0) Ow[(long)orow * LDO + d0 * 32 + r32] = (u16)f2bf(o[d0][r] * rli[r]); }
#undef FA_ROW0
#undef FA_SLOAD
#undef FA_SWRITE
#undef FA_SWAIT
#undef FA_RESC
}

template <int DQ, int SPLIT8>
__device__ __forceinline__ void attn_unit_sp(const u16* __restrict__ Qb, int LDQ, const KVSrc S, u16* __restrict__ Ob, int LDO, int NT, char* lds) {
    using C = Cfg<DQ>;
    constexpr int NK = C::NK, NCH = C::NCH, KPT = C::KPT, KPT0 = SPLIT8 / 8, NCH1 = NCH - SPLIT8;
    constexpr size_t SHM_K = C::SHM_K;
    const int tid = threadIdx.x, wid = tid >> 6, lane = tid & 63, r32 = lane & 31, hi = lane >> 5;
    char* V_lds = lds; char* K_lds = lds + 2 * SHM_V;
    float* wsf = (float*)(lds + 2 * SHM_V + 2 * SHM_K) + wid * 64; float* li_l = wsf; float* al_l = wsf + 32;
    float m_reg = -1e30f, l_reg = 0; f32x16 o[4] = {}; bf16x8 qr[NK];
    { const u16* Qw = Qb + (long)(wid * QBLK + r32) * LDQ + hi * 8;
#pragma unroll
      for (int d0 = 0; d0 < NK; ++d0) qr[d0] = *reinterpret_cast<const bf16x8*>(Qw + d0 * 16); }
    const int sr = tid >> 4, sc = (tid & 15) * 8, vst0 = v_st(sr, sc), vst1 = v_st(32 + sr, sc);
    const int vb0 = (int)(uintptr_t)V_lds + v_rd_base(lane);
    int koff[KPT], kw[KPT];
#pragma unroll
    for (int i = 0; i < KPT; ++i) {
        if (i < KPT0) { const int c = tid + 512 * i, row = c / SPLIT8, c8 = c % SPLIT8; koff[i] = row * S.kst0 + c8 * 8; kw[i] = C::kswz(row, c8 * 16); }
        else { const int c = tid + 512 * (i - KPT0), row = c / (NCH1 > 0 ? NCH1 : 1), c8 = c % (NCH1 > 0 ? NCH1 : 1); koff[i] = row * S.kst1 + c8 * 8; kw[i] = C::kswz(row, (SPLIT8 + c8) * 16); } }
    const int voff0 = sr * S.vst + sc, voff1 = (32 + sr) * S.vst + sc;
    bf16x8 vs0, vs1, ks[KPT];
#define FA_ROW0(kt) ((kt) < 4 ? S.xrow0 + 64 * (kt) : S.lrow0 + 64 * ((kt) - 4))
#define FA_SLOAD(kt) do { const long _r = FA_ROW0(kt); const u16* _v = S.v + _r * S.vst; const u16* _k0 = S.k0 + _r * S.kst0; const u16* _k1 = S.k1 + _r * S.kst1; \
    vs0 = *reinterpret_cast<const bf16x8*>(_v + voff0); vs1 = *reinterpret_cast<const bf16x8*>(_v + voff1); \
    _Pragma("unroll") for (int _q = 0; _q < KPT; ++_q) ks[_q] = *reinterpret_cast<const bf16x8*>((_q < KPT0 ? _k0 : _k1) + koff[_q]); } while (0)
#define FA_SWRITE(b) do { *(bf16x8*)(V_lds + (b) * SHM_V + vst0) = vs0; *(bf16x8*)(V_lds + (b) * SHM_V + vst1) = vs1; \
    _Pragma("unroll") for (int _q = 0; _q < KPT; ++_q) *(bf16x8*)(K_lds + (b) * SHM_K + kw[_q]) = ks[_q]; } while (0)
    f32x16 p0, p1; float mn, al; bf16x8 pa0, pa1, pa2, pa3;
    FA_SLOAD(0); asm volatile("s_waitcnt vmcnt(0)" ::: "memory"); FA_SWRITE(0); __syncthreads();
    for (int j = 0; j < NT; ++j) {
        const int b = j & 1;
        FA_SBAR(); qkt<DQ>(p0, p1, K_lds + b * SHM_K, qr, r32, hi);
        partialSM<DQ>(p0, p1, m_reg, mn, al);
        if (__any(al < 1.f)) { if (hi == 0) al_l[r32] = al; asm volatile("s_waitcnt lgkmcnt(0)" ::: "memory");
#pragma unroll
            for (int d = 0; d < 4; ++d)
#pragma unroll
                for (int r = 0; r < 16; ++r) o[d][r] *= al_l[crow(r, hi)]; }
        finishSM(p0, p1, al, l_reg, pa0, pa1, pa2, pa3); FA_SBAR();
        if (j + 1 < NT) FA_SLOAD(j + 1);
        FA_SBAR();
        pv_d0(o, vb0 + b * (int)SHM_V, pa0, pa1, pa2, pa3);
        if (j + 1 < NT) { asm volatile("s_waitcnt vmcnt(0)" ::: "memory"); FA_SWRITE(b ^ 1); }
        __syncthreads();
    }
    if (hi == 0) li_l[r32] = l_reg; asm volatile("s_waitcnt lgkmcnt(0)" ::: "memory");
    float rli[16];
#pragma unroll
    for (int r = 0; r < 16; ++r) rli[r] = __builtin_amdgcn_rcpf(li_l[crow(r, hi)]);
    u16* Ow = Ob + (long)(wid * QBLK) * LDO;
#pragma unroll
    for (int r = 0; r < 16; ++r) { const int orow = crow(r, hi);
#pragma unroll
        for (int d0 = 0; d0 < 4; ++d0) Ow[(long)orow * LDO + d0 * 32 + r32] = (u16)f2bf(o[d0][r] * rli[r]); }
#undef FA_ROW0
#undef FA_SLOAD
#undef FA_SWRITE
}
}


namespace gla {
typedef short bf16x8 __attribute__((ext_vector_type(8)));
typedef unsigned u32x2 __attribute__((ext_vector_type(2)));
constexpr int P = 72;
constexpr int ARR = 64 * P * 2;
constexpr int OFF_SET = 4 * ARR;
constexpr int OFF_ATT = 2 * OFF_SET, OFF_ST = OFF_ATT + ARR, OFF_SEG = OFF_ST + ARR, OFF_DEC = OFF_SEG + 8 * 64 * 4, LDS_END = OFF_DEC + 2 * 64 * 4;
__device__ __forceinline__ bf16x8 ldfrag(const LAS unsigned char* arr, int row, int colb) { return *(const LAS bf16x8*)(arr + row * (P * 2) + colb); }
__device__ __forceinline__ void unit(LAS unsigned char* lds, const u16* PARTS, const float* wg, const float* bg, int caf, u16* Od, int b, int h, int dir, int vh) {
    const int tid = threadIdx.x, lane = tid & 63, w = __builtin_amdgcn_readfirstlane(tid >> 6);
    const int r16 = lane & 15, fq = lane >> 4;
    const int it = w & 3, jt0 = 2 * (w >> 2);
    float wgr[16];
#pragma unroll
    for (int j = 0; j < 16; ++j) wgr[j] = wg[j * 256 + h * 64 + lane];
    const float bgr = bg[h * 64 + lane];
    f32x4 S0 = {0.f, 0.f, 0.f, 0.f}, S1 = {0.f, 0.f, 0.f, 0.f};
    for (int e = tid; e < ARR / 4; e += 512) ((LAS unsigned*)(lds + OFF_ST))[e] = 0u;
    auto rowof = [&](int pos) { return pos < CTXL ? (ML + b * CTXL + (dir ? CTXL - 1 - pos : pos)) : (b * SEQ + (dir ? SEQ - 1 - (pos - CTXL) : (pos - CTXL))); };
    unsigned short qv[8], kv[8], vv[8]; float afv[8];
#define GLA_LOAD(n) do { _Pragma("unroll") for (int i = 0; i < 8; ++i) { const int row = rowof((n) * 64 + 8 * w + i); const u16* pr = PARTS + (size_t)row * IN_AP; \
        qv[i] = pr[C_GQ + h * 64 + lane]; kv[i] = pr[C_GK + h * 64 + lane]; vv[i] = pr[C_GV + h * 128 + vh * 64 + lane]; afv[i] = bf2f(pr[caf + (lane & 15)]); } } while (0)
    GLA_LOAD(0);
    constexpr int NCHUNK = (CTXL + SEQ) / 64;
    for (int n = 0; n < NCHUNK; ++n) {
        LAS unsigned char* Qt = lds + (n & 1) * OFF_SET; LAS unsigned char* Kt = Qt + ARR; LAS unsigned char* KhT = Kt + ARR; LAS unsigned char* Vt = KhT + ARR;
        LAS float* seg = (LAS float*)(lds + OFF_SEG); LAS float* dec = (LAS float*)(lds + OFF_DEC) + (n & 1) * 64;
        float c[8]; float run = 0.f;
#pragma unroll
        for (int i = 0; i < 8; ++i) { float pre = bgr;
#pragma unroll
            for (int j = 0; j < 16; ++j) pre += __int_as_float(__builtin_amdgcn_readlane(__float_as_int(afv[i]), j)) * wgr[j];
            const float ls = fminf(pre, 0.f) - __logf(1.0f + __expf(-fabsf(pre)));
            run += ls * (1.0f / 16.0f); c[i] = run; }
        seg[w * 64 + lane] = run;
        __syncthreads();
        float prefix = 0.f, last = 0.f;
#pragma unroll
        for (int ww = 0; ww < 8; ++ww) { const float t = seg[ww * 64 + lane]; last += t; prefix += (ww < w) ? t : 0.f; }
#pragma unroll
        for (int i = 0; i < 8; ++i) { const int s = 8 * w + i; const float cum = prefix + c[i]; const float e = __expf(cum), kf = bf2f(kv[i]);
            ((LAS u16*)Qt)[s * P + lane] = (u16)f2bf(bf2f(qv[i]) * 0.125f * e);
            ((LAS u16*)Kt)[s * P + lane] = (u16)f2bf(kf * __expf(-cum));
            ((LAS u16*)KhT)[lane * P + s] = (u16)f2bf(kf * __expf(last - cum));
            ((LAS u16*)Vt)[lane * P + s] = vv[i]; }
        if (w == 0) dec[lane] = __expf(last);
        __syncthreads();
        if (n + 1 < NCHUNK) GLA_LOAD(n + 1);
        f32x4 a0 = {0.f, 0.f, 0.f, 0.f}, a1 = a0, o0 = a0, o1 = a0;
#pragma unroll
        for (int ks = 0; ks < 2; ++ks) { const int cb = ks * 64 + fq * 16;
            const bf16x8 A = ldfrag(Kt, 16 * it + r16, cb), Bq0 = ldfrag(Qt, 16 * jt0 + r16, cb), Bq1 = ldfrag(Qt, 16 * (jt0 + 1) + r16, cb), As = ldfrag(lds + OFF_ST, 16 * it + r16, cb);
            a0 = __builtin_amdgcn_mfma_f32_16x16x32_bf16(A, Bq0, a0, 0, 0, 0); a1 = __builtin_amdgcn_mfma_f32_16x16x32_bf16(A, Bq1, a1, 0, 0, 0);
            o0 = __builtin_amdgcn_mfma_f32_16x16x32_bf16(As, Bq0, o0, 0, 0, 0); o1 = __builtin_amdgcn_mfma_f32_16x16x32_bf16(As, Bq1, o1, 0, 0, 0); }
        { const int s0 = 16 * it + 4 * fq; const int t0 = 16 * jt0 + r16, t1 = t0 + 16;
          u32x2 p0, p1;
          p0.x = f2bf(s0 + 0 <= t0 ? a0[0] : 0.f) | (f2bf(s0 + 1 <= t0 ? a0[1] : 0.f) << 16); p0.y = f2bf(s0 + 2 <= t0 ? a0[2] : 0.f) | (f2bf(s0 + 3 <= t0 ? a0[3] : 0.f) << 16);
          p1.x = f2bf(s0 + 0 <= t1 ? a1[0] : 0.f) | (f2bf(s0 + 1 <= t1 ? a1[1] : 0.f) << 16); p1.y = f2bf(s0 + 2 <= t1 ? a1[2] : 0.f) | (f2bf(s0 + 3 <= t1 ? a1[3] : 0.f) << 16);
          *(LAS u32x2*)(lds + OFF_ATT + (t0 * P + s0) * 2) = p0; *(LAS u32x2*)(lds + OFF_ATT + (t1 * P + s0) * 2) = p1; }
        __syncthreads();
        const f32x4 d4 = *(const LAS f32x4*)(dec + 16 * it + 4 * fq);
        S0 = S0 * d4; S1 = S1 * d4;
#pragma unroll
        for (int ks = 0; ks < 2; ++ks) { const int cb = ks * 64 + fq * 16;
            const bf16x8 Av = ldfrag(Vt, 16 * it + r16, cb), Ba0 = ldfrag(lds + OFF_ATT, 16 * jt0 + r16, cb), Ba1 = ldfrag(lds + OFF_ATT, 16 * (jt0 + 1) + r16, cb);
            const bf16x8 Ak = ldfrag(KhT, 16 * it + r16, cb), Bv0 = ldfrag(Vt, 16 * jt0 + r16, cb), Bv1 = ldfrag(Vt, 16 * (jt0 + 1) + r16, cb);
            o0 = __builtin_amdgcn_mfma_f32_16x16x32_bf16(Av, Ba0, o0, 0, 0, 0); o1 = __builtin_amdgcn_mfma_f32_16x16x32_bf16(Av, Ba1, o1, 0, 0, 0);
            S0 = __builtin_amdgcn_mfma_f32_16x16x32_bf16(Ak, Bv0, S0, 0, 0, 0); S1 = __builtin_amdgcn_mfma_f32_16x16x32_bf16(Ak, Bv1, S1, 0, 0, 0); }
        { const int v0 = 16 * it + 4 * fq; const int t0 = 16 * jt0 + r16;
          u32x2 w0, w1; w0.x = f2bf(o0[0]) | (f2bf(o0[1]) << 16); w0.y = f2bf(o0[2]) | (f2bf(o0[3]) << 16); w1.x = f2bf(o1[0]) | (f2bf(o1[1]) << 16); w1.y = f2bf(o1[2]) | (f2bf(o1[3]) << 16);
          *(u32x2*)(Od + (size_t)rowof(n * 64 + t0) * 512 + h * 128 + vh * 64 + v0) = w0;
          *(u32x2*)(Od + (size_t)rowof(n * 64 + t0 + 16) * 512 + h * 128 + vh * 64 + v0) = w1;
          const int k0 = 16 * it + 4 * fq, vc0 = 16 * jt0 + r16;
          u32x2 q0, q1; q0.x = f2bf(S0[0]) | (f2bf(S0[1]) << 16); q0.y = f2bf(S0[2]) | (f2bf(S0[3]) << 16); q1.x = f2bf(S1[0]) | (f2bf(S1[1]) << 16); q1.y = f2bf(S1[2]) | (f2bf(S1[3]) << 16);
          *(LAS u32x2*)(lds + OFF_ST + (vc0 * P + k0) * 2) = q0; *(LAS u32x2*)(lds + OFF_ST + ((vc0 + 16) * P + k0) * 2) = q1; }
    }
#undef GLA_LOAD
}
}

__global__ void __launch_bounds__(512, 2) fwd_kernel(Args args) {
    extern __shared__ __attribute__((aligned(16))) unsigned char lds_raw[];
    LAS unsigned char* lds = (LAS unsigned char*)lds_raw;
    const int tid = threadIdx.x, lane = tid & 63, wave = __builtin_amdgcn_readfirstlane(tid >> 6);
    const int G = gridDim.x, gw = blockIdx.x * 8 + wave, NGW = G * 8;
    unsigned char* ws = args.ws;
    unsigned* ctl = (unsigned*)(ws + WS_CTL);
    volatile LAS unsigned* MISC = (volatile LAS unsigned*)(lds + MISC_OFF);
    for (int u = tid; u < (LDS_BYTES - 131072) / 4; u += 512) ((LAS unsigned*)(lds + 131072))[u] = 0u;
    __syncthreads();
    XcdBarrier bar = xcd_barrier_post(ctl + CW_BAR + args.li * 4096, MISC + 8);
    const int lo = args.ph_lo, hi = args.ph_hi;
#define IN(k) (lo <= (k) && (k) < hi)
#define GRID_BAR() xcd_barrier(bar)

    const float* x_in = args.in[0]; const float* c_in = args.in[1]; const float* ctx_in = args.in[2]; const float* cctx_in = args.in[3];
    const float* w_mod = args.in[4]; const float* b_mod = args.in[5];
    const float* g_pre_mix = args.in[6]; const float* g_post_mix = args.in[7]; const float* g_pre_ffn = args.in[8]; const float* g_post_ffn = args.in[9];
    const float* w_in_a = args.in[10]; const float* mla_g_q = args.in[11]; const float* mla_w_uq = args.in[12]; const float* mla_g_kv = args.in[13]; const float* mla_w_ukv = args.in[14];
    const float* gla_w_gf = args.in[15]; const float* gla_b_gf = args.in[16]; const float* gla_w_gb = args.in[17]; const float* gla_b_gb = args.in[18]; const float* gla_g_out = args.in[19];
    const float* w_out_a = args.in[20]; const float* w_qkv_c = args.in[21];
    const float* diff_lq1 = args.in[22]; const float* diff_lk1 = args.in[23]; const float* diff_lq2 = args.in[24]; const float* diff_lk2 = args.in[25]; const float* diff_g_out = args.in[26];
    const float* w_out_c = args.in[27]; const float* ffn_w_gate = args.in[28]; const float* ffn_w_up = args.in[29]; const float* ffn_w_down = args.in[30];
    const float* moe_w_router = args.in[31]; const float* moe_w_gate = args.in[32]; const float* moe_w_up = args.in[33]; const float* moe_w_down = args.in[34];
    float* out = args.out;
    float* MODB = (float*)(ws + WS_MOD);
    float* ROPEC = (float*)(ws + WS_ROPE); float* ROPES = ROPEC + 2048 * 32;
    int* TOKE = (int*)(ws + WS_TOKE); float* TOKG = (float*)(ws + WS_TOKG); int* TOKP = (int*)(ws + WS_TOKP);
    float* CTXS = (float*)(ws + WS_CTXS);
    u16* H0 = (u16*)(ws + WS_R0); u16* CAT = (u16*)(ws + WS_R0); u16* FB = (u16*)(ws + WS_R0); u16* O16 = (u16*)(ws + WS_R0); u16* Y2 = (u16*)(ws + WS_R0);
    u16* PARTS = (u16*)(ws + WS_PARTS); u16* YB = (u16*)(ws + WS_Y); u16* HB = (u16*)(ws + WS_Y);
    u16* H1 = (u16*)(ws + WS_H1); u16* CAT2 = (u16*)(ws + WS_H1);
    u16* HC = (u16*)(ws + WS_HC);
    u16* A2 = (u16*)(ws + WS_A2); u16* KROPE = (u16*)(ws + WS_KROPE);
    u16* OF = (u16*)(ws + WS_R3); u16* OB = OF + (size_t)M * 512;
    u16* QKVUP = (u16*)(ws + WS_QKVUP); u16* HID = (u16*)(ws + WS_R3); u16* QKVC = (u16*)(ws + WS_R3);
    u16* W_IN = (u16*)(ws + WS_W);
    u16* W_UP = (u16*)(ws + WS_W + 4 * MiB);
    u16* W_OA = (u16*)(ws + WS_W + 4 * MiB + 1536 * 1024);
    u16* W_FGU = (u16*)(ws + WS_W + 7 * MiB + 512 * 1024);
    u16* W_FD = (u16*)(ws + WS_W + 18 * MiB + 512 * 1024);
    u16* W_QKV = (u16*)(ws + WS_W + 24 * MiB);
    u16* W_OC = (u16*)(ws + WS_W + 30 * MiB);
    unsigned char* W_MGU = ws + WS_WMGU; unsigned char* W_MD = ws + WS_WMD; unsigned char* XS8 = ws + WS_XS8; unsigned char* HID8 = ws + WS_R0;
    u16* YS = (u16*)(ws + WS_YS);
    auto map_id = [](int n0) { return RowMap2{n0, 1}; };
    auto map_gate = [](int n0) { return RowMap2{(n0 >> 7) * 256 + (n0 & 127), 1}; };
    auto map_up = [](int n0) { return RowMap2{(n0 >> 7) * 256 + 128 + (n0 & 127), 1}; };
    auto map8_id = [](int n0) { return n0; };
    auto map8_gate = [](int n0) { return (n0 >> 7) * 256 + (n0 & 127); };
    auto map8_up = [](int n0) { return (n0 >> 7) * 256 + 128 + (n0 & 127); };

    if (IN(0)) {
        LAS float* sT = (LAS float*)lds;
        LAS float* red = sT + 1024 * 20;
        for (int e = tid; e < 17 * 1024; e += 512) { const int r = e >> 10, k = e & 1023; const float v = r < 16 ? c_in[r * 1024 + k] : cctx_in[k]; sT[k * 20 + r] = silu_f(v); }
        __syncthreads();
        for (int g = blockIdx.x; g < 192; g += G) {
            const int l = g / 96, n = (g % 96) * 64 + lane;
            const float* wp = w_mod + (size_t)l * 1024 * 6144 + n;
            float acc[17];
#pragma unroll
            for (int r = 0; r < 17; ++r) acc[r] = 0.f;
            const int kb = wave * 128;
#pragma unroll 4
            for (int kk = 0; kk < 128; ++kk) { const int k = kb + kk; const float w = wp[(size_t)k * 6144];
                const LAS float* sp = sT + k * 20;
#pragma unroll
                for (int r = 0; r < 17; ++r) acc[r] += sp[r] * w; }
#pragma unroll
            for (int r = 0; r < 17; ++r) red[(wave * 17 + r) * 64 + lane] = acc[r];
            __syncthreads();
            for (int e = tid; e < 17 * 64; e += 512) { const int r = e >> 6, ln = e & 63; float s = 0.f;
#pragma unroll
                for (int w8 = 0; w8 < 8; ++w8) s += red[(w8 * 17 + r) * 64 + ln];
                const int nn = (g % 96) * 64 + ln;
                MODB[(size_t)(l * 17 + r) * 6144 + nn] = s + b_mod[l * 6144 + nn]; }
            __syncthreads();
        }
        for (int e = blockIdx.x * 512 + tid; e < 2048 * 32; e += G * 512) { const int t = e >> 5, i = e & 31; const int pos = i < 16 ? (t >> 6) : (t & 63);
            const float freq = powf(10000.0f, -(float)(i & 15) / 16.0f); const float ang = (float)pos * freq;
            ROPEC[e] = cosf(ang); ROPES[e] = sinf(ang); }
        __syncthreads();
        { LAS float* scr = (LAS float*)(lds + wave * 8448); int off = 0;
          cvt_matrix(w_in_a, 1024, IN_A, W_IN, 1024, 0, map_id, scr, lane, gw, NGW, off);
          cvt_matrix(mla_w_uq, 256, 768, W_UP, 384, 0, [](int n0) { const int h = n0 / 192, j = n0 % 192; return j < 128 ? RowMap2{n0, 1} : RowMap2{h * 192 + 128 + (j == 160 ? 1 : 0), 2}; }, scr, lane, gw, NGW, off);
          cvt_matrix(mla_w_ukv, 128, 1024, W_UP, 384, 256, [](int n0) { return RowMap2{768 + n0, 1}; }, scr, lane, gw, NGW, off);
          cvt_matrix(w_out_a, 1024, 1024, W_OA, 1024, 0, map_id, scr, lane, gw, NGW, off);
          cvt_matrix(ffn_w_gate, 1024, FFN, W_FGU, 1024, 0, map_gate, scr, lane, gw, NGW, off);
          cvt_matrix(ffn_w_up, 1024, FFN, W_FGU, 1024, 0, map_up, scr, lane, gw, NGW, off);
          cvt_matrix(ffn_w_down, FFN, 1024, W_FD, FFN, 0, map_id, scr, lane, gw, NGW, off);
          cvt_matrix(w_qkv_c, 1024, 3072, W_QKV, 1024, 0, [](int n0) { return n0 < 2048 ? RowMap2{(n0 & ~63) + ((n0 & 32) ? 1 : 0), 2} : RowMap2{n0, 1}; }, scr, lane, gw, NGW, off);
          cvt_matrix(w_out_c, 1024, 1024, W_OC, 1024, 0, map_id, scr, lane, gw, NGW, off);
          const uint4 z = make_uint4(0u, 0u, 0u, 0u);
          for (int e = blockIdx.x * 512 + tid; e < 32 * 128; e += G * 512) *(uint4*)(W_IN + (size_t)IN_A * 1024 + (size_t)e * 8) = z;
          for (int e = blockIdx.x * 512 + tid; e < 768 * 16; e += G * 512) { const int r = e >> 4, c8 = e & 15; *(uint4*)(W_UP + (size_t)r * 384 + 256 + c8 * 8) = z; }
          for (int e = blockIdx.x * 512 + tid; e < 1024 * 32; e += G * 512) { const int r = 768 + (e >> 5), c8 = e & 31; *(uint4*)(W_UP + (size_t)r * 384 + c8 * 8) = z; } }
        GRID_BAR();
    }
    if (IN(1)) {
        for (int row = gw; row < M; row += NGW) {
            const float* src = row < ML ? x_in + (size_t)row * 1024 : ctx_in + (size_t)(row - ML) * 1024;
            const int mr = row < ML ? (row >> 11) : 16;
            f32x4 xv[4], hv[4]; ld_row_f32(src, lane, xv);
            premod(xv, hv, g_pre_mix, modp(ws, 0, mr, 0), modp(ws, 0, mr, 1), lane);
            st_row_bf16(H0 + (size_t)row * 1024, lane, hv);
        }
        GRID_BAR();
    }
    if (IN(2)) {
        { pg8::Gemm g{H0, W_IN, 1024, 1024, 0, 0}; pg8::DenseOrder S; S.init(M / 256, IN_AP / 256, G, (int)blockIdx.x); pg8::EpiStore E{PARTS, IN_AP};
          pg8::gemm_phase<pg8::EpiStore, pg8::DenseOrder, PG8_ALIGN, PG8_SP2>(lds, g, S, E); }
        GRID_BAR();
    }
    if (IN(3)) {
        for (int row = gw; row < M; row += NGW) {
            const u16* pr = PARTS + (size_t)row * IN_AP;
            { const uint2 w = *(const uint2*)(pr + C_CQ + 4 * lane); float v[4] = {bf2f(w.x & 0xffffu), bf2f(w.x >> 16), bf2f(w.y & 0xffffu), bf2f(w.y >> 16)};
              float s = wave_sum(v[0] * v[0] + v[1] * v[1] + v[2] * v[2] + v[3] * v[3]); const float r = 1.0f / sqrtf(s * (1.0f / 256.0f) + EPS);
              const f32x4 g = *(const f32x4*)(mla_g_q + 4 * lane);
              uint2 o; o.x = f2bf(v[0] * r * g.x) | (f2bf(v[1] * r * g.y) << 16); o.y = f2bf(v[2] * r * g.z) | (f2bf(v[3] * r * g.w) << 16);
              *(uint2*)(A2 + (size_t)row * 384 + 4 * lane) = o; }
            { const unsigned w = *(const unsigned*)(pr + C_CKV + 2 * lane); float v0 = bf2f(w & 0xffffu), v1 = bf2f(w >> 16);
              float s = wave_sum(v0 * v0 + v1 * v1); const float r = 1.0f / sqrtf(s * (1.0f / 128.0f) + EPS);
              const float2 g = *(const float2*)(mla_g_kv + 2 * lane);
              *(unsigned*)(A2 + (size_t)row * 384 + 256 + 2 * lane) = f2bf(v0 * r * g.x) | (f2bf(v1 * r * g.y) << 16); }
            if (lane < 32) { float x1 = bf2f(pr[C_KR + lane]), x2 = bf2f(pr[C_KR + 32 + lane]);
              if (row < ML) { const int t = row & 2047; const float cs = ROPEC[t * 32 + lane], sn = ROPES[t * 32 + lane]; const float n1 = x1 * cs - x2 * sn, n2 = x2 * cs + x1 * sn; x1 = n1; x2 = n2; }
              *(unsigned*)(KROPE + (size_t)row * 64 + 2 * lane) = f2bf(x1) | (f2bf(x2) << 16); }
        }
        for (int u = blockIdx.x; u < 256; u += G) {
            const int vh = u & 1, dir = (u >> 1) & 1, h = (u >> 2) & 3, b = u >> 4;
            __syncthreads();
            gla::unit(lds, PARTS, dir ? gla_w_gb : gla_w_gf, dir ? gla_b_gb : gla_b_gf, dir ? C_AB : C_AF, dir ? OB : OF, b, h, dir, vh);
        }
        GRID_BAR();
    }
    if (IN(4)) {
        { pg8::Gemm g{A2, W_UP, 384, 384, 0, 0}; pg8::DenseOrder S; S.init(M / 256, UPN / 256, G, (int)blockIdx.x); pg8::EpiStoreRope<1> E{QKVUP, UPN, ROPEC, ROPES};
          pg8::gemm_phase<pg8::EpiStoreRope<1>, pg8::DenseOrder, PG8_ALIGN, PG8_SP2>(lds, g, S, E); }
        GRID_BAR();
    }
    if (IN(5)) {
        for (int row = gw; row < M; row += NGW) {
            const int h = lane >> 4, v0 = (lane & 15) * 8;
            const uint4 wf = *(const uint4*)(OF + (size_t)row * 512 + h * 128 + v0), wb = *(const uint4*)(OB + (size_t)row * 512 + h * 128 + v0);
            const unsigned af[4] = {wf.x, wf.y, wf.z, wf.w}, ab[4] = {wb.x, wb.y, wb.z, wb.w};
            float o[8]; float s = 0.f;
#pragma unroll
            for (int i = 0; i < 4; ++i) { o[2 * i] = bf2f(af[i] & 0xffffu) + bf2f(ab[i] & 0xffffu); o[2 * i + 1] = bf2f(af[i] >> 16) + bf2f(ab[i] >> 16); s += o[2 * i] * o[2 * i] + o[2 * i + 1] * o[2 * i + 1]; }
#pragma unroll
            for (int off = 1; off < 16; off <<= 1) s += __shfl_xor(s, off);
            const float r = 1.0f / sqrtf(s * (1.0f / 128.0f) + EPS);
            const uint4 wr4 = *(const uint4*)(PARTS + (size_t)row * IN_AP + C_GR + h * 128 + v0); const unsigned ar[4] = {wr4.x, wr4.y, wr4.z, wr4.w};
            unsigned ow[4];
#pragma unroll
            for (int i = 0; i < 4; ++i) { const float a = o[2 * i] * r * gla_g_out[v0 + 2 * i] * silu_f(bf2f(ar[i] & 0xffffu)), b2 = o[2 * i + 1] * r * gla_g_out[v0 + 2 * i + 1] * silu_f(bf2f(ar[i] >> 16)); ow[i] = f2bf(a) | (f2bf(b2) << 16); }
            *(uint4*)(CAT + (size_t)row * 1024 + 512 + h * 128 + v0) = make_uint4(ow[0], ow[1], ow[2], ow[3]);
        }
        { const int NU_L = NB * 4 * 8, NU_X = NB * 4;
          for (int u = blockIdx.x; u < NU_L + NU_X; u += G) {
            const bool isx = u >= NU_L; const int uu = isx ? u - NU_L : u;
            const int qb = isx ? 0 : (uu & 7), h = isx ? (uu & 3) : ((uu >> 3) & 3), b = isx ? (uu >> 2) : (uu >> 5);
            const int r0 = isx ? (ML + b * CTXL) : (b * SEQ + qb * 256);
            fa::KVSrc S; S.k0 = QKVUP + 768 + h * 256; S.kst0 = UPN; S.k1 = KROPE; S.kst1 = 64; S.split8 = 16; S.v = QKVUP + 768 + h * 256 + 128; S.vst = UPN;
            S.xrow0 = ML + b * CTXL; S.lrow0 = b * SEQ;
            __syncthreads();
            fa::attn_unit_sp<192, 16>(QKVUP + (size_t)r0 * UPN + h * 192, UPN, S, CAT + (size_t)r0 * 1024 + h * 128, 1024, isx ? 4 : 36, (char*)lds_raw);
          } }
        GRID_BAR();
    }
    if (IN(6)) {
        { pg8::Gemm g{CAT, W_OA, 1024, 1024, 0, 0}; pg8::DenseOrder S; S.init(M / 256, 4, G, (int)blockIdx.x); pg8::EpiStore E{YB, 1024};
          pg8::gemm_phase<pg8::EpiStore, pg8::DenseOrder, PG8_ALIGN, PG8_SP2>(lds, g, S, E); }
        GRID_BAR();
    }
    if (IN(7)) {
        for (int row = gw; row < M; row += NGW) {
            const float* src = row < ML ? x_in + (size_t)row * 1024 : ctx_in + (size_t)(row - ML) * 1024;
            float* dst = row < ML ? out + (size_t)row * 1024 : CTXS + (size_t)(row - ML) * 1024;
            const int mr = row < ML ? (row >> 11) : 16;
            f32x4 xv[4], tv[4], hv[4]; ld_row_f32(src, lane, xv); ld_row_bf16(YB + (size_t)row * 1024, lane, tv);
            rms_apply(tv, g_post_mix, lane);
            const float* gate = modp(ws, 0, mr, 2);
#pragma unroll
            for (int j = 0; j < 4; ++j) xv[j] = xv[j] + *(const f32x4*)(gate + 4 * lane + 256 * j) * tv[j];
            st_row_f32(dst, lane, xv);
            premod(xv, hv, g_pre_ffn, modp(ws, 0, mr, 3), modp(ws, 0, mr, 4), lane);
            st_row_bf16(H1 + (size_t)row * 1024, lane, hv);
        }
        GRID_BAR();
    }
    if (IN(8)) {
        { pg8::Gemm g{H1, W_FGU, 1024, 1024, 0, 0}; pg8::DenseOrder S; S.init(M / 256, 2 * FFN / 256, G, (int)blockIdx.x); pg8::EpiSwiglu E{HID, FFN};
          pg8::gemm_phase<pg8::EpiSwiglu, pg8::DenseOrder, PG8_ALIGN, PG8_SP2>(lds, g, S, E); }
        GRID_BAR();
    }
    if (IN(9)) {
        { pg8::Gemm g{HID, W_FD, FFN, FFN, 0, 0}; pg8::DenseOrder S; S.init(M / 256, 4, G, (int)blockIdx.x); pg8::EpiStore E{FB, 1024};
          pg8::gemm_phase<pg8::EpiStore, pg8::DenseOrder, PG8_ALIGN, PG8_SP2>(lds, g, S, E); }
        GRID_BAR();
    }
    if (IN(10)) {
        for (int row = gw; row < M; row += NGW) {
            float* dst = row < ML ? out + (size_t)row * 1024 : CTXS + (size_t)(row - ML) * 1024;
            const int mr = row < ML ? (row >> 11) : 16;
            f32x4 xv[4], tv[4], hv[4]; ld_row_f32(dst, lane, xv); ld_row_bf16(FB + (size_t)row * 1024, lane, tv);
            rms_apply(tv, g_post_ffn, lane);
            const float* gate = modp(ws, 0, mr, 5);
#pragma unroll
            for (int j = 0; j < 4; ++j) xv[j] = xv[j] + *(const f32x4*)(gate + 4 * lane + 256 * j) * tv[j];
            st_row_f32(dst, lane, xv);
            premod(xv, hv, g_pre_mix + 1024, modp(ws, 1, mr, 0), modp(ws, 1, mr, 1), lane);
            st_row_bf16(HB + (size_t)row * 1024, lane, hv);
        }
        GRID_BAR();
    }
    if (IN(11)) {
        { pg8::Gemm g{HB, W_QKV, 1024, 1024, 0, 0}; pg8::DenseOrder S; S.init(M / 256, 12, G, (int)blockIdx.x); pg8::EpiStoreRope<0> E{QKVC, 3072, ROPEC, ROPES};
          pg8::gemm_phase<pg8::EpiStoreRope<0>, pg8::DenseOrder, PG8_ALIGN, PG8_SP2>(lds, g, S, E); }
        GRID_BAR();
    }
    if (IN(12)) {
        { const int NU = NB * 16 * 8;
          for (int u = blockIdx.x; u < NU; u += G) {
            const int qb = u & 7, j = (u >> 3) & 15, b = u >> 7;
            const int r0 = b * SEQ + qb * 256;
            fa::KVSrc S; S.k0 = QKVC + 1024 + j * 64; S.kst0 = 3072; S.k1 = QKVC; S.kst1 = 3072; S.split8 = 8; S.v = QKVC + 2048 + (j >> 1) * 128; S.vst = 3072;
            S.xrow0 = ML + b * CTXL; S.lrow0 = b * SEQ;
            __syncthreads();
            fa::attn_unit<64>(QKVC + (size_t)r0 * 3072 + j * 64, 3072, S, O16 + (size_t)r0 * 2048 + j * 128, 2048, 36, (char*)lds_raw);
          } }
        GRID_BAR();
    }
    if (IN(13)) {
        { LAS float* scr = (LAS float*)(lds + wave * 8448); int off = 0;
#pragma unroll 1
          for (int e = 0; e < NE; ++e) {
              cvt_matrix8(moe_w_gate + (size_t)e * 1024 * ED, 1024, ED, W_MGU + (size_t)e * 2 * ED * 1024, 1024, 64.0f, map8_gate, scr, lane, gw, NGW, off);
              cvt_matrix8(moe_w_up + (size_t)e * 1024 * ED, 1024, ED, W_MGU + (size_t)e * 2 * ED * 1024, 1024, 64.0f, map8_up, scr, lane, gw, NGW, off);
              cvt_matrix8(moe_w_down + (size_t)e * ED * 1024, ED, 1024, W_MD + (size_t)e * 1024 * ED, ED, 64.0f, map8_id, scr, lane, gw, NGW, off); } }
        const float s1 = wave_sum(diff_lq1[lane] * diff_lk1[lane]), s2 = wave_sum(diff_lq2[lane] * diff_lk2[lane]);
        const float lam = expf(s1) - expf(s2) + LAM_INIT;
        for (int row = gw; row < ML; row += NGW) {
            const int h = lane >> 3, v0 = (lane & 7) * 16;
            const u16* p1 = O16 + (size_t)row * 2048 + (2 * h) * 128 + v0; const u16* p2 = p1 + 128;
            float o[16]; float s = 0.f;
#pragma unroll
            for (int i = 0; i < 16; ++i) { o[i] = bf2f(p1[i]) - lam * bf2f(p2[i]); s += o[i] * o[i]; }
#pragma unroll
            for (int off = 1; off < 8; off <<= 1) s += __shfl_xor(s, off);
            const float r = 1.0f / sqrtf(s * (1.0f / 128.0f) + EPS);
            u16* po = CAT2 + (size_t)row * 1024 + h * 128 + v0;
#pragma unroll
            for (int i = 0; i < 16; ++i) po[i] = (u16)f2bf(o[i] * r * diff_g_out[v0 + i] * (1.0f - LAM_INIT));
        }
        GRID_BAR();
    }
    if (IN(14)) {
        { pg8::Gemm g{CAT2, W_OC, 1024, 1024, 0, 0}; pg8::DenseOrder S; S.init(ML / 256, 4, G, (int)blockIdx.x); pg8::EpiStore E{Y2, 1024};
          pg8::gemm_phase<pg8::EpiStore, pg8::DenseOrder, PG8_ALIGN, PG8_SP2>(lds, g, S, E); }
        GRID_BAR();
    }
    if (IN(15)) {
        LAS int* lcnt = (LAS int*)lds;
        LAS int* gbase = lcnt + 8;
        LAS int* le = gbase + 8;
        LAS int* lr = le + 256;
        LAS float* lg = (LAS float*)(lr + 256);
        for (int base = blockIdx.x * 128; base < ML; base += G * 128) {
            __syncthreads();
            if (tid < 8) lcnt[tid] = 0;
            __syncthreads();
            for (int i = 0; i < 16; ++i) {
                const int lrow = wave * 16 + i, row = base + lrow;
                float* dst = out + (size_t)row * 1024;
                const int mr = row >> 11;
                f32x4 xv[4], tv[4], hv[4]; ld_row_f32(dst, lane, xv); ld_row_bf16(Y2 + (size_t)row * 1024, lane, tv);
                rms_apply(tv, g_post_mix + 1024, lane);
                const float* gate = modp(ws, 1, mr, 2);
#pragma unroll
                for (int j = 0; j < 4; ++j) xv[j] = xv[j] + *(const f32x4*)(gate + 4 * lane + 256 * j) * tv[j];
                st_row_f32(dst, lane, xv);
                premod(xv, hv, g_pre_ffn + 1024, modp(ws, 1, mr, 3), modp(ws, 1, mr, 4), lane);
                st_row_bf16(HC + (size_t)row * 1024, lane, hv);
                float lg8[8];
#pragma unroll
                for (int e = 0; e < 8; ++e) lg8[e] = 0.f;
#pragma unroll
                for (int j = 0; j < 4; ++j)
#pragma unroll
                    for (int q = 0; q < 4; ++q) { const int k = 4 * lane + 256 * j + q; const float hvv = hv[j][q];
                        const f32x4 wa = *(const f32x4*)(moe_w_router + (size_t)k * 8), wb = *(const f32x4*)(moe_w_router + (size_t)k * 8 + 4);
                        lg8[0] += hvv * wa.x; lg8[1] += hvv * wa.y; lg8[2] += hvv * wa.z; lg8[3] += hvv * wa.w;
                        lg8[4] += hvv * wb.x; lg8[5] += hvv * wb.y; lg8[6] += hvv * wb.z; lg8[7] += hvv * wb.w; }
#pragma unroll
                for (int e = 0; e < 8; ++e) lg8[e] = wave_sum(lg8[e]);
                if (lane == 0) {
                    int e0 = 0; float v0 = lg8[0];
#pragma unroll
                    for (int e = 1; e < 8; ++e) if (lg8[e] > v0) { v0 = lg8[e]; e0 = e; }
                    int e1 = -1; float v1 = -3.0e38f;
#pragma unroll
                    for (int e = 0; e < 8; ++e) if (e != e0 && lg8[e] > v1) { v1 = lg8[e]; e1 = e; }
                    const float g0 = 1.0f / (1.0f + expf(v1 - v0));
                    le[lrow * 2] = e0; le[lrow * 2 + 1] = e1; lg[lrow * 2] = g0; lg[lrow * 2 + 1] = 1.0f - g0;
                    lr[lrow * 2] = __hip_atomic_fetch_add(&lcnt[e0], 1, __ATOMIC_RELAXED, __HIP_MEMORY_SCOPE_WORKGROUP); lr[lrow * 2 + 1] = __hip_atomic_fetch_add(&lcnt[e1], 1, __ATOMIC_RELAXED, __HIP_MEMORY_SCOPE_WORKGROUP);
                }
            }
            __syncthreads();
            if (tid < 8) gbase[tid] = (int)atomicAdd(ctl + CW_ECNT + 64 * tid, (unsigned)lcnt[tid]);
            __syncthreads();
            if (tid < 256) { const int e = le[tid]; TOKE[(size_t)base * 2 + tid] = e; TOKG[(size_t)base * 2 + tid] = lg[tid]; TOKP[(size_t)base * 2 + tid] = gbase[e] + lr[tid]; }
        }
        GRID_BAR();
    }
    if (IN(16)) {
        LAS int* pst = (LAS int*)lds;
        if (tid == 0) { int acc = 0; for (int e = 0; e < 8; ++e) { pst[e] = acc; const int c = (int)ctl[CW_ECNT + 64 * e]; acc += (c + 255) / 256 * 256; } pst[8] = acc; }
        __syncthreads();
        if (blockIdx.x == 0) {
            if (tid == 0) ctl[CW_MOET] = (unsigned)(pst[8] / 256);
            for (int t = tid; t < pst[8] / 256; t += 512) { int e = 0; for (int q = 1; q < 8; ++q) if (t * 256 >= pst[q]) e = q; ctl[CW_TILEE + t] = (unsigned)e; }
        }
        for (int s = gw; s < 2 * ML; s += NGW) {
            const int e = TOKE[s], pos = pst[e] + TOKP[s];
            { const uint4* src = (const uint4*)(HC + (size_t)(s >> 1) * 1024 + lane * 16); const uint4 a = src[0], b2 = src[1];
              const unsigned wv[8] = {a.x, a.y, a.z, a.w, b2.x, b2.y, b2.z, b2.w}; unsigned o4[4];
#pragma unroll
              for (int q = 0; q < 4; ++q) { unsigned t = 0u;
                  t = __builtin_amdgcn_cvt_pk_fp8_f32(pg8::clamp8(bf2f(wv[2 * q] & 0xffffu)), pg8::clamp8(bf2f(wv[2 * q] >> 16)), t, false);
                  t = __builtin_amdgcn_cvt_pk_fp8_f32(pg8::clamp8(bf2f(wv[2 * q + 1] & 0xffffu)), pg8::clamp8(bf2f(wv[2 * q + 1] >> 16)), t, true); o4[q] = t; }
              *(uint4*)(XS8 + (size_t)pos * 1024 + lane * 16) = make_uint4(o4[0], o4[1], o4[2], o4[3]); }
            if (lane == 0) TOKP[s] = pos;
        }
        GRID_BAR();
    }
    if (IN(17)) {
        const int T = (int)ctl[CW_MOET];
        { pg8::Gemm g{XS8, W_MGU, 1024, 1024, 0x7f7f7f7f, 0x79797979}; pg8::MoeOrder S; S.init(T, 2 * ED / 256, G, (int)blockIdx.x); S.tile_e = ctl + CW_TILEE; S.nper = 2 * ED / 256; S.a_off = 0; S.o_off = 0;
          pg8::EpiSwiglu8 E{HID8, ED, 1.0f, 8.0f};
          pg8::gemm_phase<pg8::EpiSwiglu8, pg8::MoeOrder, PG8_ALIGN, PG8_SP2, 1>(lds, g, S, E); }
        GRID_BAR();
    }
    if (IN(18)) {
        const int T = (int)ctl[CW_MOET];
        { pg8::Gemm g{HID8, W_MD, ED, ED, 0x7c7c7c7c, 0x79797979}; pg8::MoeOrder S; S.init(T, 4, G, (int)blockIdx.x); S.tile_e = ctl + CW_TILEE; S.nper = 4; S.a_off = 0; S.o_off = 0;
          pg8::EpiStore E{YS, 1024};
          pg8::gemm_phase<pg8::EpiStore, pg8::MoeOrder, PG8_ALIGN, PG8_SP2, 1>(lds, g, S, E); }
        GRID_BAR();
    }
    if (IN(19)) {
        for (int row = gw; row < ML; row += NGW) {
            float* dst = out + (size_t)row * 1024;
            const int mr = row >> 11;
            const int p0 = TOKP[row * 2], p1 = TOKP[row * 2 + 1]; const float g0 = TOKG[row * 2], g1 = TOKG[row * 2 + 1];
            f32x4 xv[4], a[4], b2[4]; ld_row_f32(dst, lane, xv); ld_row_bf16(YS + (size_t)p0 * 1024, lane, a); ld_row_bf16(YS + (size_t)p1 * 1024, lane, b2);
#pragma unroll
            for (int j = 0; j < 4; ++j) a[j] = a[j] * g0 + b2[j] * g1;
            rms_apply(a, g_post_ffn + 1024, lane);
            const float* gate = modp(ws, 1, mr, 5);
#pragma unroll
            for (int j = 0; j < 4; ++j) xv[j] = xv[j] + *(const f32x4*)(gate + 4 * lane + 256 * j) * a[j];
            st_row_f32(dst, lane, xv);
        }
    }
#undef IN
#undef GRID_BAR
}

extern "C" void kernel_launch(void* const* d_in, const int* in_sizes, int n_in, void* d_out, int out_size, void* d_ws, size_t ws_size, hipStream_t stream) {
    static int grid = 0;
    if (grid == 0) {
        if (n_in != 35 || in_sizes[0] != ML * D || out_size != ML * D || ws_size < WS_END) {
            fprintf(stderr, "kernel_launch: shape mismatch n_in %d in0 %d out %d ws %zu (need %zu)\n", n_in, n_in > 0 ? in_sizes[0] : -1, out_size, ws_size, (size_t)WS_END); grid = -1; return; }
        int dev = 0, cus = 0, per_cu = 0;
        if (hipGetDevice(&dev) != hipSuccess || hipDeviceGetAttribute(&cus, hipDeviceAttributeMultiprocessorCount, dev) != hipSuccess) { grid = -1; return; }
        if (hipFuncSetAttribute((const void*)fwd_kernel, hipFuncAttributeMaxDynamicSharedMemorySize, LDS_BYTES) != hipSuccess) { fprintf(stderr, "kernel_launch: hipFuncSetAttribute failed\n"); grid = -1; return; }
        if (hipOccupancyMaxActiveBlocksPerMultiprocessor(&per_cu, (const void*)fwd_kernel, 512, LDS_BYTES) != hipSuccess || per_cu < 1)
            fprintf(stderr, "kernel_launch: occupancy query reports %d\n", per_cu);
        (void)hipGetLastError();
        grid = cus;
    }
    if (grid < 0) return;
    if (hipMemsetAsync((char*)d_ws + WS_CTL, 0, CTL_ZERO_BYTES, stream) != hipSuccess) return;
    Args a{};
    for (int i = 0; i < 35; ++i) a.in[i] = (const float*)d_in[i];
    a.out = (float*)d_out; a.ws = (unsigned char*)d_ws; a.ph_lo = 0; a.ph_hi = 100; a.li = 0; a.pad = 0;
    hipLaunchKernelGGL(fwd_kernel, dim3(grid), dim3(512), LDS_BYTES, stream, a);
#ifdef PROBE_PHASES
    { const int pp[] = {PROBE_PHASES}; int li = 1;
      for (int k : pp) { a.ph_lo = k; a.ph_hi = k + 1; a.li = li++; hipLaunchKernelGGL(fwd_kernel, dim3(grid), dim3(512), LDS_BYTES, stream, a); } }
#endif
}
```

```cpp
#include <hip/hip_runtime.h>
#include <cstdio>
#include <cstdint>

constexpr int D = 1024, NB = 16, SEQ = 2048, CTXL = 256;
constexpr int ML = NB * SEQ, MX = NB * CTXL, M = ML + MX;
constexpr int IN_A = 2016, IN_AP = 2048;
constexpr int C_CQ = 0, C_CKV = 256, C_KR = 384, C_GQ = 448, C_GK = 704, C_GV = 960, C_GR = 1472, C_AF = 1984, C_AB = 2000;
constexpr int UPN = 1792;
constexpr int FFN = 2816, NE = 8, ED = 3584;
constexpr int CAP = 2 * ML + NE * 256, MAXT = CAP / 256;
constexpr float EPS = 1e-6f;
constexpr float LAM_INIT = 0.35550906759f;

constexpr size_t MiB = 1u << 20;
constexpr size_t WS_CTL = 0, CTL_ZERO_BYTES = 512 * 1024;
constexpr size_t WS_MOD = 1 * MiB;
constexpr size_t WS_ROPE = 2 * MiB;
constexpr size_t WS_TOKE = 2 * MiB + 512 * 1024;
constexpr size_t WS_TOKG = WS_TOKE + 256 * 1024;
constexpr size_t WS_TOKP = WS_TOKG + 256 * 1024;
constexpr size_t WS_CTXS = 4 * MiB;
constexpr size_t WS_W = 20 * MiB;
constexpr size_t WS_R0 = 52 * MiB;
constexpr size_t WS_PARTS = 124 * MiB;
constexpr size_t WS_Y = 124 * MiB;
constexpr size_t WS_H1 = 196 * MiB;
constexpr size_t WS_HC = 116 * MiB;
constexpr size_t WS_A2 = 268 * MiB;
constexpr size_t WS_KROPE = 295 * MiB;
constexpr size_t WS_R3 = 300 * MiB;
constexpr size_t WS_QKVUP = 372 * MiB;
constexpr size_t WS_WMD = 332 * MiB;
constexpr size_t WS_WMGU = 360 * MiB;
constexpr size_t WS_XS8 = 416 * MiB;
constexpr size_t WS_YS = 360 * MiB;
constexpr size_t WS_XST = 516 * MiB;
constexpr size_t WS_END = 580 * MiB;
constexpr int CW_BAR = 16384;
constexpr int CW_ECNT = 8192;
constexpr int CW_ATQ = 8960;
constexpr int CW_SUB = 12288;
constexpr int CW_MOET = 9000;
constexpr int CW_TILEE = 9216;

typedef unsigned short u16;
typedef float f32x4 __attribute__((ext_vector_type(4)));
#define LAS __attribute__((address_space(3)))
constexpr int LDS_BYTES = 150528;
constexpr int MISC_BASE = 149504;
constexpr int MISC_OFF = MISC_BASE + 320;

#define XB_TMO      128
#define XB_XCNT(j)  (256  + 64 * (j))
#define XB_XSUB(j)  (1280 + 64 * (j))
#define XB_XGEN(j)  (2304 + 64 * (j))
#define XB_TOP      3328
#define XB_TOPGEN   3392
#define XCD_BAR_WORDS 3456
#define XB_SPIN_CAP (1u << 23)
__device__ __forceinline__ unsigned xb_ld(unsigned* p)              { return __hip_atomic_load(p, __ATOMIC_RELAXED, __HIP_MEMORY_SCOPE_AGENT); }
__device__ __forceinline__ unsigned xb_add(unsigned* p, unsigned v) { return __hip_atomic_fetch_add(p, v, __ATOMIC_RELAXED, __HIP_MEMORY_SCOPE_AGENT); }
__device__ __forceinline__ unsigned xb_xcc_id() { return (unsigned)__builtin_amdgcn_s_getreg((3 << 11) | 20) & 0xFu; }
#define XB_SPIN(cond, bar) do { unsigned _sp = 0; while (cond) { __builtin_amdgcn_s_sleep(1); \
    if ((++_sp & 255u) == 0u) { if (xb_ld(&(bar)[XB_TMO])) break; if (_sp > XB_SPIN_CAP) { atomicAdd(&(bar)[XB_TMO], 1u); break; } } } } while (0)
struct XcdBarrier { unsigned* bar; unsigned x; volatile LAS unsigned* st; };
__device__ __forceinline__ XcdBarrier xcd_barrier_post(unsigned* bar, volatile LAS unsigned* st) {
    XcdBarrier b; b.bar = bar; b.x = xb_xcc_id(); b.st = st;
    if (threadIdx.x == 0) (void)xb_add(&bar[XB_XCNT(b.x)], 1u);
    return b;
}
__device__ __forceinline__ void xcd_barrier_complete(unsigned* bar, unsigned x, unsigned& nloc, unsigned& nx) {
    const unsigned G = gridDim.x * gridDim.y * gridDim.z;
    unsigned sum, cnt, mine, sp = 0u;
    for (;;) {
        sum = 0u; cnt = 0u; mine = 0u;
#pragma unroll
        for (unsigned j = 0; j < 16; ++j) { const unsigned c = xb_ld(&bar[XB_XCNT(j)]); sum += c; cnt += (c > 0u) ? 1u : 0u; mine = (j == x) ? c : mine; }
        if (sum == G) break;
        __builtin_amdgcn_s_sleep(1);
        if ((++sp & 255u) == 0u) { if (xb_ld(&bar[XB_TMO])) break; if (sp > XB_SPIN_CAP) { atomicAdd(&bar[XB_TMO], 1u); break; } }
    }
    nloc = mine > 0u ? mine : 1u; nx = cnt > 0u ? cnt : 1u;
}
__device__ __forceinline__ void xcd_barrier(const XcdBarrier& b) {
    asm volatile("s_waitcnt vmcnt(0)" ::: "memory");
    __syncthreads();
    if (threadIdx.x == 0) {
        unsigned* bar = b.bar;
        __builtin_amdgcn_s_waitcnt(0);
        unsigned nloc = b.st[0], nx = b.st[1];
        if (nloc == 0u) { xcd_barrier_complete(bar, b.x, nloc, nx); b.st[0] = nloc; b.st[1] = nx; }
        const unsigned old = xb_add(&bar[XB_XSUB(b.x)], 1u);
        const unsigned gen = old / nloc;
        if (old + 1u == (gen + 1u) * nloc) {
            __builtin_amdgcn_fence(__ATOMIC_RELEASE, "agent");
            asm volatile("s_waitcnt vmcnt(0)" ::: "memory");
            const unsigned og = xb_add(&bar[XB_TOP], 1u);
            const unsigned tg = og / nx;
            if (og + 1u == (tg + 1u) * nx) xb_add(&bar[XB_TOPGEN], 1u);
            else XB_SPIN(xb_ld(&bar[XB_TOPGEN]) == tg, bar);
            __builtin_amdgcn_fence(__ATOMIC_ACQUIRE, "agent");
            xb_add(&bar[XB_XGEN(b.x)], 1u);
            asm volatile("s_waitcnt vmcnt(0)" ::: "memory");
        } else {
            XB_SPIN(xb_ld(&bar[XB_XGEN(b.x)]) == gen, bar);
            __builtin_amdgcn_fence(__ATOMIC_ACQUIRE, "agent");
            asm volatile("s_waitcnt vmcnt(0)" ::: "memory");
        }
    }
    __syncthreads();
}

__device__ __forceinline__ void sub_arrive(unsigned* ctr) {
    asm volatile("s_waitcnt vmcnt(0)" ::: "memory");
    __syncthreads();
    if (threadIdx.x == 0) { __builtin_amdgcn_fence(__ATOMIC_RELEASE, "agent"); asm volatile("s_waitcnt vmcnt(0)" ::: "memory"); (void)xb_add(ctr, 1u); }
}
__device__ __forceinline__ void sub_wait(unsigned* ctr, unsigned n) {
    if (threadIdx.x == 0) { unsigned sp = 0u; while (xb_ld(ctr) < n) { __builtin_amdgcn_s_sleep(2); if (++sp > XB_SPIN_CAP) break; }
        __builtin_amdgcn_fence(__ATOMIC_ACQUIRE, "agent"); asm volatile("s_waitcnt vmcnt(0)" ::: "memory"); }
    __syncthreads();
}

__device__ __forceinline__ float bf2f(unsigned h) { return __uint_as_float(h << 16); }
__device__ __forceinline__ unsigned f2bf(float f) { unsigned u = __float_as_uint(f); return (u + 0x7fffu + ((u >> 16) & 1u)) >> 16; }
template <int CTRL> __device__ __forceinline__ float dpp_mov(float v) { return __builtin_bit_cast(float, __builtin_amdgcn_update_dpp(0, __builtin_bit_cast(int, v), CTRL, 0xF, 0xF, true)); }
__device__ __forceinline__ float row16_sum(float v) {
    v += dpp_mov<0xB1>(v);
    v += dpp_mov<0x4E>(v);
    v += dpp_mov<0x141>(v);
    v += dpp_mov<0x140>(v);
    return v;
}
__device__ __forceinline__ float wave_sum(float v) {
    v = row16_sum(v);
    const float r0 = __int_as_float(__builtin_amdgcn_readlane(__float_as_int(v), 0)), r1 = __int_as_float(__builtin_amdgcn_readlane(__float_as_int(v), 16));
    const float r2 = __int_as_float(__builtin_amdgcn_readlane(__float_as_int(v), 32)), r3 = __int_as_float(__builtin_amdgcn_readlane(__float_as_int(v), 48));
    return (r0 + r1) + (r2 + r3);
}
__device__ __forceinline__ float silu_f(float x) { return x / (1.0f + __expf(-x)); }
__device__ __forceinline__ void ld_row_f32(const float* p, int lane, f32x4 (&v)[4]) {
#pragma unroll
    for (int j = 0; j < 4; ++j) v[j] = *(const f32x4*)(p + 4 * lane + 256 * j);
}
__device__ __forceinline__ void ld_row_bf16(const u16* p, int lane, f32x4 (&v)[4]) {
#pragma unroll
    for (int j = 0; j < 4; ++j) { const uint2 w = *(const uint2*)(p + 4 * lane + 256 * j);
        v[j] = (f32x4){bf2f(w.x & 0xffffu), bf2f(w.x >> 16), bf2f(w.y & 0xffffu), bf2f(w.y >> 16)}; }
}
typedef float f32x2h __attribute__((ext_vector_type(2)));
__device__ __forceinline__ void ld_row_fp8(const unsigned char* p, int lane, f32x4 (&v)[4]) {
#pragma unroll
    for (int j = 0; j < 4; ++j) { const int w = *(const int*)(p + 4 * lane + 256 * j);
        const f32x2h lo = __builtin_amdgcn_cvt_pk_f32_fp8(w, false), hi = __builtin_amdgcn_cvt_pk_f32_fp8(w, true);
        v[j] = (f32x4){lo.x, lo.y, hi.x, hi.y}; }
}
__device__ __forceinline__ void st_row_f32(float* p, int lane, const f32x4 (&v)[4]) {
#pragma unroll
    for (int j = 0; j < 4; ++j) *(f32x4*)(p + 4 * lane + 256 * j) = v[j];
}
__device__ __forceinline__ void st_row_bf16(u16* p, int lane, const f32x4 (&v)[4]) {
#pragma unroll
    for (int j = 0; j < 4; ++j) { uint2 w; w.x = f2bf(v[j].x) | (f2bf(v[j].y) << 16); w.y = f2bf(v[j].z) | (f2bf(v[j].w) << 16);
        *(uint2*)(p + 4 * lane + 256 * j) = w; }
}
__device__ __forceinline__ float row_rstd(const f32x4 (&v)[4]) {
    float s = 0.f;
#pragma unroll
    for (int j = 0; j < 4; ++j) s += (v[j].x * v[j].x + v[j].y * v[j].y) + (v[j].z * v[j].z + v[j].w * v[j].w);
    s = wave_sum(s);
    return 1.0f / sqrtf(s * (1.0f / 1024.0f) + EPS);
}
__device__ __forceinline__ void rms_apply(f32x4 (&v)[4], const float* g, int lane) {
    const float r = row_rstd(v);
#pragma unroll
    for (int j = 0; j < 4; ++j) { const f32x4 gg = *(const f32x4*)(g + 4 * lane + 256 * j); v[j] = v[j] * r * gg; }
}
__device__ __forceinline__ void ld_vec(const float* p, int lane, f32x4 (&v)[4]) {
#pragma unroll
    for (int j = 0; j < 4; ++j) v[j] = *(const f32x4*)(p + 4 * lane + 256 * j);
}
__device__ __forceinline__ void premod(const f32x4 (&x)[4], f32x4 (&h)[4], const float* g, const float* shift, const float* scale, int lane) {
    const float r = row_rstd(x);
#pragma unroll
    for (int j = 0; j < 4; ++j) { const int c = 4 * lane + 256 * j; const f32x4 gg = *(const f32x4*)(g + c), sh = *(const f32x4*)(shift + c), sc = *(const f32x4*)(scale + c);
        h[j] = x[j] * r * gg * (1.0f + sc) + sh; }
}

struct Args { const float* in[35]; float* out; unsigned char* ws; int ph_lo, ph_hi, li, pad; };

__device__ __forceinline__ const float* modp(const unsigned char* ws, int l, int r, int which) { return (const float*)(ws + WS_MOD) + ((size_t)(l * 17 + r) * 6 + which) * 1024; }

#ifndef PG8_SP2
#define PG8_SP2 true
#endif
#ifndef PG8_ALIGN
#define PG8_ALIGN true
#endif
namespace pg8 {
typedef short bf16x8 __attribute__((ext_vector_type(8)));
typedef unsigned u32x4 __attribute__((ext_vector_type(4)));
typedef int v8i __attribute__((ext_vector_type(8)));
typedef int v4i __attribute__((ext_vector_type(4)));
typedef unsigned u32x2 __attribute__((ext_vector_type(2)));
constexpr int BM = 256, BK = 64, HALF = 128, HTB = HALF * BK * 2, STAGE_BYTES = 8 * HTB, NXCD = 8, WGM = 8;
__host__ __device__ __forceinline__ int lds_byte(int r, int c) { const int st = (r >> 4) * 2 + (c >> 5), rr = r & 15, cc = c & 31, ob = rr * 64 + cc * 2; return st * 1024 + (ob ^ (((ob >> 9) & 1) << 5)); }
__host__ __device__ __forceinline__ void stage_rc(int b, int& R, int& C) { const int st = b / 1024, sb = b % 1024, swz = sb ^ (((sb >> 9) & 1) << 5); R = (st >> 1) * 16 + swz / 64; C = (st & 1) * 32 + (swz % 64) / 2; }
__host__ __device__ __forceinline__ int perm32(int rho) { const int n = rho >> 4, i = rho & 15; return 8 * (i >> 2) + 4 * n + (i & 3); }

struct Unit { int pm, pn, po, pc; };
struct Gemm { const void* A; const void* Bt; int lda; int K; int sa, sb; };

struct DenseOrder {
    int nM, nN, nwg, G, c;
    __device__ __forceinline__ void init(int nM_, int nN_, int G_, int c_) { nM = nM_; nN = nN_; nwg = nM * nN; G = G_; c = c_; }
    __device__ __forceinline__ bool next2(int i, int& pm, int& pn) const {
        const long L = (long)i * G + c; if (L >= nwg) return false;
        int wgid = (int)L; { const int q = nwg / NXCD, r = nwg % NXCD, xcd = wgid % NXCD, off = wgid / NXCD; wgid = (xcd < r ? xcd * (q + 1) : r * (q + 1) + (xcd - r) * q) + off; }
        const int nig = WGM * nN, gid = wgid / nig, fm = gid * WGM, gsz = (nM - fm) < WGM ? (nM - fm) : WGM;
        pm = fm + ((wgid % nig) % gsz); pn = (wgid % nig) / gsz; return true;
    }
    __device__ __forceinline__ bool next(int i, Unit& u) const { int pm, pn; if (!next2(i, pm, pn)) return false; u.pm = pm; u.pn = pn; u.po = pm; u.pc = pn; return true; }
    __device__ __forceinline__ void a_ready(const Unit&) const {}
    __device__ __forceinline__ void done(const Unit&) const {}
};
struct MoeOrder : DenseOrder {
    const unsigned* tile_e; int nper, a_off, o_off;
    __device__ __forceinline__ bool next(int i, Unit& u) const { int pm, pn; if (!next2(i, pm, pn)) return false;
        const int e = (int)tile_e[pm]; u.pm = a_off + pm; u.pn = e * nper + pn; u.po = o_off + pm; u.pc = pn; return true; }
};

__device__ __forceinline__ unsigned cvt_pk_bf16(float lo, float hi) { unsigned r; asm volatile("v_cvt_pk_bf16_f32 %0, %1, %2" : "=v"(r) : "v"(lo), "v"(hi)); return r; }

struct EpiStore {
    static constexpr bool PERM = true, AFTER_DRAIN = false;
    u16* O; int ldc;
    __device__ __forceinline__ void operator()(const f32x4 (&acc)[2][2][4][2], const Unit& u, int wr, int wc, int fr, int fq) const {
        const int row0 = u.po * BM + wr * 64 + fr, col0 = u.pc * BM + wc * 32 + 8 * fq;
#pragma unroll
        for (int ai = 0; ai < 2; ++ai)
#pragma unroll
            for (int m = 0; m < 4; ++m) { u16* rowp = O + (size_t)(row0 + ai * HALF + m * 16) * ldc + col0;
#pragma unroll
                for (int bj = 0; bj < 2; ++bj) { const f32x4 v0 = acc[ai][bj][m][0], v1 = acc[ai][bj][m][1];
                    u32x4 w; w.x = cvt_pk_bf16(v0[0], v0[1]); w.y = cvt_pk_bf16(v0[2], v0[3]); w.z = cvt_pk_bf16(v1[0], v1[1]); w.w = cvt_pk_bf16(v1[2], v1[3]);
                    *(u32x4*)(rowp + bj * HALF) = w; } }
    }
};
template <int MODE> struct EpiStoreRope {
    static constexpr bool PERM = true, AFTER_DRAIN = false; static constexpr float QSC = (MODE == 0 ? 0.125f : 0.07216878364870322f) * 1.4426950408889634f;
    u16* O; int ldc; const float* rc; const float* rs;
    __device__ __forceinline__ void operator()(const f32x4 (&acc)[2][2][4][2], const Unit& u, int wr, int wc, int fr, int fq) const {
        const int row0 = u.po * BM + wr * 64 + fr, col0 = u.pc * BM + wc * 32 + 8 * fq;
        const bool lat = u.po * BM < ML;
#pragma unroll
        for (int ai = 0; ai < 2; ++ai)
#pragma unroll
            for (int m = 0; m < 4; ++m) { const int row = row0 + ai * HALF + m * 16; u16* rowp = O + (size_t)row * ldc + col0; const int t = row & (SEQ - 1);
#pragma unroll
                for (int bj = 0; bj < 2; ++bj) { f32x4 v0 = acc[ai][bj][m][0], v1 = acc[ai][bj][m][1];
                    const int c8 = col0 + bj * HALF;
                    const bool rope = lat && (MODE == 0 ? (c8 < 2048) : (c8 < 768 && (c8 % 192) >= 128));
                    if (rope) { const int i0 = (c8 & 63) >> 1; const f32x4 cs = *(const f32x4*)(rc + t * 32 + i0), sn = *(const f32x4*)(rs + t * 32 + i0);
                        const f32x4 a = v0, b = v1;
                        v0[0] = a[0] * cs[0] - a[1] * sn[0]; v0[1] = a[1] * cs[0] + a[0] * sn[0]; v0[2] = a[2] * cs[1] - a[3] * sn[1]; v0[3] = a[3] * cs[1] + a[2] * sn[1];
                        v1[0] = b[0] * cs[2] - b[1] * sn[2]; v1[1] = b[1] * cs[2] + b[0] * sn[2]; v1[2] = b[2] * cs[3] - b[3] * sn[3]; v1[3] = b[3] * cs[3] + b[2] * sn[3]; }
                    if (MODE == 0 ? (c8 < 1024) : (c8 < 768)) { v0 = v0 * QSC; v1 = v1 * QSC; }
                    u32x4 w; w.x = cvt_pk_bf16(v0[0], v0[1]); w.y = cvt_pk_bf16(v0[2], v0[3]); w.z = cvt_pk_bf16(v1[0], v1[1]); w.w = cvt_pk_bf16(v1[2], v1[3]);
                    *(u32x4*)(rowp + bj * HALF) = w; } }
    }
};
struct EpiSwiglu {
    static constexpr bool PERM = true, AFTER_DRAIN = false;
    u16* O; int ldc;
    __device__ __forceinline__ void operator()(const f32x4 (&acc)[2][2][4][2], const Unit& u, int wr, int wc, int fr, int fq) const {
        const int row0 = u.po * BM + wr * 64 + fr, col0 = u.pc * HALF + wc * 32 + 8 * fq;
#pragma unroll
        for (int ai = 0; ai < 2; ++ai)
#pragma unroll
            for (int m = 0; m < 4; ++m) { u16* rowp = O + (size_t)(row0 + ai * HALF + m * 16) * ldc + col0;
                float hv[8];
#pragma unroll
                for (int n = 0; n < 2; ++n)
#pragma unroll
                    for (int q = 0; q < 4; ++q) { const float g = acc[ai][0][m][n][q], up = acc[ai][1][m][n][q]; hv[n * 4 + q] = g * __builtin_amdgcn_rcpf(1.0f + __expf(-g)) * up; }
                u32x4 w; w.x = cvt_pk_bf16(hv[0], hv[1]); w.y = cvt_pk_bf16(hv[2], hv[3]); w.z = cvt_pk_bf16(hv[4], hv[5]); w.w = cvt_pk_bf16(hv[6], hv[7]);
                *(u32x4*)rowp = w; }
    }
};

__device__ __forceinline__ float clamp8(float x) { return __builtin_amdgcn_fmed3f(x, -448.0f, 448.0f); }
__device__ __forceinline__ unsigned cvt_pk4_fp8(float a, float b, float c, float d) { unsigned r;
    asm volatile("v_cvt_pk_fp8_f32 %0, %1, %2\n\tv_cvt_pk_fp8_f32 %0, %3, %4 op_sel:[0,0,1]" : "=&v"(r) : "v"(a), "v"(b), "v"(c), "v"(d)); return r; }
struct EpiStore8 {
    static constexpr bool PERM = true, AFTER_DRAIN = false;
    unsigned char* O; int ldc; float osc;
    __device__ __forceinline__ void operator()(const f32x4 (&acc)[2][2][4][2], const Unit& u, int wr, int wc, int fr, int fq) const {
        const int row0 = u.po * BM + wr * 64 + fr, col0 = u.pc * BM + wc * 32 + 8 * fq;
#pragma unroll
        for (int ai = 0; ai < 2; ++ai)
#pragma unroll
            for (int m = 0; m < 4; ++m) { unsigned char* rowp = O + (size_t)(row0 + ai * HALF + m * 16) * ldc + col0;
#pragma unroll
                for (int bj = 0; bj < 2; ++bj) { const f32x4 v0 = acc[ai][bj][m][0] * osc, v1 = acc[ai][bj][m][1] * osc;
                    u32x2 w; w.x = cvt_pk4_fp8(clamp8(v0[0]), clamp8(v0[1]), clamp8(v0[2]), clamp8(v0[3])); w.y = cvt_pk4_fp8(clamp8(v1[0]), clamp8(v1[1]), clamp8(v1[2]), clamp8(v1[3]));
                    *(u32x2*)(rowp + bj * HALF) = w; } }
    }
};
struct EpiSwiglu8 {
    static constexpr bool PERM = true, AFTER_DRAIN = false;
    unsigned char* O; int ldc;
    __device__ __forceinline__ void operator()(const f32x4 (&acc)[2][2][4][2], const Unit& u, int wr, int wc, int fr, int fq) const {
        const int row0 = u.po * BM + wr * 64 + fr, col0 = u.pc * HALF + wc * 32 + 8 * fq;
#pragma unroll
        for (int ai = 0; ai < 2; ++ai)
#pragma unroll
            for (int m = 0; m < 4; ++m) { unsigned char* rowp = O + (size_t)(row0 + ai * HALF + m * 16) * ldc + col0;
                float hv[8];
#pragma unroll
                for (int n = 0; n < 2; ++n)
#pragma unroll
                    for (int q = 0; q < 4; ++q) { const float gt = acc[ai][0][m][n][q], up = acc[ai][1][m][n][q];
                        hv[n * 4 + q] = clamp8((gt * up) * __builtin_amdgcn_rcpf(1.0f + __builtin_amdgcn_exp2f(gt * -1.4426950408889634f))); }
                u32x2 w; w.x = cvt_pk4_fp8(hv[0], hv[1], hv[2], hv[3]); w.y = cvt_pk4_fp8(hv[4], hv[5], hv[6], hv[7]); *(u32x2*)rowp = w; }
    }
};
template <class Epi, class Sched, bool ALIGN_EPI = false, bool SP2 = false, int EB = 2>
__device__ __forceinline__ void gemm_phase(LAS unsigned char* lds, const Gemm g, const Sched& S, const Epi& E) {
    const int tid = threadIdx.x, wid = __builtin_amdgcn_readfirstlane(tid >> 6), lane = tid & 63, wr = wid >> 2, wc = wid & 3, fr = lane & 15, fq = lane >> 4;
    const int K = g.K, nt = K * EB / (BK * 2), lda = g.lda;
    const auto rsA = __builtin_amdgcn_make_buffer_rsrc((void*)g.A, 0, 0x7fffffff, 0x00020000);
    const auto rsB = __builtin_amdgcn_make_buffer_rsrc((void*)g.Bt, 0, 0x7fffffff, 0x00020000);
    unsigned voffA, voffB;
    { int R, C; stage_rc(tid * 16, R, C); const int Rb = Epi::PERM ? ((R & ~31) + perm32(R & 31)) : R;
      voffA = (unsigned)(R * lda * EB + C * 2); voffB = (unsigned)(Rb * K * EB + C * 2); }
    const unsigned kstep = (unsigned)(BK * 2);
    const unsigned hA = (unsigned)(HALF * lda * EB), hB = (unsigned)(HALF * K * EB);
    const unsigned qA = hA >> 1, qB = hB >> 1;
    const unsigned tA = 2 * hA, tB = 2 * hB;
    const unsigned ldsw = (unsigned)wid * 1024u;
    const int aoff = lds_byte(wr * 64 + fr, fq * 8), boff = lds_byte(wc * 32 + fr, fq * 8);
#define PG8_SA(b, h) (((b) * 2 + (h)) * HTB)
#define PG8_SB(b, h) ((4 + (b) * 2 + (h)) * HTB)
#define PG8_STAGE_A(bufoff, soff) do { __builtin_amdgcn_raw_ptr_buffer_load_lds(rsA, (LAS unsigned*)(lds + (bufoff) + ldsw), 16, voffA, (soff), 0, 0); \
        __builtin_amdgcn_raw_ptr_buffer_load_lds(rsA, (LAS unsigned*)(lds + (bufoff) + ldsw + 8192), 16, voffA, (soff) + qA, 0, 0); } while (0)
#define PG8_STAGE_B(bufoff, soff) do { __builtin_amdgcn_raw_ptr_buffer_load_lds(rsB, (LAS unsigned*)(lds + (bufoff) + ldsw), 16, voffB, (soff), 0, 0); \
        __builtin_amdgcn_raw_ptr_buffer_load_lds(rsB, (LAS unsigned*)(lds + (bufoff) + ldsw + 8192), 16, voffB, (soff) + qB, 0, 0); } while (0)
#define PG8_LDA(dst, b, h) do { if constexpr (EB == 2) { _Pragma("unroll") for (int m = 0; m < 4; ++m) _Pragma("unroll") for (int k = 0; k < 2; ++k) dst[m][k] = *(const LAS bf16x8*)(lds + PG8_SA(b, h) + aoff + m * 2048 + k * 1024); } \
        else { _Pragma("unroll") for (int m = 0; m < 4; ++m) dst##8[m] = __builtin_shufflevector(*(const LAS v4i*)(lds + PG8_SA(b, h) + aoff + m * 2048), *(const LAS v4i*)(lds + PG8_SA(b, h) + aoff + m * 2048 + 1024), 0, 1, 2, 3, 4, 5, 6, 7); } } while (0)
#define PG8_LDB(dst, b, h) do { if constexpr (EB == 2) { _Pragma("unroll") for (int n = 0; n < 2; ++n) _Pragma("unroll") for (int k = 0; k < 2; ++k) dst[n][k] = *(const LAS bf16x8*)(lds + PG8_SB(b, h) + boff + n * 2048 + k * 1024); } \
        else { _Pragma("unroll") for (int n = 0; n < 2; ++n) dst##8[n] = __builtin_shufflevector(*(const LAS v4i*)(lds + PG8_SB(b, h) + boff + n * 2048), *(const LAS v4i*)(lds + PG8_SB(b, h) + boff + n * 2048 + 1024), 0, 1, 2, 3, 4, 5, 6, 7); } } while (0)
#define PG8_MMA(ai, bj, At, Bt) do { __builtin_amdgcn_s_setprio(1); _Pragma("unroll") for (int m = 0; m < 4; ++m) _Pragma("unroll") for (int n = 0; n < 2; ++n) { \
        if constexpr (EB == 2) { _Pragma("unroll") for (int k = 0; k < 2; ++k) acc[ai][bj][m][n] = __builtin_amdgcn_mfma_f32_16x16x32_bf16(Bt[n][k], At[m][k], acc[ai][bj][m][n], 0, 0, 0); } \
        else { asm volatile("v_mfma_scale_f32_16x16x128_f8f6f4 %0, %1, %2, %0, %3, %4 op_sel_hi:[0,0,0]" : "+v"(acc[ai][bj][m][n]) : "v"(Bt##8[n]), "v"(At##8[m]), "v"(vsb), "v"(vsa)); } } \
        __builtin_amdgcn_s_setprio(0); } while (0)
#define PG8_WAIT_V(n) asm volatile("s_waitcnt vmcnt(" #n ")" ::: "memory")
#define PG8_WAIT_L(n) asm volatile("s_waitcnt lgkmcnt(" #n ")" ::: "memory")
#define PG8_BAR __builtin_amdgcn_s_barrier()
#define PG8_SCHED __builtin_amdgcn_sched_barrier(0)
    Unit cur, nxt; int ui = 0;
    if (!S.next(0, cur)) return;
    int vsa = g.sa, vsb = g.sb; asm volatile("" : "+v"(vsa), "+v"(vsb));
    f32x4 acc[2][2][4][2];
#pragma unroll
    for (int a = 0; a < 2; ++a)
#pragma unroll
        for (int b = 0; b < 2; ++b)
#pragma unroll
            for (int m = 0; m < 4; ++m)
#pragma unroll
                for (int n = 0; n < 2; ++n) acc[a][b][m][n] = (f32x4){0.f, 0.f, 0.f, 0.f};
    bf16x8 At[4][2], B0[2][2], B1[2][2]; v8i At8[4], B08[2], B18[2];
    unsigned cA = (unsigned)cur.pm * tA, cB = (unsigned)cur.pn * tB;
    S.a_ready(cur);
    if constexpr (SP2) {
        PG8_STAGE_B(PG8_SB(0, 0), cB); PG8_STAGE_B(PG8_SB(0, 1), cB + hB); PG8_STAGE_A(PG8_SA(0, 0), cA); PG8_STAGE_A(PG8_SA(0, 1), cA + hA);
        if (wr == 1) PG8_BAR;
        PG8_WAIT_V(2); PG8_BAR;
        PG8_STAGE_B(PG8_SB(1, 0), cB + kstep); PG8_STAGE_A(PG8_SA(1, 0), cA + kstep); PG8_STAGE_B(PG8_SB(1, 1), cB + hB + kstep);
        PG8_WAIT_V(6); PG8_BAR;
    } else {
        PG8_STAGE_B(PG8_SB(0, 0), cB); PG8_STAGE_A(PG8_SA(0, 0), cA); PG8_STAGE_B(PG8_SB(0, 1), cB + hB); PG8_STAGE_A(PG8_SA(0, 1), cA + hA);
        if (wr == 1) PG8_BAR;
        PG8_WAIT_V(4); PG8_BAR;
        PG8_STAGE_B(PG8_SB(1, 0), cB + kstep); PG8_STAGE_A(PG8_SA(1, 0), cA + kstep); PG8_STAGE_B(PG8_SB(1, 1), cB + hB + kstep);
        PG8_WAIT_V(6); PG8_BAR;
    }
    for (;;) {
        const bool has_next = S.next(ui + 1, nxt);
        const unsigned nA = has_next ? (unsigned)nxt.pm * tA : cA, nB = has_next ? (unsigned)nxt.pn * tB : cB;
#pragma unroll 1
        for (int t = 0; t < nt; t += 2) {
            const bool last = (t == nt - 2);
            const unsigned a1 = cA + (unsigned)(t + 1) * kstep;
            const unsigned a2 = last ? nA : cA + (unsigned)(t + 2) * kstep, b2 = last ? nB : cB + (unsigned)(t + 2) * kstep;
            const unsigned a3 = a2 + kstep, b3 = b2 + kstep;
            if (last && has_next) S.a_ready(nxt);
            if constexpr (SP2) {
            PG8_LDB(B0, 0, 0); PG8_LDB(B1, 0, 1); PG8_SCHED; PG8_LDA(At, 0, 0); PG8_STAGE_A(PG8_SA(1, 1), a1 + hA);
            PG8_WAIT_V(8); PG8_WAIT_L(0); PG8_BAR; PG8_MMA(0, 0, At, B0); PG8_MMA(0, 1, At, B1); PG8_BAR; PG8_SCHED;
            PG8_LDA(At, 0, 1); PG8_STAGE_B(PG8_SB(0, 0), b2); PG8_STAGE_B(PG8_SB(0, 1), b2 + hB); PG8_STAGE_A(PG8_SA(0, 0), a2);
            PG8_WAIT_V(8); PG8_WAIT_L(0); PG8_BAR; PG8_MMA(1, 0, At, B0); PG8_MMA(1, 1, At, B1); PG8_BAR; PG8_SCHED;
            PG8_LDB(B0, 1, 0); PG8_LDB(B1, 1, 1); PG8_SCHED; PG8_LDA(At, 1, 0); PG8_STAGE_A(PG8_SA(0, 1), a2 + hA);
            PG8_WAIT_V(8); PG8_WAIT_L(0); PG8_BAR; PG8_MMA(0, 0, At, B0); PG8_MMA(0, 1, At, B1); PG8_BAR; PG8_SCHED;
            PG8_LDA(At, 1, 1); PG8_STAGE_B(PG8_SB(1, 0), b3); PG8_STAGE_B(PG8_SB(1, 1), b3 + hB); PG8_STAGE_A(PG8_SA(1, 0), a3);
            PG8_WAIT_V(8); PG8_WAIT_L(0); PG8_BAR; PG8_MMA(1, 0, At, B0); PG8_MMA(1, 1, At, B1); PG8_BAR; PG8_SCHED;
            } else {
            PG8_LDB(B0, 0, 0); PG8_SCHED; PG8_LDA(At, 0, 0); PG8_STAGE_A(PG8_SA(1, 1), a1 + hA);
            PG8_WAIT_L(8); PG8_BAR; PG8_WAIT_L(0); PG8_MMA(0, 0, At, B0); PG8_BAR; PG8_SCHED;
            PG8_LDB(B1, 0, 1); PG8_STAGE_B(PG8_SB(0, 0), b2);
            PG8_BAR; PG8_WAIT_L(0); PG8_MMA(0, 1, At, B1); PG8_BAR;
            PG8_LDA(At, 0, 1); PG8_STAGE_A(PG8_SA(0, 0), a2);
            PG8_BAR; PG8_WAIT_L(0); PG8_MMA(1, 0, At, B0); PG8_BAR; PG8_SCHED;
            PG8_STAGE_B(PG8_SB(0, 1), b2 + hB);
            PG8_WAIT_V(6); PG8_BAR; PG8_MMA(1, 1, At, B1); PG8_BAR;
            PG8_LDB(B0, 1, 0); PG8_SCHED; PG8_LDA(At, 1, 0); PG8_STAGE_A(PG8_SA(0, 1), a2 + hA);
            PG8_WAIT_L(8); PG8_BAR; PG8_WAIT_L(0); PG8_MMA(0, 0, At, B0); PG8_BAR; PG8_SCHED;
            PG8_LDB(B1, 1, 1); PG8_STAGE_B(PG8_SB(1, 0), b3);
            PG8_BAR; PG8_WAIT_L(0); PG8_MMA(0, 1, At, B1); PG8_BAR;
            PG8_LDA(At, 1, 1); PG8_STAGE_A(PG8_SA(1, 0), a3);
            PG8_BAR; PG8_WAIT_L(0); PG8_MMA(1, 0, At, B0); PG8_BAR; PG8_SCHED;
            PG8_STAGE_B(PG8_SB(1, 1), b3 + hB);
            PG8_WAIT_V(6); PG8_BAR; PG8_MMA(1, 1, At, B1); PG8_BAR;
            }
        }
        if constexpr (ALIGN_EPI) { if (wr == 0) PG8_BAR; }
        if constexpr (EB == 1) asm volatile("s_nop 15\n\ts_nop 15" ::: "memory");
        E(acc, cur, wr, wc, fr, fq); S.done(cur);
        if (!has_next) break;
#pragma unroll
        for (int a = 0; a < 2; ++a)
#pragma unroll
            for (int b = 0; b < 2; ++b)
#pragma unroll
                for (int m = 0; m < 4; ++m)
#pragma unroll
                    for (int n = 0; n < 2; ++n) acc[a][b][m][n] = (f32x4){0.f, 0.f, 0.f, 0.f};
        cur = nxt; cA = nA; cB = nB; ++ui;
        if constexpr (EB == 1) asm volatile("s_nop 7" ::: "memory");
        if constexpr (ALIGN_EPI) { if (wr == 1) PG8_BAR; }
    }
    PG8_WAIT_V(0);
    if constexpr (!ALIGN_EPI) { if (wr == 0) PG8_BAR; }
    PG8_BAR;
#undef PG8_SA
#undef PG8_SB
#undef PG8_STAGE_A
#undef PG8_STAGE_B
#undef PG8_LDA
#undef PG8_LDB
#undef PG8_MMA
#undef PG8_WAIT_V
#undef PG8_WAIT_L
#undef PG8_BAR
#undef PG8_SCHED
}
}

struct RowMap2 { int r0, st; };
__device__ __forceinline__ void cvt_item(const float* W, int ldw, u16* WT, int ldt, int k0, int n0, int drow0, int dstr, int dcol0, LAS float* scr, int lane) {
#pragma unroll 8
    for (int i = 0; i < 32; ++i) { const int kk = 2 * i + (lane >> 5); scr[kk * 33 + (lane & 31)] = W[(size_t)(k0 + kk) * ldw + n0 + (lane & 31)]; }
    asm volatile("s_waitcnt lgkmcnt(0)" ::: "memory");
    const int c = lane & 7;
#pragma unroll
    for (int j = 0; j < 4; ++j) { const int n = (lane >> 3) + 8 * j; const LAS float* s = scr + (8 * c) * 33 + n;
        uint4 o; o.x = f2bf(s[0 * 33]) | (f2bf(s[1 * 33]) << 16); o.y = f2bf(s[2 * 33]) | (f2bf(s[3 * 33]) << 16); o.z = f2bf(s[4 * 33]) | (f2bf(s[5 * 33]) << 16); o.w = f2bf(s[6 * 33]) | (f2bf(s[7 * 33]) << 16);
        *(uint4*)(WT + (size_t)(drow0 + n * dstr) * ldt + dcol0 + k0 + 8 * c) = o; }
    asm volatile("s_waitcnt lgkmcnt(0)" ::: "memory");
}
__device__ __forceinline__ void cvt_item8(const float* W, int ldw, unsigned char* WT, int ldt, int k0, int n0, int drow0, float scale, LAS float* scr, int lane) {
#pragma unroll 8
    for (int i = 0; i < 32; ++i) { const int kk = 2 * i + (lane >> 5); scr[kk * 33 + (lane & 31)] = W[(size_t)(k0 + kk) * ldw + n0 + (lane & 31)]; }
    asm volatile("s_waitcnt lgkmcnt(0)" ::: "memory");
    const int c = lane & 3;
#pragma unroll
    for (int j = 0; j < 2; ++j) { const int n = (lane >> 2) + 16 * j; const LAS float* s = scr + (16 * c) * 33 + n;
        unsigned w[4];
#pragma unroll
        for (int q = 0; q < 4; ++q) { unsigned t = 0u; t = __builtin_amdgcn_cvt_pk_fp8_f32(s[(4 * q + 0) * 33] * scale, s[(4 * q + 1) * 33] * scale, t, false);
            t = __builtin_amdgcn_cvt_pk_fp8_f32(s[(4 * q + 2) * 33] * scale, s[(4 * q + 3) * 33] * scale, t, true); w[q] = t; }
        *(uint4*)(WT + (size_t)(drow0 + n) * ldt + k0 + 16 * c) = make_uint4(w[0], w[1], w[2], w[3]); }
    asm volatile("s_waitcnt lgkmcnt(0)" ::: "memory");
}
template <class RowMap>
__device__ __forceinline__ void cvt_matrix8(const float* W, int K, int N, unsigned char* WT, int ldt, float scale, const RowMap& rowmap, LAS float* scr, int lane, int gw, int NGW, int& off) {
    const int nblk = N / 32, nitems = (K / 64) * nblk;
    int it = (gw - off) % NGW; if (it < 0) it += NGW;
    for (; it < nitems; it += NGW) { const int kb = it / nblk, nb = it % nblk; cvt_item8(W, N, WT, ldt, kb * 64, nb * 32, rowmap(nb * 32), scale, scr, lane); }
    off = (off + nitems) % NGW;
}
template <class RowMap>
__device__ __forceinline__ void cvt_matrix(const float* W, int K, int N, u16* WT, int ldt, int dcol0, const RowMap& rowmap, LAS float* scr, int lane, int gw, int NGW, int& off) {
    const int nblk = N / 32, nitems = (K / 64) * nblk;
    int it = (gw - off) % NGW; if (it < 0) it += NGW;
    for (; it < nitems; it += NGW) { const int kb = it / nblk, nb = it % nblk; const RowMap2 rm = rowmap(nb * 32); cvt_item(W, N, WT, ldt, kb * 64, nb * 32, rm.r0, rm.st, dcol0, scr, lane); }
    off = (off + nitems) % NGW;
}


namespace fa {
using bf16x8 = __attribute__((ext_vector_type(8))) short;
using s16x4  = __attribute__((ext_vector_type(4))) short;
using f32x16 = __attribute__((ext_vector_type(16))) float;
using u32x4  = __attribute__((ext_vector_type(4))) unsigned;
constexpr int NW = 8, QBLK = 32, KVBLK = 64, DV = 128;
constexpr float THR = 8.f;
constexpr size_t SHM_V = KVBLK * DV * 2;
#define FA_SBAR() __builtin_amdgcn_sched_barrier(0)
__device__ __forceinline__ int crow(int r, int hi) { return (r & 3) + 8 * (r >> 2) + 4 * hi; }
__device__ __forceinline__ unsigned cvtpk(float lo, float hi) { unsigned r; asm volatile("v_cvt_pk_bf16_f32 %0, %1, %2" : "=v"(r) : "v"(lo), "v"(hi)); return r; }
template <int DQ> struct Cfg {
    static constexpr int NK = DQ / 16, NCH = DQ / 8, KPT = NCH / 8;
    static constexpr size_t SHM_K = (size_t)KVBLK * DQ * 2;
    static constexpr float SCALE = DQ == 192 ? 0.07216878364870322f : (DQ == 64 ? 0.125f : 0.08838834764831845f);
    __device__ static __forceinline__ int kswz(int row, int colB) { return row * (DQ * 2) + (colB ^ ((row & 7) << 4)); }
};
template <int DQ> __device__ __forceinline__ void partialSM(f32x16& p0, f32x16& p1, float& m_reg, float& mn, float& alpha) {
    constexpr float SCALE = Cfg<DQ>::SCALE, C = SCALE * 1.4426950408889634f;
    float pmax = p0[0];
#pragma unroll
    for (int r = 1; r < 16; ++r) pmax = fmaxf(pmax, p0[r]);
#pragma unroll
    for (int r = 0; r < 16; ++r) pmax = fmaxf(pmax, p1[r]);
    { auto rr = __builtin_amdgcn_permlane32_swap(__float_as_uint(pmax), __float_as_uint(pmax), false, false);
      pmax = fmaxf(__uint_as_float(rr[0]), __uint_as_float(rr[1])); }
    if (__builtin_expect(__all(pmax - m_reg <= THR / SCALE), 1)) { mn = m_reg; alpha = 1.f; }
    else { mn = fmaxf(m_reg, pmax); alpha = __builtin_amdgcn_exp2f((m_reg - mn) * C); m_reg = mn; }
    const float mnC = -mn * C;
#pragma unroll
    for (int r = 0; r < 16; ++r) p0[r] = fmaf(p0[r], C, mnC);
#pragma unroll
    for (int r = 0; r < 16; ++r) p1[r] = fmaf(p1[r], C, mnC);
#pragma unroll
    for (int r = 0; r < 16; ++r) p0[r] = __builtin_amdgcn_exp2f(p0[r]);
}
__device__ __forceinline__ void finishSM(f32x16& p0, f32x16& p1, float alpha, float& l_reg, bf16x8& pa0, bf16x8& pa1, bf16x8& pa2, bf16x8& pa3) {
#pragma unroll
    for (int r = 0; r < 16; ++r) p1[r] = __builtin_amdgcn_exp2f(p1[r]);
    float ps = 0;
#pragma unroll
    for (int r = 0; r < 16; ++r) ps += p0[r];
#pragma unroll
    for (int r = 0; r < 16; ++r) ps += p1[r];
    { auto rr = __builtin_amdgcn_permlane32_swap(__float_as_uint(ps), __float_as_uint(ps), false, false);
      ps = __uint_as_float(rr[0]) + __uint_as_float(rr[1]); }
    l_reg = l_reg * alpha + ps;
#define FA_PK4(P, BASE, OUT) do { unsigned a0 = cvtpk(P[BASE + 0], P[BASE + 1]), a1 = cvtpk(P[BASE + 2], P[BASE + 3]);   \
    unsigned b0 = cvtpk(P[BASE + 4], P[BASE + 5]), b1 = cvtpk(P[BASE + 6], P[BASE + 7]);                              \
    auto r0 = __builtin_amdgcn_permlane32_swap(a0, b0, false, false); auto r1 = __builtin_amdgcn_permlane32_swap(a1, b1, false, false); \
    u32x4 w = {r0[0], r1[0], r0[1], r1[1]}; OUT = *reinterpret_cast<bf16x8*>(&w); } while (0)
    FA_PK4(p0, 0, pa0); FA_PK4(p0, 8, pa1); FA_PK4(p1, 0, pa2); FA_PK4(p1, 8, pa3);
#undef FA_PK4
}
template <int DQ> __device__ __forceinline__ void qkt(f32x16& p0, f32x16& p1, const char* Ks, const bf16x8* qr, int r32, int hi) {
    p0 = f32x16{}; p1 = f32x16{};
#pragma unroll
    for (int d0 = 0; d0 < Cfg<DQ>::NK; ++d0) { const int cb = (d0 * 16 + hi * 8) * 2;
        const bf16x8 b0 = *reinterpret_cast<const bf16x8*>(Ks + Cfg<DQ>::kswz(r32, cb));
        const bf16x8 b1 = *reinterpret_cast<const bf16x8*>(Ks + Cfg<DQ>::kswz(32 + r32, cb));
        p0 = __builtin_amdgcn_mfma_f32_32x32x16_bf16(b0, qr[d0], p0, 0, 0, 0);
        p1 = __builtin_amdgcn_mfma_f32_32x32x16_bf16(b1, qr[d0], p1, 0, 0, 0); }
}
__device__ __forceinline__ int v_st(int k, int c) { const int kk = (k & ~0xC) | ((k & 4) << 1) | ((k & 8) >> 1); return ((kk >> 3) * 4 + (c >> 5)) * 512 + ((kk & 7) * 32 + (c & 31)) * 2; }
__device__ __forceinline__ int v_rd_base(int lane) { return ((lane & 3) << 3) | (((lane >> 2) & 3) << 6) | (((lane >> 4) & 1) << 5) | (((lane >> 5) & 1) << 8); }
constexpr int v_rd_off(int d0, int ks, int half) { return d0 * 512 + ks * 4096 + half * 2048; }
template <int OFF> __device__ __forceinline__ s16x4 tr_read(int vb) {
    s16x4 r; asm volatile("ds_read_b64_tr_b16 %0, %1 offset:%2" : "=&v"(r) : "v"(vb), "i"(OFF) : "memory"); return r;
}
template <int D0> __device__ __forceinline__ void pv_one(f32x16& od, int vb, bf16x8 pa0, bf16x8 pa1, bf16x8 pa2, bf16x8 pa3) {
    const s16x4 l0 = tr_read<v_rd_off(D0, 0, 0)>(vb), h0 = tr_read<v_rd_off(D0, 0, 1)>(vb), l1 = tr_read<v_rd_off(D0, 1, 0)>(vb), h1 = tr_read<v_rd_off(D0, 1, 1)>(vb);
    const s16x4 l2 = tr_read<v_rd_off(D0, 2, 0)>(vb), h2 = tr_read<v_rd_off(D0, 2, 1)>(vb), l3 = tr_read<v_rd_off(D0, 3, 0)>(vb), h3 = tr_read<v_rd_off(D0, 3, 1)>(vb);
    asm volatile("s_waitcnt lgkmcnt(0)" ::: "memory"); FA_SBAR();
#define FA_PK(L, H) (bf16x8){L[0], L[1], L[2], L[3], H[0], H[1], H[2], H[3]}
    od = __builtin_amdgcn_mfma_f32_32x32x16_bf16(pa0, FA_PK(l0, h0), od, 0, 0, 0);
    od = __builtin_amdgcn_mfma_f32_32x32x16_bf16(pa1, FA_PK(l1, h1), od, 0, 0, 0);
    od = __builtin_amdgcn_mfma_f32_32x32x16_bf16(pa2, FA_PK(l2, h2), od, 0, 0, 0);
    od = __builtin_amdgcn_mfma_f32_32x32x16_bf16(pa3, FA_PK(l3, h3), od, 0, 0, 0);
#undef FA_PK
}
__device__ __forceinline__ void pv_d0(f32x16* o, int vb, bf16x8 pa0, bf16x8 pa1, bf16x8 pa2, bf16x8 pa3) {
    pv_one<0>(o[0], vb, pa0, pa1, pa2, pa3); pv_one<1>(o[1], vb, pa0, pa1, pa2, pa3); pv_one<2>(o[2], vb, pa0, pa1, pa2, pa3); pv_one<3>(o[3], vb, pa0, pa1, pa2, pa3);
}
struct KVSrc { const u16* k0; int kst0; const u16* k1; int kst1; int split8; const u16* v; int vst; int xrow0, lrow0; };
constexpr size_t shm_bytes(int DQ) { return 2 * SHM_V + 2 * (size_t)KVBLK * DQ * 2 + NW * 64 * 4; }
constexpr size_t STASH1 = 65536;
template <int S1OFF> __device__ __forceinline__ void diff_combine(const char* lds, u16* __restrict__ Ob, int LDO, float lam, const float* __restrict__ g_o, float oscale) {
    int tid_ = threadIdx.x; asm volatile("" : "+v"(tid_));
    const int tid = tid_, wid = tid >> 6, lane = tid & 63;
    const u16* s1 = (const u16*)(lds + S1OFF) + wid * (QBLK * DV); const u16* s2 = (const u16*)lds + wid * (QBLK * DV);
    const float g0 = g_o[2 * lane] * oscale, g1 = g_o[2 * lane + 1] * oscale;
    asm volatile("s_waitcnt lgkmcnt(0)" ::: "memory");
    for (int r = 0; r < QBLK; ++r) {
        const unsigned a = *(const unsigned*)(s1 + r * DV + 2 * lane), b = *(const unsigned*)(s2 + r * DV + 2 * lane);
        const float o0 = bf2f(a & 0xffffu) - lam * bf2f(b & 0xffffu), o1 = bf2f(a >> 16) - lam * bf2f(b >> 16);
        const float ss = wave_sum(o0 * o0 + o1 * o1);
        const float rs = 1.0f / sqrtf(ss * (1.0f / 128.0f) + 1e-6f);
        *(unsigned*)(Ob + (long)(wid * QBLK + r) * LDO + 2 * lane) = f2bf(o0 * rs * g0) | (f2bf(o1 * rs * g1) << 16);
    }
}

template <int DQ, int omode>
__device__ __forceinline__ void attn_unit(const u16* __restrict__ Qb, int LDQ, const KVSrc S, u16* __restrict__ Ob, int LDO, int NT, char* lds) {
    using C = Cfg<DQ>;
    constexpr int NK = C::NK, NCH = C::NCH, KPT = C::KPT;
    constexpr size_t SHM_K = C::SHM_K;
    int tid_ = threadIdx.x; asm volatile("" : "+v"(tid_));
    const int tid = tid_, wid = tid >> 6, lane = tid & 63, r32 = lane & 31, hi = lane >> 5;
    char* V_lds = lds; char* K_lds = lds + 2 * SHM_V;
    float* wsf = (float*)(lds + 2 * SHM_V + 2 * SHM_K) + wid * 64; float* li_l = wsf; float* al_l = wsf + 32;
    float m_reg = -1e30f, l_reg = 0; f32x16 o[4] = {}; bf16x8 qr[NK];
    const u16* Qw = Qb + (long)(wid * QBLK + r32) * LDQ + hi * 8;
#pragma unroll
    for (int d0 = 0; d0 < NK; ++d0) qr[d0] = *reinterpret_cast<const bf16x8*>(Qw + d0 * 16);
    const int sr = tid >> 4, sc = (tid & 15) * 8, vst0 = v_st(sr, sc), vst1 = v_st(32 + sr, sc);
    const int vb0 = (int)(uintptr_t)V_lds + v_rd_base(lane);
    const u16* kp[KPT]; int kst[KPT]; int kw[KPT];
#pragma unroll
    for (int i = 0; i < KPT; ++i) { const int c = tid + 512 * i, row = c / NCH, c8 = c % NCH;
        if (c8 < S.split8) { kp[i] = S.k0 + (long)row * S.kst0 + c8 * 8; kst[i] = S.kst0; } else { kp[i] = S.k1 + (long)row * S.kst1 + (c8 - S.split8) * 8; kst[i] = S.kst1; }
        kw[i] = C::kswz(row, c8 * 16); }
    const u16* vp0 = S.v + (long)sr * S.vst + sc; const u16* vp1 = S.v + (long)(32 + sr) * S.vst + sc;
    struct { bf16x8 vs0, vs1, ks[KPT]; } sr_[2];
#define FA_ROW0(kt) ((kt) < 4 ? S.xrow0 + 64 * (kt) : S.lrow0 + 64 * ((kt) - 4))
#define FA_SLOAD(i, kt) do { const long _r = FA_ROW0(kt); sr_[i].vs0 = *reinterpret_cast<const bf16x8*>(vp0 + _r * S.vst); sr_[i].vs1 = *reinterpret_cast<const bf16x8*>(vp1 + _r * S.vst); \
    _Pragma("unroll") for (int _q = 0; _q < KPT; ++_q) sr_[i].ks[_q] = *reinterpret_cast<const bf16x8*>(kp[_q] + _r * kst[_q]); } while (0)
#define FA_SWRITE(b, i) do { *(bf16x8*)(V_lds + (b) * SHM_V + vst0) = sr_[i].vs0; *(bf16x8*)(V_lds + (b) * SHM_V + vst1) = sr_[i].vs1; \
    _Pragma("unroll") for (int _q = 0; _q < KPT; ++_q) *(bf16x8*)(K_lds + (b) * SHM_K + kw[_q]) = sr_[i].ks[_q]; } while (0)
#define FA_SWAIT() asm volatile("s_waitcnt vmcnt(%0)" :: "n"(2 + KPT) : "memory")
#define FA_RESC(a) do { if (__any((a) < 1.f)) { if (hi == 0) al_l[r32] = (a); asm volatile("s_waitcnt lgkmcnt(0)" ::: "memory"); \
    _Pragma("unroll") for (int d = 0; d < 4; ++d) _Pragma("unroll") for (int r = 0; r < 16; ++r) o[d][r] *= al_l[crow(r, hi)]; } } while (0)
    f32x16 pA0, pA1, pB0, pB1; float mnA, mnB, alA, alB; bf16x8 pa0, pa1, pa2, pa3;
    constexpr int SE = 0, SO = 1;
    FA_SLOAD(SE, 0); asm volatile("s_waitcnt vmcnt(0)" ::: "memory"); FA_SWRITE(0, SE); __syncthreads();
    qkt<DQ>(pA0, pA1, K_lds, qr, r32, hi); partialSM<DQ>(pA0, pA1, m_reg, mnA, alA);
    FA_SLOAD(SO, 1); if (2 < NT) FA_SLOAD(SE, 2);
    FA_SWAIT(); FA_SWRITE(1, SO); __syncthreads();
    for (int j = 1; j + 1 < NT; j += 2) {
        FA_SBAR(); qkt<DQ>(pB0, pB1, K_lds + SHM_K, qr, r32, hi);
        finishSM(pA0, pA1, alA, l_reg, pa0, pa1, pa2, pa3); FA_SBAR();
        FA_SLOAD(SO, j + 2); FA_SBAR();
        pv_d0(o, vb0, pa0, pa1, pa2, pa3); partialSM<DQ>(pB0, pB1, m_reg, mnB, alB);
        __syncthreads(); FA_SWAIT(); FA_SWRITE(0, SE);
        FA_RESC(alB); __syncthreads();
        FA_SBAR(); qkt<DQ>(pA0, pA1, K_lds, qr, r32, hi);
        finishSM(pB0, pB1, alB, l_reg, pa0, pa1, pa2, pa3); FA_SBAR();
        if (j + 3 < NT) FA_SLOAD(SE, j + 3); FA_SBAR();
        pv_d0(o, vb0 + (int)SHM_V, pa0, pa1, pa2, pa3); partialSM<DQ>(pA0, pA1, m_reg, mnA, alA);
        __syncthreads(); FA_SWAIT(); FA_SWRITE(1, SO);
        FA_RESC(alA); __syncthreads();
    }
    FA_SBAR(); qkt<DQ>(pB0, pB1, K_lds + SHM_K, qr, r32, hi);
    finishSM(pA0, pA1, alA, l_reg, pa0, pa1, pa2, pa3); FA_SBAR();
    pv_d0(o, vb0, pa0, pa1, pa2, pa3); partialSM<DQ>(pB0, pB1, m_reg, mnB, alB);
    __syncthreads(); FA_RESC(alB);
    finishSM(pB0, pB1, alB, l_reg, pa0, pa1, pa2, pa3); FA_SBAR();
    pv_d0(o, vb0 + (int)SHM_V, pa0, pa1, pa2, pa3);
    if (hi == 0) li_l[r32] = l_reg; asm volatile("s_waitcnt lgkmcnt(0)" ::: "memory");
    float rli[16];
#pragma unroll
    for (int r = 0; r < 16; ++r) rli[r] = __builtin_amdgcn_rcpf(li_l[crow(r, hi)]);
    u16* Ow = Ob + (long)(wid * QBLK) * LDO;
    if constexpr (omode == 0) {
#pragma unroll
        for (int r = 0; r < 16; ++r) { const int orow = crow(r, hi);
#pragma unroll
            for (int d0 = 0; d0 < 4; ++d0) Ow[(long)orow * LDO + d0 * 32 + r32] = (u16)f2bf(o[d0][r] * rli[r]); }
    } else {
        if constexpr (omode == 2) __syncthreads();
        u16* stash = (u16*)(lds + (omode == 1 ? STASH1 : 0)) + wid * (QBLK * DV);
#pragma unroll
        for (int r = 0; r < 16; ++r) { const int orow = crow(r, hi);
#pragma unroll
            for (int d0 = 0; d0 < 4; ++d0) stash[orow * DV + d0 * 32 + r32] = (u16)f2bf(o[d0][r] * rli[r]); }
    }
#undef FA_ROW0
#undef FA_SLOAD
#undef FA_SWRITE
#undef FA_SWAIT
#undef FA_RESC
}

constexpr int A2_KSL = 8192, A2_VSL = 16384, A2_K = 0, A2_V = 4 * A2_KSL, A2_WS = A2_V + 3 * A2_VSL, A2_STASH1 = A2_WS + NW * 256, A2_END = A2_STASH1 + NW * QBLK * DV * 2;
constexpr float A2_QSCALE = 0.125f * 1.4426950408889634f;
typedef __attribute__((address_space(3))) const char* lds_cptr;
typedef short v4i16_t __attribute__((ext_vector_type(4)));
typedef float f32x2_t __attribute__((ext_vector_type(2))); typedef __bf16 bf16x2_t __attribute__((ext_vector_type(2)));
__device__ __forceinline__ void glds16(const void* g, unsigned lds_dst) { unsigned keep;
    asm volatile("s_mov_b32 %0, m0\n\ts_mov_b32 m0, %2\n\ts_nop 0\n\tglobal_load_lds_dwordx4 %1, off\n\ts_mov_b32 m0, %0" : "=&s"(keep) : "v"(g), "s"(lds_dst) : "memory"); }
__device__ __forceinline__ unsigned cvtpk_s(float lo, float hi) { f32x2_t v = {lo, hi}; bf16x2_t b = __builtin_convertvector(v, bf16x2_t); return __builtin_bit_cast(unsigned, b); }
__device__ __forceinline__ bf16x8 kfr(lds_cptr p) { return *(const __attribute__((address_space(3))) bf16x8*)p; }
__device__ __forceinline__ s16x4 vtr(lds_cptr p) { return __builtin_bit_cast(s16x4, __builtin_amdgcn_ds_read_tr16_b64_v4i16((__attribute__((address_space(3))) v4i16_t*)p)); }
#define A2_MFMA(a, b, c) __builtin_amdgcn_mfma_f32_32x32x16_bf16(a, b, c, 0, 0, 0)
#define A2_WAIT_BAR(N) asm volatile("s_waitcnt vmcnt(" #N ") lgkmcnt(0)\n\ts_barrier" ::: "memory")
#define A2_PIN(x) asm volatile("" : "+v"(x))
#define A2_MX3(a, b, c) __builtin_fmaxf(__builtin_fmaxf((a), (b)), (c))
template <int omode, int THRL>
__device__ __forceinline__ void attn64_unit(const u16* __restrict__ Qb, int LDQ, const KVSrc S, int NT, char* lds) {
    int tid_ = threadIdx.x; asm volatile("" : "+v"(tid_));
    const int tid = tid_, lane = tid & 63, r32 = lane & 31, hi = lane >> 5; const int wid = __builtin_amdgcn_readfirstlane(tid >> 6);
    const unsigned lds0 = (unsigned)(uintptr_t)lds; float* wsf = (float*)(lds + A2_WS) + wid * 64;
    const u16* ksrc = S.k0 + (long)(8 * wid + (lane >> 3)) * S.kst0 + ((lane & 7) ^ (lane >> 3)) * 8;
    const u16* vsrc = S.v + (long)(8 * wid + (lane >> 3)) * S.vst + (((lane >> 2) ^ (lane >> 4)) & 1) * 32 + (lane & 3) * 8;
    const unsigned kdst = lds0 + A2_K + wid * 1024, vdst = lds0 + A2_V + wid * 1024;
#define A2_ROW0(t) ((t) < 4 ? S.xrow0 + 64 * (t) : S.lrow0 + 64 * ((t) - 4))
#define DMA_K(t, slot) glds16(ksrc + (long)A2_ROW0(t) * S.kst0, (unsigned)__builtin_amdgcn_readfirstlane(kdst + (slot)))
#define DMA_V(t, slot) do { const u16* v_ = vsrc + (long)A2_ROW0(t) * S.vst; const unsigned d_ = (unsigned)__builtin_amdgcn_readfirstlane(vdst + (slot)); glds16(v_, d_); glds16(v_ + 64, d_ + 8192); } while (0)
    const lds_cptr shm3 = (lds_cptr)lds;
    const lds_cptr kp0 = shm3 + A2_K + r32 * 128;
    int kx[4];
#pragma unroll
    for (int d0 = 0; d0 < 4; ++d0) kx[d0] = ((2 * d0 + hi) ^ (r32 & 7)) * 16;
    const lds_cptr vp0 = shm3 + A2_V + ((lane >> 4) & 1) * 32 + (lane & 3) * 8 + (4 * hi + ((lane & 15) >> 2)) * 128 + ((lane >> 3) & 1) * 64;
    const lds_cptr vp1 = vp0 + 64 - ((lane >> 3) & 1) * 128;
    asm volatile("s_waitcnt vmcnt(0)" ::: "memory");
    DMA_K(0, 0); DMA_V(0, 0); DMA_K(1, A2_KSL); DMA_K(2, 2 * A2_KSL);
    bf16x8 qr[4];
    { const u16* Qw = Qb + (long)(wid * QBLK + r32) * LDQ + hi * 8;
#pragma unroll
      for (int d0 = 0; d0 < 4; ++d0) qr[d0] = *reinterpret_cast<const bf16x8*>(Qw + d0 * 16); }
    float mhat = 0.f, l_reg = 0.f; f32x16 o[4]; o[0] = f32x16{}; o[1] = f32x16{}; o[2] = f32x16{}; o[3] = f32x16{};
    f32x16 negm = f32x16{}; A2_PIN(negm);
    bool resc = false;
    f32x16 pA0, pA1, pB0, pB1; bf16x8 kf[8]; s16x4 vlo[4], vhi[4]; u32x4 pw0, pw1, pw2, pw3;
    int ks_cur = A2_KSL, ks_next = 2 * A2_KSL, ks_dma = 0;
    int vs_prev = 0, vs_cur = A2_VSL, vs_dma = 2 * A2_VSL;
#define ROT() do { ks_dma = ks_cur; ks_cur = ks_next; ks_next = (ks_next + A2_KSL) & (4 * A2_KSL - 1); const int t_ = vs_prev; vs_prev = vs_cur; vs_cur = vs_dma; vs_dma = t_; } while (0)
#define RESC() do { if (resc) { asm volatile("s_waitcnt lgkmcnt(0)" ::: "memory"); \
      _Pragma("unroll") for (int d_ = 0; d_ < 4; ++d_) _Pragma("unroll") for (int r = 0; r < 16; ++r) o[d_][r] *= wsf[crow(r, hi)]; } } while (0)
    A2_WAIT_BAR(8);
#pragma unroll
    for (int j = 0; j < 8; ++j) kf[j] = kfr(kp0 + kx[j >> 1] + (j & 1) * 4096);
    pA0 = A2_MFMA(kf[0], qr[0], negm); pA1 = A2_MFMA(kf[1], qr[0], negm); pA0 = A2_MFMA(kf[2], qr[1], pA0); pA1 = A2_MFMA(kf[3], qr[1], pA1);
    pA0 = A2_MFMA(kf[4], qr[2], pA0); pA1 = A2_MFMA(kf[5], qr[2], pA1); pA0 = A2_MFMA(kf[6], qr[3], pA0); pA1 = A2_MFMA(kf[7], qr[3], pA1);
    { float a = A2_MX3(pA0[0], pA0[1], pA1[0]), b = A2_MX3(pA0[2], pA0[3], pA1[1]); a = A2_MX3(a, pA1[2], pA1[3]);
#pragma unroll
      for (int r = 4; r < 16; r += 4) { a = A2_MX3(a, pA0[r], pA0[r + 1]); b = A2_MX3(b, pA0[r + 2], pA0[r + 3]); a = A2_MX3(a, pA1[r], pA1[r + 1]); b = A2_MX3(b, pA1[r + 2], pA1[r + 3]); }
      float rm = __builtin_fmaxf(a, b); { auto rr = __builtin_amdgcn_permlane32_swap(__float_as_uint(rm), __float_as_uint(rm), false, false); rm = __builtin_fmaxf(__uint_as_float(rr[0]), __uint_as_float(rr[1])); }
      mhat = rm;
#pragma unroll
      for (int r = 0; r < 16; ++r) { pA0[r] = __builtin_amdgcn_exp2f(pA0[r] - rm); pA1[r] = __builtin_amdgcn_exp2f(pA1[r] - rm); negm[r] = -rm; }
      A2_PIN(negm); }
    A2_WAIT_BAR(0);
    DMA_K(3, 3 * A2_KSL); DMA_V(1, A2_VSL);
    kf[0] = kfr(kp0 + A2_KSL + kx[0]); kf[1] = kfr(kp0 + A2_KSL + kx[0] + 4096); kf[2] = kfr(kp0 + A2_KSL + kx[1]); kf[3] = kfr(kp0 + A2_KSL + kx[1] + 4096);
#define PKW(P, B) cvtpk_s(P[B], P[(B) + 1])
#define PAF(k) __builtin_bit_cast(bf16x8, pw##k)
#define VFR(i) (bf16x8){vlo[i][0], vlo[i][1], vlo[i][2], vlo[i][3], vhi[i][0], vhi[i][1], vhi[i][2], vhi[i][3]}
#define VRD(i) do { vlo[(i) & 3] = vtr((((i) & 1) ? vq_ : vp_) + ((((i) & 3) >> 1) * 8192 + ((i) >> 2) * 2048)); vhi[(i) & 3] = vtr((((i) & 1) ? vq_ : vp_) + ((((i) & 3) >> 1) * 8192 + ((i) >> 2) * 2048 + 1024)); } while (0)
#define GAPA(MF, a0, a1, a2, a3, W0, W1, PW) do { MF; sacc += a0; sacc += a1; sacc += a2; sacc += a3; A2_PIN(sacc); W0; W1; A2_PIN(PW); FA_SBAR(); } while (0)
#define GAPB(i, PK_, X, B) do { o[(i) & 3] = A2_MFMA(PK_, VFR((i) & 3), o[(i) & 3]); X[B] = __builtin_amdgcn_exp2f(X[B]); X[(B) + 1] = __builtin_amdgcn_exp2f(X[(B) + 1]); A2_PIN(X); FA_SBAR(); } while (0)
#define KRD(G, j, off) do { if (G) { kf[j] = kfr(kn_ + (off)); FA_SBAR(); } } while (0)
#define STEP(C0, C1, P0, P1, t, GK, GV, GL) do { FA_SBAR(); \
    const lds_cptr kp_ = kp0 + ks_cur; const lds_cptr vp_ = vp0 + vs_prev; const lds_cptr vq_ = vp1 + vs_prev; const lds_cptr kn_ = kp0 + ks_next; \
    kf[4] = kfr(kp_ + kx[2]); kf[5] = kfr(kp_ + kx[2] + 4096); FA_SBAR(); float sacc = P0[0] + P0[1]; \
                       GAPA(C0 = A2_MFMA(kf[0], qr[0], negm), P0[2], P0[3], P0[4], P0[5],     pw0[0] = PKW(P0, 0),  pw0[1] = PKW(P0, 2),  pw0); \
    kf[6] = kfr(kp_ + kx[3]); kf[7] = kfr(kp_ + kx[3] + 4096); FA_SBAR(); \
                       GAPA(C1 = A2_MFMA(kf[1], qr[0], negm), P0[6], P0[7], P0[8], P0[9],     pw0[2] = PKW(P0, 4),  pw0[3] = PKW(P0, 6),  pw0); \
                       GAPA(C0 = A2_MFMA(kf[2], qr[1], C0),   P0[10], P0[11], P0[12], P0[13], pw1[0] = PKW(P0, 8),  pw1[1] = PKW(P0, 10), pw1); \
                       GAPA(C1 = A2_MFMA(kf[3], qr[1], C1),   P0[14], P0[15], P1[0], P1[1],   pw1[2] = PKW(P0, 12), pw1[3] = PKW(P0, 14), pw1); \
                       GAPA(C0 = A2_MFMA(kf[4], qr[2], C0),   P1[2], P1[3], P1[4], P1[5],     pw2[0] = PKW(P1, 0),  pw2[1] = PKW(P1, 2),  pw2); \
    VRD(0); FA_SBAR(); GAPA(C1 = A2_MFMA(kf[5], qr[2], C1),   P1[6], P1[7], P1[8], P1[9],     pw2[2] = PKW(P1, 4),  pw2[3] = PKW(P1, 6),  pw2); \
    VRD(1); FA_SBAR(); GAPA(C0 = A2_MFMA(kf[6], qr[3], C0),   P1[10], P1[11], P1[12], P1[13], pw3[0] = PKW(P1, 8),  pw3[1] = PKW(P1, 10), pw3); \
    VRD(2); FA_SBAR(); GAPA(C1 = A2_MFMA(kf[7], qr[3], C1),   P1[14], P1[15], 0.f, 0.f,       pw3[2] = PKW(P1, 12), pw3[3] = PKW(P1, 14), pw3); \
    l_reg += sacc; \
    { float a = A2_MX3(C0[0], C0[1], C1[0]), b = A2_MX3(C0[2], C0[3], C1[1]); a = A2_MX3(a, C1[2], C1[3]); \
      _Pragma("unroll") for (int r = 4; r < 16; r += 4) { a = A2_MX3(a, C0[r], C0[r + 1]); b = A2_MX3(b, C0[r + 2], C0[r + 3]); a = A2_MX3(a, C1[r], C1[r + 1]); b = A2_MX3(b, C1[r + 2], C1[r + 3]); } \
      float rm = __builtin_fmaxf(a, b); { auto rr = __builtin_amdgcn_permlane32_swap(__float_as_uint(rm), __float_as_uint(rm), false, false); rm = __builtin_fmaxf(__uint_as_float(rr[0]), __uint_as_float(rr[1])); } \
      resc = false; \
      if (__builtin_expect(__any(rm > (float)THRL), 0)) { const float dl = __builtin_fmaxf(rm, 0.f); mhat += dl;                         \
        _Pragma("unroll") for (int r = 0; r < 16; ++r) { C0[r] -= dl; C1[r] -= dl; } \
        _Pragma("unroll") for (int r = 0; r < 16; ++r) negm[r] = -mhat; A2_PIN(negm); \
        const float f = __builtin_amdgcn_exp2f(-dl); l_reg *= f; if (hi == 0) wsf[r32] = f; resc = true; } } \
    FA_SBAR(); \
    VRD(3);  FA_SBAR(); GAPB(0,  PAF(0), C0, 0);   VRD(4);  FA_SBAR(); GAPB(1,  PAF(0), C0, 2);   VRD(5);  FA_SBAR(); if (GK) { DMA_K((t) + 3, ks_dma); } GAPB(2,  PAF(0), C0, 4);   VRD(6);  FA_SBAR(); GAPB(3,  PAF(0), C0, 6); \
    VRD(7);  FA_SBAR(); KRD(GL, 0, kx[0]); GAPB(4,  PAF(1), C0, 8);   VRD(8);  FA_SBAR(); KRD(GL, 1, kx[0] + 4096); GAPB(5,  PAF(1), C0, 10);  VRD(9);  FA_SBAR(); KRD(GL, 2, kx[1]); GAPB(6,  PAF(1), C0, 12);  VRD(10); FA_SBAR(); KRD(GL, 3, kx[1] + 4096); GAPB(7,  PAF(1), C0, 14); \
    VRD(11); FA_SBAR(); GAPB(8,  PAF(2), C1, 0);   VRD(12); FA_SBAR(); if (GV) { DMA_V((t) + 1, vs_dma); } GAPB(9,  PAF(2), C1, 2);   VRD(13); FA_SBAR(); GAPB(10, PAF(2), C1, 4);   VRD(14); FA_SBAR(); GAPB(11, PAF(2), C1, 6); \
    VRD(15); FA_SBAR(); GAPB(12, PAF(3), C1, 8);   GAPB(13, PAF(3), C1, 10);  GAPB(14, PAF(3), C1, 12);  GAPB(15, PAF(3), C1, 14); \
    } while (0)
    int t = 1;
    for (; t + 5 < NT; t += 2) {
        STEP(pB0, pB1, pA0, pA1, t, true, true, true);     A2_WAIT_BAR(3); RESC(); ROT();
        STEP(pA0, pA1, pB0, pB1, t + 1, true, true, true); A2_WAIT_BAR(3); RESC(); ROT();
    }
#define ENDW(tt) do { if ((tt) + 3 < NT) { A2_WAIT_BAR(3); } else if ((tt) + 2 < NT) { A2_WAIT_BAR(2); } else { A2_WAIT_BAR(0); } } while (0)
    for (; t + 1 < NT; t += 2) {
        STEP(pB0, pB1, pA0, pA1, t, (t + 3 < NT), (t + 1 < NT), (t + 1 < NT));         ENDW(t);     RESC(); ROT();
        STEP(pA0, pA1, pB0, pB1, t + 1, (t + 4 < NT), (t + 2 < NT), (t + 2 < NT));     ENDW(t + 1); RESC(); ROT();
    }
    STEP(pB0, pB1, pA0, pA1, NT - 1, false, false, false); RESC();
    { float sacc = pB0[0] + pB0[1];
#pragma unroll
      for (int r = 2; r < 16; ++r) sacc += pB0[r];
#pragma unroll
      for (int r = 0; r < 16; ++r) sacc += pB1[r];
      l_reg += sacc;
      pw0 = (u32x4){PKW(pB0, 0), PKW(pB0, 2), PKW(pB0, 4), PKW(pB0, 6)}; pw1 = (u32x4){PKW(pB0, 8), PKW(pB0, 10), PKW(pB0, 12), PKW(pB0, 14)};
      pw2 = (u32x4){PKW(pB1, 0), PKW(pB1, 2), PKW(pB1, 4), PKW(pB1, 6)}; pw3 = (u32x4){PKW(pB1, 8), PKW(pB1, 10), PKW(pB1, 12), PKW(pB1, 14)};
      const lds_cptr vp_ = vp0 + vs_cur; const lds_cptr vq_ = vp1 + vs_cur;
      VRD(0); VRD(1); VRD(2); VRD(3);
      o[0] = A2_MFMA(PAF(0), VFR(0), o[0]); o[1] = A2_MFMA(PAF(0), VFR(1), o[1]); o[2] = A2_MFMA(PAF(0), VFR(2), o[2]); o[3] = A2_MFMA(PAF(0), VFR(3), o[3]); FA_SBAR();
      VRD(4); VRD(5); VRD(6); VRD(7);
      o[0] = A2_MFMA(PAF(1), VFR(0), o[0]); o[1] = A2_MFMA(PAF(1), VFR(1), o[1]); o[2] = A2_MFMA(PAF(1), VFR(2), o[2]); o[3] = A2_MFMA(PAF(1), VFR(3), o[3]); FA_SBAR();
      VRD(8); VRD(9); VRD(10); VRD(11);
      o[0] = A2_MFMA(PAF(2), VFR(0), o[0]); o[1] = A2_MFMA(PAF(2), VFR(1), o[1]); o[2] = A2_MFMA(PAF(2), VFR(2), o[2]); o[3] = A2_MFMA(PAF(2), VFR(3), o[3]); FA_SBAR();
      VRD(12); VRD(13); VRD(14); VRD(15);
      o[0] = A2_MFMA(PAF(3), VFR(0), o[0]); o[1] = A2_MFMA(PAF(3), VFR(1), o[1]); o[2] = A2_MFMA(PAF(3), VFR(2), o[2]); o[3] = A2_MFMA(PAF(3), VFR(3), o[3]); }
    { auto rr = __builtin_amdgcn_permlane32_swap(__float_as_uint(l_reg), __float_as_uint(l_reg), false, false); l_reg = __uint_as_float(rr[0]) + __uint_as_float(rr[1]); }
    if (hi == 0) wsf[32 + r32] = l_reg; asm volatile("s_waitcnt lgkmcnt(0)" ::: "memory");
    float rli[16];
#pragma unroll
    for (int r = 0; r < 16; ++r) rli[r] = __builtin_amdgcn_rcpf(wsf[32 + crow(r, hi)]);
    if constexpr (omode == 2) asm volatile("s_waitcnt lgkmcnt(0)\n\ts_barrier" ::: "memory");
    { u16* stash = (u16*)(lds + (omode == 1 ? A2_STASH1 : 0)) + wid * (QBLK * DV);
#pragma unroll
      for (int r = 0; r < 16; ++r) { const int orow = crow(r, hi);
#pragma unroll
          for (int d0 = 0; d0 < 4; ++d0) stash[orow * DV + d0 * 32 + r32] = (u16)f2bf(o[d0][r] * rli[r]); } }
#undef A2_ROW0
#undef DMA_K
#undef DMA_V
#undef ROT
#undef RESC
#undef PKW
#undef PAF
#undef VFR
#undef VRD
#undef GAPA
#undef GAPB
#undef KRD
#undef STEP
#undef ENDW
}

constexpr int A1_KSL = 24576, A1_VSL = 16384, A1_K = 0, A1_V = 4 * A1_KSL, A1_WS = A1_V + 3 * A1_VSL, A1_END = A1_WS + NW * 256;
constexpr float A1_QSCALE = 0.07216878364870322f * 1.4426950408889634f;
template <int THRL>
__device__ __forceinline__ void attn192_unit(const u16* __restrict__ Qb, int LDQ, const KVSrc S, u16* __restrict__ Ob, int LDO, int NT, char* lds) {
    int tid_ = threadIdx.x; asm volatile("" : "+v"(tid_));
    const int tid = tid_, lane = tid & 63, r32 = lane & 31, hi = lane >> 5; const int wid = __builtin_amdgcn_readfirstlane(tid >> 6);
    const unsigned lds0 = (unsigned)(uintptr_t)lds; float* wsf = (float*)(lds + A1_WS) + wid * 64;
    const u16* ksrc0 = S.k0 + (long)(8 * wid + (lane >> 3)) * S.kst0 + ((lane & 7) ^ (lane >> 3)) * 8;
    const u16* ksrc1 = S.k1 + (long)(8 * wid + (lane >> 3)) * S.kst1 + ((lane & 7) ^ (lane >> 3)) * 8;
    const u16* vsrc = S.v + (long)(8 * wid + (lane >> 3)) * S.vst + (((lane >> 2) ^ (lane >> 4)) & 1) * 32 + (lane & 3) * 8;
    const unsigned kdst = lds0 + A1_K + wid * 1024, vdst = lds0 + A1_V + wid * 1024;
#define A2_ROW0(t) ((t) < 4 ? S.xrow0 + 64 * (t) : S.lrow0 + 64 * ((t) - 4))
#define DMA_K(t, slot) do { const long r_ = A2_ROW0(t); const u16* k_ = ksrc0 + r_ * S.kst0; const unsigned d_ = (unsigned)__builtin_amdgcn_readfirstlane(kdst + (slot)); \
      glds16(k_, d_); glds16(k_ + 64, d_ + 8192); glds16(ksrc1 + r_ * S.kst1, d_ + 16384); } while (0)
#define DMA_V(t, slot) do { const u16* v_ = vsrc + (long)A2_ROW0(t) * S.vst; const unsigned d_ = (unsigned)__builtin_amdgcn_readfirstlane(vdst + (slot)); glds16(v_, d_); glds16(v_ + 64, d_ + 8192); } while (0)
    const lds_cptr shm3 = (lds_cptr)lds;
    const lds_cptr kp0 = shm3 + A1_K + r32 * 128;
    int kx[4];
#pragma unroll
    for (int d0 = 0; d0 < 4; ++d0) kx[d0] = ((2 * d0 + hi) ^ (r32 & 7)) * 16;
    const lds_cptr vp0 = shm3 + A1_V + ((lane >> 4) & 1) * 32 + (lane & 3) * 8 + (4 * hi + ((lane & 15) >> 2)) * 128 + ((lane >> 3) & 1) * 64;
    const lds_cptr vp1 = vp0 + 64 - ((lane >> 3) & 1) * 128;
    asm volatile("s_waitcnt vmcnt(0)" ::: "memory");
    DMA_K(0, 0); DMA_V(0, 0); DMA_K(1, A1_KSL); DMA_K(2, 2 * A1_KSL);
    bf16x8 qr[12];
    { const u16* Qw = Qb + (long)(wid * QBLK + r32) * LDQ + hi * 8;
#pragma unroll
      for (int d0 = 0; d0 < 12; ++d0) qr[d0] = *reinterpret_cast<const bf16x8*>(Qw + d0 * 16); }
    float mhat = 0.f, l_reg = 0.f; f32x16 o[4]; o[0] = f32x16{}; o[1] = f32x16{}; o[2] = f32x16{}; o[3] = f32x16{};
    bool resc = false;
    f32x16 pA0, pA1, pB0, pB1; bf16x8 kf[4]; s16x4 vlo[4], vhi[4]; u32x4 pw0, pw1, pw2, pw3;
    int ks_cur = A1_KSL, ks_next = 2 * A1_KSL, ks_dma = 0;
    int vs_prev = 0, vs_cur = A1_VSL, vs_dma = 2 * A1_VSL;
#define ROT() do { ks_dma = ks_cur; ks_cur = ks_next; ks_next = (ks_next == 3 * A1_KSL) ? 0 : ks_next + A1_KSL; const int t_ = vs_prev; vs_prev = vs_cur; vs_cur = vs_dma; vs_dma = t_; } while (0)
#define RESC() do { if (resc) { asm volatile("s_waitcnt lgkmcnt(0)" ::: "memory"); \
      _Pragma("unroll") for (int d_ = 0; d_ < 4; ++d_) _Pragma("unroll") for (int r = 0; r < 16; ++r) o[d_][r] *= wsf[crow(r, hi)]; } } while (0)
#define KFR(j) kfr(kp_ + (((j) >> 3) * 8192 + ((j) & 1) * 4096) + kx[((j) >> 1) & 3])
    A2_WAIT_BAR(20);
    { const lds_cptr kp_ = kp0;
      pA0 = f32x16{}; pA1 = f32x16{};
#pragma unroll
      for (int d0 = 0; d0 < 12; ++d0) { const bf16x8 b0 = KFR(2 * d0), b1 = KFR(2 * d0 + 1); pA0 = A2_MFMA(b0, qr[d0], pA0); pA1 = A2_MFMA(b1, qr[d0], pA1); } }
    { float a = A2_MX3(pA0[0], pA0[1], pA1[0]), b = A2_MX3(pA0[2], pA0[3], pA1[1]); a = A2_MX3(a, pA1[2], pA1[3]);
#pragma unroll
      for (int r = 4; r < 16; r += 4) { a = A2_MX3(a, pA0[r], pA0[r + 1]); b = A2_MX3(b, pA0[r + 2], pA0[r + 3]); a = A2_MX3(a, pA1[r], pA1[r + 1]); b = A2_MX3(b, pA1[r + 2], pA1[r + 3]); }
      float rm = __builtin_fmaxf(a, b); { auto rr = __builtin_amdgcn_permlane32_swap(__float_as_uint(rm), __float_as_uint(rm), false, false); rm = __builtin_fmaxf(__uint_as_float(rr[0]), __uint_as_float(rr[1])); }
      mhat = rm;
#pragma unroll
      for (int r = 0; r < 16; ++r) { pA0[r] = __builtin_amdgcn_exp2f(pA0[r] - rm); pA1[r] = __builtin_amdgcn_exp2f(pA1[r] - rm); } }
    A2_WAIT_BAR(0);
    DMA_K(3, 3 * A1_KSL); DMA_V(1, A1_VSL);
    { const lds_cptr kp_ = kp0 + A1_KSL; kf[0] = KFR(0); kf[1] = KFR(1); kf[2] = KFR(2); }
#define PKW(P, B) cvtpk_s(P[B], P[(B) + 1])
#define PAF(k) __builtin_bit_cast(bf16x8, pw##k)
#define VFR(i) (bf16x8){vlo[i][0], vlo[i][1], vlo[i][2], vlo[i][3], vhi[i][0], vhi[i][1], vhi[i][2], vhi[i][3]}
#define VRD(i) do { vlo[(i) & 3] = vtr((((i) & 1) ? vq_ : vp_) + ((((i) & 3) >> 1) * 8192 + ((i) >> 2) * 2048)); vhi[(i) & 3] = vtr((((i) & 1) ? vq_ : vp_) + ((((i) & 3) >> 1) * 8192 + ((i) >> 2) * 2048 + 1024)); } while (0)
#define GAPA2(MF, a0, a1, W0, PW) do { MF; sacc += a0; sacc += a1; A2_PIN(sacc); W0; A2_PIN(PW); FA_SBAR(); } while (0)
#define GAPA0(MF) do { MF; FA_SBAR(); } while (0)
#define GAPB(i, PK_, X, B) do { o[(i) & 3] = A2_MFMA(PK_, VFR((i) & 3), o[(i) & 3]); X[B] = __builtin_amdgcn_exp2f(X[B] - mh); X[(B) + 1] = __builtin_amdgcn_exp2f(X[(B) + 1] - mh); A2_PIN(X); FA_SBAR(); } while (0)
#define STEP(C0, C1, P0, P1, t, GK, GV, GL) do { FA_SBAR(); \
    const lds_cptr kp_ = kp0 + ks_cur; const lds_cptr vp_ = vp0 + vs_prev; const lds_cptr vq_ = vp1 + vs_prev; float sacc = 0.f; \
    kf[3] = KFR(3); FA_SBAR(); GAPA2(C0 = A2_MFMA(kf[0], qr[0], f32x16{}), P0[0], P0[1], pw0[0] = PKW(P0, 0), pw0); \
    kf[0] = KFR(4); FA_SBAR(); GAPA2(C1 = A2_MFMA(kf[1], qr[0], f32x16{}), P0[2], P0[3], pw0[1] = PKW(P0, 2), pw0); \
    kf[1] = KFR(5); FA_SBAR(); GAPA2(C0 = A2_MFMA(kf[2], qr[1], C0), P0[4], P0[5], pw0[2] = PKW(P0, 4), pw0); \
    kf[2] = KFR(6); FA_SBAR(); GAPA2(C1 = A2_MFMA(kf[3], qr[1], C1), P0[6], P0[7], pw0[3] = PKW(P0, 6), pw0); \
    kf[3] = KFR(7); FA_SBAR(); GAPA2(C0 = A2_MFMA(kf[0], qr[2], C0), P0[8], P0[9], pw1[0] = PKW(P0, 8), pw1); \
    kf[0] = KFR(8); FA_SBAR(); GAPA2(C1 = A2_MFMA(kf[1], qr[2], C1), P0[10], P0[11], pw1[1] = PKW(P0, 10), pw1); \
    kf[1] = KFR(9); FA_SBAR(); GAPA2(C0 = A2_MFMA(kf[2], qr[3], C0), P0[12], P0[13], pw1[2] = PKW(P0, 12), pw1); \
    kf[2] = KFR(10); FA_SBAR(); GAPA2(C1 = A2_MFMA(kf[3], qr[3], C1), P0[14], P0[15], pw1[3] = PKW(P0, 14), pw1); \
    kf[3] = KFR(11); FA_SBAR(); GAPA2(C0 = A2_MFMA(kf[0], qr[4], C0), P1[0], P1[1], pw2[0] = PKW(P1, 0), pw2); \
    kf[0] = KFR(12); FA_SBAR(); GAPA2(C1 = A2_MFMA(kf[1], qr[4], C1), P1[2], P1[3], pw2[1] = PKW(P1, 2), pw2); \
    kf[1] = KFR(13); FA_SBAR(); GAPA2(C0 = A2_MFMA(kf[2], qr[5], C0), P1[4], P1[5], pw2[2] = PKW(P1, 4), pw2); \
    kf[2] = KFR(14); FA_SBAR(); GAPA2(C1 = A2_MFMA(kf[3], qr[5], C1), P1[6], P1[7], pw2[3] = PKW(P1, 6), pw2); \
    kf[3] = KFR(15); FA_SBAR(); GAPA2(C0 = A2_MFMA(kf[0], qr[6], C0), P1[8], P1[9], pw3[0] = PKW(P1, 8), pw3); \
    kf[0] = KFR(16); FA_SBAR(); GAPA2(C1 = A2_MFMA(kf[1], qr[6], C1), P1[10], P1[11], pw3[1] = PKW(P1, 10), pw3); \
    kf[1] = KFR(17); FA_SBAR(); GAPA2(C0 = A2_MFMA(kf[2], qr[7], C0), P1[12], P1[13], pw3[2] = PKW(P1, 12), pw3); \
    kf[2] = KFR(18); FA_SBAR(); GAPA2(C1 = A2_MFMA(kf[3], qr[7], C1), P1[14], P1[15], pw3[3] = PKW(P1, 14), pw3); \
    kf[3] = KFR(19); FA_SBAR(); GAPA0(C0 = A2_MFMA(kf[0], qr[8], C0)); \
    kf[0] = KFR(20); FA_SBAR(); GAPA0(C1 = A2_MFMA(kf[1], qr[8], C1)); \
    kf[1] = KFR(21); FA_SBAR(); GAPA0(C0 = A2_MFMA(kf[2], qr[9], C0)); \
    kf[2] = KFR(22); FA_SBAR(); GAPA0(C1 = A2_MFMA(kf[3], qr[9], C1)); \
    kf[3] = KFR(23); FA_SBAR(); GAPA0(C0 = A2_MFMA(kf[0], qr[10], C0)); \
    VRD(0); FA_SBAR(); GAPA0(C1 = A2_MFMA(kf[1], qr[10], C1)); \
    VRD(1); FA_SBAR(); GAPA0(C0 = A2_MFMA(kf[2], qr[11], C0)); \
    VRD(2); FA_SBAR(); GAPA0(C1 = A2_MFMA(kf[3], qr[11], C1)); \
    l_reg += sacc; \
    { float a = A2_MX3(C0[0], C0[1], C1[0]), b = A2_MX3(C0[2], C0[3], C1[1]); a = A2_MX3(a, C1[2], C1[3]); \
      _Pragma("unroll") for (int r = 4; r < 16; r += 4) { a = A2_MX3(a, C0[r], C0[r + 1]); b = A2_MX3(b, C0[r + 2], C0[r + 3]); a = A2_MX3(a, C1[r], C1[r + 1]); b = A2_MX3(b, C1[r + 2], C1[r + 3]); } \
      float rm = __builtin_fmaxf(a, b); { auto rr = __builtin_amdgcn_permlane32_swap(__float_as_uint(rm), __float_as_uint(rm), false, false); rm = __builtin_fmaxf(__uint_as_float(rr[0]), __uint_as_float(rr[1])); } \
      rm -= mhat; resc = false; \
      if (__builtin_expect(__any(rm > (float)THRL), 0)) { const float dl = __builtin_fmaxf(rm, 0.f); mhat += dl;                         \
        const float f = __builtin_amdgcn_exp2f(-dl); l_reg *= f; if (hi == 0) wsf[r32] = f; resc = true; } } \
    const float mh = mhat; const lds_cptr kn_ = kp0 + ks_next; FA_SBAR(); \
    VRD(3); FA_SBAR(); GAPB(0, PAF(0), C0, 0); \
    VRD(4); FA_SBAR(); GAPB(1, PAF(0), C0, 2); \
    VRD(5); FA_SBAR(); if (GK) { DMA_K((t) + 3, ks_dma); } GAPB(2, PAF(0), C0, 4); \
    VRD(6); FA_SBAR(); GAPB(3, PAF(0), C0, 6); \
    VRD(7); FA_SBAR(); if (GL) { kf[0] = kfr(kn_ + kx[0]); FA_SBAR(); } GAPB(4, PAF(1), C0, 8); \
    VRD(8); FA_SBAR(); if (GL) { kf[1] = kfr(kn_ + kx[0] + 4096); FA_SBAR(); } GAPB(5, PAF(1), C0, 10); \
    VRD(9); FA_SBAR(); if (GL) { kf[2] = kfr(kn_ + kx[1]); FA_SBAR(); } GAPB(6, PAF(1), C0, 12); \
    VRD(10); FA_SBAR(); GAPB(7, PAF(1), C0, 14); \
    VRD(11); FA_SBAR(); GAPB(8, PAF(2), C1, 0); \
    VRD(12); FA_SBAR(); if (GV) { DMA_V((t) + 1, vs_dma); } GAPB(9, PAF(2), C1, 2); \
    VRD(13); FA_SBAR(); GAPB(10, PAF(2), C1, 4); \
    VRD(14); FA_SBAR(); GAPB(11, PAF(2), C1, 6); \
    VRD(15); FA_SBAR(); GAPB(12, PAF(3), C1, 8); \
    GAPB(13, PAF(3), C1, 10); \
    GAPB(14, PAF(3), C1, 12); \
    GAPB(15, PAF(3), C1, 14); \
    } while (0)
    int t = 1;
    for (; t + 5 < NT; t += 2) {
        STEP(pB0, pB1, pA0, pA1, t, true, true, true);     A2_WAIT_BAR(5); RESC(); ROT();
        STEP(pA0, pA1, pB0, pB1, t + 1, true, true, true); A2_WAIT_BAR(5); RESC(); ROT();
    }
#define ENDW(tt) do { if ((tt) + 3 < NT) { A2_WAIT_BAR(5); } else if ((tt) + 2 < NT) { A2_WAIT_BAR(2); } else { A2_WAIT_BAR(0); } } while (0)
    for (; t + 1 < NT; t += 2) {
        STEP(pB0, pB1, pA0, pA1, t, (t + 3 < NT), (t + 1 < NT), (t + 1 < NT));         ENDW(t);     RESC(); ROT();
        STEP(pA0, pA1, pB0, pB1, t + 1, (t + 4 < NT), (t + 2 < NT), (t + 2 < NT));     ENDW(t + 1); RESC(); ROT();
    }
    STEP(pB0, pB1, pA0, pA1, NT - 1, false, false, false); RESC();
    { float sacc = pB0[0] + pB0[1];
#pragma unroll
      for (int r = 2; r < 16; ++r) sacc += pB0[r];
#pragma unroll
      for (int r = 0; r < 16; ++r) sacc += pB1[r];
      l_reg += sacc;
      pw0 = (u32x4){PKW(pB0, 0), PKW(pB0, 2), PKW(pB0, 4), PKW(pB0, 6)}; pw1 = (u32x4){PKW(pB0, 8), PKW(pB0, 10), PKW(pB0, 12), PKW(pB0, 14)};
      pw2 = (u32x4){PKW(pB1, 0), PKW(pB1, 2), PKW(pB1, 4), PKW(pB1, 6)}; pw3 = (u32x4){PKW(pB1, 8), PKW(pB1, 10), PKW(pB1, 12), PKW(pB1, 14)};
      const lds_cptr vp_ = vp0 + vs_cur; const lds_cptr vq_ = vp1 + vs_cur;
      VRD(0); VRD(1); VRD(2); VRD(3);
      o[0] = A2_MFMA(PAF(0), VFR(0), o[0]); o[1] = A2_MFMA(PAF(0), VFR(1), o[1]); o[2] = A2_MFMA(PAF(0), VFR(2), o[2]); o[3] = A2_MFMA(PAF(0), VFR(3), o[3]); FA_SBAR();
      VRD(4); VRD(5); VRD(6); VRD(7);
      o[0] = A2_MFMA(PAF(1), VFR(0), o[0]); o[1] = A2_MFMA(PAF(1), VFR(1), o[1]); o[2] = A2_MFMA(PAF(1), VFR(2), o[2]); o[3] = A2_MFMA(PAF(1), VFR(3), o[3]); FA_SBAR();
      VRD(8); VRD(9); VRD(10); VRD(11);
      o[0] = A2_MFMA(PAF(2), VFR(0), o[0]); o[1] = A2_MFMA(PAF(2), VFR(1), o[1]); o[2] = A2_MFMA(PAF(2), VFR(2), o[2]); o[3] = A2_MFMA(PAF(2), VFR(3), o[3]); FA_SBAR();
      VRD(12); VRD(13); VRD(14); VRD(15);
      o[0] = A2_MFMA(PAF(3), VFR(0), o[0]); o[1] = A2_MFMA(PAF(3), VFR(1), o[1]); o[2] = A2_MFMA(PAF(3), VFR(2), o[2]); o[3] = A2_MFMA(PAF(3), VFR(3), o[3]); }
    { auto rr = __builtin_amdgcn_permlane32_swap(__float_as_uint(l_reg), __float_as_uint(l_reg), false, false); l_reg = __uint_as_float(rr[0]) + __uint_as_float(rr[1]); }
    if (hi == 0) wsf[32 + r32] = l_reg; asm volatile("s_waitcnt lgkmcnt(0)" ::: "memory");
    float rli[16];
#pragma unroll
    for (int r = 0; r < 16; ++r) rli[r] = __builtin_amdgcn_rcpf(wsf[32 + crow(r, hi)]);
    { u16* Ow = Ob + (long)(wid * QBLK) * LDO;
#pragma unroll
      for (int r = 0; r < 16; ++r) { const int orow = crow(r, hi);
#pragma unroll
          for (int d0 = 0; d0 < 4; ++d0) Ow[(long)orow * LDO + d0 * 32 + r32] = (u16)f2bf(o[d0][r] * rli[r]); } }
#undef A2_ROW0
#undef DMA_K
#undef DMA_V
#undef ROT
#undef RESC
#undef KFR
#undef PKW
#undef PAF
#undef VFR
#undef VRD
#undef GAPA2
#undef GAPA0
#undef GAPB
#undef STEP
#undef ENDW
}

template <int DQ, int SPLIT8>
__device__ __forceinline__ void attn_unit_sp(const u16* __restrict__ Qb, int LDQ, const KVSrc S, u16* __restrict__ Ob, int LDO, int NT, char* lds) {
    using C = Cfg<DQ>;
    constexpr int NK = C::NK, NCH = C::NCH, KPT = C::KPT, KPT0 = SPLIT8 / 8, NCH1 = NCH - SPLIT8;
    constexpr size_t SHM_K = C::SHM_K;
    int tid_ = threadIdx.x; asm volatile("" : "+v"(tid_));
    const int tid = tid_, wid = tid >> 6, lane = tid & 63, r32 = lane & 31, hi = lane >> 5;
    char* V_lds = lds; char* K_lds = lds + 2 * SHM_V;
    float* wsf = (float*)(lds + 2 * SHM_V + 2 * SHM_K) + wid * 64; float* li_l = wsf; float* al_l = wsf + 32;
    float m_reg = -1e30f, l_reg = 0; f32x16 o[4] = {}; bf16x8 qr[NK];
    { const u16* Qw = Qb + (long)(wid * QBLK + r32) * LDQ + hi * 8;
#pragma unroll
      for (int d0 = 0; d0 < NK; ++d0) qr[d0] = *reinterpret_cast<const bf16x8*>(Qw + d0 * 16); }
    const int sr = tid >> 4, sc = (tid & 15) * 8, vst0 = v_st(sr, sc), vst1 = v_st(32 + sr, sc);
    const int vb0 = (int)(uintptr_t)V_lds + v_rd_base(lane);
    int koff[KPT], kw[KPT];
#pragma unroll
    for (int i = 0; i < KPT; ++i) {
        if (i < KPT0) { const int c = tid + 512 * i, row = c / SPLIT8, c8 = c % SPLIT8; koff[i] = row * S.kst0 + c8 * 8; kw[i] = C::kswz(row, c8 * 16); }
        else { const int c = tid + 512 * (i - KPT0), row = c / (NCH1 > 0 ? NCH1 : 1), c8 = c % (NCH1 > 0 ? NCH1 : 1); koff[i] = row * S.kst1 + c8 * 8; kw[i] = C::kswz(row, (SPLIT8 + c8) * 16); } }
    const int voff0 = sr * S.vst + sc, voff1 = (32 + sr) * S.vst + sc;
    bf16x8 vs0, vs1, ks[KPT];
#define FA_ROW0(kt) ((kt) < 4 ? S.xrow0 + 64 * (kt) : S.lrow0 + 64 * ((kt) - 4))
#define FA_SLOAD(kt) do { const long _r = FA_ROW0(kt); const u16* _v = S.v + _r * S.vst; const u16* _k0 = S.k0 + _r * S.kst0; const u16* _k1 = S.k1 + _r * S.kst1; \
    vs0 = *reinterpret_cast<const bf16x8*>(_v + voff0); vs1 = *reinterpret_cast<const bf16x8*>(_v + voff1); \
    _Pragma("unroll") for (int _q = 0; _q < KPT; ++_q) ks[_q] = *reinterpret_cast<const bf16x8*>((_q < KPT0 ? _k0 : _k1) + koff[_q]); } while (0)
#define FA_SWRITE(b) do { *(bf16x8*)(V_lds + (b) * SHM_V + vst0) = vs0; *(bf16x8*)(V_lds + (b) * SHM_V + vst1) = vs1; \
    _Pragma("unroll") for (int _q = 0; _q < KPT; ++_q) *(bf16x8*)(K_lds + (b) * SHM_K + kw[_q]) = ks[_q]; } while (0)
    f32x16 p0, p1; float mn, al; bf16x8 pa0, pa1, pa2, pa3;
    FA_SLOAD(0); asm volatile("s_waitcnt vmcnt(0)" ::: "memory"); FA_SWRITE(0); __syncthreads();
    for (int j = 0; j < NT; ++j) {
        const int b = j & 1;
        FA_SBAR(); qkt<DQ>(p0, p1, K_lds + b * SHM_K, qr, r32, hi);
        partialSM<DQ>(p0, p1, m_reg, mn, al);
        if (__any(al < 1.f)) { if (hi == 0) al_l[r32] = al; asm volatile("s_waitcnt lgkmcnt(0)" ::: "memory");
#pragma unroll
            for (int d = 0; d < 4; ++d)
#pragma unroll
                for (int r = 0; r < 16; ++r) o[d][r] *= al_l[crow(r, hi)]; }
        finishSM(p0, p1, al, l_reg, pa0, pa1, pa2, pa3); FA_SBAR();
        if (j + 1 < NT) FA_SLOAD(j + 1);
        FA_SBAR();
        pv_d0(o, vb0 + b * (int)SHM_V, pa0, pa1, pa2, pa3);
        if (j + 1 < NT) { asm volatile("s_waitcnt vmcnt(0)" ::: "memory"); FA_SWRITE(b ^ 1); }
        __syncthreads();
    }
    if (hi == 0) li_l[r32] = l_reg; asm volatile("s_waitcnt lgkmcnt(0)" ::: "memory");
    float rli[16];
#pragma unroll
    for (int r = 0; r < 16; ++r) rli[r] = __builtin_amdgcn_rcpf(li_l[crow(r, hi)]);
    u16* Ow = Ob + (long)(wid * QBLK) * LDO;
#pragma unroll
    for (int r = 0; r < 16; ++r) { const int orow = crow(r, hi);
#pragma unroll
        for (int d0 = 0; d0 < 4; ++d0) Ow[(long)orow * LDO + d0 * 32 + r32] = (u16)f2bf(o[d0][r] * rli[r]); }
#undef FA_ROW0
#undef FA_SLOAD
#undef FA_SWRITE
}
}


namespace gla {
typedef short bf16x8 __attribute__((ext_vector_type(8)));
typedef unsigned u32x4g __attribute__((ext_vector_type(4)));
typedef unsigned u32x2 __attribute__((ext_vector_type(2)));
constexpr int P = 72;
constexpr int ARR = 64 * P * 2;
constexpr int OFF_SET = 5 * ARR;
constexpr int OFF_ATT = 2 * OFF_SET, OFF_ST = OFF_ATT + ARR  , OFF_SEG = OFF_ST + 2 * ARR, OFF_DEC = OFF_SEG + 8 * 64 * 4, LDS_END = OFF_DEC + 2 * 64 * 4;
static_assert(LDS_END <= 131072, "GLA LDS map");
static_assert(fa::A2_END <= MISC_BASE && fa::A1_END <= MISC_BASE, "attention LDS map");
__device__ __forceinline__ bf16x8 ldfrag(const LAS unsigned char* arr, int row, int colb) { return *(const LAS bf16x8*)(arr + row * (P * 2) + colb); }
#define GLA_MFMA(a, b, c) __builtin_amdgcn_mfma_f32_16x16x32_bf16(a, b, c, 0, 0, 0)
__device__ __forceinline__ void unit(LAS unsigned char* lds, const u16* PARTS, const float* wg, const float* bg, int caf, u16* Od, int b, int h, int dir) {
    int tid_ = threadIdx.x; asm volatile("" : "+v"(tid_));
    const int tid = tid_, lane = tid & 63, w = __builtin_amdgcn_readfirstlane(tid >> 6);
    const int r16 = lane & 15, fq = lane >> 4;
    const int it = w & 3, jt0 = 2 * (w >> 2);
    float wgr[16];
#pragma unroll
    for (int j = 0; j < 16; ++j) wgr[j] = wg[j * 256 + h * 64 + lane];
    const float bgr = bg[h * 64 + lane];
    f32x4 S[2][2];
#pragma unroll
    for (int vh = 0; vh < 2; ++vh)
#pragma unroll
        for (int j = 0; j < 2; ++j) S[vh][j] = (f32x4){0.f, 0.f, 0.f, 0.f};
    for (int e = tid; e < 2 * ARR / 4; e += 512) ((LAS unsigned*)(lds + OFF_ST))[e] = 0u;
    auto rowof = [&](int pos) { return pos < CTXL ? (ML + b * CTXL + (dir ? CTXL - 1 - pos : pos)) : (b * SEQ + (dir ? SEQ - 1 - (pos - CTXL) : (pos - CTXL))); };
    unsigned short qv[8], kv[8], vv[8][2]; float afv[8];
#define GLA_LOAD(n) do { _Pragma("unroll") for (int i = 0; i < 8; ++i) { const int row = rowof((n) * 64 + 8 * w + i); const u16* pr = PARTS + (size_t)row * IN_AP; \
        qv[i] = pr[C_GQ + h * 64 + lane]; kv[i] = pr[C_GK + h * 64 + lane]; vv[i][0] = pr[C_GV + h * 128 + lane]; vv[i][1] = pr[C_GV + h * 128 + 64 + lane]; afv[i] = bf2f(pr[caf + (lane & 15)]); } } while (0)
    GLA_LOAD(0);
    constexpr int NCHUNK = (CTXL + SEQ) / 64;
    for (int n = 0; n < NCHUNK; ++n) {
        LAS unsigned char* Qt = lds + (n & 1) * OFF_SET; LAS unsigned char* Kt = Qt + ARR; LAS unsigned char* KhT = Kt + ARR; LAS unsigned char* Vt = KhT + ARR;
        LAS unsigned char* St = lds + OFF_ST; LAS unsigned char* At = lds + OFF_ATT;
        LAS float* seg = (LAS float*)(lds + OFF_SEG); LAS float* dec = (LAS float*)(lds + OFF_DEC) + (n & 1) * 64;
        float c[8]; float run = 0.f;
#pragma unroll
        for (int i = 0; i < 8; ++i) { float pre = bgr;
#pragma unroll
            for (int j = 0; j < 16; ++j) pre += __int_as_float(__builtin_amdgcn_readlane(__float_as_int(afv[i]), j)) * wgr[j];
            const float ls = fminf(pre, 0.f) - __logf(1.0f + __expf(-fabsf(pre)));
            run += ls * (1.0f / 16.0f); c[i] = run; }
        seg[w * 64 + lane] = run;
        __syncthreads();
        float prefix = 0.f, last = 0.f;
#pragma unroll
        for (int ww = 0; ww < 8; ++ww) { const float t = seg[ww * 64 + lane]; last += t; prefix += (ww < w) ? t : 0.f; }
        const float elast = __expf(last);
        unsigned khp[4], vtp[2][4];
#pragma unroll
        for (int i = 0; i < 8; ++i) { const int s = 8 * w + i; const float cum = prefix + c[i]; const float e = __expf(cum), ie = __builtin_amdgcn_rcpf(e), kf = bf2f(kv[i]);
            ((LAS u16*)Qt)[s * P + lane] = (u16)f2bf(bf2f(qv[i]) * 0.125f * e);
            const float kt = kf * ie;
            ((LAS u16*)Kt)[s * P + lane] = (u16)f2bf(kt);
            const unsigned kh = f2bf(kt * elast);
            if (i & 1) { khp[i >> 1] |= kh << 16; vtp[0][i >> 1] |= (unsigned)vv[i][0] << 16; vtp[1][i >> 1] |= (unsigned)vv[i][1] << 16; }
            else { khp[i >> 1] = kh; vtp[0][i >> 1] = vv[i][0]; vtp[1][i >> 1] = vv[i][1]; } }
        *(LAS u32x4g*)(KhT + (lane * P + 8 * w) * 2) = (u32x4g){khp[0], khp[1], khp[2], khp[3]};
        *(LAS u32x4g*)(Vt + (lane * P + 8 * w) * 2) = (u32x4g){vtp[0][0], vtp[0][1], vtp[0][2], vtp[0][3]};
        *(LAS u32x4g*)(Vt + ((64 + lane) * P + 8 * w) * 2) = (u32x4g){vtp[1][0], vtp[1][1], vtp[1][2], vtp[1][3]};
        if (w == 0) dec[lane] = elast;
        __syncthreads();
        if (n + 1 < NCHUNK) GLA_LOAD(n + 1);
        f32x4 a0 = {0.f, 0.f, 0.f, 0.f}, a1 = a0; f32x4 o[2][2] = {{a0, a0}, {a0, a0}};
#pragma unroll
        for (int ks = 0; ks < 2; ++ks) { const int cb = ks * 64 + fq * 16;
            const bf16x8 A = ldfrag(Kt, 16 * it + r16, cb), Bq0 = ldfrag(Qt, 16 * jt0 + r16, cb), Bq1 = ldfrag(Qt, 16 * (jt0 + 1) + r16, cb);
            const bf16x8 As0 = ldfrag(St, 16 * it + r16, cb), As1 = ldfrag(St, 64 + 16 * it + r16, cb);
            a0 = GLA_MFMA(A, Bq0, a0); a1 = GLA_MFMA(A, Bq1, a1);
            o[0][0] = GLA_MFMA(As0, Bq0, o[0][0]); o[0][1] = GLA_MFMA(As0, Bq1, o[0][1]);
            o[1][0] = GLA_MFMA(As1, Bq0, o[1][0]); o[1][1] = GLA_MFMA(As1, Bq1, o[1][1]); }
        { const int s0 = 16 * it + 4 * fq; const int t0 = 16 * jt0 + r16, t1 = t0 + 16;
          u32x2 p0, p1;
          p0.x = f2bf(s0 + 0 <= t0 ? a0[0] : 0.f) | (f2bf(s0 + 1 <= t0 ? a0[1] : 0.f) << 16); p0.y = f2bf(s0 + 2 <= t0 ? a0[2] : 0.f) | (f2bf(s0 + 3 <= t0 ? a0[3] : 0.f) << 16);
          p1.x = f2bf(s0 + 0 <= t1 ? a1[0] : 0.f) | (f2bf(s0 + 1 <= t1 ? a1[1] : 0.f) << 16); p1.y = f2bf(s0 + 2 <= t1 ? a1[2] : 0.f) | (f2bf(s0 + 3 <= t1 ? a1[3] : 0.f) << 16);
          *(LAS u32x2*)(At + (t0 * P + s0) * 2) = p0; *(LAS u32x2*)(At + (t1 * P + s0) * 2) = p1; }
        __syncthreads();
        const f32x4 d4 = *(const LAS f32x4*)(dec + 16 * it + 4 * fq);
#pragma unroll
        for (int vh = 0; vh < 2; ++vh)
#pragma unroll
            for (int j = 0; j < 2; ++j) S[vh][j] = S[vh][j] * d4;
#pragma unroll
        for (int ks = 0; ks < 2; ++ks) { const int cb = ks * 64 + fq * 16;
            const bf16x8 Ba0 = ldfrag(At, 16 * jt0 + r16, cb), Ba1 = ldfrag(At, 16 * (jt0 + 1) + r16, cb), Ak = ldfrag(KhT, 16 * it + r16, cb);
#pragma unroll
            for (int vh = 0; vh < 2; ++vh) {
                const bf16x8 Av = ldfrag(Vt, 64 * vh + 16 * it + r16, cb), Bv0 = ldfrag(Vt, 64 * vh + 16 * jt0 + r16, cb), Bv1 = ldfrag(Vt, 64 * vh + 16 * (jt0 + 1) + r16, cb);
                o[vh][0] = GLA_MFMA(Av, Ba0, o[vh][0]); o[vh][1] = GLA_MFMA(Av, Ba1, o[vh][1]);
                S[vh][0] = GLA_MFMA(Ak, Bv0, S[vh][0]); S[vh][1] = GLA_MFMA(Ak, Bv1, S[vh][1]); } }
        { const int v0 = 16 * it + 4 * fq, t0 = 16 * jt0 + r16, k0 = 16 * it + 4 * fq, vc0 = 16 * jt0 + r16;
          u16* od0 = Od + (size_t)rowof(n * 64 + t0) * 512 + h * 128 + v0; u16* od1 = Od + (size_t)rowof(n * 64 + t0 + 16) * 512 + h * 128 + v0;
#pragma unroll
          for (int vh = 0; vh < 2; ++vh) {
              u32x2 w0, w1; w0.x = f2bf(o[vh][0][0]) | (f2bf(o[vh][0][1]) << 16); w0.y = f2bf(o[vh][0][2]) | (f2bf(o[vh][0][3]) << 16);
              w1.x = f2bf(o[vh][1][0]) | (f2bf(o[vh][1][1]) << 16); w1.y = f2bf(o[vh][1][2]) | (f2bf(o[vh][1][3]) << 16);
              *(u32x2*)(od0 + vh * 64) = w0; *(u32x2*)(od1 + vh * 64) = w1;
              u32x2 q0, q1; q0.x = f2bf(S[vh][0][0]) | (f2bf(S[vh][0][1]) << 16); q0.y = f2bf(S[vh][0][2]) | (f2bf(S[vh][0][3]) << 16);
              q1.x = f2bf(S[vh][1][0]) | (f2bf(S[vh][1][1]) << 16); q1.y = f2bf(S[vh][1][2]) | (f2bf(S[vh][1][3]) << 16);
              *(LAS u32x2*)(St + ((64 * vh + vc0) * P + k0) * 2) = q0; *(LAS u32x2*)(St + ((64 * vh + vc0 + 16) * P + k0) * 2) = q1; } }
    }
#undef GLA_LOAD
}
#undef GLA_MFMA
}

__global__ void __launch_bounds__(512, 2) fwd_kernel(Args args) {
    extern __shared__ __attribute__((aligned(16))) unsigned char lds_raw[];
    LAS unsigned char* lds = (LAS unsigned char*)lds_raw;
    const int tid = threadIdx.x, lane = tid & 63, wave = __builtin_amdgcn_readfirstlane(tid >> 6);
    const int G = gridDim.x, gw = blockIdx.x * 8 + wave, NGW = G * 8;
    unsigned char* ws = args.ws;
    unsigned* ctl = (unsigned*)(ws + WS_CTL);
    volatile LAS unsigned* MISC = (volatile LAS unsigned*)(lds + MISC_OFF);
    for (int u = tid; u < (LDS_BYTES - MISC_BASE) / 4; u += 512) ((LAS unsigned*)(lds + MISC_BASE))[u] = 0u;
    __syncthreads();
    XcdBarrier bar = xcd_barrier_post(ctl + CW_BAR + args.li * 4096, MISC + 8);
    const int lo = args.ph_lo, hi = args.ph_hi;
#define IN(k) (lo <= (k) && (k) < hi)
#ifdef PROBE_AMP
    unsigned long long amp_t0 = 0;
#define PH_BEGIN(k) do { if ((PROBE_AMP >> (k)) & 1) amp_t0 = __builtin_amdgcn_s_memrealtime(); } while (0)
#define PH_END(k) do { if ((PROBE_AMP >> (k)) & 1) { const unsigned long long t1 = __builtin_amdgcn_s_memrealtime(); const unsigned long long tgt = t1 + 4ull * (t1 - amp_t0); \
        while (__builtin_amdgcn_s_memrealtime() < tgt) __builtin_amdgcn_s_sleep(32); } } while (0)
#else
#define PH_BEGIN(k) do {} while (0)
#define PH_END(k) do {} while (0)
#endif
#define GRID_BAR() xcd_barrier(bar)

    const float* x_in = args.in[0]; const float* c_in = args.in[1]; const float* ctx_in = args.in[2]; const float* cctx_in = args.in[3];
    const float* w_mod = args.in[4]; const float* b_mod = args.in[5];
    const float* g_pre_mix = args.in[6]; const float* g_post_mix = args.in[7]; const float* g_pre_ffn = args.in[8]; const float* g_post_ffn = args.in[9];
    const float* w_in_a = args.in[10]; const float* mla_g_q = args.in[11]; const float* mla_w_uq = args.in[12]; const float* mla_g_kv = args.in[13]; const float* mla_w_ukv = args.in[14];
    const float* gla_w_gf = args.in[15]; const float* gla_b_gf = args.in[16]; const float* gla_w_gb = args.in[17]; const float* gla_b_gb = args.in[18]; const float* gla_g_out = args.in[19];
    const float* w_out_a = args.in[20]; const float* w_qkv_c = args.in[21];
    const float* diff_lq1 = args.in[22]; const float* diff_lk1 = args.in[23]; const float* diff_lq2 = args.in[24]; const float* diff_lk2 = args.in[25]; const float* diff_g_out = args.in[26];
    const float* w_out_c = args.in[27]; const float* ffn_w_gate = args.in[28]; const float* ffn_w_up = args.in[29]; const float* ffn_w_down = args.in[30];
    const float* moe_w_router = args.in[31]; const float* moe_w_gate = args.in[32]; const float* moe_w_up = args.in[33]; const float* moe_w_down = args.in[34];
    float* out = args.out;
    float* MODB = (float*)(ws + WS_MOD);
    float* ROPEC = (float*)(ws + WS_ROPE); float* ROPES = ROPEC + 2048 * 32;
    int* TOKE = (int*)(ws + WS_TOKE); float* TOKG = (float*)(ws + WS_TOKG); int* TOKP = (int*)(ws + WS_TOKP);
    float* CTXS = (float*)(ws + WS_CTXS);
    u16* H0 = (u16*)(ws + WS_R0); u16* CAT = (u16*)(ws + WS_R0); u16* FB = (u16*)(ws + WS_R0); u16* O16 = (u16*)(ws + WS_R0); u16* Y2 = (u16*)(ws + WS_R0);
    u16* PARTS = (u16*)(ws + WS_PARTS); u16* YB = (u16*)(ws + WS_Y); u16* HB = (u16*)(ws + WS_Y);
    u16* H1 = (u16*)(ws + WS_H1); u16* CAT2 = (u16*)(ws + WS_H1);
    unsigned char* HC8 = ws + WS_HC;
    u16* A2 = (u16*)(ws + WS_A2); u16* KROPE = (u16*)(ws + WS_KROPE);
    u16* OF = (u16*)(ws + WS_R3); u16* OB = OF + (size_t)M * 512;
    u16* QKVUP = (u16*)(ws + WS_QKVUP); u16* HID = (u16*)(ws + WS_R3); u16* QKVC = (u16*)(ws + WS_R3);
    u16* W_IN = (u16*)(ws + WS_W);
    u16* W_UP = (u16*)(ws + WS_W + 4 * MiB);
    u16* W_OA = (u16*)(ws + WS_W + 4 * MiB + 1536 * 1024);
    u16* W_FGU = (u16*)(ws + WS_W + 7 * MiB + 512 * 1024);
    u16* W_FD = (u16*)(ws + WS_W + 18 * MiB + 512 * 1024);
    u16* W_QKV = (u16*)(ws + WS_W + 24 * MiB);
    u16* W_OC = (u16*)(ws + WS_W + 30 * MiB);
    unsigned char* W_MGU = ws + WS_WMGU; unsigned char* W_MD = ws + WS_WMD; unsigned char* XS8 = ws + WS_XS8; unsigned char* HID8 = ws + WS_R0;
    unsigned char* YS8 = ws + WS_YS; u16* XST = (u16*)(ws + WS_XST);
    unsigned char* W8_FGU = (unsigned char*)W_FGU; unsigned char* W8_FD = W8_FGU + (size_t)2 * FFN * 1024;
    unsigned char* H1_8 = (unsigned char*)H1; unsigned char* HIDL8 = (unsigned char*)HID;
    auto map_id = [](int n0) { return RowMap2{n0, 1}; };
    auto map_gate = [](int n0) { return RowMap2{(n0 >> 7) * 256 + (n0 & 127), 1}; };
    auto map_up = [](int n0) { return RowMap2{(n0 >> 7) * 256 + 128 + (n0 & 127), 1}; };
    auto map8_id = [](int n0) { return n0; };
    auto map8_gate = [](int n0) { return (n0 >> 7) * 256 + (n0 & 127); };
    auto map8_up = [](int n0) { return (n0 >> 7) * 256 + 128 + (n0 & 127); };

    if (IN(0)) {
        PH_BEGIN(0);
        LAS float* sT = (LAS float*)lds;
        LAS float* red = sT + 1024 * 20;
        for (int e = tid; e < 17 * 1024; e += 512) { const int r = e >> 10, k = e & 1023; const float v = r < 16 ? c_in[r * 1024 + k] : cctx_in[k]; sT[k * 20 + r] = silu_f(v); }
        __syncthreads();
        for (int g = blockIdx.x; g < 192; g += G) {
            const int l = g / 96, n = (g % 96) * 64 + lane;
            const float* wp = w_mod + (size_t)l * 1024 * 6144 + n;
            float acc[17];
#pragma unroll
            for (int r = 0; r < 17; ++r) acc[r] = 0.f;
            const int kb = wave * 128;
            float wa[8], wb[8];
#pragma unroll
            for (int u = 0; u < 8; ++u) wa[u] = wp[(size_t)(kb + u) * 6144];
#pragma unroll 1
            for (int kk0 = 0; kk0 < 128; kk0 += 16) {
#pragma unroll
                for (int u = 0; u < 8; ++u) wb[u] = wp[(size_t)(kb + kk0 + 8 + u) * 6144];
#pragma unroll
                for (int u = 0; u < 8; ++u) { const LAS float* sp = sT + (kb + kk0 + u) * 20;
#pragma unroll
                    for (int r = 0; r < 17; ++r) acc[r] += sp[r] * wa[u];
                    __builtin_amdgcn_sched_barrier(0); }
                const int kn = (kk0 + 16 < 128) ? kk0 + 16 : kk0;
#pragma unroll
                for (int u = 0; u < 8; ++u) wa[u] = wp[(size_t)(kb + kn + u) * 6144];
#pragma unroll
                for (int u = 0; u < 8; ++u) { const LAS float* sp = sT + (kb + kk0 + 8 + u) * 20;
#pragma unroll
                    for (int r = 0; r < 17; ++r) acc[r] += sp[r] * wb[u];
                    __builtin_amdgcn_sched_barrier(0); }
            }
#pragma unroll
            for (int r = 0; r < 17; ++r) red[(wave * 17 + r) * 64 + lane] = acc[r];
            __syncthreads();
            for (int e = tid; e < 17 * 64; e += 512) { const int r = e >> 6, ln = e & 63; float s = 0.f;
#pragma unroll
                for (int w8 = 0; w8 < 8; ++w8) s += red[(w8 * 17 + r) * 64 + ln];
                const int nn = (g % 96) * 64 + ln;
                MODB[(size_t)(l * 17 + r) * 6144 + nn] = s + b_mod[l * 6144 + nn]; }
            __syncthreads();
        }
        for (int e = blockIdx.x * 512 + tid; e < 2048 * 32; e += G * 512) { const int t = e >> 5, i = e & 31; const int pos = i < 16 ? (t >> 6) : (t & 63);
            const float freq = powf(10000.0f, -(float)(i & 15) / 16.0f); const float ang = (float)pos * freq;
            ROPEC[e] = cosf(ang); ROPES[e] = sinf(ang); }
        __syncthreads();
        { LAS float* scr = (LAS float*)(lds + wave * 8448); int off = 0;
          cvt_matrix(w_in_a, 1024, IN_A, W_IN, 1024, 0, map_id, scr, lane, gw, NGW, off);
          cvt_matrix(mla_w_uq, 256, 768, W_UP, 384, 0, [](int n0) { const int h = n0 / 192, j = n0 % 192; return j < 128 ? RowMap2{n0, 1} : RowMap2{h * 192 + 128 + (j == 160 ? 1 : 0), 2}; }, scr, lane, gw, NGW, off);
          cvt_matrix(mla_w_ukv, 128, 1024, W_UP, 384, 256, [](int n0) { return RowMap2{768 + n0, 1}; }, scr, lane, gw, NGW, off);
          cvt_matrix(w_out_a, 1024, 1024, W_OA, 1024, 0, map_id, scr, lane, gw, NGW, off);
          cvt_matrix8(ffn_w_gate, 1024, FFN, W8_FGU, 1024, 64.0f, map8_gate, scr, lane, gw, NGW, off);
          cvt_matrix8(ffn_w_up, 1024, FFN, W8_FGU, 1024, 512.0f, map8_up, scr, lane, gw, NGW, off);
          cvt_matrix8(ffn_w_down, FFN, 1024, W8_FD, FFN, 64.0f, map8_id, scr, lane, gw, NGW, off);
          cvt_matrix(w_qkv_c, 1024, 3072, W_QKV, 1024, 0, [](int n0) { return n0 < 2048 ? RowMap2{(n0 & ~63) + ((n0 & 32) ? 1 : 0), 2} : RowMap2{n0, 1}; }, scr, lane, gw, NGW, off);
          cvt_matrix(w_out_c, 1024, 1024, W_OC, 1024, 0, map_id, scr, lane, gw, NGW, off);
          const uint4 z = make_uint4(0u, 0u, 0u, 0u);
          for (int e = blockIdx.x * 512 + tid; e < 32 * 128; e += G * 512) *(uint4*)(W_IN + (size_t)IN_A * 1024 + (size_t)e * 8) = z;
          for (int e = blockIdx.x * 512 + tid; e < 768 * 16; e += G * 512) { const int r = e >> 4, c8 = e & 15; *(uint4*)(W_UP + (size_t)r * 384 + 256 + c8 * 8) = z; }
          for (int e = blockIdx.x * 512 + tid; e < 1024 * 32; e += G * 512) { const int r = 768 + (e >> 5), c8 = e & 31; *(uint4*)(W_UP + (size_t)r * 384 + c8 * 8) = z; } }
        GRID_BAR(); PH_END(0);
    }
    if (IN(1)) {
        PH_BEGIN(1);
        { const int rpw = (M + NGW - 1) / NGW, rb = gw * rpw, re = (rb + rpw < M) ? rb + rpw : M;
          f32x4 gv[4], sh[4], sc[4]; ld_vec(g_pre_mix, lane, gv); int cur = -1;
          for (int row = rb; row < re; ++row) {
            const float* src = row < ML ? x_in + (size_t)row * 1024 : ctx_in + (size_t)(row - ML) * 1024;
            const int mr = row < ML ? (row >> 11) : 16;
            if (mr != cur) { ld_vec(modp(ws, 0, mr, 0), lane, sh); ld_vec(modp(ws, 0, mr, 1), lane, sc); cur = mr; }
            f32x4 xv[4], hv[4]; ld_row_f32(src, lane, xv);
            const float r = row_rstd(xv);
#pragma unroll
            for (int j = 0; j < 4; ++j) hv[j] = xv[j] * r * gv[j] * (1.0f + sc[j]) + sh[j];
            st_row_bf16(H0 + (size_t)row * 1024, lane, hv);
          } }
        GRID_BAR(); PH_END(1);
    }
    if (IN(2)) {
        PH_BEGIN(2);
        { pg8::Gemm g{H0, W_IN, 1024, 1024, 0, 0}; pg8::DenseOrder S; S.init(M / 256, IN_AP / 256, G, (int)blockIdx.x); pg8::EpiStore E{PARTS, IN_AP};
          pg8::gemm_phase<pg8::EpiStore, pg8::DenseOrder, PG8_ALIGN, PG8_SP2>(lds, g, S, E); }
        GRID_BAR(); PH_END(2);
    }
    if (IN(3)) {
        PH_BEGIN(3);
        { const bool split = (G % 16 == 0);
          const int role = (int)(blockIdx.x >> 3) & 1, ridx = (int)((blockIdx.x >> 4) << 3) | (int)(blockIdx.x & 7);
          const int eg = split ? ridx : (int)blockIdx.x, en = split ? G / 2 : G;
          unsigned* sb = ctl + CW_SUB + args.li * 128;
          if (!split || role == 0) {
            for (int row = eg * 8 + wave; row < M; row += en * 8) {
                const u16* pr = PARTS + (size_t)row * IN_AP;
                { const uint2 w = *(const uint2*)(pr + C_CQ + 4 * lane); float v[4] = {bf2f(w.x & 0xffffu), bf2f(w.x >> 16), bf2f(w.y & 0xffffu), bf2f(w.y >> 16)};
                  float s = wave_sum(v[0] * v[0] + v[1] * v[1] + v[2] * v[2] + v[3] * v[3]); const float r = 1.0f / sqrtf(s * (1.0f / 256.0f) + EPS);
                  const f32x4 g = *(const f32x4*)(mla_g_q + 4 * lane);
                  uint2 o; o.x = f2bf(v[0] * r * g.x) | (f2bf(v[1] * r * g.y) << 16); o.y = f2bf(v[2] * r * g.z) | (f2bf(v[3] * r * g.w) << 16);
                  *(uint2*)(A2 + (size_t)row * 384 + 4 * lane) = o; }
                { const unsigned w = *(const unsigned*)(pr + C_CKV + 2 * lane); float v0 = bf2f(w & 0xffffu), v1 = bf2f(w >> 16);
                  float s = wave_sum(v0 * v0 + v1 * v1); const float r = 1.0f / sqrtf(s * (1.0f / 128.0f) + EPS);
                  const float2 g = *(const float2*)(mla_g_kv + 2 * lane);
                  *(unsigned*)(A2 + (size_t)row * 384 + 256 + 2 * lane) = f2bf(v0 * r * g.x) | (f2bf(v1 * r * g.y) << 16); }
                if (lane < 32) { float x1 = bf2f(pr[C_KR + lane]), x2 = bf2f(pr[C_KR + 32 + lane]);
                  if (row < ML) { const int t = row & 2047; const float cs = ROPEC[t * 32 + lane], sn = ROPES[t * 32 + lane]; const float n1 = x1 * cs - x2 * sn, n2 = x2 * cs + x1 * sn; x1 = n1; x2 = n2; }
                  *(unsigned*)(KROPE + (size_t)row * 64 + 2 * lane) = f2bf(x1) | (f2bf(x2) << 16); }
            }
            sub_arrive(sb); sub_wait(sb, (unsigned)en);
            { pg8::Gemm g{A2, W_UP, 384, 384, 0, 0}; pg8::DenseOrder S; S.init(M / 256, UPN / 256, en, eg); pg8::EpiStoreRope<1> E{QKVUP, UPN, ROPEC, ROPES};
              pg8::gemm_phase<pg8::EpiStoreRope<1>, pg8::DenseOrder, PG8_ALIGN, PG8_SP2>(lds, g, S, E); }
            sub_arrive(sb + 64);
          }
          if (!split || role) {
              for (int u = split ? ridx : (int)blockIdx.x; u < 128; u += split ? G / 2 : G) {
                  const int dir = u & 1, h = (u >> 1) & 3, b = u >> 3;
                  __syncthreads();
                  gla::unit(lds, PARTS, dir ? gla_w_gb : gla_w_gf, dir ? gla_b_gb : gla_b_gf, dir ? C_AB : C_AF, dir ? OB : OF, b, h, dir);
              } }
          __syncthreads();
          sub_wait(sb + 64, (unsigned)en);
          const int NU_L = NB * 4 * 8, NU_X = NB * 4;
          LAS unsigned* qslot = (LAS unsigned*)(lds + MISC_BASE + 64);
          for (;;) {
            __syncthreads();
            if (tid == 0) *qslot = atomicAdd(ctl + CW_ATQ, 1u);
            __syncthreads();
            const int u = (int)*qslot;
            if (u >= NU_L + NU_X) break;
            const bool isx = u >= NU_L; const int uu = isx ? u - NU_L : u;
            const int qb = isx ? 0 : (uu & 7), h = isx ? (uu & 3) : ((uu >> 3) & 3), b = isx ? (uu >> 2) : (uu >> 5);
            const int r0 = isx ? (ML + b * CTXL) : (b * SEQ + qb * 256);
            fa::KVSrc S; S.k0 = QKVUP + 768 + h * 256; S.kst0 = UPN; S.k1 = KROPE; S.kst1 = 64; S.split8 = 16; S.v = QKVUP + 768 + h * 256 + 128; S.vst = UPN;
            S.xrow0 = ML + b * CTXL; S.lrow0 = b * SEQ;
            fa::attn192_unit<8>(QKVUP + (size_t)r0 * UPN + h * 192, UPN, S, CAT + (size_t)r0 * 1024 + h * 128, 1024, isx ? 4 : 36, (char*)lds_raw);
          } }
        GRID_BAR();
        for (int row = gw; row < M; row += NGW) {
            const int h = lane >> 4, v0 = (lane & 15) * 8;
            const uint4 wf = *(const uint4*)(OF + (size_t)row * 512 + h * 128 + v0), wb = *(const uint4*)(OB + (size_t)row * 512 + h * 128 + v0);
            const unsigned af[4] = {wf.x, wf.y, wf.z, wf.w}, ab[4] = {wb.x, wb.y, wb.z, wb.w};
            float o[8]; float s = 0.f;
#pragma unroll
            for (int i = 0; i < 4; ++i) { o[2 * i] = bf2f(af[i] & 0xffffu) + bf2f(ab[i] & 0xffffu); o[2 * i + 1] = bf2f(af[i] >> 16) + bf2f(ab[i] >> 16); s += o[2 * i] * o[2 * i] + o[2 * i + 1] * o[2 * i + 1]; }
#pragma unroll
            for (int off = 1; off < 2; ++off) s = row16_sum(s);
            const float r = 1.0f / sqrtf(s * (1.0f / 128.0f) + EPS);
            const uint4 wr4 = *(const uint4*)(PARTS + (size_t)row * IN_AP + C_GR + h * 128 + v0); const unsigned ar[4] = {wr4.x, wr4.y, wr4.z, wr4.w};
            unsigned ow[4];
#pragma unroll
            for (int i = 0; i < 4; ++i) { const float a = o[2 * i] * r * gla_g_out[v0 + 2 * i] * silu_f(bf2f(ar[i] & 0xffffu)), b2 = o[2 * i + 1] * r * gla_g_out[v0 + 2 * i + 1] * silu_f(bf2f(ar[i] >> 16)); ow[i] = f2bf(a) | (f2bf(b2) << 16); }
            *(uint4*)(CAT + (size_t)row * 1024 + 512 + h * 128 + v0) = make_uint4(ow[0], ow[1], ow[2], ow[3]);
        }
        GRID_BAR(); PH_END(3);
    }
    if (IN(6)) {
        PH_BEGIN(6);
        { pg8::Gemm g{CAT, W_OA, 1024, 1024, 0, 0}; pg8::DenseOrder S; S.init(M / 256, 4, G, (int)blockIdx.x); pg8::EpiStore E{YB, 1024};
          pg8::gemm_phase<pg8::EpiStore, pg8::DenseOrder, PG8_ALIGN, PG8_SP2>(lds, g, S, E); }
        GRID_BAR(); PH_END(6);
    }
    if (IN(7)) {
        PH_BEGIN(7);
        { const int rpw = (M + NGW - 1) / NGW, rb = gw * rpw, re = (rb + rpw < M) ? rb + rpw : M;
          f32x4 gpo[4], gpr[4], gt[4], sh[4], sc[4]; ld_vec(g_post_mix, lane, gpo); ld_vec(g_pre_ffn, lane, gpr); int cur = -1;
          for (int row = rb; row < re; ++row) {
            const float* src = row < ML ? x_in + (size_t)row * 1024 : ctx_in + (size_t)(row - ML) * 1024;
            const int mr = row < ML ? (row >> 11) : 16;
            if (mr != cur) { ld_vec(modp(ws, 0, mr, 2), lane, gt); ld_vec(modp(ws, 0, mr, 3), lane, sh); ld_vec(modp(ws, 0, mr, 4), lane, sc); cur = mr; }
            f32x4 xv[4], tv[4], hv[4]; ld_row_f32(src, lane, xv); ld_row_bf16(YB + (size_t)row * 1024, lane, tv);
            const float rt = row_rstd(tv);
#pragma unroll
            for (int j = 0; j < 4; ++j) xv[j] = xv[j] + gt[j] * (tv[j] * rt * gpo[j]);
            if (row < ML) st_row_bf16(XST + (size_t)row * 1024, lane, xv); else st_row_f32(CTXS + (size_t)(row - ML) * 1024, lane, xv);
            const float r = row_rstd(xv);
#pragma unroll
            for (int j = 0; j < 4; ++j) hv[j] = xv[j] * r * gpr[j] * (1.0f + sc[j]) + sh[j];
#pragma unroll
            for (int j = 0; j < 4; ++j) { unsigned t = 0u; t = __builtin_amdgcn_cvt_pk_fp8_f32(pg8::clamp8(hv[j].x), pg8::clamp8(hv[j].y), t, false); t = __builtin_amdgcn_cvt_pk_fp8_f32(pg8::clamp8(hv[j].z), pg8::clamp8(hv[j].w), t, true);
                *(unsigned*)(H1_8 + (size_t)row * 1024 + 4 * lane + 256 * j) = t; }
          } }
        GRID_BAR(); PH_END(7);
    }
    if (IN(8)) {
        PH_BEGIN(8);
        { pg8::Gemm g{H1_8, W8_FGU, 1024, 1024, 0x7f7f7f7f, 0x79797979}; pg8::DenseOrder S; S.init(M / 256, 2 * FFN / 256, G, (int)blockIdx.x); pg8::EpiSwiglu8 E{HIDL8, FFN};
          pg8::gemm_phase<pg8::EpiSwiglu8, pg8::DenseOrder, PG8_ALIGN, PG8_SP2, 1>(lds, g, S, E); }
        GRID_BAR(); PH_END(8);
    }
    if (IN(9)) {
        PH_BEGIN(9);
        { pg8::Gemm g{HIDL8, W8_FD, FFN, FFN, 0x7c7c7c7c, 0x79797979}; pg8::DenseOrder S; S.init(M / 256, 4, G, (int)blockIdx.x); pg8::EpiStore E{FB, 1024};
          pg8::gemm_phase<pg8::EpiStore, pg8::DenseOrder, PG8_ALIGN, PG8_SP2, 1>(lds, g, S, E); }
        GRID_BAR(); PH_END(9);
    }
    if (IN(10)) {
        PH_BEGIN(10);
        { const int rpw = (M + NGW - 1) / NGW, rb = gw * rpw, re = (rb + rpw < M) ? rb + rpw : M;
          f32x4 gpo[4], gpr[4], gt[4], sh[4], sc[4]; ld_vec(g_post_ffn, lane, gpo); ld_vec(g_pre_mix + 1024, lane, gpr); int cur = -1;
          for (int row = rb; row < re; ++row) {
            const int mr = row < ML ? (row >> 11) : 16;
            if (mr != cur) { ld_vec(modp(ws, 0, mr, 5), lane, gt); ld_vec(modp(ws, 1, mr, 0), lane, sh); ld_vec(modp(ws, 1, mr, 1), lane, sc); cur = mr; }
            f32x4 xv[4], tv[4], hv[4];
            if (row < ML) ld_row_bf16(XST + (size_t)row * 1024, lane, xv); else ld_row_f32(CTXS + (size_t)(row - ML) * 1024, lane, xv);
            ld_row_bf16(FB + (size_t)row * 1024, lane, tv);
            const float rt = row_rstd(tv);
#pragma unroll
            for (int j = 0; j < 4; ++j) xv[j] = xv[j] + gt[j] * (tv[j] * rt * gpo[j]);
            if (row < ML) st_row_bf16(XST + (size_t)row * 1024, lane, xv); else st_row_f32(CTXS + (size_t)(row - ML) * 1024, lane, xv);
            const float r = row_rstd(xv);
#pragma unroll
            for (int j = 0; j < 4; ++j) hv[j] = xv[j] * r * gpr[j] * (1.0f + sc[j]) + sh[j];
            st_row_bf16(HB + (size_t)row * 1024, lane, hv);
          } }
        GRID_BAR(); PH_END(10);
    }
    if (IN(11)) {
        PH_BEGIN(11);
        { pg8::Gemm g{HB, W_QKV, 1024, 1024, 0, 0}; pg8::DenseOrder S; S.init(M / 256, 12, G, (int)blockIdx.x); pg8::EpiStoreRope<0> E{QKVC, 3072, ROPEC, ROPES};
          pg8::gemm_phase<pg8::EpiStoreRope<0>, pg8::DenseOrder, PG8_ALIGN, PG8_SP2>(lds, g, S, E); }
        GRID_BAR(); PH_END(11);
    }
    if (IN(12)) {
        PH_BEGIN(12);
        { const float s1 = wave_sum(diff_lq1[lane] * diff_lk1[lane]), s2 = wave_sum(diff_lq2[lane] * diff_lk2[lane]);
          const float lam = __int_as_float(__builtin_amdgcn_readfirstlane(__float_as_int(expf(s1) - expf(s2) + LAM_INIT)));
          const int NU = NB * 8 * 8;
          const bool xl = (G % 64 == 0); const int xq = (int)blockIdx.x & 7, xj = (int)blockIdx.x >> 3;
          for (int i = 0;; ++i) {
            int u; if (xl) { const int p = (i * (G / 64) + (xj >> 3)) * 8 + xq; if (p >= NB * 8) break; u = p * 8 + (xj & 7); } else { u = (int)blockIdx.x + i * G; if (u >= NU) break; }
            const int qb = u & 7, h = (u >> 3) & 7, b = u >> 6;
            const int r0 = b * SEQ + qb * 256;
            fa::KVSrc S; S.k0 = QKVC + 1024 + (2 * h) * 64; S.kst0 = 3072; S.k1 = QKVC; S.kst1 = 3072; S.split8 = 8; S.v = QKVC + 2048 + h * 128; S.vst = 3072;
            S.xrow0 = ML + b * CTXL; S.lrow0 = b * SEQ;
            __syncthreads();
            fa::attn64_unit<1, 8>(QKVC + (size_t)r0 * 3072 + (2 * h) * 64, 3072, S, 36, (char*)lds_raw);
            S.k0 += 64;
            __syncthreads();
            fa::attn64_unit<2, 8>(QKVC + (size_t)r0 * 3072 + (2 * h + 1) * 64, 3072, S, 36, (char*)lds_raw);
            fa::diff_combine<fa::A2_STASH1>((const char*)lds_raw, CAT2 + (size_t)r0 * 1024 + h * 128, 1024, lam, diff_g_out, 1.0f - LAM_INIT);
          } }
        GRID_BAR(); PH_END(12);
    }
    if (IN(14)) {
        PH_BEGIN(14);
        const bool split = (G % 16 == 0);
        const int role = (int)(blockIdx.x >> 3) & 1, ridx = (int)((blockIdx.x >> 4) << 3) | (int)(blockIdx.x & 7);
        if (!split || role) {
            LAS float* scr = (LAS float*)(lds + wave * 8448); int off = 0;
            const int cgw = split ? ridx * 8 + wave : gw, cng = split ? NGW / 2 : NGW;
#pragma unroll 1
            for (int e = 0; e < NE; ++e) {
                cvt_matrix8(moe_w_gate + (size_t)e * 1024 * ED, 1024, ED, W_MGU + (size_t)e * 2 * ED * 1024, 1024, 64.0f, map8_gate, scr, lane, cgw, cng, off);
                cvt_matrix8(moe_w_up + (size_t)e * 1024 * ED, 1024, ED, W_MGU + (size_t)e * 2 * ED * 1024, 1024, 512.0f, map8_up, scr, lane, cgw, cng, off);
                cvt_matrix8(moe_w_down + (size_t)e * ED * 1024, ED, 1024, W_MD + (size_t)e * 1024 * ED, ED, 64.0f, map8_id, scr, lane, cgw, cng, off); }
            __syncthreads();
        }
        if (!split || !role) {
            pg8::Gemm g{CAT2, W_OC, 1024, 1024, 0, 0}; pg8::DenseOrder S; S.init(ML / 256, 4, split ? G / 2 : G, split ? ridx : (int)blockIdx.x); pg8::EpiStore E{Y2, 1024};
            pg8::gemm_phase<pg8::EpiStore, pg8::DenseOrder, PG8_ALIGN, PG8_SP2>(lds, g, S, E);
        }
        GRID_BAR(); PH_END(14);
    }
    if (IN(15)) {
        PH_BEGIN(15);
        LAS int* lcnt = (LAS int*)lds;
        LAS int* gbase = lcnt + 8;
        LAS int* le = gbase + 8;
        LAS int* lr = le + 256;
        LAS float* lg = (LAS float*)(lr + 256);
        f32x4 wra[4][4], wrb[4][4];
#pragma unroll
        for (int j = 0; j < 4; ++j)
#pragma unroll
            for (int q = 0; q < 4; ++q) { const int k = 4 * lane + 256 * j + q; wra[j][q] = *(const f32x4*)(moe_w_router + (size_t)k * 8); wrb[j][q] = *(const f32x4*)(moe_w_router + (size_t)k * 8 + 4); }
        for (int base = blockIdx.x * 128; base < ML; base += G * 128) {
            __syncthreads();
            if (tid < 8) lcnt[tid] = 0;
            __syncthreads();
            for (int i = 0; i < 16; ++i) {
                const int lrow = wave * 16 + i, row = base + lrow;
                u16* dst = XST + (size_t)row * 1024;
                const int mr = row >> 11;
                f32x4 xv[4], tv[4], hv[4]; ld_row_bf16(dst, lane, xv); ld_row_bf16(Y2 + (size_t)row * 1024, lane, tv);
                rms_apply(tv, g_post_mix + 1024, lane);
                const float* gate = modp(ws, 1, mr, 2);
#pragma unroll
                for (int j = 0; j < 4; ++j) xv[j] = xv[j] + *(const f32x4*)(gate + 4 * lane + 256 * j) * tv[j];
                st_row_bf16(dst, lane, xv);
                premod(xv, hv, g_pre_ffn + 1024, modp(ws, 1, mr, 3), modp(ws, 1, mr, 4), lane);
#pragma unroll
                for (int j = 0; j < 4; ++j) { unsigned t = 0u; t = __builtin_amdgcn_cvt_pk_fp8_f32(pg8::clamp8(hv[j].x), pg8::clamp8(hv[j].y), t, false); t = __builtin_amdgcn_cvt_pk_fp8_f32(pg8::clamp8(hv[j].z), pg8::clamp8(hv[j].w), t, true);
                    *(unsigned*)(HC8 + (size_t)row * 1024 + 4 * lane + 256 * j) = t; }
                f32x4 la = {0.f, 0.f, 0.f, 0.f}, lb = la;
#pragma unroll
                for (int j = 0; j < 4; ++j)
#pragma unroll
                    for (int q = 0; q < 4; ++q) { la += hv[j][q] * wra[j][q]; lb += hv[j][q] * wrb[j][q]; }
                const bool b5 = lane & 32, b4 = lane & 16, b3 = lane & 8;
                f32x4 k4 = b5 ? lb : la, s4 = b5 ? la : lb;
#pragma unroll
                for (int q = 0; q < 4; ++q) { auto rr = __builtin_amdgcn_permlane32_swap(__float_as_uint(s4[q]), __float_as_uint(s4[q]), false, false); k4[q] += __uint_as_float(b5 ? rr[0] : rr[1]); }
                float k2a = b4 ? k4[2] : k4[0], k2b = b4 ? k4[3] : k4[1]; const float s2a = b4 ? k4[0] : k4[2], s2b = b4 ? k4[1] : k4[3];
                { auto ra = __builtin_amdgcn_permlane16_swap(__float_as_uint(s2a), __float_as_uint(s2a), false, false); k2a += __uint_as_float(b4 ? ra[0] : ra[1]);
                  auto rb = __builtin_amdgcn_permlane16_swap(__float_as_uint(s2b), __float_as_uint(s2b), false, false); k2b += __uint_as_float(b4 ? rb[0] : rb[1]); }
                float k1 = b3 ? k2b : k2a; const float s1v = b3 ? k2a : k2b;
                k1 += dpp_mov<0x128>(s1v);
                k1 += dpp_mov<0xB1>(k1); k1 += dpp_mov<0x4E>(k1); k1 += dpp_mov<0x141>(k1);
                float lg8[8];
#pragma unroll
                for (int e = 0; e < 8; ++e) lg8[e] = __int_as_float(__builtin_amdgcn_readlane(__float_as_int(k1), (e & 1) * 8 + ((e >> 1) & 1) * 16 + (e >> 2) * 32));
                if (lane == 0) {
                    int e0 = 0; float v0 = lg8[0];
#pragma unroll
                    for (int e = 1; e < 8; ++e) if (lg8[e] > v0) { v0 = lg8[e]; e0 = e; }
                    int e1 = -1; float v1 = -3.0e38f;
#pragma unroll
                    for (int e = 0; e < 8; ++e) if (e != e0 && lg8[e] > v1) { v1 = lg8[e]; e1 = e; }
                    const float g0 = 1.0f / (1.0f + expf(v1 - v0));
                    le[lrow * 2] = e0; le[lrow * 2 + 1] = e1; lg[lrow * 2] = g0; lg[lrow * 2 + 1] = 1.0f - g0;
                    lr[lrow * 2] = __hip_atomic_fetch_add(&lcnt[e0], 1, __ATOMIC_RELAXED, __HIP_MEMORY_SCOPE_WORKGROUP); lr[lrow * 2 + 1] = __hip_atomic_fetch_add(&lcnt[e1], 1, __ATOMIC_RELAXED, __HIP_MEMORY_SCOPE_WORKGROUP);
                }
            }
            __syncthreads();
            if (tid < 8) gbase[tid] = (int)atomicAdd(ctl + CW_ECNT + 64 * tid, (unsigned)lcnt[tid]);
            __syncthreads();
            if (tid < 256) { const int e = le[tid]; TOKE[(size_t)base * 2 + tid] = e; TOKG[(size_t)base * 2 + tid] = lg[tid]; TOKP[(size_t)base * 2 + tid] = gbase[e] + lr[tid]; }
        }
        GRID_BAR(); PH_END(15);
    }
    if (IN(16)) {
        PH_BEGIN(16);
        LAS int* pst = (LAS int*)lds;
        if (tid == 0) { int acc = 0; for (int e = 0; e < 8; ++e) { pst[e] = acc; const int c = (int)ctl[CW_ECNT + 64 * e]; acc += (c + 255) / 256 * 256; } pst[8] = acc; }
        __syncthreads();
        if (blockIdx.x == 0) {
            if (tid == 0) ctl[CW_MOET] = (unsigned)(pst[8] / 256);
            for (int t = tid; t < pst[8] / 256; t += 512) { int e = 0; for (int q = 1; q < 8; ++q) if (t * 256 >= pst[q]) e = q; ctl[CW_TILEE + t] = (unsigned)e; }
        }
        for (int s = gw; s < 2 * ML; s += NGW) {
            const int e = TOKE[s], pos = pst[e] + TOKP[s];
            *(uint4*)(XS8 + (size_t)pos * 1024 + lane * 16) = *(const uint4*)(HC8 + (size_t)(s >> 1) * 1024 + lane * 16);
            if (lane == 0) TOKP[s] = pos;
        }
        GRID_BAR(); PH_END(16);
    }
    if (IN(17)) {
        PH_BEGIN(17);
        const int T = (int)ctl[CW_MOET];
        { pg8::Gemm g{XS8, W_MGU, 1024, 1024, 0x7f7f7f7f, 0x79797979}; pg8::MoeOrder S; S.init(T, 2 * ED / 256, G, (int)blockIdx.x); S.tile_e = ctl + CW_TILEE; S.nper = 2 * ED / 256; S.a_off = 0; S.o_off = 0;
          pg8::EpiSwiglu8 E{HID8, ED};
          pg8::gemm_phase<pg8::EpiSwiglu8, pg8::MoeOrder, PG8_ALIGN, PG8_SP2, 1>(lds, g, S, E); }
        GRID_BAR(); PH_END(17);
    }
    if (IN(18)) {
        PH_BEGIN(18);
        const int T = (int)ctl[CW_MOET];
        { pg8::Gemm g{HID8, W_MD, ED, ED, 0x7c7c7c7c, 0x79797979}; pg8::MoeOrder S; S.init(T, 4, G, (int)blockIdx.x); S.tile_e = ctl + CW_TILEE; S.nper = 4; S.a_off = 0; S.o_off = 0;
          pg8::EpiStore8 E{YS8, 1024, 16.0f};
          pg8::gemm_phase<pg8::EpiStore8, pg8::MoeOrder, PG8_ALIGN, PG8_SP2, 1>(lds, g, S, E); }
        GRID_BAR(); PH_END(18);
    }
    if (IN(19)) {
        PH_BEGIN(19);
        { const int rpw = (ML + NGW - 1) / NGW, rb = gw * rpw, re = (rb + rpw < ML) ? rb + rpw : ML;
          f32x4 gpo[4], gt[4]; ld_vec(g_post_ffn + 1024, lane, gpo); int cur = -1;
          for (int row = rb; row < re; ++row) {
            const int mr = row >> 11;
            if (mr != cur) { ld_vec(modp(ws, 1, mr, 5), lane, gt); cur = mr; }
            const int p0 = TOKP[row * 2], p1 = TOKP[row * 2 + 1]; const float g0 = TOKG[row * 2], g1 = TOKG[row * 2 + 1];
            f32x4 xv[4], a[4], b2[4]; ld_row_bf16(XST + (size_t)row * 1024, lane, xv); ld_row_fp8(YS8 + (size_t)p0 * 1024, lane, a); ld_row_fp8(YS8 + (size_t)p1 * 1024, lane, b2);
#pragma unroll
            for (int j = 0; j < 4; ++j) a[j] = a[j] * g0 + b2[j] * g1;
            const float r = row_rstd(a);
#pragma unroll
            for (int j = 0; j < 4; ++j) xv[j] = xv[j] + gt[j] * (a[j] * r * gpo[j]);
            st_row_f32(out + (size_t)row * 1024, lane, xv);
          } }
        PH_END(19);
    }
#undef IN
#undef GRID_BAR
}

extern "C" void kernel_launch(void* const* d_in, const int* in_sizes, int n_in, void* d_out, int out_size, void* d_ws, size_t ws_size, hipStream_t stream) {
    static int grid = 0;
    if (grid == 0) {
        if (n_in != 35 || in_sizes[0] != ML * D || out_size != ML * D || ws_size < WS_END) {
            fprintf(stderr, "kernel_launch: shape mismatch n_in %d in0 %d out %d ws %zu (need %zu)\n", n_in, n_in > 0 ? in_sizes[0] : -1, out_size, ws_size, (size_t)WS_END); grid = -1; return; }
        int dev = 0, cus = 0, per_cu = 0;
        if (hipGetDevice(&dev) != hipSuccess || hipDeviceGetAttribute(&cus, hipDeviceAttributeMultiprocessorCount, dev) != hipSuccess) { grid = -1; return; }
        if (hipFuncSetAttribute((const void*)fwd_kernel, hipFuncAttributeMaxDynamicSharedMemorySize, LDS_BYTES) != hipSuccess) { fprintf(stderr, "kernel_launch: hipFuncSetAttribute failed\n"); grid = -1; return; }
        if (hipOccupancyMaxActiveBlocksPerMultiprocessor(&per_cu, (const void*)fwd_kernel, 512, LDS_BYTES) != hipSuccess || per_cu < 1)
            fprintf(stderr, "kernel_launch: occupancy query reports %d\n", per_cu);
        (void)hipGetLastError();
        grid = cus;
    }
    if (grid < 0) return;
    if (hipMemsetAsync((char*)d_ws + WS_CTL, 0, CTL_ZERO_BYTES, stream) != hipSuccess) return;
    Args a{};
    for (int i = 0; i < 35; ++i) a.in[i] = (const float*)d_in[i];
    a.out = (float*)d_out; a.ws = (unsigned char*)d_ws; a.ph_lo = 0; a.ph_hi = 100; a.li = 0; a.pad = 0;
    hipLaunchKernelGGL(fwd_kernel, dim3(grid), dim3(512), LDS_BYTES, stream, a);
#ifdef PROBE_PHASES
    { const int pp[] = {PROBE_PHASES}; int li = 1;
      for (int k : pp) { a.ph_lo = k; a.ph_hi = k + 1; a.li = li++; hipLaunchKernelGGL(fwd_kernel, dim3(grid), dim3(512), LDS_BYTES, stream, a); } }
#endif
}
```

```cpp
#include <hip/hip_runtime.h>
#include <cstdio>
#include <cstdint>

constexpr int D = 1024, NB = 16, SEQ = 2048, CTXL = 256;
constexpr int ML = NB * SEQ, MX = NB * CTXL, M = ML + MX;
constexpr int IN_A = 2016, IN_AP = 2048;
constexpr int C_CQ = 0, C_CKV = 256, C_KR = 384, C_GQ = 448, C_GK = 704, C_GV = 960, C_GR = 1472, C_AF = 1984, C_AB = 2000;
constexpr int UPN = 1792;
constexpr int FFN = 2816, NE = 8, ED = 3584;
constexpr int CAP = 2 * ML + NE * 256, MAXT = CAP / 256;
constexpr float EPS = 1e-6f;
constexpr float LAM_INIT = 0.35550906759f;

constexpr size_t MiB = 1u << 20;
constexpr size_t WS_CTL = 0, CTL_ZERO_BYTES = 512 * 1024;
constexpr size_t WS_MOD = 1 * MiB;
constexpr size_t WS_ROPE = 2 * MiB;
constexpr size_t WS_TOKE = 2 * MiB + 512 * 1024;
constexpr size_t WS_TOKG = WS_TOKE + 256 * 1024;
constexpr size_t WS_TOKP = WS_TOKG + 256 * 1024;
constexpr size_t WS_CTXS = 4 * MiB;
constexpr size_t WS_W = 20 * MiB;
constexpr size_t WS_R0 = 52 * MiB;
constexpr size_t WS_PARTS = 124 * MiB;
constexpr size_t WS_Y = 124 * MiB;
constexpr size_t WS_H1 = 196 * MiB;
constexpr size_t WS_HC = 116 * MiB;
constexpr size_t WS_A2 = 268 * MiB;
constexpr size_t WS_KROPE = 295 * MiB;
constexpr size_t WS_R3 = 300 * MiB;
constexpr size_t WS_QKVUP = 372 * MiB;
constexpr size_t WS_WMD = 332 * MiB;
constexpr size_t WS_WMGU = 360 * MiB;
constexpr size_t WS_XS8 = 416 * MiB;
constexpr size_t WS_YS = 360 * MiB;
constexpr size_t WS_XST = 516 * MiB;
constexpr size_t WS_END = 580 * MiB;
constexpr int CW_BAR = 16384;
constexpr int CW_ECNT = 8192;
constexpr int CW_ATQ = 8960;
constexpr int CW_SUB = 12288;
constexpr int CW_MOET = 9000;
constexpr int CW_TILEE = 9216;

typedef unsigned short u16;
typedef float f32x4 __attribute__((ext_vector_type(4)));
#define LAS __attribute__((address_space(3)))
constexpr int LDS_BYTES = 150528;
constexpr int MISC_BASE = 149504;
constexpr int MISC_OFF = MISC_BASE + 320;

#define XB_TMO      128
#define XB_XCNT(j)  (256  + 64 * (j))
#define XB_XSUB(j)  (1280 + 64 * (j))
#define XB_XGEN(j)  (2304 + 64 * (j))
#define XB_TOP      3328
#define XB_TOPGEN   3392
#define XCD_BAR_WORDS 3456
#define XB_SPIN_CAP (1u << 23)
__device__ __forceinline__ unsigned xb_ld(unsigned* p)              { return __hip_atomic_load(p, __ATOMIC_RELAXED, __HIP_MEMORY_SCOPE_AGENT); }
__device__ __forceinline__ unsigned xb_add(unsigned* p, unsigned v) { return __hip_atomic_fetch_add(p, v, __ATOMIC_RELAXED, __HIP_MEMORY_SCOPE_AGENT); }
__device__ __forceinline__ unsigned xb_xcc_id() { return (unsigned)__builtin_amdgcn_s_getreg((3 << 11) | 20) & 0xFu; }
#define XB_SPIN(cond, bar) do { unsigned _sp = 0; while (cond) { __builtin_amdgcn_s_sleep(1); \
    if ((++_sp & 255u) == 0u) { if (xb_ld(&(bar)[XB_TMO])) break; if (_sp > XB_SPIN_CAP) { atomicAdd(&(bar)[XB_TMO], 1u); break; } } } } while (0)
struct XcdBarrier { unsigned* bar; unsigned x; volatile LAS unsigned* st; };
__device__ __forceinline__ XcdBarrier xcd_barrier_post(unsigned* bar, volatile LAS unsigned* st) {
    XcdBarrier b; b.bar = bar; b.x = xb_xcc_id(); b.st = st;
    if (threadIdx.x == 0) (void)xb_add(&bar[XB_XCNT(b.x)], 1u);
    return b;
}
__device__ __forceinline__ void xcd_barrier_complete(unsigned* bar, unsigned x, unsigned& nloc, unsigned& nx) {
    const unsigned G = gridDim.x * gridDim.y * gridDim.z;
    unsigned sum, cnt, mine, sp = 0u;
    for (;;) {
        sum = 0u; cnt = 0u; mine = 0u;
#pragma unroll
        for (unsigned j = 0; j < 16; ++j) { const unsigned c = xb_ld(&bar[XB_XCNT(j)]); sum += c; cnt += (c > 0u) ? 1u : 0u; mine = (j == x) ? c : mine; }
        if (sum == G) break;
        __builtin_amdgcn_s_sleep(1);
        if ((++sp & 255u) == 0u) { if (xb_ld(&bar[XB_TMO])) break; if (sp > XB_SPIN_CAP) { atomicAdd(&bar[XB_TMO], 1u); break; } }
    }
    nloc = mine > 0u ? mine : 1u; nx = cnt > 0u ? cnt : 1u;
}
__device__ __forceinline__ void xcd_barrier(const XcdBarrier& b) {
    asm volatile("s_waitcnt vmcnt(0)" ::: "memory");
    __syncthreads();
    if (threadIdx.x == 0) {
        unsigned* bar = b.bar;
        __builtin_amdgcn_s_waitcnt(0);
        unsigned nloc = b.st[0], nx = b.st[1];
        if (nloc == 0u) { xcd_barrier_complete(bar, b.x, nloc, nx); b.st[0] = nloc; b.st[1] = nx; }
        const unsigned old = xb_add(&bar[XB_XSUB(b.x)], 1u);
        const unsigned gen = old / nloc;
        if (old + 1u == (gen + 1u) * nloc) {
            __builtin_amdgcn_fence(__ATOMIC_RELEASE, "agent");
            asm volatile("s_waitcnt vmcnt(0)" ::: "memory");
            const unsigned og = xb_add(&bar[XB_TOP], 1u);
            const unsigned tg = og / nx;
            if (og + 1u == (tg + 1u) * nx) xb_add(&bar[XB_TOPGEN], 1u);
            else XB_SPIN(xb_ld(&bar[XB_TOPGEN]) == tg, bar);
            __builtin_amdgcn_fence(__ATOMIC_ACQUIRE, "agent");
            xb_add(&bar[XB_XGEN(b.x)], 1u);
            asm volatile("s_waitcnt vmcnt(0)" ::: "memory");
        } else {
            XB_SPIN(xb_ld(&bar[XB_XGEN(b.x)]) == gen, bar);
            __builtin_amdgcn_fence(__ATOMIC_ACQUIRE, "agent");
            asm volatile("s_waitcnt vmcnt(0)" ::: "memory");
        }
    }
    __syncthreads();
}

__device__ __forceinline__ void sub_arrive(unsigned* ctr) {
    asm volatile("s_waitcnt vmcnt(0)" ::: "memory");
    __syncthreads();
    if (threadIdx.x == 0) { __builtin_amdgcn_fence(__ATOMIC_RELEASE, "agent"); asm volatile("s_waitcnt vmcnt(0)" ::: "memory"); (void)xb_add(ctr, 1u); }
}
__device__ __forceinline__ void sub_wait(unsigned* ctr, unsigned n) {
    if (threadIdx.x == 0) { unsigned sp = 0u; while (xb_ld(ctr) < n) { __builtin_amdgcn_s_sleep(2); if (++sp > XB_SPIN_CAP) break; }
        __builtin_amdgcn_fence(__ATOMIC_ACQUIRE, "agent"); asm volatile("s_waitcnt vmcnt(0)" ::: "memory"); }
    __syncthreads();
}

__device__ __forceinline__ float bf2f(unsigned h) { return __uint_as_float(h << 16); }
__device__ __forceinline__ unsigned f2bf(float f) { unsigned u = __float_as_uint(f); return (u + 0x7fffu + ((u >> 16) & 1u)) >> 16; }
template <int CTRL> __device__ __forceinline__ float dpp_mov(float v) { return __builtin_bit_cast(float, __builtin_amdgcn_update_dpp(0, __builtin_bit_cast(int, v), CTRL, 0xF, 0xF, true)); }
__device__ __forceinline__ float row16_sum(float v) {
    v += dpp_mov<0xB1>(v);
    v += dpp_mov<0x4E>(v);
    v += dpp_mov<0x141>(v);
    v += dpp_mov<0x140>(v);
    return v;
}
__device__ __forceinline__ float wave_sum(float v) {
    v = row16_sum(v);
    const float r0 = __int_as_float(__builtin_amdgcn_readlane(__float_as_int(v), 0)), r1 = __int_as_float(__builtin_amdgcn_readlane(__float_as_int(v), 16));
    const float r2 = __int_as_float(__builtin_amdgcn_readlane(__float_as_int(v), 32)), r3 = __int_as_float(__builtin_amdgcn_readlane(__float_as_int(v), 48));
    return (r0 + r1) + (r2 + r3);
}
__device__ __forceinline__ float silu_f(float x) { return x / (1.0f + __expf(-x)); }
__device__ __forceinline__ void ld_row_f32(const float* p, int lane, f32x4 (&v)[4]) {
#pragma unroll
    for (int j = 0; j < 4; ++j) v[j] = *(const f32x4*)(p + 4 * lane + 256 * j);
}
__device__ __forceinline__ void ld_row_bf16(const u16* p, int lane, f32x4 (&v)[4]) {
#pragma unroll
    for (int j = 0; j < 4; ++j) { const uint2 w = *(const uint2*)(p + 4 * lane + 256 * j);
        v[j] = (f32x4){bf2f(w.x & 0xffffu), bf2f(w.x >> 16), bf2f(w.y & 0xffffu), bf2f(w.y >> 16)}; }
}
typedef float f32x2h __attribute__((ext_vector_type(2)));
__device__ __forceinline__ void ld_row_fp8(const unsigned char* p, int lane, f32x4 (&v)[4]) {
#pragma unroll
    for (int j = 0; j < 4; ++j) { const int w = *(const int*)(p + 4 * lane + 256 * j);
        const f32x2h lo = __builtin_amdgcn_cvt_pk_f32_fp8(w, false), hi = __builtin_amdgcn_cvt_pk_f32_fp8(w, true);
        v[j] = (f32x4){lo.x, lo.y, hi.x, hi.y}; }
}
__device__ __forceinline__ void st_row_f32(float* p, int lane, const f32x4 (&v)[4]) {
#pragma unroll
    for (int j = 0; j < 4; ++j) *(f32x4*)(p + 4 * lane + 256 * j) = v[j];
}
__device__ __forceinline__ void st_row_bf16(u16* p, int lane, const f32x4 (&v)[4]) {
#pragma unroll
    for (int j = 0; j < 4; ++j) { uint2 w; w.x = f2bf(v[j].x) | (f2bf(v[j].y) << 16); w.y = f2bf(v[j].z) | (f2bf(v[j].w) << 16);
        *(uint2*)(p + 4 * lane + 256 * j) = w; }
}
__device__ __forceinline__ float row_rstd(const f32x4 (&v)[4]) {
    float s = 0.f;
#pragma unroll
    for (int j = 0; j < 4; ++j) s += (v[j].x * v[j].x + v[j].y * v[j].y) + (v[j].z * v[j].z + v[j].w * v[j].w);
    s = wave_sum(s);
    return 1.0f / sqrtf(s * (1.0f / 1024.0f) + EPS);
}
__device__ __forceinline__ void rms_apply(f32x4 (&v)[4], const float* g, int lane) {
    const float r = row_rstd(v);
#pragma unroll
    for (int j = 0; j < 4; ++j) { const f32x4 gg = *(const f32x4*)(g + 4 * lane + 256 * j); v[j] = v[j] * r * gg; }
}
__device__ __forceinline__ void ld_vec(const float* p, int lane, f32x4 (&v)[4]) {
#pragma unroll
    for (int j = 0; j < 4; ++j) v[j] = *(const f32x4*)(p + 4 * lane + 256 * j);
}
__device__ __forceinline__ void premod(const f32x4 (&x)[4], f32x4 (&h)[4], const float* g, const float* shift, const float* scale, int lane) {
    const float r = row_rstd(x);
#pragma unroll
    for (int j = 0; j < 4; ++j) { const int c = 4 * lane + 256 * j; const f32x4 gg = *(const f32x4*)(g + c), sh = *(const f32x4*)(shift + c), sc = *(const f32x4*)(scale + c);
        h[j] = x[j] * r * gg * (1.0f + sc) + sh; }
}

struct Args { const float* in[35]; float* out; unsigned char* ws; int ph_lo, ph_hi, li, pad; };

__device__ __forceinline__ const float* modp(const unsigned char* ws, int l, int r, int which) { return (const float*)(ws + WS_MOD) + ((size_t)(l * 17 + r) * 6 + which) * 1024; }

#ifndef PG8_SP2
#define PG8_SP2 true
#endif
#ifndef PG8_ALIGN
#define PG8_ALIGN true
#endif
namespace pg8 {
typedef short bf16x8 __attribute__((ext_vector_type(8)));
typedef unsigned u32x4 __attribute__((ext_vector_type(4)));
typedef int v8i __attribute__((ext_vector_type(8)));
typedef int v4i __attribute__((ext_vector_type(4)));
typedef unsigned u32x2 __attribute__((ext_vector_type(2)));
constexpr int BM = 256, BK = 64, HALF = 128, HTB = HALF * BK * 2, STAGE_BYTES = 8 * HTB, NXCD = 8, WGM = 8;
__host__ __device__ __forceinline__ int lds_byte(int r, int c) { const int st = (r >> 4) * 2 + (c >> 5), rr = r & 15, cc = c & 31, ob = rr * 64 + cc * 2; return st * 1024 + (ob ^ (((ob >> 9) & 1) << 5)); }
__host__ __device__ __forceinline__ void stage_rc(int b, int& R, int& C) { const int st = b / 1024, sb = b % 1024, swz = sb ^ (((sb >> 9) & 1) << 5); R = (st >> 1) * 16 + swz / 64; C = (st & 1) * 32 + (swz % 64) / 2; }
__host__ __device__ __forceinline__ int perm32(int rho) { const int n = rho >> 4, i = rho & 15; return 8 * (i >> 2) + 4 * n + (i & 3); }

struct Unit { int pm, pn, po, pc; };
struct Gemm { const void* A; const void* Bt; int lda; int K; int sa, sb; };

struct DenseOrder {
    int nM, nN, nwg, G, c;
    __device__ __forceinline__ void init(int nM_, int nN_, int G_, int c_) { nM = nM_; nN = nN_; nwg = nM * nN; G = G_; c = c_; }
    __device__ __forceinline__ bool next2(int i, int& pm, int& pn) const {
        const long L = (long)i * G + c; if (L >= nwg) return false;
        int wgid = (int)L; { const int q = nwg / NXCD, r = nwg % NXCD, xcd = wgid % NXCD, off = wgid / NXCD; wgid = (xcd < r ? xcd * (q + 1) : r * (q + 1) + (xcd - r) * q) + off; }
        const int nig = WGM * nN, gid = wgid / nig, fm = gid * WGM, gsz = (nM - fm) < WGM ? (nM - fm) : WGM;
        pm = fm + ((wgid % nig) % gsz); pn = (wgid % nig) / gsz; return true;
    }
    __device__ __forceinline__ bool next(int i, Unit& u) const { int pm, pn; if (!next2(i, pm, pn)) return false; u.pm = pm; u.pn = pn; u.po = pm; u.pc = pn; return true; }
    __device__ __forceinline__ void a_ready(const Unit&) const {}
    __device__ __forceinline__ void done(const Unit&) const {}
};
struct MoeOrder : DenseOrder {
    const unsigned* tile_e; int nper, a_off, o_off;
    __device__ __forceinline__ bool next(int i, Unit& u) const { int pm, pn; if (!next2(i, pm, pn)) return false;
        const int e = (int)tile_e[pm]; u.pm = a_off + pm; u.pn = e * nper + pn; u.po = o_off + pm; u.pc = pn; return true; }
};

__device__ __forceinline__ unsigned cvt_pk_bf16(float lo, float hi) { unsigned r; asm volatile("v_cvt_pk_bf16_f32 %0, %1, %2" : "=v"(r) : "v"(lo), "v"(hi)); return r; }

struct EpiStore {
    static constexpr bool PERM = true, AFTER_DRAIN = false;
    u16* O; int ldc;
    __device__ __forceinline__ void operator()(const f32x4 (&acc)[2][2][4][2], const Unit& u, int wr, int wc, int fr, int fq) const {
        const int row0 = u.po * BM + wr * 64 + fr, col0 = u.pc * BM + wc * 32 + 8 * fq;
#pragma unroll
        for (int ai = 0; ai < 2; ++ai)
#pragma unroll
            for (int m = 0; m < 4; ++m) { u16* rowp = O + (size_t)(row0 + ai * HALF + m * 16) * ldc + col0;
#pragma unroll
                for (int bj = 0; bj < 2; ++bj) { const f32x4 v0 = acc[ai][bj][m][0], v1 = acc[ai][bj][m][1];
                    u32x4 w; w.x = cvt_pk_bf16(v0[0], v0[1]); w.y = cvt_pk_bf16(v0[2], v0[3]); w.z = cvt_pk_bf16(v1[0], v1[1]); w.w = cvt_pk_bf16(v1[2], v1[3]);
                    *(u32x4*)(rowp + bj * HALF) = w; } }
    }
};
template <int MODE> struct EpiStoreRope {
    static constexpr bool PERM = true, AFTER_DRAIN = false; static constexpr float QSC = (MODE == 0 ? 0.125f : 0.07216878364870322f) * 1.4426950408889634f;
    u16* O; int ldc; const float* rc; const float* rs;
    __device__ __forceinline__ void operator()(const f32x4 (&acc)[2][2][4][2], const Unit& u, int wr, int wc, int fr, int fq) const {
        const int row0 = u.po * BM + wr * 64 + fr, col0 = u.pc * BM + wc * 32 + 8 * fq;
        const bool lat = u.po * BM < ML;
#pragma unroll
        for (int ai = 0; ai < 2; ++ai)
#pragma unroll
            for (int m = 0; m < 4; ++m) { const int row = row0 + ai * HALF + m * 16; u16* rowp = O + (size_t)row * ldc + col0; const int t = row & (SEQ - 1);
#pragma unroll
                for (int bj = 0; bj < 2; ++bj) { f32x4 v0 = acc[ai][bj][m][0], v1 = acc[ai][bj][m][1];
                    const int c8 = col0 + bj * HALF;
                    const bool rope = lat && (MODE == 0 ? (c8 < 2048) : (c8 < 768 && (c8 % 192) >= 128));
                    if (rope) { const int i0 = (c8 & 63) >> 1; const f32x4 cs = *(const f32x4*)(rc + t * 32 + i0), sn = *(const f32x4*)(rs + t * 32 + i0);
                        const f32x4 a = v0, b = v1;
                        v0[0] = a[0] * cs[0] - a[1] * sn[0]; v0[1] = a[1] * cs[0] + a[0] * sn[0]; v0[2] = a[2] * cs[1] - a[3] * sn[1]; v0[3] = a[3] * cs[1] + a[2] * sn[1];
                        v1[0] = b[0] * cs[2] - b[1] * sn[2]; v1[1] = b[1] * cs[2] + b[0] * sn[2]; v1[2] = b[2] * cs[3] - b[3] * sn[3]; v1[3] = b[3] * cs[3] + b[2] * sn[3]; }
                    if (MODE == 0 ? (c8 < 1024) : (c8 < 768)) { v0 = v0 * QSC; v1 = v1 * QSC; }
                    u32x4 w; w.x = cvt_pk_bf16(v0[0], v0[1]); w.y = cvt_pk_bf16(v0[2], v0[3]); w.z = cvt_pk_bf16(v1[0], v1[1]); w.w = cvt_pk_bf16(v1[2], v1[3]);
                    *(u32x4*)(rowp + bj * HALF) = w; } }
    }
};
struct EpiSwiglu {
    static constexpr bool PERM = true, AFTER_DRAIN = false;
    u16* O; int ldc;
    __device__ __forceinline__ void operator()(const f32x4 (&acc)[2][2][4][2], const Unit& u, int wr, int wc, int fr, int fq) const {
        const int row0 = u.po * BM + wr * 64 + fr, col0 = u.pc * HALF + wc * 32 + 8 * fq;
#pragma unroll
        for (int ai = 0; ai < 2; ++ai)
#pragma unroll
            for (int m = 0; m < 4; ++m) { u16* rowp = O + (size_t)(row0 + ai * HALF + m * 16) * ldc + col0;
                float hv[8];
#pragma unroll
                for (int n = 0; n < 2; ++n)
#pragma unroll
                    for (int q = 0; q < 4; ++q) { const float g = acc[ai][0][m][n][q], up = acc[ai][1][m][n][q]; hv[n * 4 + q] = g * __builtin_amdgcn_rcpf(1.0f + __expf(-g)) * up; }
                u32x4 w; w.x = cvt_pk_bf16(hv[0], hv[1]); w.y = cvt_pk_bf16(hv[2], hv[3]); w.z = cvt_pk_bf16(hv[4], hv[5]); w.w = cvt_pk_bf16(hv[6], hv[7]);
                *(u32x4*)rowp = w; }
    }
};

__device__ __forceinline__ float clamp8(float x) { return __builtin_amdgcn_fmed3f(x, -448.0f, 448.0f); }
__device__ __forceinline__ unsigned cvt_pk4_fp8(float a, float b, float c, float d) { unsigned r;
    asm volatile("v_cvt_pk_fp8_f32 %0, %1, %2\n\tv_cvt_pk_fp8_f32 %0, %3, %4 op_sel:[0,0,1]" : "=&v"(r) : "v"(a), "v"(b), "v"(c), "v"(d)); return r; }
struct EpiStore8 {
    static constexpr bool PERM = true, AFTER_DRAIN = false;
    unsigned char* O; int ldc; float osc;
    __device__ __forceinline__ void operator()(const f32x4 (&acc)[2][2][4][2], const Unit& u, int wr, int wc, int fr, int fq) const {
        const int row0 = u.po * BM + wr * 64 + fr, col0 = u.pc * BM + wc * 32 + 8 * fq;
#pragma unroll
        for (int ai = 0; ai < 2; ++ai)
#pragma unroll
            for (int m = 0; m < 4; ++m) { unsigned char* rowp = O + (size_t)(row0 + ai * HALF + m * 16) * ldc + col0;
#pragma unroll
                for (int bj = 0; bj < 2; ++bj) { const f32x4 v0 = acc[ai][bj][m][0] * osc, v1 = acc[ai][bj][m][1] * osc;
                    u32x2 w; w.x = cvt_pk4_fp8(clamp8(v0[0]), clamp8(v0[1]), clamp8(v0[2]), clamp8(v0[3])); w.y = cvt_pk4_fp8(clamp8(v1[0]), clamp8(v1[1]), clamp8(v1[2]), clamp8(v1[3]));
                    *(u32x2*)(rowp + bj * HALF) = w; } }
    }
};
struct EpiSwiglu8 {
    static constexpr bool PERM = true, AFTER_DRAIN = false;
    unsigned char* O; int ldc;
    __device__ __forceinline__ void operator()(const f32x4 (&acc)[2][2][4][2], const Unit& u, int wr, int wc, int fr, int fq) const {
        const int row0 = u.po * BM + wr * 64 + fr, col0 = u.pc * HALF + wc * 32 + 8 * fq;
#pragma unroll
        for (int ai = 0; ai < 2; ++ai)
#pragma unroll
            for (int m = 0; m < 4; ++m) { unsigned char* rowp = O + (size_t)(row0 + ai * HALF + m * 16) * ldc + col0;
                float hv[8];
#pragma unroll
                for (int n = 0; n < 2; ++n)
#pragma unroll
                    for (int q = 0; q < 4; ++q) { const float gt = acc[ai][0][m][n][q], up = acc[ai][1][m][n][q];
                        hv[n * 4 + q] = clamp8((gt * up) * __builtin_amdgcn_rcpf(1.0f + __builtin_amdgcn_exp2f(gt * -1.4426950408889634f))); }
                u32x2 w; w.x = cvt_pk4_fp8(hv[0], hv[1], hv[2], hv[3]); w.y = cvt_pk4_fp8(hv[4], hv[5], hv[6], hv[7]); *(u32x2*)rowp = w; }
    }
};
template <class Epi, class Sched, bool ALIGN_EPI = false, bool SP2 = false, int EB = 2>
__device__ __forceinline__ void gemm_phase(LAS unsigned char* lds, const Gemm g, const Sched& S, const Epi& E) {
    const int tid = threadIdx.x, wid = __builtin_amdgcn_readfirstlane(tid >> 6), lane = tid & 63, wr = wid >> 2, wc = wid & 3, fr = lane & 15, fq = lane >> 4;
    const int K = g.K, nt = K * EB / (BK * 2), lda = g.lda;
    const auto rsA = __builtin_amdgcn_make_buffer_rsrc((void*)g.A, 0, 0x7fffffff, 0x00020000);
    const auto rsB = __builtin_amdgcn_make_buffer_rsrc((void*)g.Bt, 0, 0x7fffffff, 0x00020000);
    unsigned voffA, voffB;
    { int R, C; stage_rc(tid * 16, R, C); const int Rb = Epi::PERM ? ((R & ~31) + perm32(R & 31)) : R;
      voffA = (unsigned)(R * lda * EB + C * 2); voffB = (unsigned)(Rb * K * EB + C * 2); }
    const unsigned kstep = (unsigned)(BK * 2);
    const unsigned hA = (unsigned)(HALF * lda * EB), hB = (unsigned)(HALF * K * EB);
    const unsigned qA = hA >> 1, qB = hB >> 1;
    const unsigned tA = 2 * hA, tB = 2 * hB;
    const unsigned ldsw = (unsigned)wid * 1024u;
    const int aoff = lds_byte(wr * 64 + fr, fq * 8), boff = lds_byte(wc * 32 + fr, fq * 8);
#define PG8_SA(b, h) (((b) * 2 + (h)) * HTB)
#define PG8_SB(b, h) ((4 + (b) * 2 + (h)) * HTB)
#define PG8_STAGE_A(bufoff, soff) do { __builtin_amdgcn_raw_ptr_buffer_load_lds(rsA, (LAS unsigned*)(lds + (bufoff) + ldsw), 16, voffA, (soff), 0, 0); \
        __builtin_amdgcn_raw_ptr_buffer_load_lds(rsA, (LAS unsigned*)(lds + (bufoff) + ldsw + 8192), 16, voffA, (soff) + qA, 0, 0); } while (0)
#define PG8_STAGE_B(bufoff, soff) do { __builtin_amdgcn_raw_ptr_buffer_load_lds(rsB, (LAS unsigned*)(lds + (bufoff) + ldsw), 16, voffB, (soff), 0, 0); \
        __builtin_amdgcn_raw_ptr_buffer_load_lds(rsB, (LAS unsigned*)(lds + (bufoff) + ldsw + 8192), 16, voffB, (soff) + qB, 0, 0); } while (0)
#define PG8_LDA(dst, b, h) do { if constexpr (EB == 2) { _Pragma("unroll") for (int m = 0; m < 4; ++m) _Pragma("unroll") for (int k = 0; k < 2; ++k) dst[m][k] = *(const LAS bf16x8*)(lds + PG8_SA(b, h) + aoff + m * 2048 + k * 1024); } \
        else { _Pragma("unroll") for (int m = 0; m < 4; ++m) dst##8[m] = __builtin_shufflevector(*(const LAS v4i*)(lds + PG8_SA(b, h) + aoff + m * 2048), *(const LAS v4i*)(lds + PG8_SA(b, h) + aoff + m * 2048 + 1024), 0, 1, 2, 3, 4, 5, 6, 7); } } while (0)
#define PG8_LDB(dst, b, h) do { if constexpr (EB == 2) { _Pragma("unroll") for (int n = 0; n < 2; ++n) _Pragma("unroll") for (int k = 0; k < 2; ++k) dst[n][k] = *(const LAS bf16x8*)(lds + PG8_SB(b, h) + boff + n * 2048 + k * 1024); } \
        else { _Pragma("unroll") for (int n = 0; n < 2; ++n) dst##8[n] = __builtin_shufflevector(*(const LAS v4i*)(lds + PG8_SB(b, h) + boff + n * 2048), *(const LAS v4i*)(lds + PG8_SB(b, h) + boff + n * 2048 + 1024), 0, 1, 2, 3, 4, 5, 6, 7); } } while (0)
#define PG8_MMA(ai, bj, At, Bt) do { __builtin_amdgcn_s_setprio(1); _Pragma("unroll") for (int m = 0; m < 4; ++m) _Pragma("unroll") for (int n = 0; n < 2; ++n) { \
        if constexpr (EB == 2) { _Pragma("unroll") for (int k = 0; k < 2; ++k) acc[ai][bj][m][n] = __builtin_amdgcn_mfma_f32_16x16x32_bf16(Bt[n][k], At[m][k], acc[ai][bj][m][n], 0, 0, 0); } \
        else { asm volatile("v_mfma_scale_f32_16x16x128_f8f6f4 %0, %1, %2, %0, %3, %4 op_sel_hi:[0,0,0]" : "+v"(acc[ai][bj][m][n]) : "v"(Bt##8[n]), "v"(At##8[m]), "v"(vsb), "v"(vsa)); } } \
        __builtin_amdgcn_s_setprio(0); } while (0)
#define PG8_WAIT_V(n) asm volatile("s_waitcnt vmcnt(" #n ")" ::: "memory")
#define PG8_WAIT_L(n) asm volatile("s_waitcnt lgkmcnt(" #n ")" ::: "memory")
#define PG8_BAR __builtin_amdgcn_s_barrier()
#define PG8_SCHED __builtin_amdgcn_sched_barrier(0)
    Unit cur, nxt; int ui = 0;
    if (!S.next(0, cur)) return;
    int vsa = g.sa, vsb = g.sb; asm volatile("" : "+v"(vsa), "+v"(vsb));
    f32x4 acc[2][2][4][2];
#pragma unroll
    for (int a = 0; a < 2; ++a)
#pragma unroll
        for (int b = 0; b < 2; ++b)
#pragma unroll
            for (int m = 0; m < 4; ++m)
#pragma unroll
                for (int n = 0; n < 2; ++n) acc[a][b][m][n] = (f32x4){0.f, 0.f, 0.f, 0.f};
    bf16x8 At[4][2], B0[2][2], B1[2][2]; v8i At8[4], B08[2], B18[2];
    unsigned cA = (unsigned)cur.pm * tA, cB = (unsigned)cur.pn * tB;
    S.a_ready(cur);
    if constexpr (SP2) {
        PG8_STAGE_B(PG8_SB(0, 0), cB); PG8_STAGE_B(PG8_SB(0, 1), cB + hB); PG8_STAGE_A(PG8_SA(0, 0), cA); PG8_STAGE_A(PG8_SA(0, 1), cA + hA);
        if (wr == 1) PG8_BAR;
        PG8_WAIT_V(2); PG8_BAR;
        PG8_STAGE_B(PG8_SB(1, 0), cB + kstep); PG8_STAGE_A(PG8_SA(1, 0), cA + kstep); PG8_STAGE_B(PG8_SB(1, 1), cB + hB + kstep);
        PG8_WAIT_V(6); PG8_BAR;
    } else {
        PG8_STAGE_B(PG8_SB(0, 0), cB); PG8_STAGE_A(PG8_SA(0, 0), cA); PG8_STAGE_B(PG8_SB(0, 1), cB + hB); PG8_STAGE_A(PG8_SA(0, 1), cA + hA);
        if (wr == 1) PG8_BAR;
        PG8_WAIT_V(4); PG8_BAR;
        PG8_STAGE_B(PG8_SB(1, 0), cB + kstep); PG8_STAGE_A(PG8_SA(1, 0), cA + kstep); PG8_STAGE_B(PG8_SB(1, 1), cB + hB + kstep);
        PG8_WAIT_V(6); PG8_BAR;
    }
    for (;;) {
        const bool has_next = S.next(ui + 1, nxt);
        const unsigned nA = has_next ? (unsigned)nxt.pm * tA : cA, nB = has_next ? (unsigned)nxt.pn * tB : cB;
#pragma unroll 1
        for (int t = 0; t < nt; t += 2) {
            const bool last = (t == nt - 2);
            const unsigned a1 = cA + (unsigned)(t + 1) * kstep;
            const unsigned a2 = last ? nA : cA + (unsigned)(t + 2) * kstep, b2 = last ? nB : cB + (unsigned)(t + 2) * kstep;
            const unsigned a3 = a2 + kstep, b3 = b2 + kstep;
            if (last && has_next) S.a_ready(nxt);
            if constexpr (SP2) {
            PG8_LDB(B0, 0, 0); PG8_LDB(B1, 0, 1); PG8_SCHED; PG8_LDA(At, 0, 0); PG8_STAGE_A(PG8_SA(1, 1), a1 + hA);
            PG8_WAIT_V(8); PG8_WAIT_L(0); PG8_BAR; PG8_MMA(0, 0, At, B0); PG8_MMA(0, 1, At, B1); PG8_BAR; PG8_SCHED;
            PG8_LDA(At, 0, 1); PG8_STAGE_B(PG8_SB(0, 0), b2); PG8_STAGE_B(PG8_SB(0, 1), b2 + hB); PG8_STAGE_A(PG8_SA(0, 0), a2);
            PG8_WAIT_V(8); PG8_WAIT_L(0); PG8_BAR; PG8_MMA(1, 0, At, B0); PG8_MMA(1, 1, At, B1); PG8_BAR; PG8_SCHED;
            PG8_LDB(B0, 1, 0); PG8_LDB(B1, 1, 1); PG8_SCHED; PG8_LDA(At, 1, 0); PG8_STAGE_A(PG8_SA(0, 1), a2 + hA);
            PG8_WAIT_V(8); PG8_WAIT_L(0); PG8_BAR; PG8_MMA(0, 0, At, B0); PG8_MMA(0, 1, At, B1); PG8_BAR; PG8_SCHED;
            PG8_LDA(At, 1, 1); PG8_STAGE_B(PG8_SB(1, 0), b3); PG8_STAGE_B(PG8_SB(1, 1), b3 + hB); PG8_STAGE_A(PG8_SA(1, 0), a3);
            PG8_WAIT_V(8); PG8_WAIT_L(0); PG8_BAR; PG8_MMA(1, 0, At, B0); PG8_MMA(1, 1, At, B1); PG8_BAR; PG8_SCHED;
            } else {
            PG8_LDB(B0, 0, 0); PG8_SCHED; PG8_LDA(At, 0, 0); PG8_STAGE_A(PG8_SA(1, 1), a1 + hA);
            PG8_WAIT_L(8); PG8_BAR; PG8_WAIT_L(0); PG8_MMA(0, 0, At, B0); PG8_BAR; PG8_SCHED;
            PG8_LDB(B1, 0, 1); PG8_STAGE_B(PG8_SB(0, 0), b2);
            PG8_BAR; PG8_WAIT_L(0); PG8_MMA(0, 1, At, B1); PG8_BAR;
            PG8_LDA(At, 0, 1); PG8_STAGE_A(PG8_SA(0, 0), a2);
            PG8_BAR; PG8_WAIT_L(0); PG8_MMA(1, 0, At, B0); PG8_BAR; PG8_SCHED;
            PG8_STAGE_B(PG8_SB(0, 1), b2 + hB);
            PG8_WAIT_V(6); PG8_BAR; PG8_MMA(1, 1, At, B1); PG8_BAR;
            PG8_LDB(B0, 1, 0); PG8_SCHED; PG8_LDA(At, 1, 0); PG8_STAGE_A(PG8_SA(0, 1), a2 + hA);
            PG8_WAIT_L(8); PG8_BAR; PG8_WAIT_L(0); PG8_MMA(0, 0, At, B0); PG8_BAR; PG8_SCHED;
            PG8_LDB(B1, 1, 1); PG8_STAGE_B(PG8_SB(1, 0), b3);
            PG8_BAR; PG8_WAIT_L(0); PG8_MMA(0, 1, At, B1); PG8_BAR;
            PG8_LDA(At, 1, 1); PG8_STAGE_A(PG8_SA(1, 0), a3);
            PG8_BAR; PG8_WAIT_L(0); PG8_MMA(1, 0, At, B0); PG8_BAR; PG8_SCHED;
            PG8_STAGE_B(PG8_SB(1, 1), b3 + hB);
            PG8_WAIT_V(6); PG8_BAR; PG8_MMA(1, 1, At, B1); PG8_BAR;
            }
        }
        if constexpr (ALIGN_EPI) { if (wr == 0) PG8_BAR; }
        if constexpr (EB == 1) asm volatile("s_nop 15\n\ts_nop 15" ::: "memory");
        E(acc, cur, wr, wc, fr, fq); S.done(cur);
        if (!has_next) break;
#pragma unroll
        for (int a = 0; a < 2; ++a)
#pragma unroll
            for (int b = 0; b < 2; ++b)
#pragma unroll
                for (int m = 0; m < 4; ++m)
#pragma unroll
                    for (int n = 0; n < 2; ++n) acc[a][b][m][n] = (f32x4){0.f, 0.f, 0.f, 0.f};
        cur = nxt; cA = nA; cB = nB; ++ui;
        if constexpr (EB == 1) asm volatile("s_nop 7" ::: "memory");
        if constexpr (ALIGN_EPI) { if (wr == 1) PG8_BAR; }
    }
    PG8_WAIT_V(0);
    if constexpr (!ALIGN_EPI) { if (wr == 0) PG8_BAR; }
    PG8_BAR;
#undef PG8_SA
#undef PG8_SB
#undef PG8_STAGE_A
#undef PG8_STAGE_B
#undef PG8_LDA
#undef PG8_LDB
#undef PG8_MMA
#undef PG8_WAIT_V
#undef PG8_WAIT_L
#undef PG8_BAR
#undef PG8_SCHED
}
}

struct RowMap2 { int r0, st; };
__device__ __forceinline__ void cvt_item(const float* W, int ldw, u16* WT, int ldt, int k0, int n0, int drow0, int dstr, int dcol0, LAS float* scr, int lane) {
#pragma unroll 8
    for (int i = 0; i < 32; ++i) { const int kk = 2 * i + (lane >> 5); scr[kk * 33 + (lane & 31)] = W[(size_t)(k0 + kk) * ldw + n0 + (lane & 31)]; }
    asm volatile("s_waitcnt lgkmcnt(0)" ::: "memory");
    const int c = lane & 7;
#pragma unroll
    for (int j = 0; j < 4; ++j) { const int n = (lane >> 3) + 8 * j; const LAS float* s = scr + (8 * c) * 33 + n;
        uint4 o; o.x = f2bf(s[0 * 33]) | (f2bf(s[1 * 33]) << 16); o.y = f2bf(s[2 * 33]) | (f2bf(s[3 * 33]) << 16); o.z = f2bf(s[4 * 33]) | (f2bf(s[5 * 33]) << 16); o.w = f2bf(s[6 * 33]) | (f2bf(s[7 * 33]) << 16);
        *(uint4*)(WT + (size_t)(drow0 + n * dstr) * ldt + dcol0 + k0 + 8 * c) = o; }
    asm volatile("s_waitcnt lgkmcnt(0)" ::: "memory");
}
__device__ __forceinline__ void cvt_item8(const float* W, int ldw, unsigned char* WT, int ldt, int k0, int n0, int drow0, float scale, LAS float* scr, int lane) {
#pragma unroll 8
    for (int i = 0; i < 32; ++i) { const int kk = 2 * i + (lane >> 5); scr[kk * 33 + (lane & 31)] = W[(size_t)(k0 + kk) * ldw + n0 + (lane & 31)]; }
    asm volatile("s_waitcnt lgkmcnt(0)" ::: "memory");
    const int c = lane & 3;
#pragma unroll
    for (int j = 0; j < 2; ++j) { const int n = (lane >> 2) + 16 * j; const LAS float* s = scr + (16 * c) * 33 + n;
        unsigned w[4];
#pragma unroll
        for (int q = 0; q < 4; ++q) { unsigned t = 0u; t = __builtin_amdgcn_cvt_pk_fp8_f32(s[(4 * q + 0) * 33] * scale, s[(4 * q + 1) * 33] * scale, t, false);
            t = __builtin_amdgcn_cvt_pk_fp8_f32(s[(4 * q + 2) * 33] * scale, s[(4 * q + 3) * 33] * scale, t, true); w[q] = t; }
        *(uint4*)(WT + (size_t)(drow0 + n) * ldt + k0 + 16 * c) = make_uint4(w[0], w[1], w[2], w[3]); }
    asm volatile("s_waitcnt lgkmcnt(0)" ::: "memory");
}
template <class RowMap>
__device__ __forceinline__ void cvt_matrix8(const float* W, int K, int N, unsigned char* WT, int ldt, float scale, const RowMap& rowmap, LAS float* scr, int lane, int gw, int NGW, int& off) {
    const int nblk = N / 32, nitems = (K / 64) * nblk;
    int it = (gw - off) % NGW; if (it < 0) it += NGW;
    for (; it < nitems; it += NGW) { const int kb = it / nblk, nb = it % nblk; cvt_item8(W, N, WT, ldt, kb * 64, nb * 32, rowmap(nb * 32), scale, scr, lane); }
    off = (off + nitems) % NGW;
}
template <class RowMap>
__device__ __forceinline__ void cvt_matrix(const float* W, int K, int N, u16* WT, int ldt, int dcol0, const RowMap& rowmap, LAS float* scr, int lane, int gw, int NGW, int& off) {
    const int nblk = N / 32, nitems = (K / 64) * nblk;
    int it = (gw - off) % NGW; if (it < 0) it += NGW;
    for (; it < nitems; it += NGW) { const int kb = it / nblk, nb = it % nblk; const RowMap2 rm = rowmap(nb * 32); cvt_item(W, N, WT, ldt, kb * 64, nb * 32, rm.r0, rm.st, dcol0, scr, lane); }
    off = (off + nitems) % NGW;
}


namespace fa {
using bf16x8 = __attribute__((ext_vector_type(8))) short;
using s16x4  = __attribute__((ext_vector_type(4))) short;
using f32x16 = __attribute__((ext_vector_type(16))) float;
using u32x4  = __attribute__((ext_vector_type(4))) unsigned;
constexpr int NW = 8, QBLK = 32, KVBLK = 64, DV = 128;
constexpr float THR = 8.f;
constexpr size_t SHM_V = KVBLK * DV * 2;
#define FA_SBAR() __builtin_amdgcn_sched_barrier(0)
__device__ __forceinline__ int crow(int r, int hi) { return (r & 3) + 8 * (r >> 2) + 4 * hi; }
__device__ __forceinline__ unsigned cvtpk(float lo, float hi) { unsigned r; asm volatile("v_cvt_pk_bf16_f32 %0, %1, %2" : "=v"(r) : "v"(lo), "v"(hi)); return r; }
template <int DQ> struct Cfg {
    static constexpr int NK = DQ / 16, NCH = DQ / 8, KPT = NCH / 8;
    static constexpr size_t SHM_K = (size_t)KVBLK * DQ * 2;
    static constexpr float SCALE = DQ == 192 ? 0.07216878364870322f : (DQ == 64 ? 0.125f : 0.08838834764831845f);
    __device__ static __forceinline__ int kswz(int row, int colB) { return row * (DQ * 2) + (colB ^ ((row & 7) << 4)); }
};
template <int DQ> __device__ __forceinline__ void partialSM(f32x16& p0, f32x16& p1, float& m_reg, float& mn, float& alpha) {
    constexpr float SCALE = Cfg<DQ>::SCALE, C = SCALE * 1.4426950408889634f;
    float pmax = p0[0];
#pragma unroll
    for (int r = 1; r < 16; ++r) pmax = fmaxf(pmax, p0[r]);
#pragma unroll
    for (int r = 0; r < 16; ++r) pmax = fmaxf(pmax, p1[r]);
    { auto rr = __builtin_amdgcn_permlane32_swap(__float_as_uint(pmax), __float_as_uint(pmax), false, false);
      pmax = fmaxf(__uint_as_float(rr[0]), __uint_as_float(rr[1])); }
    if (__builtin_expect(__all(pmax - m_reg <= THR / SCALE), 1)) { mn = m_reg; alpha = 1.f; }
    else { mn = fmaxf(m_reg, pmax); alpha = __builtin_amdgcn_exp2f((m_reg - mn) * C); m_reg = mn; }
    const float mnC = -mn * C;
#pragma unroll
    for (int r = 0; r < 16; ++r) p0[r] = fmaf(p0[r], C, mnC);
#pragma unroll
    for (int r = 0; r < 16; ++r) p1[r] = fmaf(p1[r], C, mnC);
#pragma unroll
    for (int r = 0; r < 16; ++r) p0[r] = __builtin_amdgcn_exp2f(p0[r]);
}
__device__ __forceinline__ void finishSM(f32x16& p0, f32x16& p1, float alpha, float& l_reg, bf16x8& pa0, bf16x8& pa1, bf16x8& pa2, bf16x8& pa3) {
#pragma unroll
    for (int r = 0; r < 16; ++r) p1[r] = __builtin_amdgcn_exp2f(p1[r]);
    float ps = 0;
#pragma unroll
    for (int r = 0; r < 16; ++r) ps += p0[r];
#pragma unroll
    for (int r = 0; r < 16; ++r) ps += p1[r];
    { auto rr = __builtin_amdgcn_permlane32_swap(__float_as_uint(ps), __float_as_uint(ps), false, false);
      ps = __uint_as_float(rr[0]) + __uint_as_float(rr[1]); }
    l_reg = l_reg * alpha + ps;
#define FA_PK4(P, BASE, OUT) do { unsigned a0 = cvtpk(P[BASE + 0], P[BASE + 1]), a1 = cvtpk(P[BASE + 2], P[BASE + 3]);   \
    unsigned b0 = cvtpk(P[BASE + 4], P[BASE + 5]), b1 = cvtpk(P[BASE + 6], P[BASE + 7]);                              \
    auto r0 = __builtin_amdgcn_permlane32_swap(a0, b0, false, false); auto r1 = __builtin_amdgcn_permlane32_swap(a1, b1, false, false); \
    u32x4 w = {r0[0], r1[0], r0[1], r1[1]}; OUT = *reinterpret_cast<bf16x8*>(&w); } while (0)
    FA_PK4(p0, 0, pa0); FA_PK4(p0, 8, pa1); FA_PK4(p1, 0, pa2); FA_PK4(p1, 8, pa3);
#undef FA_PK4
}
template <int DQ> __device__ __forceinline__ void qkt(f32x16& p0, f32x16& p1, const char* Ks, const bf16x8* qr, int r32, int hi) {
    p0 = f32x16{}; p1 = f32x16{};
#pragma unroll
    for (int d0 = 0; d0 < Cfg<DQ>::NK; ++d0) { const int cb = (d0 * 16 + hi * 8) * 2;
        const bf16x8 b0 = *reinterpret_cast<const bf16x8*>(Ks + Cfg<DQ>::kswz(r32, cb));
        const bf16x8 b1 = *reinterpret_cast<const bf16x8*>(Ks + Cfg<DQ>::kswz(32 + r32, cb));
        p0 = __builtin_amdgcn_mfma_f32_32x32x16_bf16(b0, qr[d0], p0, 0, 0, 0);
        p1 = __builtin_amdgcn_mfma_f32_32x32x16_bf16(b1, qr[d0], p1, 0, 0, 0); }
}
__device__ __forceinline__ int v_st(int k, int c) { const int kk = (k & ~0xC) | ((k & 4) << 1) | ((k & 8) >> 1); return ((kk >> 3) * 4 + (c >> 5)) * 512 + ((kk & 7) * 32 + (c & 31)) * 2; }
__device__ __forceinline__ int v_rd_base(int lane) { return ((lane & 3) << 3) | (((lane >> 2) & 3) << 6) | (((lane >> 4) & 1) << 5) | (((lane >> 5) & 1) << 8); }
constexpr int v_rd_off(int d0, int ks, int half) { return d0 * 512 + ks * 4096 + half * 2048; }
template <int OFF> __device__ __forceinline__ s16x4 tr_read(int vb) {
    s16x4 r; asm volatile("ds_read_b64_tr_b16 %0, %1 offset:%2" : "=&v"(r) : "v"(vb), "i"(OFF) : "memory"); return r;
}
template <int D0> __device__ __forceinline__ void pv_one(f32x16& od, int vb, bf16x8 pa0, bf16x8 pa1, bf16x8 pa2, bf16x8 pa3) {
    const s16x4 l0 = tr_read<v_rd_off(D0, 0, 0)>(vb), h0 = tr_read<v_rd_off(D0, 0, 1)>(vb), l1 = tr_read<v_rd_off(D0, 1, 0)>(vb), h1 = tr_read<v_rd_off(D0, 1, 1)>(vb);
    const s16x4 l2 = tr_read<v_rd_off(D0, 2, 0)>(vb), h2 = tr_read<v_rd_off(D0, 2, 1)>(vb), l3 = tr_read<v_rd_off(D0, 3, 0)>(vb), h3 = tr_read<v_rd_off(D0, 3, 1)>(vb);
    asm volatile("s_waitcnt lgkmcnt(0)" ::: "memory"); FA_SBAR();
#define FA_PK(L, H) (bf16x8){L[0], L[1], L[2], L[3], H[0], H[1], H[2], H[3]}
    od = __builtin_amdgcn_mfma_f32_32x32x16_bf16(pa0, FA_PK(l0, h0), od, 0, 0, 0);
    od = __builtin_amdgcn_mfma_f32_32x32x16_bf16(pa1, FA_PK(l1, h1), od, 0, 0, 0);
    od = __builtin_amdgcn_mfma_f32_32x32x16_bf16(pa2, FA_PK(l2, h2), od, 0, 0, 0);
    od = __builtin_amdgcn_mfma_f32_32x32x16_bf16(pa3, FA_PK(l3, h3), od, 0, 0, 0);
#undef FA_PK
}
__device__ __forceinline__ void pv_d0(f32x16* o, int vb, bf16x8 pa0, bf16x8 pa1, bf16x8 pa2, bf16x8 pa3) {
    pv_one<0>(o[0], vb, pa0, pa1, pa2, pa3); pv_one<1>(o[1], vb, pa0, pa1, pa2, pa3); pv_one<2>(o[2], vb, pa0, pa1, pa2, pa3); pv_one<3>(o[3], vb, pa0, pa1, pa2, pa3);
}
struct KVSrc { const u16* k0; int kst0; const u16* k1; int kst1; int split8; const u16* v; int vst; int xrow0, lrow0; };
constexpr size_t shm_bytes(int DQ) { return 2 * SHM_V + 2 * (size_t)KVBLK * DQ * 2 + NW * 64 * 4; }
constexpr size_t STASH1 = 65536;
template <int S1OFF> __device__ __forceinline__ void diff_combine(const char* lds, u16* __restrict__ Ob, int LDO, float lam, const float* __restrict__ g_o, float oscale) {
    int tid_ = threadIdx.x; asm volatile("" : "+v"(tid_));
    const int tid = tid_, wid = tid >> 6, lane = tid & 63;
    const u16* s1 = (const u16*)(lds + S1OFF) + wid * (QBLK * DV); const u16* s2 = (const u16*)lds + wid * (QBLK * DV);
    const float g0 = g_o[2 * lane] * oscale, g1 = g_o[2 * lane + 1] * oscale;
    asm volatile("s_waitcnt lgkmcnt(0)" ::: "memory");
    for (int r = 0; r < QBLK; ++r) {
        const unsigned a = *(const unsigned*)(s1 + r * DV + 2 * lane), b = *(const unsigned*)(s2 + r * DV + 2 * lane);
        const float o0 = bf2f(a & 0xffffu) - lam * bf2f(b & 0xffffu), o1 = bf2f(a >> 16) - lam * bf2f(b >> 16);
        const float ss = wave_sum(o0 * o0 + o1 * o1);
        const float rs = 1.0f / sqrtf(ss * (1.0f / 128.0f) + 1e-6f);
        *(unsigned*)(Ob + (long)(wid * QBLK + r) * LDO + 2 * lane) = f2bf(o0 * rs * g0) | (f2bf(o1 * rs * g1) << 16);
    }
}

template <int DQ, int omode>
__device__ __forceinline__ void attn_unit(const u16* __restrict__ Qb, int LDQ, const KVSrc S, u16* __restrict__ Ob, int LDO, int NT, char* lds) {
    using C = Cfg<DQ>;
    constexpr int NK = C::NK, NCH = C::NCH, KPT = C::KPT;
    constexpr size_t SHM_K = C::SHM_K;
    int tid_ = threadIdx.x; asm volatile("" : "+v"(tid_));
    const int tid = tid_, wid = tid >> 6, lane = tid & 63, r32 = lane & 31, hi = lane >> 5;
    char* V_lds = lds; char* K_lds = lds + 2 * SHM_V;
    float* wsf = (float*)(lds + 2 * SHM_V + 2 * SHM_K) + wid * 64; float* li_l = wsf; float* al_l = wsf + 32;
    float m_reg = -1e30f, l_reg = 0; f32x16 o[4] = {}; bf16x8 qr[NK];
    const u16* Qw = Qb + (long)(wid * QBLK + r32) * LDQ + hi * 8;
#pragma unroll
    for (int d0 = 0; d0 < NK; ++d0) qr[d0] = *reinterpret_cast<const bf16x8*>(Qw + d0 * 16);
    const int sr = tid >> 4, sc = (tid & 15) * 8, vst0 = v_st(sr, sc), vst1 = v_st(32 + sr, sc);
    const int vb0 = (int)(uintptr_t)V_lds + v_rd_base(lane);
    const u16* kp[KPT]; int kst[KPT]; int kw[KPT];
#pragma unroll
    for (int i = 0; i < KPT; ++i) { const int c = tid + 512 * i, row = c / NCH, c8 = c % NCH;
        if (c8 < S.split8) { kp[i] = S.k0 + (long)row * S.kst0 + c8 * 8; kst[i] = S.kst0; } else { kp[i] = S.k1 + (long)row * S.kst1 + (c8 - S.split8) * 8; kst[i] = S.kst1; }
        kw[i] = C::kswz(row, c8 * 16); }
    const u16* vp0 = S.v + (long)sr * S.vst + sc; const u16* vp1 = S.v + (long)(32 + sr) * S.vst + sc;
    struct { bf16x8 vs0, vs1, ks[KPT]; } sr_[2];
#define FA_ROW0(kt) ((kt) < 4 ? S.xrow0 + 64 * (kt) : S.lrow0 + 64 * ((kt) - 4))
#define FA_SLOAD(i, kt) do { const long _r = FA_ROW0(kt); sr_[i].vs0 = *reinterpret_cast<const bf16x8*>(vp0 + _r * S.vst); sr_[i].vs1 = *reinterpret_cast<const bf16x8*>(vp1 + _r * S.vst); \
    _Pragma("unroll") for (int _q = 0; _q < KPT; ++_q) sr_[i].ks[_q] = *reinterpret_cast<const bf16x8*>(kp[_q] + _r * kst[_q]); } while (0)
#define FA_SWRITE(b, i) do { *(bf16x8*)(V_lds + (b) * SHM_V + vst0) = sr_[i].vs0; *(bf16x8*)(V_lds + (b) * SHM_V + vst1) = sr_[i].vs1; \
    _Pragma("unroll") for (int _q = 0; _q < KPT; ++_q) *(bf16x8*)(K_lds + (b) * SHM_K + kw[_q]) = sr_[i].ks[_q]; } while (0)
#define FA_SWAIT() asm volatile("s_waitcnt vmcnt(%0)" :: "n"(2 + KPT) : "memory")
#define FA_RESC(a) do { if (__any((a) < 1.f)) { if (hi == 0) al_l[r32] = (a); asm volatile("s_waitcnt lgkmcnt(0)" ::: "memory"); \
    _Pragma("unroll") for (int d = 0; d < 4; ++d) _Pragma("unroll") for (int r = 0; r < 16; ++r) o[d][r] *= al_l[crow(r, hi)]; } } while (0)
    f32x16 pA0, pA1, pB0, pB1; float mnA, mnB, alA, alB; bf16x8 pa0, pa1, pa2, pa3;
    constexpr int SE = 0, SO = 1;
    FA_SLOAD(SE, 0); asm volatile("s_waitcnt vmcnt(0)" ::: "memory"); FA_SWRITE(0, SE); __syncthreads();
    qkt<DQ>(pA0, pA1, K_lds, qr, r32, hi); partialSM<DQ>(pA0, pA1, m_reg, mnA, alA);
    FA_SLOAD(SO, 1); if (2 < NT) FA_SLOAD(SE, 2);
    FA_SWAIT(); FA_SWRITE(1, SO); __syncthreads();
    for (int j = 1; j + 1 < NT; j += 2) {
        FA_SBAR(); qkt<DQ>(pB0, pB1, K_lds + SHM_K, qr, r32, hi);
        finishSM(pA0, pA1, alA, l_reg, pa0, pa1, pa2, pa3); FA_SBAR();
        FA_SLOAD(SO, j + 2); FA_SBAR();
        pv_d0(o, vb0, pa0, pa1, pa2, pa3); partialSM<DQ>(pB0, pB1, m_reg, mnB, alB);
        __syncthreads(); FA_SWAIT(); FA_SWRITE(0, SE);
        FA_RESC(alB); __syncthreads();
        FA_SBAR(); qkt<DQ>(pA0, pA1, K_lds, qr, r32, hi);
        finishSM(pB0, pB1, alB, l_reg, pa0, pa1, pa2, pa3); FA_SBAR();
        if (j + 3 < NT) FA_SLOAD(SE, j + 3); FA_SBAR();
        pv_d0(o, vb0 + (int)SHM_V, pa0, pa1, pa2, pa3); partialSM<DQ>(pA0, pA1, m_reg, mnA, alA);
        __syncthreads(); FA_SWAIT(); FA_SWRITE(1, SO);
        FA_RESC(alA); __syncthreads();
    }
    FA_SBAR(); qkt<DQ>(pB0, pB1, K_lds + SHM_K, qr, r32, hi);
    finishSM(pA0, pA1, alA, l_reg, pa0, pa1, pa2, pa3); FA_SBAR();
    pv_d0(o, vb0, pa0, pa1, pa2, pa3); partialSM<DQ>(pB0, pB1, m_reg, mnB, alB);
    __syncthreads(); FA_RESC(alB);
    finishSM(pB0, pB1, alB, l_reg, pa0, pa1, pa2, pa3); FA_SBAR();
    pv_d0(o, vb0 + (int)SHM_V, pa0, pa1, pa2, pa3);
    if (hi == 0) li_l[r32] = l_reg; asm volatile("s_waitcnt lgkmcnt(0)" ::: "memory");
    float rli[16];
#pragma unroll
    for (int r = 0; r < 16; ++r) rli[r] = __builtin_amdgcn_rcpf(li_l[crow(r, hi)]);
    u16* Ow = Ob + (long)(wid * QBLK) * LDO;
    if constexpr (omode == 0) {
#pragma unroll
        for (int r = 0; r < 16; ++r) { const int orow = crow(r, hi);
#pragma unroll
            for (int d0 = 0; d0 < 4; ++d0) Ow[(long)orow * LDO + d0 * 32 + r32] = (u16)f2bf(o[d0][r] * rli[r]); }
    } else {
        if constexpr (omode == 2) __syncthreads();
        u16* stash = (u16*)(lds + (omode == 1 ? STASH1 : 0)) + wid * (QBLK * DV);
#pragma unroll
        for (int r = 0; r < 16; ++r) { const int orow = crow(r, hi);
#pragma unroll
            for (int d0 = 0; d0 < 4; ++d0) stash[orow * DV + d0 * 32 + r32] = (u16)f2bf(o[d0][r] * rli[r]); }
    }
#undef FA_ROW0
#undef FA_SLOAD
#undef FA_SWRITE
#undef FA_SWAIT
#undef FA_RESC
}

constexpr int A2_KSL = 8192, A2_VSL = 16384, A2_K = 0, A2_V = 4 * A2_KSL, A2_WS = A2_V + 3 * A2_VSL, A2_STASH1 = A2_WS + NW * 256, A2_END = A2_STASH1 + NW * QBLK * DV * 2;
constexpr float A2_QSCALE = 0.125f * 1.4426950408889634f;
typedef __attribute__((address_space(3))) const char* lds_cptr;
typedef short v4i16_t __attribute__((ext_vector_type(4)));
typedef float f32x2_t __attribute__((ext_vector_type(2))); typedef __bf16 bf16x2_t __attribute__((ext_vector_type(2)));
__device__ __forceinline__ void glds16(const void* g, unsigned lds_dst) { unsigned keep;
    asm volatile("s_mov_b32 %0, m0\n\ts_mov_b32 m0, %2\n\ts_nop 0\n\tglobal_load_lds_dwordx4 %1, off\n\ts_mov_b32 m0, %0" : "=&s"(keep) : "v"(g), "s"(lds_dst) : "memory"); }
__device__ __forceinline__ unsigned cvtpk_s(float lo, float hi) { f32x2_t v = {lo, hi}; bf16x2_t b = __builtin_convertvector(v, bf16x2_t); return __builtin_bit_cast(unsigned, b); }
__device__ __forceinline__ bf16x8 kfr(lds_cptr p) { return *(const __attribute__((address_space(3))) bf16x8*)p; }
__device__ __forceinline__ s16x4 vtr(lds_cptr p) { return __builtin_bit_cast(s16x4, __builtin_amdgcn_ds_read_tr16_b64_v4i16((__attribute__((address_space(3))) v4i16_t*)p)); }
#define A2_MFMA(a, b, c) __builtin_amdgcn_mfma_f32_32x32x16_bf16(a, b, c, 0, 0, 0)
#define A2_WAIT_BAR(N) asm volatile("s_waitcnt vmcnt(" #N ") lgkmcnt(0)\n\ts_barrier" ::: "memory")
#define A2_PIN(x) asm volatile("" : "+v"(x))
#define A2_MX3(a, b, c) __builtin_fmaxf(__builtin_fmaxf((a), (b)), (c))
template <int omode, int THRL>
__device__ __forceinline__ void attn64_unit(const u16* __restrict__ Qb, int LDQ, const KVSrc S, int NT, char* lds) {
    int tid_ = threadIdx.x; asm volatile("" : "+v"(tid_));
    const int tid = tid_, lane = tid & 63, r32 = lane & 31, hi = lane >> 5; const int wid = __builtin_amdgcn_readfirstlane(tid >> 6);
    const unsigned lds0 = (unsigned)(uintptr_t)lds; float* wsf = (float*)(lds + A2_WS) + wid * 64;
    const u16* ksrc = S.k0 + (long)(8 * wid + (lane >> 3)) * S.kst0 + ((lane & 7) ^ (lane >> 3)) * 8;
    const u16* vsrc = S.v + (long)(8 * wid + (lane >> 3)) * S.vst + (((lane >> 2) ^ (lane >> 4)) & 1) * 32 + (lane & 3) * 8;
    const unsigned kdst = lds0 + A2_K + wid * 1024, vdst = lds0 + A2_V + wid * 1024;
#define A2_ROW0(t) ((t) < 4 ? S.xrow0 + 64 * (t) : S.lrow0 + 64 * ((t) - 4))
#define DMA_K(t, slot) glds16(ksrc + (long)A2_ROW0(t) * S.kst0, (unsigned)__builtin_amdgcn_readfirstlane(kdst + (slot)))
#define DMA_V(t, slot) do { const u16* v_ = vsrc + (long)A2_ROW0(t) * S.vst; const unsigned d_ = (unsigned)__builtin_amdgcn_readfirstlane(vdst + (slot)); glds16(v_, d_); glds16(v_ + 64, d_ + 8192); } while (0)
    const lds_cptr shm3 = (lds_cptr)lds;
    const lds_cptr kp0 = shm3 + A2_K + r32 * 128;
    int kx[4];
#pragma unroll
    for (int d0 = 0; d0 < 4; ++d0) kx[d0] = ((2 * d0 + hi) ^ (r32 & 7)) * 16;
    const lds_cptr vp0 = shm3 + A2_V + ((lane >> 4) & 1) * 32 + (lane & 3) * 8 + (4 * hi + ((lane & 15) >> 2)) * 128 + ((lane >> 3) & 1) * 64;
    const lds_cptr vp1 = vp0 + 64 - ((lane >> 3) & 1) * 128;
    asm volatile("s_waitcnt vmcnt(0)" ::: "memory");
    DMA_K(0, 0); DMA_V(0, 0); DMA_K(1, A2_KSL); DMA_K(2, 2 * A2_KSL);
    bf16x8 qr[4];
    { const u16* Qw = Qb + (long)(wid * QBLK + r32) * LDQ + hi * 8;
#pragma unroll
      for (int d0 = 0; d0 < 4; ++d0) qr[d0] = *reinterpret_cast<const bf16x8*>(Qw + d0 * 16); }
    float mhat = 0.f, l_reg = 0.f; f32x16 o[4]; o[0] = f32x16{}; o[1] = f32x16{}; o[2] = f32x16{}; o[3] = f32x16{};
    f32x16 negm = f32x16{}; A2_PIN(negm);
    bool resc = false;
    f32x16 pA0, pA1, pB0, pB1; bf16x8 kf[8]; s16x4 vlo[4], vhi[4]; u32x4 pw0, pw1, pw2, pw3;
    int ks_cur = A2_KSL, ks_next = 2 * A2_KSL, ks_dma = 0;
    int vs_prev = 0, vs_cur = A2_VSL, vs_dma = 2 * A2_VSL;
#define ROT() do { ks_dma = ks_cur; ks_cur = ks_next; ks_next = (ks_next + A2_KSL) & (4 * A2_KSL - 1); const int t_ = vs_prev; vs_prev = vs_cur; vs_cur = vs_dma; vs_dma = t_; } while (0)
#define RESC() do { if (resc) { asm volatile("s_waitcnt lgkmcnt(0)" ::: "memory"); \
      _Pragma("unroll") for (int d_ = 0; d_ < 4; ++d_) _Pragma("unroll") for (int r = 0; r < 16; ++r) o[d_][r] *= wsf[crow(r, hi)]; } } while (0)
    A2_WAIT_BAR(8);
#pragma unroll
    for (int j = 0; j < 8; ++j) kf[j] = kfr(kp0 + kx[j >> 1] + (j & 1) * 4096);
    pA0 = A2_MFMA(kf[0], qr[0], negm); pA1 = A2_MFMA(kf[1], qr[0], negm); pA0 = A2_MFMA(kf[2], qr[1], pA0); pA1 = A2_MFMA(kf[3], qr[1], pA1);
    pA0 = A2_MFMA(kf[4], qr[2], pA0); pA1 = A2_MFMA(kf[5], qr[2], pA1); pA0 = A2_MFMA(kf[6], qr[3], pA0); pA1 = A2_MFMA(kf[7], qr[3], pA1);
    { float a = A2_MX3(pA0[0], pA0[1], pA1[0]), b = A2_MX3(pA0[2], pA0[3], pA1[1]); a = A2_MX3(a, pA1[2], pA1[3]);
#pragma unroll
      for (int r = 4; r < 16; r += 4) { a = A2_MX3(a, pA0[r], pA0[r + 1]); b = A2_MX3(b, pA0[r + 2], pA0[r + 3]); a = A2_MX3(a, pA1[r], pA1[r + 1]); b = A2_MX3(b, pA1[r + 2], pA1[r + 3]); }
      float rm = __builtin_fmaxf(a, b); { auto rr = __builtin_amdgcn_permlane32_swap(__float_as_uint(rm), __float_as_uint(rm), false, false); rm = __builtin_fmaxf(__uint_as_float(rr[0]), __uint_as_float(rr[1])); }
      mhat = rm;
#pragma unroll
      for (int r = 0; r < 16; ++r) { pA0[r] = __builtin_amdgcn_exp2f(pA0[r] - rm); pA1[r] = __builtin_amdgcn_exp2f(pA1[r] - rm); negm[r] = -rm; }
      A2_PIN(negm); }
    A2_WAIT_BAR(0);
    DMA_K(3, 3 * A2_KSL); DMA_V(1, A2_VSL);
    kf[0] = kfr(kp0 + A2_KSL + kx[0]); kf[1] = kfr(kp0 + A2_KSL + kx[0] + 4096); kf[2] = kfr(kp0 + A2_KSL + kx[1]); kf[3] = kfr(kp0 + A2_KSL + kx[1] + 4096);
#define PKW(P, B) cvtpk_s(P[B], P[(B) + 1])
#define PAF(k) __builtin_bit_cast(bf16x8, pw##k)
#define VFR(i) (bf16x8){vlo[i][0], vlo[i][1], vlo[i][2], vlo[i][3], vhi[i][0], vhi[i][1], vhi[i][2], vhi[i][3]}
#define VRD(i) do { vlo[(i) & 3] = vtr((((i) & 1) ? vq_ : vp_) + ((((i) & 3) >> 1) * 8192 + ((i) >> 2) * 2048)); vhi[(i) & 3] = vtr((((i) & 1) ? vq_ : vp_) + ((((i) & 3) >> 1) * 8192 + ((i) >> 2) * 2048 + 1024)); } while (0)
#define GAPA(MF, a0, a1, a2, a3, W0, W1, PW) do { MF; sacc += a0; sacc += a1; sacc += a2; sacc += a3; A2_PIN(sacc); W0; W1; A2_PIN(PW); FA_SBAR(); } while (0)
#define GAPB(i, PK_, X, B) do { o[(i) & 3] = A2_MFMA(PK_, VFR((i) & 3), o[(i) & 3]); X[B] = __builtin_amdgcn_exp2f(X[B]); X[(B) + 1] = __builtin_amdgcn_exp2f(X[(B) + 1]); A2_PIN(X); FA_SBAR(); } while (0)
#define KRD(G, j, off) do { if (G) { kf[j] = kfr(kn_ + (off)); FA_SBAR(); } } while (0)
#define STEP(C0, C1, P0, P1, t, GK, GV, GL) do { FA_SBAR(); \
    const lds_cptr kp_ = kp0 + ks_cur; const lds_cptr vp_ = vp0 + vs_prev; const lds_cptr vq_ = vp1 + vs_prev; const lds_cptr kn_ = kp0 + ks_next; \
    kf[4] = kfr(kp_ + kx[2]); kf[5] = kfr(kp_ + kx[2] + 4096); FA_SBAR(); float sacc = P0[0] + P0[1]; \
                       GAPA(C0 = A2_MFMA(kf[0], qr[0], negm), P0[2], P0[3], P0[4], P0[5],     pw0[0] = PKW(P0, 0),  pw0[1] = PKW(P0, 2),  pw0); \
    kf[6] = kfr(kp_ + kx[3]); kf[7] = kfr(kp_ + kx[3] + 4096); FA_SBAR(); \
                       GAPA(C1 = A2_MFMA(kf[1], qr[0], negm), P0[6], P0[7], P0[8], P0[9],     pw0[2] = PKW(P0, 4),  pw0[3] = PKW(P0, 6),  pw0); \
                       GAPA(C0 = A2_MFMA(kf[2], qr[1], C0),   P0[10], P0[11], P0[12], P0[13], pw1[0] = PKW(P0, 8),  pw1[1] = PKW(P0, 10), pw1); \
                       GAPA(C1 = A2_MFMA(kf[3], qr[1], C1),   P0[14], P0[15], P1[0], P1[1],   pw1[2] = PKW(P0, 12), pw1[3] = PKW(P0, 14), pw1); \
                       GAPA(C0 = A2_MFMA(kf[4], qr[2], C0),   P1[2], P1[3], P1[4], P1[5],     pw2[0] = PKW(P1, 0),  pw2[1] = PKW(P1, 2),  pw2); \
    VRD(0); FA_SBAR(); GAPA(C1 = A2_MFMA(kf[5], qr[2], C1),   P1[6], P1[7], P1[8], P1[9],     pw2[2] = PKW(P1, 4),  pw2[3] = PKW(P1, 6),  pw2); \
    VRD(1); FA_SBAR(); GAPA(C0 = A2_MFMA(kf[6], qr[3], C0),   P1[10], P1[11], P1[12], P1[13], pw3[0] = PKW(P1, 8),  pw3[1] = PKW(P1, 10), pw3); \
    VRD(2); FA_SBAR(); GAPA(C1 = A2_MFMA(kf[7], qr[3], C1),   P1[14], P1[15], 0.f, 0.f,       pw3[2] = PKW(P1, 12), pw3[3] = PKW(P1, 14), pw3); \
    l_reg += sacc; \
    if (GK) { DMA_K((t) + 3, ks_dma); } if (GV) { DMA_V((t) + 1, vs_dma); } \
    { float a = A2_MX3(C0[0], C0[1], C1[0]), b = A2_MX3(C0[2], C0[3], C1[1]); a = A2_MX3(a, C1[2], C1[3]); \
      _Pragma("unroll") for (int r = 4; r < 16; r += 4) { a = A2_MX3(a, C0[r], C0[r + 1]); b = A2_MX3(b, C0[r + 2], C0[r + 3]); a = A2_MX3(a, C1[r], C1[r + 1]); b = A2_MX3(b, C1[r + 2], C1[r + 3]); } \
      float rm = __builtin_fmaxf(a, b); { auto rr = __builtin_amdgcn_permlane32_swap(__float_as_uint(rm), __float_as_uint(rm), false, false); rm = __builtin_fmaxf(__uint_as_float(rr[0]), __uint_as_float(rr[1])); } \
      resc = false; \
      if (__builtin_expect(__any(rm > (float)THRL), 0)) { const float dl = __builtin_fmaxf(rm, 0.f); mhat += dl;                         \
        _Pragma("unroll") for (int r = 0; r < 16; ++r) { C0[r] -= dl; C1[r] -= dl; } \
        _Pragma("unroll") for (int r = 0; r < 16; ++r) negm[r] = -mhat; A2_PIN(negm); \
        const float f = __builtin_amdgcn_exp2f(-dl); l_reg *= f; if (hi == 0) wsf[r32] = f; resc = true; } } \
    FA_SBAR(); \
    VRD(3);  FA_SBAR(); GAPB(0,  PAF(0), C0, 0);   VRD(4);  FA_SBAR(); GAPB(1,  PAF(0), C0, 2);   VRD(5);  FA_SBAR(); GAPB(2,  PAF(0), C0, 4);   VRD(6);  FA_SBAR(); GAPB(3,  PAF(0), C0, 6); \
    VRD(7);  FA_SBAR(); GAPB(4,  PAF(1), C0, 8);   VRD(8);  FA_SBAR(); GAPB(5,  PAF(1), C0, 10);  VRD(9);  FA_SBAR(); GAPB(6,  PAF(1), C0, 12);  VRD(10); FA_SBAR(); GAPB(7,  PAF(1), C0, 14); \
    VRD(11); FA_SBAR(); GAPB(8,  PAF(2), C1, 0);   VRD(12); FA_SBAR(); GAPB(9,  PAF(2), C1, 2);   VRD(13); FA_SBAR(); GAPB(10, PAF(2), C1, 4);   VRD(14); FA_SBAR(); GAPB(11, PAF(2), C1, 6); \
    VRD(15); FA_SBAR(); GAPB(12, PAF(3), C1, 8);   KRD(GL, 0, kx[0]); KRD(GL, 1, kx[0] + 4096);  GAPB(13, PAF(3), C1, 10);  KRD(GL, 2, kx[1]); KRD(GL, 3, kx[1] + 4096); GAPB(14, PAF(3), C1, 12);  GAPB(15, PAF(3), C1, 14); \
    } while (0)
    int t = 1;
    for (; t + 5 < NT; t += 2) {
        STEP(pB0, pB1, pA0, pA1, t, true, true, true);     A2_WAIT_BAR(3); RESC(); ROT();
        STEP(pA0, pA1, pB0, pB1, t + 1, true, true, true); A2_WAIT_BAR(3); RESC(); ROT();
    }
#define ENDW(tt) do { if ((tt) + 3 < NT) { A2_WAIT_BAR(3); } else if ((tt) + 2 < NT) { A2_WAIT_BAR(2); } else { A2_WAIT_BAR(0); } } while (0)
    for (; t + 1 < NT; t += 2) {
        STEP(pB0, pB1, pA0, pA1, t, (t + 3 < NT), (t + 1 < NT), (t + 1 < NT));         ENDW(t);     RESC(); ROT();
        STEP(pA0, pA1, pB0, pB1, t + 1, (t + 4 < NT), (t + 2 < NT), (t + 2 < NT));     ENDW(t + 1); RESC(); ROT();
    }
    STEP(pB0, pB1, pA0, pA1, NT - 1, false, false, false); RESC();
    { float sacc = pB0[0] + pB0[1];
#pragma unroll
      for (int r = 2; r < 16; ++r) sacc += pB0[r];
#pragma unroll
      for (int r = 0; r < 16; ++r) sacc += pB1[r];
      l_reg += sacc;
      pw0 = (u32x4){PKW(pB0, 0), PKW(pB0, 2), PKW(pB0, 4), PKW(pB0, 6)}; pw1 = (u32x4){PKW(pB0, 8), PKW(pB0, 10), PKW(pB0, 12), PKW(pB0, 14)};
      pw2 = (u32x4){PKW(pB1, 0), PKW(pB1, 2), PKW(pB1, 4), PKW(pB1, 6)}; pw3 = (u32x4){PKW(pB1, 8), PKW(pB1, 10), PKW(pB1, 12), PKW(pB1, 14)};
      const lds_cptr vp_ = vp0 + vs_cur; const lds_cptr vq_ = vp1 + vs_cur;
      VRD(0); VRD(1); VRD(2); VRD(3);
      o[0] = A2_MFMA(PAF(0), VFR(0), o[0]); o[1] = A2_MFMA(PAF(0), VFR(1), o[1]); o[2] = A2_MFMA(PAF(0), VFR(2), o[2]); o[3] = A2_MFMA(PAF(0), VFR(3), o[3]); FA_SBAR();
      VRD(4); VRD(5); VRD(6); VRD(7);
      o[0] = A2_MFMA(PAF(1), VFR(0), o[0]); o[1] = A2_MFMA(PAF(1), VFR(1), o[1]); o[2] = A2_MFMA(PAF(1), VFR(2), o[2]); o[3] = A2_MFMA(PAF(1), VFR(3), o[3]); FA_SBAR();
      VRD(8); VRD(9); VRD(10); VRD(11);
      o[0] = A2_MFMA(PAF(2), VFR(0), o[0]); o[1] = A2_MFMA(PAF(2), VFR(1), o[1]); o[2] = A2_MFMA(PAF(2), VFR(2), o[2]); o[3] = A2_MFMA(PAF(2), VFR(3), o[3]); FA_SBAR();
      VRD(12); VRD(13); VRD(14); VRD(15);
      o[0] = A2_MFMA(PAF(3), VFR(0), o[0]); o[1] = A2_MFMA(PAF(3), VFR(1), o[1]); o[2] = A2_MFMA(PAF(3), VFR(2), o[2]); o[3] = A2_MFMA(PAF(3), VFR(3), o[3]); }
    { auto rr = __builtin_amdgcn_permlane32_swap(__float_as_uint(l_reg), __float_as_uint(l_reg), false, false); l_reg = __uint_as_float(rr[0]) + __uint_as_float(rr[1]); }
    if (hi == 0) wsf[32 + r32] = l_reg; asm volatile("s_waitcnt lgkmcnt(0)" ::: "memory");
    float rli[16];
#pragma unroll
    for (int r = 0; r < 16; ++r) rli[r] = __builtin_amdgcn_rcpf(wsf[32 + crow(r, hi)]);
    if constexpr (omode == 2) asm volatile("s_waitcnt lgkmcnt(0)\n\ts_barrier" ::: "memory");
    { u16* stash = (u16*)(lds + (omode == 1 ? A2_STASH1 : 0)) + wid * (QBLK * DV);
#pragma unroll
      for (int r = 0; r < 16; ++r) { const int orow = crow(r, hi);
#pragma unroll
          for (int d0 = 0; d0 < 4; ++d0) stash[orow * DV + d0 * 32 + r32] = (u16)f2bf(o[d0][r] * rli[r]); } }
#undef A2_ROW0
#undef DMA_K
#undef DMA_V
#undef ROT
#undef RESC
#undef PKW
#undef PAF
#undef VFR
#undef VRD
#undef GAPA
#undef GAPB
#undef KRD
#undef STEP
#undef ENDW
}

constexpr int A1_KSL = 24576, A1_VSL = 16384, A1_K = 0, A1_V = 4 * A1_KSL, A1_WS = A1_V + 3 * A1_VSL, A1_END = A1_WS + NW * 256;
constexpr float A1_QSCALE = 0.07216878364870322f * 1.4426950408889634f;
template <int THRL>
__device__ __forceinline__ void attn192_unit(const u16* __restrict__ Qb, int LDQ, const KVSrc S, u16* __restrict__ Ob, int LDO, int NT, char* lds) {
    int tid_ = threadIdx.x; asm volatile("" : "+v"(tid_));
    const int tid = tid_, lane = tid & 63, r32 = lane & 31, hi = lane >> 5; const int wid = __builtin_amdgcn_readfirstlane(tid >> 6);
    const unsigned lds0 = (unsigned)(uintptr_t)lds; float* wsf = (float*)(lds + A1_WS) + wid * 64;
    const u16* ksrc0 = S.k0 + (long)(8 * wid + (lane >> 3)) * S.kst0 + ((lane & 7) ^ (lane >> 3)) * 8;
    const u16* ksrc1 = S.k1 + (long)(8 * wid + (lane >> 3)) * S.kst1 + ((lane & 7) ^ (lane >> 3)) * 8;
    const u16* vsrc = S.v + (long)(8 * wid + (lane >> 3)) * S.vst + (((lane >> 2) ^ (lane >> 4)) & 1) * 32 + (lane & 3) * 8;
    const unsigned kdst = lds0 + A1_K + wid * 1024, vdst = lds0 + A1_V + wid * 1024;
#define A2_ROW0(t) ((t) < 4 ? S.xrow0 + 64 * (t) : S.lrow0 + 64 * ((t) - 4))
#define DMA_K(t, slot) do { const long r_ = A2_ROW0(t); const u16* k_ = ksrc0 + r_ * S.kst0; const unsigned d_ = (unsigned)__builtin_amdgcn_readfirstlane(kdst + (slot)); \
      glds16(k_, d_); glds16(k_ + 64, d_ + 8192); glds16(ksrc1 + r_ * S.kst1, d_ + 16384); } while (0)
#define DMA_V(t, slot) do { const u16* v_ = vsrc + (long)A2_ROW0(t) * S.vst; const unsigned d_ = (unsigned)__builtin_amdgcn_readfirstlane(vdst + (slot)); glds16(v_, d_); glds16(v_ + 64, d_ + 8192); } while (0)
    const lds_cptr shm3 = (lds_cptr)lds;
    const lds_cptr kp0 = shm3 + A1_K + r32 * 128;
    int kx[4];
#pragma unroll
    for (int d0 = 0; d0 < 4; ++d0) kx[d0] = ((2 * d0 + hi) ^ (r32 & 7)) * 16;
    const lds_cptr vp0 = shm3 + A1_V + ((lane >> 4) & 1) * 32 + (lane & 3) * 8 + (4 * hi + ((lane & 15) >> 2)) * 128 + ((lane >> 3) & 1) * 64;
    const lds_cptr vp1 = vp0 + 64 - ((lane >> 3) & 1) * 128;
    asm volatile("s_waitcnt vmcnt(0)" ::: "memory");
    DMA_K(0, 0); DMA_V(0, 0); DMA_K(1, A1_KSL); DMA_K(2, 2 * A1_KSL);
    bf16x8 qr[12];
    { const u16* Qw = Qb + (long)(wid * QBLK + r32) * LDQ + hi * 8;
#pragma unroll
      for (int d0 = 0; d0 < 12; ++d0) qr[d0] = *reinterpret_cast<const bf16x8*>(Qw + d0 * 16); }
    float mhat = 0.f, l_reg = 0.f; f32x16 o[4]; o[0] = f32x16{}; o[1] = f32x16{}; o[2] = f32x16{}; o[3] = f32x16{};
    bool resc = false;
    f32x16 pA0, pA1, pB0, pB1; bf16x8 kf[4]; s16x4 vlo[4], vhi[4]; u32x4 pw0, pw1, pw2, pw3;
    int ks_cur = A1_KSL, ks_next = 2 * A1_KSL, ks_dma = 0;
    int vs_prev = 0, vs_cur = A1_VSL, vs_dma = 2 * A1_VSL;
#define ROT() do { ks_dma = ks_cur; ks_cur = ks_next; ks_next = (ks_next == 3 * A1_KSL) ? 0 : ks_next + A1_KSL; const int t_ = vs_prev; vs_prev = vs_cur; vs_cur = vs_dma; vs_dma = t_; } while (0)
#define RESC() do { if (resc) { asm volatile("s_waitcnt lgkmcnt(0)" ::: "memory"); \
      _Pragma("unroll") for (int d_ = 0; d_ < 4; ++d_) _Pragma("unroll") for (int r = 0; r < 16; ++r) o[d_][r] *= wsf[crow(r, hi)]; } } while (0)
#define KFR(j) kfr(kp_ + (((j) >> 3) * 8192 + ((j) & 1) * 4096) + kx[((j) >> 1) & 3])
    A2_WAIT_BAR(20);
    { const lds_cptr kp_ = kp0;
      pA0 = f32x16{}; pA1 = f32x16{};
#pragma unroll
      for (int d0 = 0; d0 < 12; ++d0) { const bf16x8 b0 = KFR(2 * d0), b1 = KFR(2 * d0 + 1); pA0 = A2_MFMA(b0, qr[d0], pA0); pA1 = A2_MFMA(b1, qr[d0], pA1); } }
    { float a = A2_MX3(pA0[0], pA0[1], pA1[0]), b = A2_MX3(pA0[2], pA0[3], pA1[1]); a = A2_MX3(a, pA1[2], pA1[3]);
#pragma unroll
      for (int r = 4; r < 16; r += 4) { a = A2_MX3(a, pA0[r], pA0[r + 1]); b = A2_MX3(b, pA0[r + 2], pA0[r + 3]); a = A2_MX3(a, pA1[r], pA1[r + 1]); b = A2_MX3(b, pA1[r + 2], pA1[r + 3]); }
      float rm = __builtin_fmaxf(a, b); { auto rr = __builtin_amdgcn_permlane32_swap(__float_as_uint(rm), __float_as_uint(rm), false, false); rm = __builtin_fmaxf(__uint_as_float(rr[0]), __uint_as_float(rr[1])); }
      mhat = rm;
#pragma unroll
      for (int r = 0; r < 16; ++r) { pA0[r] = __builtin_amdgcn_exp2f(pA0[r] - rm); pA1[r] = __builtin_amdgcn_exp2f(pA1[r] - rm); } }
    A2_WAIT_BAR(0);
    DMA_K(3, 3 * A1_KSL); DMA_V(1, A1_VSL);
    { const lds_cptr kp_ = kp0 + A1_KSL; kf[0] = KFR(0); kf[1] = KFR(1); kf[2] = KFR(2); }
#define PKW(P, B) cvtpk_s(P[B], P[(B) + 1])
#define PAF(k) __builtin_bit_cast(bf16x8, pw##k)
#define VFR(i) (bf16x8){vlo[i][0], vlo[i][1], vlo[i][2], vlo[i][3], vhi[i][0], vhi[i][1], vhi[i][2], vhi[i][3]}
#define VRD(i) do { vlo[(i) & 3] = vtr((((i) & 1) ? vq_ : vp_) + ((((i) & 3) >> 1) * 8192 + ((i) >> 2) * 2048)); vhi[(i) & 3] = vtr((((i) & 1) ? vq_ : vp_) + ((((i) & 3) >> 1) * 8192 + ((i) >> 2) * 2048 + 1024)); } while (0)
#define GAPA2(MF, a0, a1, W0, PW) do { MF; sacc += a0; sacc += a1; A2_PIN(sacc); W0; A2_PIN(PW); FA_SBAR(); } while (0)
#define GAPA0(MF) do { MF; FA_SBAR(); } while (0)
#define GAPB(i, PK_, X, B) do { o[(i) & 3] = A2_MFMA(PK_, VFR((i) & 3), o[(i) & 3]); X[B] = __builtin_amdgcn_exp2f(X[B] - mh); X[(B) + 1] = __builtin_amdgcn_exp2f(X[(B) + 1] - mh); A2_PIN(X); FA_SBAR(); } while (0)
#define STEP(C0, C1, P0, P1, t, GK, GV, GL) do { FA_SBAR(); \
    const lds_cptr kp_ = kp0 + ks_cur; const lds_cptr vp_ = vp0 + vs_prev; const lds_cptr vq_ = vp1 + vs_prev; float sacc = 0.f; \
    kf[3] = KFR(3); FA_SBAR(); GAPA2(C0 = A2_MFMA(kf[0], qr[0], f32x16{}), P0[0], P0[1], pw0[0] = PKW(P0, 0), pw0); \
    kf[0] = KFR(4); FA_SBAR(); GAPA2(C1 = A2_MFMA(kf[1], qr[0], f32x16{}), P0[2], P0[3], pw0[1] = PKW(P0, 2), pw0); \
    kf[1] = KFR(5); FA_SBAR(); GAPA2(C0 = A2_MFMA(kf[2], qr[1], C0), P0[4], P0[5], pw0[2] = PKW(P0, 4), pw0); \
    kf[2] = KFR(6); FA_SBAR(); GAPA2(C1 = A2_MFMA(kf[3], qr[1], C1), P0[6], P0[7], pw0[3] = PKW(P0, 6), pw0); \
    kf[3] = KFR(7); FA_SBAR(); GAPA2(C0 = A2_MFMA(kf[0], qr[2], C0), P0[8], P0[9], pw1[0] = PKW(P0, 8), pw1); \
    kf[0] = KFR(8); FA_SBAR(); GAPA2(C1 = A2_MFMA(kf[1], qr[2], C1), P0[10], P0[11], pw1[1] = PKW(P0, 10), pw1); \
    kf[1] = KFR(9); FA_SBAR(); GAPA2(C0 = A2_MFMA(kf[2], qr[3], C0), P0[12], P0[13], pw1[2] = PKW(P0, 12), pw1); \
    kf[2] = KFR(10); FA_SBAR(); GAPA2(C1 = A2_MFMA(kf[3], qr[3], C1), P0[14], P0[15], pw1[3] = PKW(P0, 14), pw1); \
    kf[3] = KFR(11); FA_SBAR(); GAPA2(C0 = A2_MFMA(kf[0], qr[4], C0), P1[0], P1[1], pw2[0] = PKW(P1, 0), pw2); \
    kf[0] = KFR(12); FA_SBAR(); GAPA2(C1 = A2_MFMA(kf[1], qr[4], C1), P1[2], P1[3], pw2[1] = PKW(P1, 2), pw2); \
    kf[1] = KFR(13); FA_SBAR(); GAPA2(C0 = A2_MFMA(kf[2], qr[5], C0), P1[4], P1[5], pw2[2] = PKW(P1, 4), pw2); \
    kf[2] = KFR(14); FA_SBAR(); GAPA2(C1 = A2_MFMA(kf[3], qr[5], C1), P1[6], P1[7], pw2[3] = PKW(P1, 6), pw2); \
    kf[3] = KFR(15); FA_SBAR(); GAPA2(C0 = A2_MFMA(kf[0], qr[6], C0), P1[8], P1[9], pw3[0] = PKW(P1, 8), pw3); \
    kf[0] = KFR(16); FA_SBAR(); GAPA2(C1 = A2_MFMA(kf[1], qr[6], C1), P1[10], P1[11], pw3[1] = PKW(P1, 10), pw3); \
    kf[1] = KFR(17); FA_SBAR(); GAPA2(C0 = A2_MFMA(kf[2], qr[7], C0), P1[12], P1[13], pw3[2] = PKW(P1, 12), pw3); \
    kf[2] = KFR(18); FA_SBAR(); GAPA2(C1 = A2_MFMA(kf[3], qr[7], C1), P1[14], P1[15], pw3[3] = PKW(P1, 14), pw3); \
    kf[3] = KFR(19); FA_SBAR(); GAPA0(C0 = A2_MFMA(kf[0], qr[8], C0)); \
    kf[0] = KFR(20); FA_SBAR(); GAPA0(C1 = A2_MFMA(kf[1], qr[8], C1)); \
    kf[1] = KFR(21); FA_SBAR(); GAPA0(C0 = A2_MFMA(kf[2], qr[9], C0)); \
    kf[2] = KFR(22); FA_SBAR(); GAPA0(C1 = A2_MFMA(kf[3], qr[9], C1)); \
    kf[3] = KFR(23); FA_SBAR(); GAPA0(C0 = A2_MFMA(kf[0], qr[10], C0)); \
    VRD(0); FA_SBAR(); GAPA0(C1 = A2_MFMA(kf[1], qr[10], C1)); \
    VRD(1); FA_SBAR(); GAPA0(C0 = A2_MFMA(kf[2], qr[11], C0)); \
    VRD(2); FA_SBAR(); GAPA0(C1 = A2_MFMA(kf[3], qr[11], C1)); \
    l_reg += sacc; \
    if (GK) { DMA_K((t) + 3, ks_dma); } if (GV) { DMA_V((t) + 1, vs_dma); } \
    { float a = A2_MX3(C0[0], C0[1], C1[0]), b = A2_MX3(C0[2], C0[3], C1[1]); a = A2_MX3(a, C1[2], C1[3]); \
      _Pragma("unroll") for (int r = 4; r < 16; r += 4) { a = A2_MX3(a, C0[r], C0[r + 1]); b = A2_MX3(b, C0[r + 2], C0[r + 3]); a = A2_MX3(a, C1[r], C1[r + 1]); b = A2_MX3(b, C1[r + 2], C1[r + 3]); } \
      float rm = __builtin_fmaxf(a, b); { auto rr = __builtin_amdgcn_permlane32_swap(__float_as_uint(rm), __float_as_uint(rm), false, false); rm = __builtin_fmaxf(__uint_as_float(rr[0]), __uint_as_float(rr[1])); } \
      rm -= mhat; resc = false; \
      if (__builtin_expect(__any(rm > (float)THRL), 0)) { const float dl = __builtin_fmaxf(rm, 0.f); mhat += dl;                         \
        const float f = __builtin_amdgcn_exp2f(-dl); l_reg *= f; if (hi == 0) wsf[r32] = f; resc = true; } } \
    const float mh = mhat; const lds_cptr kn_ = kp0 + ks_next; FA_SBAR(); \
    VRD(3); FA_SBAR(); GAPB(0, PAF(0), C0, 0); \
    VRD(4); FA_SBAR(); GAPB(1, PAF(0), C0, 2); \
    VRD(5); FA_SBAR(); GAPB(2, PAF(0), C0, 4); \
    VRD(6); FA_SBAR(); GAPB(3, PAF(0), C0, 6); \
    VRD(7); FA_SBAR(); GAPB(4, PAF(1), C0, 8); \
    VRD(8); FA_SBAR(); GAPB(5, PAF(1), C0, 10); \
    VRD(9); FA_SBAR(); GAPB(6, PAF(1), C0, 12); \
    VRD(10); FA_SBAR(); GAPB(7, PAF(1), C0, 14); \
    VRD(11); FA_SBAR(); GAPB(8, PAF(2), C1, 0); \
    VRD(12); FA_SBAR(); GAPB(9, PAF(2), C1, 2); \
    VRD(13); FA_SBAR(); GAPB(10, PAF(2), C1, 4); \
    VRD(14); FA_SBAR(); GAPB(11, PAF(2), C1, 6); \
    VRD(15); FA_SBAR(); GAPB(12, PAF(3), C1, 8); \
    if (GL) { kf[0] = kfr(kn_ + kx[0]); FA_SBAR(); } GAPB(13, PAF(3), C1, 10); \
    if (GL) { kf[1] = kfr(kn_ + kx[0] + 4096); FA_SBAR(); } GAPB(14, PAF(3), C1, 12); \
    if (GL) { kf[2] = kfr(kn_ + kx[1]); FA_SBAR(); } GAPB(15, PAF(3), C1, 14); \
    } while (0)
    int t = 1;
    for (; t + 5 < NT; t += 2) {
        STEP(pB0, pB1, pA0, pA1, t, true, true, true);     A2_WAIT_BAR(5); RESC(); ROT();
        STEP(pA0, pA1, pB0, pB1, t + 1, true, true, true); A2_WAIT_BAR(5); RESC(); ROT();
    }
#define ENDW(tt) do { if ((tt) + 3 < NT) { A2_WAIT_BAR(5); } else if ((tt) + 2 < NT) { A2_WAIT_BAR(2); } else { A2_WAIT_BAR(0); } } while (0)
    for (; t + 1 < NT; t += 2) {
        STEP(pB0, pB1, pA0, pA1, t, (t + 3 < NT), (t + 1 < NT), (t + 1 < NT));         ENDW(t);     RESC(); ROT();
        STEP(pA0, pA1, pB0, pB1, t + 1, (t + 4 < NT), (t + 2 < NT), (t + 2 < NT));     ENDW(t + 1); RESC(); ROT();
    }
    STEP(pB0, pB1, pA0, pA1, NT - 1, false, false, false); RESC();
    { float sacc = pB0[0] + pB0[1];
#pragma unroll
      for (int r = 2; r < 16; ++r) sacc += pB0[r];
#pragma unroll
      for (int r = 0; r < 16; ++r) sacc += pB1[r];
      l_reg += sacc;
      pw0 = (u32x4){PKW(pB0, 0), PKW(pB0, 2), PKW(pB0, 4), PKW(pB0, 6)}; pw1 = (u32x4){PKW(pB0, 8), PKW(pB0, 10), PKW(pB0, 12), PKW(pB0, 14)};
      pw2 = (u32x4){PKW(pB1, 0), PKW(pB1, 2), PKW(pB1, 4), PKW(pB1, 6)}; pw3 = (u32x4){PKW(pB1, 8), PKW(pB1, 10), PKW(pB1, 12), PKW(pB1, 14)};
      const lds_cptr vp_ = vp0 + vs_cur; const lds_cptr vq_ = vp1 + vs_cur;
      VRD(0); VRD(1); VRD(2); VRD(3);
      o[0] = A2_MFMA(PAF(0), VFR(0), o[0]); o[1] = A2_MFMA(PAF(0), VFR(1), o[1]); o[2] = A2_MFMA(PAF(0), VFR(2), o[2]); o[3] = A2_MFMA(PAF(0), VFR(3), o[3]); FA_SBAR();
      VRD(4); VRD(5); VRD(6); VRD(7);
      o[0] = A2_MFMA(PAF(1), VFR(0), o[0]); o[1] = A2_MFMA(PAF(1), VFR(1), o[1]); o[2] = A2_MFMA(PAF(1), VFR(2), o[2]); o[3] = A2_MFMA(PAF(1), VFR(3), o[3]); FA_SBAR();
      VRD(8); VRD(9); VRD(10); VRD(11);
      o[0] = A2_MFMA(PAF(2), VFR(0), o[0]); o[1] = A2_MFMA(PAF(2), VFR(1), o[1]); o[2] = A2_MFMA(PAF(2), VFR(2), o[2]); o[3] = A2_MFMA(PAF(2), VFR(3), o[3]); FA_SBAR();
      VRD(12); VRD(13); VRD(14); VRD(15);
      o[0] = A2_MFMA(PAF(3), VFR(0), o[0]); o[1] = A2_MFMA(PAF(3), VFR(1), o[1]); o[2] = A2_MFMA(PAF(3), VFR(2), o[2]); o[3] = A2_MFMA(PAF(3), VFR(3), o[3]); }
    { auto rr = __builtin_amdgcn_permlane32_swap(__float_as_uint(l_reg), __float_as_uint(l_reg), false, false); l_reg = __uint_as_float(rr[0]) + __uint_as_float(rr[1]); }
    if (hi == 0) wsf[32 + r32] = l_reg; asm volatile("s_waitcnt lgkmcnt(0)" ::: "memory");
    float rli[16];
#pragma unroll
    for (int r = 0; r < 16; ++r) rli[r] = __builtin_amdgcn_rcpf(wsf[32 + crow(r, hi)]);
    { u16* Ow = Ob + (long)(wid * QBLK) * LDO;
#pragma unroll
      for (int r = 0; r < 16; ++r) { const int orow = crow(r, hi);
#pragma unroll
          for (int d0 = 0; d0 < 4; ++d0) Ow[(long)orow * LDO + d0 * 32 + r32] = (u16)f2bf(o[d0][r] * rli[r]); } }
#undef A2_ROW0
#undef DMA_K
#undef DMA_V
#undef ROT
#undef RESC
#undef KFR
#undef PKW
#undef PAF
#undef VFR
#undef VRD
#undef GAPA2
#undef GAPA0
#undef GAPB
#undef STEP
#undef ENDW
}

template <int DQ, int SPLIT8>
__device__ __forceinline__ void attn_unit_sp(const u16* __restrict__ Qb, int LDQ, const KVSrc S, u16* __restrict__ Ob, int LDO, int NT, char* lds) {
    using C = Cfg<DQ>;
    constexpr int NK = C::NK, NCH = C::NCH, KPT = C::KPT, KPT0 = SPLIT8 / 8, NCH1 = NCH - SPLIT8;
    constexpr size_t SHM_K = C::SHM_K;
    int tid_ = threadIdx.x; asm volatile("" : "+v"(tid_));
    const int tid = tid_, wid = tid >> 6, lane = tid & 63, r32 = lane & 31, hi = lane >> 5;
    char* V_lds = lds; char* K_lds = lds + 2 * SHM_V;
    float* wsf = (float*)(lds + 2 * SHM_V + 2 * SHM_K) + wid * 64; float* li_l = wsf; float* al_l = wsf + 32;
    float m_reg = -1e30f, l_reg = 0; f32x16 o[4] = {}; bf16x8 qr[NK];
    { const u16* Qw = Qb + (long)(wid * QBLK + r32) * LDQ + hi * 8;
#pragma unroll
      for (int d0 = 0; d0 < NK; ++d0) qr[d0] = *reinterpret_cast<const bf16x8*>(Qw + d0 * 16); }
    const int sr = tid >> 4, sc = (tid & 15) * 8, vst0 = v_st(sr, sc), vst1 = v_st(32 + sr, sc);
    const int vb0 = (int)(uintptr_t)V_lds + v_rd_base(lane);
    int koff[KPT], kw[KPT];
#pragma unroll
    for (int i = 0; i < KPT; ++i) {
        if (i < KPT0) { const int c = tid + 512 * i, row = c / SPLIT8, c8 = c % SPLIT8; koff[i] = row * S.kst0 + c8 * 8; kw[i] = C::kswz(row, c8 * 16); }
        else { const int c = tid + 512 * (i - KPT0), row = c / (NCH1 > 0 ? NCH1 : 1), c8 = c % (NCH1 > 0 ? NCH1 : 1); koff[i] = row * S.kst1 + c8 * 8; kw[i] = C::kswz(row, (SPLIT8 + c8) * 16); } }
    const int voff0 = sr * S.vst + sc, voff1 = (32 + sr) * S.vst + sc;
    bf16x8 vs0, vs1, ks[KPT];
#define FA_ROW0(kt) ((kt) < 4 ? S.xrow0 + 64 * (kt) : S.lrow0 + 64 * ((kt) - 4))
#define FA_SLOAD(kt) do { const long _r = FA_ROW0(kt); const u16* _v = S.v + _r * S.vst; const u16* _k0 = S.k0 + _r * S.kst0; const u16* _k1 = S.k1 + _r * S.kst1; \
    vs0 = *reinterpret_cast<const bf16x8*>(_v + voff0); vs1 = *reinterpret_cast<const bf16x8*>(_v + voff1); \
    _Pragma("unroll") for (int _q = 0; _q < KPT; ++_q) ks[_q] = *reinterpret_cast<const bf16x8*>((_q < KPT0 ? _k0 : _k1) + koff[_q]); } while (0)
#define FA_SWRITE(b) do { *(bf16x8*)(V_lds + (b) * SHM_V + vst0) = vs0; *(bf16x8*)(V_lds + (b) * SHM_V + vst1) = vs1; \
    _Pragma("unroll") for (int _q = 0; _q < KPT; ++_q) *(bf16x8*)(K_lds + (b) * SHM_K + kw[_q]) = ks[_q]; } while (0)
    f32x16 p0, p1; float mn, al; bf16x8 pa0, pa1, pa2, pa3;
    FA_SLOAD(0); asm volatile("s_waitcnt vmcnt(0)" ::: "memory"); FA_SWRITE(0); __syncthreads();
    for (int j = 0; j < NT; ++j) {
        const int b = j & 1;
        FA_SBAR(); qkt<DQ>(p0, p1, K_lds + b * SHM_K, qr, r32, hi);
        partialSM<DQ>(p0, p1, m_reg, mn, al);
        if (__any(al < 1.f)) { if (hi == 0) al_l[r32] = al; asm volatile("s_waitcnt lgkmcnt(0)" ::: "memory");
#pragma unroll
            for (int d = 0; d < 4; ++d)
#pragma unroll
                for (int r = 0; r < 16; ++r) o[d][r] *= al_l[crow(r, hi)]; }
        finishSM(p0, p1, al, l_reg, pa0, pa1, pa2, pa3); FA_SBAR();
        if (j + 1 < NT) FA_SLOAD(j + 1);
        FA_SBAR();
        pv_d0(o, vb0 + b * (int)SHM_V, pa0, pa1, pa2, pa3);
        if (j + 1 < NT) { asm volatile("s_waitcnt vmcnt(0)" ::: "memory"); FA_SWRITE(b ^ 1); }
        __syncthreads();
    }
    if (hi == 0) li_l[r32] = l_reg; asm volatile("s_waitcnt lgkmcnt(0)" ::: "memory");
    float rli[16];
#pragma unroll
    for (int r = 0; r < 16; ++r) rli[r] = __builtin_amdgcn_rcpf(li_l[crow(r, hi)]);
    u16* Ow = Ob + (long)(wid * QBLK) * LDO;
#pragma unroll
    for (int r = 0; r < 16; ++r) { const int orow = crow(r, hi);
#pragma unroll
        for (int d0 = 0; d0 < 4; ++d0) Ow[(long)orow * LDO + d0 * 32 + r32] = (u16)f2bf(o[d0][r] * rli[r]); }
#undef FA_ROW0
#undef FA_SLOAD
#undef FA_SWRITE
}
}


namespace gla {
typedef short bf16x8 __attribute__((ext_vector_type(8)));
typedef unsigned u32x4g __attribute__((ext_vector_type(4)));
typedef unsigned u32x2 __attribute__((ext_vector_type(2)));
constexpr int P = 72;
constexpr int ARR = 64 * P * 2;
constexpr int OFF_SET = 5 * ARR;
constexpr int OFF_ATT = 2 * OFF_SET, OFF_ST = OFF_ATT + ARR  , OFF_SEG = OFF_ST + 2 * ARR, OFF_DEC = OFF_SEG + 8 * 64 * 4, LDS_END = OFF_DEC + 2 * 64 * 4;
static_assert(LDS_END <= 131072, "GLA LDS map");
static_assert(fa::A2_END <= MISC_BASE && fa::A1_END <= MISC_BASE, "attention LDS map");
__device__ __forceinline__ bf16x8 ldfrag(const LAS unsigned char* arr, int row, int colb) { return *(const LAS bf16x8*)(arr + row * (P * 2) + colb); }
#define GLA_MFMA(a, b, c) __builtin_amdgcn_mfma_f32_16x16x32_bf16(a, b, c, 0, 0, 0)
__device__ __forceinline__ void unit(LAS unsigned char* lds, const u16* PARTS, const float* wg, const float* bg, int caf, u16* Od, int b, int h, int dir) {
    int tid_ = threadIdx.x; asm volatile("" : "+v"(tid_));
    const int tid = tid_, lane = tid & 63, w = __builtin_amdgcn_readfirstlane(tid >> 6);
    const int r16 = lane & 15, fq = lane >> 4;
    const int it = w & 3, jt0 = 2 * (w >> 2);
    float wgr[16];
#pragma unroll
    for (int j = 0; j < 16; ++j) wgr[j] = wg[j * 256 + h * 64 + lane];
    const float bgr = bg[h * 64 + lane];
    f32x4 S[2][2];
#pragma unroll
    for (int vh = 0; vh < 2; ++vh)
#pragma unroll
        for (int j = 0; j < 2; ++j) S[vh][j] = (f32x4){0.f, 0.f, 0.f, 0.f};
    for (int e = tid; e < 2 * ARR / 4; e += 512) ((LAS unsigned*)(lds + OFF_ST))[e] = 0u;
    auto rowof = [&](int pos) { return pos < CTXL ? (ML + b * CTXL + (dir ? CTXL - 1 - pos : pos)) : (b * SEQ + (dir ? SEQ - 1 - (pos - CTXL) : (pos - CTXL))); };
    unsigned short qv[8], kv[8], vv[8][2]; float afv[8];
#define GLA_LOAD(n) do { _Pragma("unroll") for (int i = 0; i < 8; ++i) { const int row = rowof((n) * 64 + 8 * w + i); const u16* pr = PARTS + (size_t)row * IN_AP; \
        qv[i] = pr[C_GQ + h * 64 + lane]; kv[i] = pr[C_GK + h * 64 + lane]; vv[i][0] = pr[C_GV + h * 128 + lane]; vv[i][1] = pr[C_GV + h * 128 + 64 + lane]; afv[i] = bf2f(pr[caf + (lane & 15)]); } } while (0)
    GLA_LOAD(0);
    constexpr int NCHUNK = (CTXL + SEQ) / 64;
    for (int n = 0; n < NCHUNK; ++n) {
        LAS unsigned char* Qt = lds + (n & 1) * OFF_SET; LAS unsigned char* Kt = Qt + ARR; LAS unsigned char* KhT = Kt + ARR; LAS unsigned char* Vt = KhT + ARR;
        LAS unsigned char* St = lds + OFF_ST; LAS unsigned char* At = lds + OFF_ATT;
        LAS float* seg = (LAS float*)(lds + OFF_SEG); LAS float* dec = (LAS float*)(lds + OFF_DEC) + (n & 1) * 64;
        float c[8]; float run = 0.f;
#pragma unroll
        for (int i = 0; i < 8; ++i) { float pre = bgr;
#pragma unroll
            for (int j = 0; j < 16; ++j) pre += __int_as_float(__builtin_amdgcn_readlane(__float_as_int(afv[i]), j)) * wgr[j];
            const float ls = fminf(pre, 0.f) - __logf(1.0f + __expf(-fabsf(pre)));
            run += ls * (1.0f / 16.0f); c[i] = run; }
        seg[w * 64 + lane] = run;
        __syncthreads();
        float prefix = 0.f, last = 0.f;
#pragma unroll
        for (int ww = 0; ww < 8; ++ww) { const float t = seg[ww * 64 + lane]; last += t; prefix += (ww < w) ? t : 0.f; }
        const float elast = __expf(last);
        unsigned khp[4], vtp[2][4];
#pragma unroll
        for (int i = 0; i < 8; ++i) { const int s = 8 * w + i; const float cum = prefix + c[i]; const float e = __expf(cum), ie = __builtin_amdgcn_rcpf(e), kf = bf2f(kv[i]);
            ((LAS u16*)Qt)[s * P + lane] = (u16)f2bf(bf2f(qv[i]) * 0.125f * e);
            const float kt = kf * ie;
            ((LAS u16*)Kt)[s * P + lane] = (u16)f2bf(kt);
            const unsigned kh = f2bf(kt * elast);
            if (i & 1) { khp[i >> 1] |= kh << 16; vtp[0][i >> 1] |= (unsigned)vv[i][0] << 16; vtp[1][i >> 1] |= (unsigned)vv[i][1] << 16; }
            else { khp[i >> 1] = kh; vtp[0][i >> 1] = vv[i][0]; vtp[1][i >> 1] = vv[i][1]; } }
        *(LAS u32x4g*)(KhT + (lane * P + 8 * w) * 2) = (u32x4g){khp[0], khp[1], khp[2], khp[3]};
        *(LAS u32x4g*)(Vt + (lane * P + 8 * w) * 2) = (u32x4g){vtp[0][0], vtp[0][1], vtp[0][2], vtp[0][3]};
        *(LAS u32x4g*)(Vt + ((64 + lane) * P + 8 * w) * 2) = (u32x4g){vtp[1][0], vtp[1][1], vtp[1][2], vtp[1][3]};
        if (w == 0) dec[lane] = elast;
        __syncthreads();
        if (n + 1 < NCHUNK) GLA_LOAD(n + 1);
        f32x4 a0 = {0.f, 0.f, 0.f, 0.f}, a1 = a0; f32x4 o[2][2] = {{a0, a0}, {a0, a0}};
#pragma unroll
        for (int ks = 0; ks < 2; ++ks) { const int cb = ks * 64 + fq * 16;
            const bf16x8 A = ldfrag(Kt, 16 * it + r16, cb), Bq0 = ldfrag(Qt, 16 * jt0 + r16, cb), Bq1 = ldfrag(Qt, 16 * (jt0 + 1) + r16, cb);
            const bf16x8 As0 = ldfrag(St, 16 * it + r16, cb), As1 = ldfrag(St, 64 + 16 * it + r16, cb);
            a0 = GLA_MFMA(A, Bq0, a0); a1 = GLA_MFMA(A, Bq1, a1);
            o[0][0] = GLA_MFMA(As0, Bq0, o[0][0]); o[0][1] = GLA_MFMA(As0, Bq1, o[0][1]);
            o[1][0] = GLA_MFMA(As1, Bq0, o[1][0]); o[1][1] = GLA_MFMA(As1, Bq1, o[1][1]); }
        { const int s0 = 16 * it + 4 * fq; const int t0 = 16 * jt0 + r16, t1 = t0 + 16;
          u32x2 p0, p1;
          p0.x = f2bf(s0 + 0 <= t0 ? a0[0] : 0.f) | (f2bf(s0 + 1 <= t0 ? a0[1] : 0.f) << 16); p0.y = f2bf(s0 + 2 <= t0 ? a0[2] : 0.f) | (f2bf(s0 + 3 <= t0 ? a0[3] : 0.f) << 16);
          p1.x = f2bf(s0 + 0 <= t1 ? a1[0] : 0.f) | (f2bf(s0 + 1 <= t1 ? a1[1] : 0.f) << 16); p1.y = f2bf(s0 + 2 <= t1 ? a1[2] : 0.f) | (f2bf(s0 + 3 <= t1 ? a1[3] : 0.f) << 16);
          *(LAS u32x2*)(At + (t0 * P + s0) * 2) = p0; *(LAS u32x2*)(At + (t1 * P + s0) * 2) = p1; }
        __syncthreads();
        const f32x4 d4 = *(const LAS f32x4*)(dec + 16 * it + 4 * fq);
#pragma unroll
        for (int vh = 0; vh < 2; ++vh)
#pragma unroll
            for (int j = 0; j < 2; ++j) S[vh][j] = S[vh][j] * d4;
#pragma unroll
        for (int ks = 0; ks < 2; ++ks) { const int cb = ks * 64 + fq * 16;
            const bf16x8 Ba0 = ldfrag(At, 16 * jt0 + r16, cb), Ba1 = ldfrag(At, 16 * (jt0 + 1) + r16, cb), Ak = ldfrag(KhT, 16 * it + r16, cb);
#pragma unroll
            for (int vh = 0; vh < 2; ++vh) {
                const bf16x8 Av = ldfrag(Vt, 64 * vh + 16 * it + r16, cb), Bv0 = ldfrag(Vt, 64 * vh + 16 * jt0 + r16, cb), Bv1 = ldfrag(Vt, 64 * vh + 16 * (jt0 + 1) + r16, cb);
                o[vh][0] = GLA_MFMA(Av, Ba0, o[vh][0]); o[vh][1] = GLA_MFMA(Av, Ba1, o[vh][1]);
                S[vh][0] = GLA_MFMA(Ak, Bv0, S[vh][0]); S[vh][1] = GLA_MFMA(Ak, Bv1, S[vh][1]); } }
        { const int v0 = 16 * it + 4 * fq, t0 = 16 * jt0 + r16, k0 = 16 * it + 4 * fq, vc0 = 16 * jt0 + r16;
          u16* od0 = Od + (size_t)rowof(n * 64 + t0) * 512 + h * 128 + v0; u16* od1 = Od + (size_t)rowof(n * 64 + t0 + 16) * 512 + h * 128 + v0;
#pragma unroll
          for (int vh = 0; vh < 2; ++vh) {
              u32x2 w0, w1; w0.x = f2bf(o[vh][0][0]) | (f2bf(o[vh][0][1]) << 16); w0.y = f2bf(o[vh][0][2]) | (f2bf(o[vh][0][3]) << 16);
              w1.x = f2bf(o[vh][1][0]) | (f2bf(o[vh][1][1]) << 16); w1.y = f2bf(o[vh][1][2]) | (f2bf(o[vh][1][3]) << 16);
              *(u32x2*)(od0 + vh * 64) = w0; *(u32x2*)(od1 + vh * 64) = w1;
              u32x2 q0, q1; q0.x = f2bf(S[vh][0][0]) | (f2bf(S[vh][0][1]) << 16); q0.y = f2bf(S[vh][0][2]) | (f2bf(S[vh][0][3]) << 16);
              q1.x = f2bf(S[vh][1][0]) | (f2bf(S[vh][1][1]) << 16); q1.y = f2bf(S[vh][1][2]) | (f2bf(S[vh][1][3]) << 16);
              *(LAS u32x2*)(St + ((64 * vh + vc0) * P + k0) * 2) = q0; *(LAS u32x2*)(St + ((64 * vh + vc0 + 16) * P + k0) * 2) = q1; } }
    }
#undef GLA_LOAD
}
#undef GLA_MFMA
}

__global__ void __launch_bounds__(512, 2) fwd_kernel(Args args) {
    extern __shared__ __attribute__((aligned(16))) unsigned char lds_raw[];
    LAS unsigned char* lds = (LAS unsigned char*)lds_raw;
    const int tid = threadIdx.x, lane = tid & 63, wave = __builtin_amdgcn_readfirstlane(tid >> 6);
    const int G = gridDim.x, gw = blockIdx.x * 8 + wave, NGW = G * 8;
    unsigned char* ws = args.ws;
    unsigned* ctl = (unsigned*)(ws + WS_CTL);
    volatile LAS unsigned* MISC = (volatile LAS unsigned*)(lds + MISC_OFF);
    for (int u = tid; u < (LDS_BYTES - MISC_BASE) / 4; u += 512) ((LAS unsigned*)(lds + MISC_BASE))[u] = 0u;
    __syncthreads();
    XcdBarrier bar = xcd_barrier_post(ctl + CW_BAR + args.li * 4096, MISC + 8);
    const int lo = args.ph_lo, hi = args.ph_hi;
#define IN(k) (lo <= (k) && (k) < hi)
#ifdef PROBE_AMP
    unsigned long long amp_t0 = 0;
#define PH_BEGIN(k) do { if ((PROBE_AMP >> (k)) & 1) amp_t0 = __builtin_amdgcn_s_memrealtime(); } while (0)
#define PH_END(k) do { if ((PROBE_AMP >> (k)) & 1) { const unsigned long long t1 = __builtin_amdgcn_s_memrealtime(); const unsigned long long tgt = t1 + 4ull * (t1 - amp_t0); \
        while (__builtin_amdgcn_s_memrealtime() < tgt) __builtin_amdgcn_s_sleep(32); } } while (0)
#else
#define PH_BEGIN(k) do {} while (0)
#define PH_END(k) do {} while (0)
#endif
#define GRID_BAR() xcd_barrier(bar)

    const float* x_in = args.in[0]; const float* c_in = args.in[1]; const float* ctx_in = args.in[2]; const float* cctx_in = args.in[3];
    const float* w_mod = args.in[4]; const float* b_mod = args.in[5];
    const float* g_pre_mix = args.in[6]; const float* g_post_mix = args.in[7]; const float* g_pre_ffn = args.in[8]; const float* g_post_ffn = args.in[9];
    const float* w_in_a = args.in[10]; const float* mla_g_q = args.in[11]; const float* mla_w_uq = args.in[12]; const float* mla_g_kv = args.in[13]; const float* mla_w_ukv = args.in[14];
    const float* gla_w_gf = args.in[15]; const float* gla_b_gf = args.in[16]; const float* gla_w_gb = args.in[17]; const float* gla_b_gb = args.in[18]; const float* gla_g_out = args.in[19];
    const float* w_out_a = args.in[20]; const float* w_qkv_c = args.in[21];
    const float* diff_lq1 = args.in[22]; const float* diff_lk1 = args.in[23]; const float* diff_lq2 = args.in[24]; const float* diff_lk2 = args.in[25]; const float* diff_g_out = args.in[26];
    const float* w_out_c = args.in[27]; const float* ffn_w_gate = args.in[28]; const float* ffn_w_up = args.in[29]; const float* ffn_w_down = args.in[30];
    const float* moe_w_router = args.in[31]; const float* moe_w_gate = args.in[32]; const float* moe_w_up = args.in[33]; const float* moe_w_down = args.in[34];
    float* out = args.out;
    float* MODB = (float*)(ws + WS_MOD);
    float* ROPEC = (float*)(ws + WS_ROPE); float* ROPES = ROPEC + 2048 * 32;
    int* TOKE = (int*)(ws + WS_TOKE); float* TOKG = (float*)(ws + WS_TOKG); int* TOKP = (int*)(ws + WS_TOKP);
    float* CTXS = (float*)(ws + WS_CTXS);
    u16* H0 = (u16*)(ws + WS_R0); u16* CAT = (u16*)(ws + WS_R0); u16* FB = (u16*)(ws + WS_R0); u16* O16 = (u16*)(ws + WS_R0); u16* Y2 = (u16*)(ws + WS_R0);
    u16* PARTS = (u16*)(ws + WS_PARTS); u16* YB = (u16*)(ws + WS_Y); u16* HB = (u16*)(ws + WS_Y);
    u16* H1 = (u16*)(ws + WS_H1); u16* CAT2 = (u16*)(ws + WS_H1);
    unsigned char* HC8 = ws + WS_HC;
    u16* A2 = (u16*)(ws + WS_A2); u16* KROPE = (u16*)(ws + WS_KROPE);
    u16* OF = (u16*)(ws + WS_R3); u16* OB = OF + (size_t)M * 512;
    u16* QKVUP = (u16*)(ws + WS_QKVUP); u16* HID = (u16*)(ws + WS_R3); u16* QKVC = (u16*)(ws + WS_R3);
    u16* W_IN = (u16*)(ws + WS_W);
    u16* W_UP = (u16*)(ws + WS_W + 4 * MiB);
    u16* W_OA = (u16*)(ws + WS_W + 4 * MiB + 1536 * 1024);
    u16* W_FGU = (u16*)(ws + WS_W + 7 * MiB + 512 * 1024);
    u16* W_FD = (u16*)(ws + WS_W + 18 * MiB + 512 * 1024);
    u16* W_QKV = (u16*)(ws + WS_W + 24 * MiB);
    u16* W_OC = (u16*)(ws + WS_W + 30 * MiB);
    unsigned char* W_MGU = ws + WS_WMGU; unsigned char* W_MD = ws + WS_WMD; unsigned char* XS8 = ws + WS_XS8; unsigned char* HID8 = ws + WS_R0;
    unsigned char* YS8 = ws + WS_YS; u16* XST = (u16*)(ws + WS_XST);
    unsigned char* W8_FGU = (unsigned char*)W_FGU; unsigned char* W8_FD = W8_FGU + (size_t)2 * FFN * 1024;
    unsigned char* H1_8 = (unsigned char*)H1; unsigned char* HIDL8 = (unsigned char*)HID;
    auto map_id = [](int n0) { return RowMap2{n0, 1}; };
    auto map_gate = [](int n0) { return RowMap2{(n0 >> 7) * 256 + (n0 & 127), 1}; };
    auto map_up = [](int n0) { return RowMap2{(n0 >> 7) * 256 + 128 + (n0 & 127), 1}; };
    auto map8_id = [](int n0) { return n0; };
    auto map8_gate = [](int n0) { return (n0 >> 7) * 256 + (n0 & 127); };
    auto map8_up = [](int n0) { return (n0 >> 7) * 256 + 128 + (n0 & 127); };

    if (IN(0)) {
        PH_BEGIN(0);
        LAS float* sT = (LAS float*)lds;
        LAS float* red = sT + 1024 * 20;
        { float cv[34];
#pragma unroll
          for (int i = 0; i < 34; ++i) { const int e = tid + 512 * i, r = e >> 10, k = e & 1023; cv[i] = r < 16 ? c_in[r * 1024 + k] : cctx_in[k]; }
#pragma unroll
          for (int i = 0; i < 34; ++i) { const int e = tid + 512 * i, r = e >> 10, k = e & 1023; sT[k * 20 + r] = silu_f(cv[i]); } }
        __syncthreads();
        for (int g = blockIdx.x; g < 192; g += G) {
            const int l = g / 96, n = (g % 96) * 64 + lane;
            const float* wp = w_mod + (size_t)l * 1024 * 6144 + n;
            float acc[17];
#pragma unroll
            for (int r = 0; r < 17; ++r) acc[r] = 0.f;
            const int kb = wave * 128;
            float wa[8], wb[8];
#pragma unroll
            for (int u = 0; u < 8; ++u) wa[u] = wp[(size_t)(kb + u) * 6144];
#pragma unroll 1
            for (int kk0 = 0; kk0 < 128; kk0 += 16) {
#pragma unroll
                for (int u = 0; u < 8; ++u) wb[u] = wp[(size_t)(kb + kk0 + 8 + u) * 6144];
#pragma unroll
                for (int u = 0; u < 8; ++u) { const LAS float* sp = sT + (kb + kk0 + u) * 20;
#pragma unroll
                    for (int r = 0; r < 17; ++r) acc[r] += sp[r] * wa[u];
                    __builtin_amdgcn_sched_barrier(0); }
                const int kn = (kk0 + 16 < 128) ? kk0 + 16 : kk0;
#pragma unroll
                for (int u = 0; u < 8; ++u) wa[u] = wp[(size_t)(kb + kn + u) * 6144];
#pragma unroll
                for (int u = 0; u < 8; ++u) { const LAS float* sp = sT + (kb + kk0 + 8 + u) * 20;
#pragma unroll
                    for (int r = 0; r < 17; ++r) acc[r] += sp[r] * wb[u];
                    __builtin_amdgcn_sched_barrier(0); }
            }
#pragma unroll
            for (int r = 0; r < 17; ++r) red[(wave * 17 + r) * 64 + lane] = acc[r];
            __syncthreads();
            for (int e = tid; e < 17 * 64; e += 512) { const int r = e >> 6, ln = e & 63; float s = 0.f;
#pragma unroll
                for (int w8 = 0; w8 < 8; ++w8) s += red[(w8 * 17 + r) * 64 + ln];
                const int nn = (g % 96) * 64 + ln;
                MODB[(size_t)(l * 17 + r) * 6144 + nn] = s + b_mod[l * 6144 + nn]; }
            __syncthreads();
        }
        for (int e = blockIdx.x * 512 + tid; e < 2048 * 32; e += G * 512) { const int t = e >> 5, i = e & 31; const int pos = i < 16 ? (t >> 6) : (t & 63);
            const float freq = powf(10000.0f, -(float)(i & 15) / 16.0f); const float ang = (float)pos * freq;
            ROPEC[e] = cosf(ang); ROPES[e] = sinf(ang); }
        __syncthreads();
        { LAS float* scr = (LAS float*)(lds + wave * 8448); int off = 0;
          cvt_matrix(w_in_a, 1024, IN_A, W_IN, 1024, 0, map_id, scr, lane, gw, NGW, off);
          cvt_matrix(mla_w_uq, 256, 768, W_UP, 384, 0, [](int n0) { const int h = n0 / 192, j = n0 % 192; return j < 128 ? RowMap2{n0, 1} : RowMap2{h * 192 + 128 + (j == 160 ? 1 : 0), 2}; }, scr, lane, gw, NGW, off);
          cvt_matrix(mla_w_ukv, 128, 1024, W_UP, 384, 256, [](int n0) { return RowMap2{768 + n0, 1}; }, scr, lane, gw, NGW, off);
          cvt_matrix(w_out_a, 1024, 1024, W_OA, 1024, 0, map_id, scr, lane, gw, NGW, off);
          cvt_matrix8(ffn_w_gate, 1024, FFN, W8_FGU, 1024, 64.0f, map8_gate, scr, lane, gw, NGW, off);
          cvt_matrix8(ffn_w_up, 1024, FFN, W8_FGU, 1024, 512.0f, map8_up, scr, lane, gw, NGW, off);
          cvt_matrix8(ffn_w_down, FFN, 1024, W8_FD, FFN, 64.0f, map8_id, scr, lane, gw, NGW, off);
          cvt_matrix(w_qkv_c, 1024, 3072, W_QKV, 1024, 0, [](int n0) { return n0 < 2048 ? RowMap2{(n0 & ~63) + ((n0 & 32) ? 1 : 0), 2} : RowMap2{n0, 1}; }, scr, lane, gw, NGW, off);
          cvt_matrix(w_out_c, 1024, 1024, W_OC, 1024, 0, map_id, scr, lane, gw, NGW, off);
          const uint4 z = make_uint4(0u, 0u, 0u, 0u);
          for (int e = blockIdx.x * 512 + tid; e < 32 * 128; e += G * 512) *(uint4*)(W_IN + (size_t)IN_A * 1024 + (size_t)e * 8) = z;
          for (int e = blockIdx.x * 512 + tid; e < 768 * 16; e += G * 512) { const int r = e >> 4, c8 = e & 15; *(uint4*)(W_UP + (size_t)r * 384 + 256 + c8 * 8) = z; }
          for (int e = blockIdx.x * 512 + tid; e < 1024 * 32; e += G * 512) { const int r = 768 + (e >> 5), c8 = e & 31; *(uint4*)(W_UP + (size_t)r * 384 + c8 * 8) = z; } }
        GRID_BAR(); PH_END(0);
    }
    if (IN(1)) {
        PH_BEGIN(1);
        { const int rpw = (M + NGW - 1) / NGW, rb = gw * rpw, re = (rb + rpw < M) ? rb + rpw : M;
          f32x4 gv[4], sh[4], sc[4]; ld_vec(g_pre_mix, lane, gv); int cur = -1;
          for (int row = rb; row < re; ++row) {
            const float* src = row < ML ? x_in + (size_t)row * 1024 : ctx_in + (size_t)(row - ML) * 1024;
            const int mr = row < ML ? (row >> 11) : 16;
            if (mr != cur) { ld_vec(modp(ws, 0, mr, 0), lane, sh); ld_vec(modp(ws, 0, mr, 1), lane, sc); cur = mr; }
            f32x4 xv[4], hv[4]; ld_row_f32(src, lane, xv);
            const float r = row_rstd(xv);
#pragma unroll
            for (int j = 0; j < 4; ++j) hv[j] = xv[j] * r * gv[j] * (1.0f + sc[j]) + sh[j];
            st_row_bf16(H0 + (size_t)row * 1024, lane, hv);
          } }
        GRID_BAR(); PH_END(1);
    }
    if (IN(2)) {
        PH_BEGIN(2);
        { pg8::Gemm g{H0, W_IN, 1024, 1024, 0, 0}; pg8::DenseOrder S; S.init(M / 256, IN_AP / 256, G, (int)blockIdx.x); pg8::EpiStore E{PARTS, IN_AP};
          pg8::gemm_phase<pg8::EpiStore, pg8::DenseOrder, PG8_ALIGN, PG8_SP2>(lds, g, S, E); }
        GRID_BAR(); PH_END(2);
    }
    if (IN(3)) {
        PH_BEGIN(3);
        { const bool split = (G % 16 == 0);
          const int role = (int)(blockIdx.x >> 3) & 1, ridx = (int)((blockIdx.x >> 4) << 3) | (int)(blockIdx.x & 7);
          const int eg = split ? ridx : (int)blockIdx.x, en = split ? G / 2 : G;
          unsigned* sb = ctl + CW_SUB + args.li * 128;
          if (!split || role == 0) {
            for (int row = eg * 8 + wave; row < M; row += en * 8) {
                const u16* pr = PARTS + (size_t)row * IN_AP;
                { const uint2 w = *(const uint2*)(pr + C_CQ + 4 * lane); float v[4] = {bf2f(w.x & 0xffffu), bf2f(w.x >> 16), bf2f(w.y & 0xffffu), bf2f(w.y >> 16)};
                  float s = wave_sum(v[0] * v[0] + v[1] * v[1] + v[2] * v[2] + v[3] * v[3]); const float r = 1.0f / sqrtf(s * (1.0f / 256.0f) + EPS);
                  const f32x4 g = *(const f32x4*)(mla_g_q + 4 * lane);
                  uint2 o; o.x = f2bf(v[0] * r * g.x) | (f2bf(v[1] * r * g.y) << 16); o.y = f2bf(v[2] * r * g.z) | (f2bf(v[3] * r * g.w) << 16);
                  *(uint2*)(A2 + (size_t)row * 384 + 4 * lane) = o; }
                { const unsigned w = *(const unsigned*)(pr + C_CKV + 2 * lane); float v0 = bf2f(w & 0xffffu), v1 = bf2f(w >> 16);
                  float s = wave_sum(v0 * v0 + v1 * v1); const float r = 1.0f / sqrtf(s * (1.0f / 128.0f) + EPS);
                  const float2 g = *(const float2*)(mla_g_kv + 2 * lane);
                  *(unsigned*)(A2 + (size_t)row * 384 + 256 + 2 * lane) = f2bf(v0 * r * g.x) | (f2bf(v1 * r * g.y) << 16); }
                if (lane < 32) { float x1 = bf2f(pr[C_KR + lane]), x2 = bf2f(pr[C_KR + 32 + lane]);
                  if (row < ML) { const int t = row & 2047; const float cs = ROPEC[t * 32 + lane], sn = ROPES[t * 32 + lane]; const float n1 = x1 * cs - x2 * sn, n2 = x2 * cs + x1 * sn; x1 = n1; x2 = n2; }
                  *(unsigned*)(KROPE + (size_t)row * 64 + 2 * lane) = f2bf(x1) | (f2bf(x2) << 16); }
            }
            sub_arrive(sb); sub_wait(sb, (unsigned)en);
            { pg8::Gemm g{A2, W_UP, 384, 384, 0, 0}; pg8::DenseOrder S; S.init(M / 256, UPN / 256, en, eg); pg8::EpiStoreRope<1> E{QKVUP, UPN, ROPEC, ROPES};
              pg8::gemm_phase<pg8::EpiStoreRope<1>, pg8::DenseOrder, PG8_ALIGN, PG8_SP2>(lds, g, S, E); }
            sub_arrive(sb + 64);
          }
          if (!split || role) {
              for (int u = split ? ridx : (int)blockIdx.x; u < 128; u += split ? G / 2 : G) {
                  const int dir = u & 1, h = (u >> 1) & 3, b = u >> 3;
                  __syncthreads();
                  gla::unit(lds, PARTS, dir ? gla_w_gb : gla_w_gf, dir ? gla_b_gb : gla_b_gf, dir ? C_AB : C_AF, dir ? OB : OF, b, h, dir);
              } }
          __syncthreads();
          sub_wait(sb + 64, (unsigned)en);
          const int NU_L = NB * 4 * 8, NU_X = NB * 4;
          LAS unsigned* qslot = (LAS unsigned*)(lds + MISC_BASE + 64);
          for (;;) {
            __syncthreads();
            if (tid == 0) *qslot = atomicAdd(ctl + CW_ATQ, 1u);
            __syncthreads();
            const int u = (int)*qslot;
            if (u >= NU_L + NU_X) break;
            const bool isx = u >= NU_L; const int uu = isx ? u - NU_L : u;
            const int qb = isx ? 0 : (uu & 7), h = isx ? (uu & 3) : ((uu >> 3) & 3), b = isx ? (uu >> 2) : (uu >> 5);
            const int r0 = isx ? (ML + b * CTXL) : (b * SEQ + qb * 256);
            fa::KVSrc S; S.k0 = QKVUP + 768 + h * 256; S.kst0 = UPN; S.k1 = KROPE; S.kst1 = 64; S.split8 = 16; S.v = QKVUP + 768 + h * 256 + 128; S.vst = UPN;
            S.xrow0 = ML + b * CTXL; S.lrow0 = b * SEQ;
            fa::attn192_unit<8>(QKVUP + (size_t)r0 * UPN + h * 192, UPN, S, CAT + (size_t)r0 * 1024 + h * 128, 1024, isx ? 4 : 36, (char*)lds_raw);
          } }
        GRID_BAR();
        { const int h = lane >> 4, v0 = (lane & 15) * 8;
          auto e4row = [&](int row, const uint4 wf, const uint4 wb, const uint4 wr4) {

            const unsigned af[4] = {wf.x, wf.y, wf.z, wf.w}, ab[4] = {wb.x, wb.y, wb.z, wb.w};
            float o[8]; float s = 0.f;
#pragma unroll
            for (int i = 0; i < 4; ++i) { o[2 * i] = bf2f(af[i] & 0xffffu) + bf2f(ab[i] & 0xffffu); o[2 * i + 1] = bf2f(af[i] >> 16) + bf2f(ab[i] >> 16); s += o[2 * i] * o[2 * i] + o[2 * i + 1] * o[2 * i + 1]; }
#pragma unroll
            for (int off = 1; off < 2; ++off) s = row16_sum(s);
            const float r = 1.0f / sqrtf(s * (1.0f / 128.0f) + EPS);
            const unsigned ar[4] = {wr4.x, wr4.y, wr4.z, wr4.w};
            unsigned ow[4];
#pragma unroll
            for (int i = 0; i < 4; ++i) { const float a = o[2 * i] * r * gla_g_out[v0 + 2 * i] * silu_f(bf2f(ar[i] & 0xffffu)), b2 = o[2 * i + 1] * r * gla_g_out[v0 + 2 * i + 1] * silu_f(bf2f(ar[i] >> 16)); ow[i] = f2bf(a) | (f2bf(b2) << 16); }
            *(uint4*)(CAT + (size_t)row * 1024 + 512 + h * 128 + v0) = make_uint4(ow[0], ow[1], ow[2], ow[3]);
                  };
          for (int row = gw; row < M; row += 2 * NGW) {
            const int row2 = row + NGW, rl2 = row2 < M ? row2 : row;
            const uint4 wf = *(const uint4*)(OF + (size_t)row * 512 + h * 128 + v0), wb = *(const uint4*)(OB + (size_t)row * 512 + h * 128 + v0);
            const uint4 wr4 = *(const uint4*)(PARTS + (size_t)row * IN_AP + C_GR + h * 128 + v0);
            const uint4 wf2 = *(const uint4*)(OF + (size_t)rl2 * 512 + h * 128 + v0), wb2 = *(const uint4*)(OB + (size_t)rl2 * 512 + h * 128 + v0);
            const uint4 wr42 = *(const uint4*)(PARTS + (size_t)rl2 * IN_AP + C_GR + h * 128 + v0);
            e4row(row, wf, wb, wr4);
            if (row2 < M) e4row(row2, wf2, wb2, wr42);
          } }
        GRID_BAR(); PH_END(3);
    }
    if (IN(6)) {
        PH_BEGIN(6);
        { pg8::Gemm g{CAT, W_OA, 1024, 1024, 0, 0}; pg8::DenseOrder S; S.init(M / 256, 4, G, (int)blockIdx.x); pg8::EpiStore E{YB, 1024};
          pg8::gemm_phase<pg8::EpiStore, pg8::DenseOrder, PG8_ALIGN, PG8_SP2>(lds, g, S, E); }
        GRID_BAR(); PH_END(6);
    }
    if (IN(7)) {
        PH_BEGIN(7);
        { const int rpw = (M + NGW - 1) / NGW, rb = gw * rpw, re = (rb + rpw < M) ? rb + rpw : M;
          f32x4 gpo[4], gpr[4], gt[4], sh[4], sc[4]; ld_vec(g_post_mix, lane, gpo); ld_vec(g_pre_ffn, lane, gpr); int cur = -1;
          for (int row = rb; row < re; ++row) {
            const float* src = row < ML ? x_in + (size_t)row * 1024 : ctx_in + (size_t)(row - ML) * 1024;
            const int mr = row < ML ? (row >> 11) : 16;
            if (mr != cur) { ld_vec(modp(ws, 0, mr, 2), lane, gt); ld_vec(modp(ws, 0, mr, 3), lane, sh); ld_vec(modp(ws, 0, mr, 4), lane, sc); cur = mr; }
            f32x4 xv[4], tv[4], hv[4]; ld_row_f32(src, lane, xv); ld_row_bf16(YB + (size_t)row * 1024, lane, tv);
            const float rt = row_rstd(tv);
#pragma unroll
            for (int j = 0; j < 4; ++j) xv[j] = xv[j] + gt[j] * (tv[j] * rt * gpo[j]);
            if (row < ML) st_row_bf16(XST + (size_t)row * 1024, lane, xv); else st_row_f32(CTXS + (size_t)(row - ML) * 1024, lane, xv);
            const float r = row_rstd(xv);
#pragma unroll
            for (int j = 0; j < 4; ++j) hv[j] = xv[j] * r * gpr[j] * (1.0f + sc[j]) + sh[j];
#pragma unroll
            for (int j = 0; j < 4; ++j) { unsigned t = 0u; t = __builtin_amdgcn_cvt_pk_fp8_f32(pg8::clamp8(hv[j].x), pg8::clamp8(hv[j].y), t, false); t = __builtin_amdgcn_cvt_pk_fp8_f32(pg8::clamp8(hv[j].z), pg8::clamp8(hv[j].w), t, true);
                *(unsigned*)(H1_8 + (size_t)row * 1024 + 4 * lane + 256 * j) = t; }
          } }
        GRID_BAR(); PH_END(7);
    }
    if (IN(8)) {
        PH_BEGIN(8);
        { pg8::Gemm g{H1_8, W8_FGU, 1024, 1024, 0x7f7f7f7f, 0x79797979}; pg8::DenseOrder S; S.init(M / 256, 2 * FFN / 256, G, (int)blockIdx.x); pg8::EpiSwiglu8 E{HIDL8, FFN};
          pg8::gemm_phase<pg8::EpiSwiglu8, pg8::DenseOrder, PG8_ALIGN, PG8_SP2, 1>(lds, g, S, E); }
        GRID_BAR(); PH_END(8);
    }
    if (IN(9)) {
        PH_BEGIN(9);
        { pg8::Gemm g{HIDL8, W8_FD, FFN, FFN, 0x7c7c7c7c, 0x79797979}; pg8::DenseOrder S; S.init(M / 256, 4, G, (int)blockIdx.x); pg8::EpiStore E{FB, 1024};
          pg8::gemm_phase<pg8::EpiStore, pg8::DenseOrder, PG8_ALIGN, PG8_SP2, 1>(lds, g, S, E); }
        GRID_BAR(); PH_END(9);
    }
    if (IN(10)) {
        PH_BEGIN(10);
        { const int rpw = (M + NGW - 1) / NGW, rb = gw * rpw, re = (rb + rpw < M) ? rb + rpw : M;
          f32x4 gpo[4], gpr[4], gt[4], sh[4], sc[4]; ld_vec(g_post_ffn, lane, gpo); ld_vec(g_pre_mix + 1024, lane, gpr); int cur = -1;
          for (int row = rb; row < re; ++row) {
            const int mr = row < ML ? (row >> 11) : 16;
            if (mr != cur) { ld_vec(modp(ws, 0, mr, 5), lane, gt); ld_vec(modp(ws, 1, mr, 0), lane, sh); ld_vec(modp(ws, 1, mr, 1), lane, sc); cur = mr; }
            f32x4 xv[4], tv[4], hv[4];
            if (row < ML) ld_row_bf16(XST + (size_t)row * 1024, lane, xv); else ld_row_f32(CTXS + (size_t)(row - ML) * 1024, lane, xv);
            ld_row_bf16(FB + (size_t)row * 1024, lane, tv);
            const float rt = row_rstd(tv);
#pragma unroll
            for (int j = 0; j < 4; ++j) xv[j] = xv[j] + gt[j] * (tv[j] * rt * gpo[j]);
            if (row < ML) st_row_bf16(XST + (size_t)row * 1024, lane, xv); else st_row_f32(CTXS + (size_t)(row - ML) * 1024, lane, xv);
            const float r = row_rstd(xv);
#pragma unroll
            for (int j = 0; j < 4; ++j) hv[j] = xv[j] * r * gpr[j] * (1.0f + sc[j]) + sh[j];
            st_row_bf16(HB + (size_t)row * 1024, lane, hv);
          } }
        GRID_BAR(); PH_END(10);
    }
    if (IN(11)) {
        PH_BEGIN(11);
        { pg8::Gemm g{HB, W_QKV, 1024, 1024, 0, 0}; pg8::DenseOrder S; S.init(M / 256, 12, G, (int)blockIdx.x); pg8::EpiStoreRope<0> E{QKVC, 3072, ROPEC, ROPES};
          pg8::gemm_phase<pg8::EpiStoreRope<0>, pg8::DenseOrder, PG8_ALIGN, PG8_SP2>(lds, g, S, E); }
        GRID_BAR(); PH_END(11);
    }
    if (IN(12)) {
        PH_BEGIN(12);
        { const float s1 = wave_sum(diff_lq1[lane] * diff_lk1[lane]), s2 = wave_sum(diff_lq2[lane] * diff_lk2[lane]);
          const float lam = __int_as_float(__builtin_amdgcn_readfirstlane(__float_as_int(expf(s1) - expf(s2) + LAM_INIT)));
          const int NU = NB * 8 * 8;
          const bool xl = (G % 64 == 0); const int xq = (int)blockIdx.x & 7, xj = (int)blockIdx.x >> 3;
          for (int i = 0;; ++i) {
            int u; if (xl) { const int p = (i * (G / 64) + (xj >> 3)) * 8 + xq; if (p >= NB * 8) break; u = p * 8 + (xj & 7); } else { u = (int)blockIdx.x + i * G; if (u >= NU) break; }
            const int qb = u & 7, h = (u >> 3) & 7, b = u >> 6;
            const int r0 = b * SEQ + qb * 256;
            fa::KVSrc S; S.k0 = QKVC + 1024 + (2 * h) * 64; S.kst0 = 3072; S.k1 = QKVC; S.kst1 = 3072; S.split8 = 8; S.v = QKVC + 2048 + h * 128; S.vst = 3072;
            S.xrow0 = ML + b * CTXL; S.lrow0 = b * SEQ;
            __syncthreads();
            fa::attn64_unit<1, 8>(QKVC + (size_t)r0 * 3072 + (2 * h) * 64, 3072, S, 36, (char*)lds_raw);
            S.k0 += 64;
            __syncthreads();
            fa::attn64_unit<2, 8>(QKVC + (size_t)r0 * 3072 + (2 * h + 1) * 64, 3072, S, 36, (char*)lds_raw);
            fa::diff_combine<fa::A2_STASH1>((const char*)lds_raw, CAT2 + (size_t)r0 * 1024 + h * 128, 1024, lam, diff_g_out, 1.0f - LAM_INIT);
          } }
        GRID_BAR(); PH_END(12);
    }
    if (IN(14)) {
        PH_BEGIN(14);
        const bool split = (G % 16 == 0);
        const int role = (int)(blockIdx.x >> 3) & 1, ridx = (int)((blockIdx.x >> 4) << 3) | (int)(blockIdx.x & 7);
        if (!split || role) {
            LAS float* scr = (LAS float*)(lds + wave * 8448); int off = 0;
            const int cgw = split ? ridx * 8 + wave : gw, cng = split ? NGW / 2 : NGW;
#pragma unroll 1
            for (int e = 0; e < NE; ++e) {
                cvt_matrix8(moe_w_gate + (size_t)e * 1024 * ED, 1024, ED, W_MGU + (size_t)e * 2 * ED * 1024, 1024, 64.0f, map8_gate, scr, lane, cgw, cng, off);
                cvt_matrix8(moe_w_up + (size_t)e * 1024 * ED, 1024, ED, W_MGU + (size_t)e * 2 * ED * 1024, 1024, 512.0f, map8_up, scr, lane, cgw, cng, off);
                cvt_matrix8(moe_w_down + (size_t)e * ED * 1024, ED, 1024, W_MD + (size_t)e * 1024 * ED, ED, 64.0f, map8_id, scr, lane, cgw, cng, off); }
            __syncthreads();
        }
        if (!split || !role) {
            pg8::Gemm g{CAT2, W_OC, 1024, 1024, 0, 0}; pg8::DenseOrder S; S.init(ML / 256, 4, split ? G / 2 : G, split ? ridx : (int)blockIdx.x); pg8::EpiStore E{Y2, 1024};
            pg8::gemm_phase<pg8::EpiStore, pg8::DenseOrder, PG8_ALIGN, PG8_SP2>(lds, g, S, E);
        }
        GRID_BAR(); PH_END(14);
    }
    if (IN(15)) {
        PH_BEGIN(15);
        LAS int* lcnt = (LAS int*)lds;
        LAS int* gbase = lcnt + 8;
        LAS int* le = gbase + 8;
        LAS int* lr = le + 256;
        LAS float* lg = (LAS float*)(lr + 256);
        f32x4 wra[4][4], wrb[4][4];
#pragma unroll
        for (int j = 0; j < 4; ++j)
#pragma unroll
            for (int q = 0; q < 4; ++q) { const int k = 4 * lane + 256 * j + q; wra[j][q] = *(const f32x4*)(moe_w_router + (size_t)k * 8); wrb[j][q] = *(const f32x4*)(moe_w_router + (size_t)k * 8 + 4); }
        for (int base = blockIdx.x * 128; base < ML; base += G * 128) {
            __syncthreads();
            if (tid < 8) lcnt[tid] = 0;
            __syncthreads();
            for (int i = 0; i < 16; ++i) {
                const int lrow = wave * 16 + i, row = base + lrow;
                u16* dst = XST + (size_t)row * 1024;
                const int mr = row >> 11;
                f32x4 xv[4], tv[4], hv[4]; ld_row_bf16(dst, lane, xv); ld_row_bf16(Y2 + (size_t)row * 1024, lane, tv);
                rms_apply(tv, g_post_mix + 1024, lane);
                const float* gate = modp(ws, 1, mr, 2);
#pragma unroll
                for (int j = 0; j < 4; ++j) xv[j] = xv[j] + *(const f32x4*)(gate + 4 * lane + 256 * j) * tv[j];
                st_row_bf16(dst, lane, xv);
                premod(xv, hv, g_pre_ffn + 1024, modp(ws, 1, mr, 3), modp(ws, 1, mr, 4), lane);
#pragma unroll
                for (int j = 0; j < 4; ++j) { unsigned t = 0u; t = __builtin_amdgcn_cvt_pk_fp8_f32(pg8::clamp8(hv[j].x), pg8::clamp8(hv[j].y), t, false); t = __builtin_amdgcn_cvt_pk_fp8_f32(pg8::clamp8(hv[j].z), pg8::clamp8(hv[j].w), t, true);
                    *(unsigned*)(HC8 + (size_t)row * 1024 + 4 * lane + 256 * j) = t; }
                f32x4 la = {0.f, 0.f, 0.f, 0.f}, lb = la;
#pragma unroll
                for (int j = 0; j < 4; ++j)
#pragma unroll
                    for (int q = 0; q < 4; ++q) { la += hv[j][q] * wra[j][q]; lb += hv[j][q] * wrb[j][q]; }
                const bool b5 = lane & 32, b4 = lane & 16, b3 = lane & 8;
                f32x4 k4 = b5 ? lb : la, s4 = b5 ? la : lb;
#pragma unroll
                for (int q = 0; q < 4; ++q) { auto rr = __builtin_amdgcn_permlane32_swap(__float_as_uint(s4[q]), __float_as_uint(s4[q]), false, false); k4[q] += __uint_as_float(b5 ? rr[0] : rr[1]); }
                float k2a = b4 ? k4[2] : k4[0], k2b = b4 ? k4[3] : k4[1]; const float s2a = b4 ? k4[0] : k4[2], s2b = b4 ? k4[1] : k4[3];
                { auto ra = __builtin_amdgcn_permlane16_swap(__float_as_uint(s2a), __float_as_uint(s2a), false, false); k2a += __uint_as_float(b4 ? ra[0] : ra[1]);
                  auto rb = __builtin_amdgcn_permlane16_swap(__float_as_uint(s2b), __float_as_uint(s2b), false, false); k2b += __uint_as_float(b4 ? rb[0] : rb[1]); }
                float k1 = b3 ? k2b : k2a; const float s1v = b3 ? k2a : k2b;
                k1 += dpp_mov<0x128>(s1v);
                k1 += dpp_mov<0xB1>(k1); k1 += dpp_mov<0x4E>(k1); k1 += dpp_mov<0x141>(k1);
                float lg8[8];
#pragma unroll
                for (int e = 0; e < 8; ++e) lg8[e] = __int_as_float(__builtin_amdgcn_readlane(__float_as_int(k1), (e & 1) * 8 + ((e >> 1) & 1) * 16 + (e >> 2) * 32));
                if (lane == 0) {
                    int e0 = 0; float v0 = lg8[0];
#pragma unroll
                    for (int e = 1; e < 8; ++e) if (lg8[e] > v0) { v0 = lg8[e]; e0 = e; }
                    int e1 = -1; float v1 = -3.0e38f;
#pragma unroll
                    for (int e = 0; e < 8; ++e) if (e != e0 && lg8[e] > v1) { v1 = lg8[e]; e1 = e; }
                    const float g0 = 1.0f / (1.0f + expf(v1 - v0));
                    le[lrow * 2] = e0; le[lrow * 2 + 1] = e1; lg[lrow * 2] = g0; lg[lrow * 2 + 1] = 1.0f - g0;
                    lr[lrow * 2] = __hip_atomic_fetch_add(&lcnt[e0], 1, __ATOMIC_RELAXED, __HIP_MEMORY_SCOPE_WORKGROUP); lr[lrow * 2 + 1] = __hip_atomic_fetch_add(&lcnt[e1], 1, __ATOMIC_RELAXED, __HIP_MEMORY_SCOPE_WORKGROUP);
                }
            }
            __syncthreads();
            if (tid < 8) gbase[tid] = (int)atomicAdd(ctl + CW_ECNT + 64 * tid, (unsigned)lcnt[tid]);
            __syncthreads();
            if (tid < 256) { const int e = le[tid]; TOKE[(size_t)base * 2 + tid] = e; TOKG[(size_t)base * 2 + tid] = lg[tid]; TOKP[(size_t)base * 2 + tid] = gbase[e] + lr[tid]; }
        }
        GRID_BAR(); PH_END(15);
    }
    if (IN(16)) {
        PH_BEGIN(16);
        LAS int* pst = (LAS int*)lds;
        if (tid == 0) { int acc = 0; for (int e = 0; e < 8; ++e) { pst[e] = acc; const int c = (int)ctl[CW_ECNT + 64 * e]; acc += (c + 255) / 256 * 256; } pst[8] = acc; }
        __syncthreads();
        if (blockIdx.x == 0) {
            if (tid == 0) ctl[CW_MOET] = (unsigned)(pst[8] / 256);
            for (int t = tid; t < pst[8] / 256; t += 512) { int e = 0; for (int q = 1; q < 8; ++q) if (t * 256 >= pst[q]) e = q; ctl[CW_TILEE + t] = (unsigned)e; }
        }
        int s = gw;
        for (; s + 3 * NGW < 2 * ML; s += 4 * NGW) {
            const int p0 = pst[TOKE[s]] + TOKP[s], p1 = pst[TOKE[s + NGW]] + TOKP[s + NGW], p2 = pst[TOKE[s + 2 * NGW]] + TOKP[s + 2 * NGW], p3 = pst[TOKE[s + 3 * NGW]] + TOKP[s + 3 * NGW];
            const uint4 v0 = *(const uint4*)(HC8 + (size_t)(s >> 1) * 1024 + lane * 16), v1 = *(const uint4*)(HC8 + (size_t)((s + NGW) >> 1) * 1024 + lane * 16);
            const uint4 v2 = *(const uint4*)(HC8 + (size_t)((s + 2 * NGW) >> 1) * 1024 + lane * 16), v3 = *(const uint4*)(HC8 + (size_t)((s + 3 * NGW) >> 1) * 1024 + lane * 16);
            *(uint4*)(XS8 + (size_t)p0 * 1024 + lane * 16) = v0; *(uint4*)(XS8 + (size_t)p1 * 1024 + lane * 16) = v1;
            *(uint4*)(XS8 + (size_t)p2 * 1024 + lane * 16) = v2; *(uint4*)(XS8 + (size_t)p3 * 1024 + lane * 16) = v3;
            if (lane == 0) { TOKP[s] = p0; TOKP[s + NGW] = p1; TOKP[s + 2 * NGW] = p2; TOKP[s + 3 * NGW] = p3; }
        }
        for (; s < 2 * ML; s += NGW) {
            const int e = TOKE[s], pos = pst[e] + TOKP[s];
            *(uint4*)(XS8 + (size_t)pos * 1024 + lane * 16) = *(const uint4*)(HC8 + (size_t)(s >> 1) * 1024 + lane * 16);
            if (lane == 0) TOKP[s] = pos;
        }
        GRID_BAR(); PH_END(16);
    }
    if (IN(17)) {
        PH_BEGIN(17);
        const int T = (int)ctl[CW_MOET];
        { pg8::Gemm g{XS8, W_MGU, 1024, 1024, 0x7f7f7f7f, 0x79797979}; pg8::MoeOrder S; S.init(T, 2 * ED / 256, G, (int)blockIdx.x); S.tile_e = ctl + CW_TILEE; S.nper = 2 * ED / 256; S.a_off = 0; S.o_off = 0;
          pg8::EpiSwiglu8 E{HID8, ED};
          pg8::gemm_phase<pg8::EpiSwiglu8, pg8::MoeOrder, PG8_ALIGN, PG8_SP2, 1>(lds, g, S, E); }
        GRID_BAR(); PH_END(17);
    }
    if (IN(18)) {
        PH_BEGIN(18);
        const int T = (int)ctl[CW_MOET];
        { pg8::Gemm g{HID8, W_MD, ED, ED, 0x7c7c7c7c, 0x79797979}; pg8::MoeOrder S; S.init(T, 4, G, (int)blockIdx.x); S.tile_e = ctl + CW_TILEE; S.nper = 4; S.a_off = 0; S.o_off = 0;
          pg8::EpiStore8 E{YS8, 1024, 16.0f};
          pg8::gemm_phase<pg8::EpiStore8, pg8::MoeOrder, PG8_ALIGN, PG8_SP2, 1>(lds, g, S, E); }
        GRID_BAR(); PH_END(18);
    }
    if (IN(19)) {
        PH_BEGIN(19);
        { const int rpw = (ML + NGW - 1) / NGW, rb = gw * rpw, re = (rb + rpw < ML) ? rb + rpw : ML;
          f32x4 gpo[4], gt[4]; ld_vec(g_post_ffn + 1024, lane, gpo); int cur = -1;
          for (int row = rb; row < re; ++row) {
            const int mr = row >> 11;
            if (mr != cur) { ld_vec(modp(ws, 1, mr, 5), lane, gt); cur = mr; }
            const int p0 = TOKP[row * 2], p1 = TOKP[row * 2 + 1]; const float g0 = TOKG[row * 2], g1 = TOKG[row * 2 + 1];
            f32x4 xv[4], a[4], b2[4]; ld_row_bf16(XST + (size_t)row * 1024, lane, xv); ld_row_fp8(YS8 + (size_t)p0 * 1024, lane, a); ld_row_fp8(YS8 + (size_t)p1 * 1024, lane, b2);
#pragma unroll
            for (int j = 0; j < 4; ++j) a[j] = a[j] * g0 + b2[j] * g1;
            const float r = row_rstd(a);
#pragma unroll
            for (int j = 0; j < 4; ++j) xv[j] = xv[j] + gt[j] * (a[j] * r * gpo[j]);
            st_row_f32(out + (size_t)row * 1024, lane, xv);
          } }
        PH_END(19);
    }
#undef IN
#undef GRID_BAR
}

extern "C" void kernel_launch(void* const* d_in, const int* in_sizes, int n_in, void* d_out, int out_size, void* d_ws, size_t ws_size, hipStream_t stream) {
    static int grid = 0;
    if (grid == 0) {
        if (n_in != 35 || in_sizes[0] != ML * D || out_size != ML * D || ws_size < WS_END) {
            fprintf(stderr, "kernel_launch: shape mismatch n_in %d in0 %d out %d ws %zu (need %zu)\n", n_in, n_in > 0 ? in_sizes[0] : -1, out_size, ws_size, (size_t)WS_END); grid = -1; return; }
        int dev = 0, cus = 0, per_cu = 0;
        if (hipGetDevice(&dev) != hipSuccess || hipDeviceGetAttribute(&cus, hipDeviceAttributeMultiprocessorCount, dev) != hipSuccess) { grid = -1; return; }
        if (hipFuncSetAttribute((const void*)fwd_kernel, hipFuncAttributeMaxDynamicSharedMemorySize, LDS_BYTES) != hipSuccess) { fprintf(stderr, "kernel_launch: hipFuncSetAttribute failed\n"); grid = -1; return; }
        if (hipOccupancyMaxActiveBlocksPerMultiprocessor(&per_cu, (const void*)fwd_kernel, 512, LDS_BYTES) != hipSuccess || per_cu < 1)
            fprintf(stderr, "kernel_launch: occupancy query reports %d\n", per_cu);
        (void)hipGetLastError();
        grid = cus;
    }
    if (grid < 0) return;
    if (hipMemsetAsync((char*)d_ws + WS_CTL, 0, CTL_ZERO_BYTES, stream) != hipSuccess) return;
    Args a{};
    for (int i = 0; i < 35; ++i) a.in[i] = (const float*)d_in[i];
    a.out = (float*)d_out; a.ws = (unsigned char*)d_ws; a.ph_lo = 0; a.ph_hi = 100; a.li = 0; a.pad = 0;
    hipLaunchKernelGGL(fwd_kernel, dim3(grid), dim3(512), LDS_BYTES, stream, a);
#ifdef PROBE_PHASES
    { const int pp[] = {PROBE_PHASES}; int li = 1;
      for (int k : pp) { a.ph_lo = k; a.ph_hi = k + 1; a.li = li++; hipLaunchKernelGGL(fwd_kernel, dim3(grid), dim3(512), LDS_BYTES, stream, a); } }
#endif
}
```
